# Optimizing an MI355X kernel written in HIP

```python
import math
import jax, jax.numpy as jnp
from jax import lax
import numpy as np

D_MODEL = 2048
BATCH = 1
SEQ = 16384
DEPTH = 2

D_FF = 5632
NORM_EPS = 1e-6
NEG = -1e30

A_HEADS = 4
A_DQK = 128
A_DV = 256
A_WIDTH = A_HEADS * A_DV
A_CHUNK = 64

B_HEADS = 8
B_Q_LORA = 384
B_KV_LORA = 256
B_NOPE = 128
B_ROPE = 64
B_DV = 128
B_WIDTH = B_HEADS * B_DV
B_QBLOCK = 128
ROPE_BASE = 10000.0

C_WIDTH = 1024
C_BLOCKS = 8
C_BLOCK_DIM = C_WIDTH // C_BLOCKS
C_CONV = 4
C_POW = 8.0

N_BRANCH = 3
BR_WIDTH = 1024

IN_SPLITS = (A_HEADS * A_DQK, A_HEADS * A_DQK, A_WIDTH, A_HEADS, A_HEADS, A_WIDTH,
             B_Q_LORA, B_KV_LORA, B_ROPE,
             C_WIDTH,
             N_BRANCH * D_MODEL)
N_IN = sum(IN_SPLITS)

kernel_name = "hybrid_mlstm_mla_rglru_gated_macaron"


def rmsnorm(x, g):
    xf = x.astype(jnp.float32)
    y = xf * lax.rsqrt(jnp.mean(xf * xf, axis=-1, keepdims=True) + NORM_EPS)
    return (y * g.astype(jnp.float32)).astype(x.dtype)


def swiglu(x, w_gate, w_up, w_down):
    return (jax.nn.silu(x @ w_gate) * (x @ w_up)) @ w_down


def apply_rope(x, cos, sin):
    xf = x.astype(jnp.float32)
    x1, x2 = jnp.split(xf, 2, axis=-1)
    return jnp.concatenate([x1 * cos - x2 * sin, x1 * sin + x2 * cos], axis=-1).astype(x.dtype)


def _to_chunks(t):
    b, s, h = t.shape[:3]
    t = t.reshape((b, s // A_CHUNK, A_CHUNK, h) + t.shape[3:])
    perm = (1, 0, 3, 2) + tuple(range(4, t.ndim))
    return t.transpose(perm)


def mlstm_chunkwise(q, k, v, i_pre, f_pre):
    b, s, h, _ = q.shape
    qf = q.astype(jnp.float32) * (A_DQK ** -0.5)
    kf = k.astype(jnp.float32)
    vf = v.astype(jnp.float32)
    log_i = i_pre.astype(jnp.float32)
    log_f = jax.nn.log_sigmoid(f_pre.astype(jnp.float32))
    xs = (_to_chunks(qf), _to_chunks(kf), _to_chunks(vf), _to_chunks(log_i), _to_chunks(log_f))
    causal = jnp.tril(jnp.ones((A_CHUNK, A_CHUNK), dtype=bool))

    def step(carry, inp):
        c_prev, n_prev, m_prev = carry
        qc, kc, vc, ic, lfc = inp
        bcum = jnp.cumsum(lfc, axis=-1)
        b_tot = bcum[..., -1]
        d_intra = bcum[..., :, None] - bcum[..., None, :] + ic[..., None, :]
        d_intra = jnp.where(causal, d_intra, NEG)
        d_inter = bcum + m_prev[..., None]
        m_t = jnp.maximum(jnp.max(d_intra, axis=-1), d_inter)
        w_intra = jnp.exp(d_intra - m_t[..., None])
        w_inter = jnp.exp(d_inter - m_t)
        sc = jnp.einsum('bhtd,bhsd->bhts', qc, kc) * w_intra
        num = (jnp.einsum('bhts,bhsv->bhtv', sc, vc)
               + w_inter[..., None] * jnp.einsum('bhtd,bhdv->bhtv', qc, c_prev))
        den = jnp.sum(sc, axis=-1) + w_inter * jnp.einsum('bhtd,bhd->bht', qc, n_prev)
        h_out = num / jnp.maximum(jnp.abs(den), jnp.exp(-m_t))[..., None]
        d_state = b_tot[..., None] - bcum + ic
        m_new = jnp.maximum(b_tot + m_prev, jnp.max(d_state, axis=-1))
        w_state = jnp.exp(d_state - m_new[..., None])
        w_prev = jnp.exp(b_tot + m_prev - m_new)
        c_new = w_prev[..., None, None] * c_prev + jnp.einsum('bhs,bhsd,bhsv->bhdv', w_state, kc, vc)
        n_new = w_prev[..., None] * n_prev + jnp.einsum('bhs,bhsd->bhd', w_state, kc)
        return (c_new, n_new, m_new), h_out

    init = (jnp.zeros((b, h, A_DQK, A_DV), jnp.float32),
            jnp.zeros((b, h, A_DQK), jnp.float32),
            jnp.full((b, h), NEG, jnp.float32))
    _, hs = lax.scan(step, init, xs)
    return hs.transpose(1, 0, 3, 2, 4).reshape(b, s, h, A_DV)


def mla_attention(q, k, v):
    b, s, h, dk = q.shape
    nb = s // B_QBLOCK
    scale = (B_NOPE + B_ROPE) ** -0.5
    qb = q.reshape(b, nb, B_QBLOCK, h, dk).transpose(1, 0, 2, 3, 4)
    kpos = jnp.arange(s)

    def block(args):
        qblk, start = args
        sc = jnp.einsum('bqhd,bkhd->bhqk', qblk, k).astype(jnp.float32) * scale
        qpos = start + jnp.arange(B_QBLOCK)
        sc = jnp.where(kpos[None, :] <= qpos[:, None], sc, NEG)
        p = jax.nn.softmax(sc, axis=-1)
        return jnp.einsum('bhqk,bkhd->bqhd', p.astype(v.dtype), v)

    out = lax.map(block, (qb, jnp.arange(nb) * B_QBLOCK))
    return out.transpose(1, 0, 2, 3, 4).reshape(b, s, h * B_DV)


def causal_depthwise_conv(x, w, bias):
    y = lax.conv_general_dilated(x, w[:, None, :].astype(x.dtype), window_strides=(1,),
                                 padding=[(C_CONV - 1, 0)],
                                 dimension_numbers=('NWC', 'WIO', 'NWC'),
                                 feature_group_count=x.shape[-1])
    return y + bias


def rg_lru(x, w_a, b_a, w_x, b_x, lam):
    b, s, c = x.shape
    xb = x.reshape(b, s, C_BLOCKS, C_BLOCK_DIM)
    r = jax.nn.sigmoid(jnp.einsum('bsnd,nde->bsne', xb, w_a).reshape(b, s, c) + b_a).astype(jnp.float32)
    gi = jax.nn.sigmoid(jnp.einsum('bsnd,nde->bsne', xb, w_x).reshape(b, s, c) + b_x).astype(jnp.float32)
    log_a = -C_POW * r * jax.nn.softplus(-lam.astype(jnp.float32))
    a = jnp.exp(log_a)
    u = jnp.sqrt(-jnp.expm1(2.0 * log_a)) * (gi * x.astype(jnp.float32))

    def combine(left, right):
        a1, b1 = left
        a2, b2 = right
        return a1 * a2, a2 * b1 + b2

    _, h = lax.associative_scan(combine, (a, u), axis=1)
    return h.astype(x.dtype)


def hybrid_layer(x, cos, sin, ffn1_norm, ffn1_w_gate, ffn1_w_up, ffn1_w_down, mix_norm, w_in,
                 mlstm_gate_bias, mlstm_out_norm, mla_q_norm, mla_w_uq, mla_kv_norm, mla_w_ukv,
                 lru_conv_w, lru_conv_b, lru_w_a, lru_b_a, lru_w_x, lru_b_x, lru_lambda,
                 w_branch, w_out, ffn2_norm, ffn2_w_gate, ffn2_w_up, ffn2_w_down):
    b, s, _ = x.shape
    x = x + 0.5 * swiglu(rmsnorm(x, ffn1_norm), ffn1_w_gate, ffn1_w_up, ffn1_w_down)

    u = rmsnorm(x, mix_norm)
    proj = u @ w_in
    offsets = np.cumsum(IN_SPLITS)[:-1].tolist()
    (a_q, a_k, a_v, a_i, a_f, a_o, b_cq, b_ckv, b_kr, c_x, gates) = jnp.split(proj, offsets, axis=-1)

    h_a = mlstm_chunkwise(a_q.reshape(b, s, A_HEADS, A_DQK), a_k.reshape(b, s, A_HEADS, A_DQK),
                          a_v.reshape(b, s, A_HEADS, A_DV),
                          a_i + mlstm_gate_bias[:A_HEADS], a_f + mlstm_gate_bias[A_HEADS:])
    h_a = rmsnorm(h_a, mlstm_out_norm.reshape(A_HEADS, A_DV)).reshape(b, s, A_WIDTH)
    y_a = (jax.nn.sigmoid(a_o.astype(jnp.float32)) * h_a).astype(x.dtype)

    q = (rmsnorm(b_cq, mla_q_norm) @ mla_w_uq).reshape(b, s, B_HEADS, B_NOPE + B_ROPE)
    q_nope, q_rope = jnp.split(q, [B_NOPE], axis=-1)
    q_rope = apply_rope(q_rope, cos[None, :, None, :], sin[None, :, None, :])
    kv = (rmsnorm(b_ckv, mla_kv_norm) @ mla_w_ukv).reshape(b, s, B_HEADS, B_NOPE + B_DV)
    k_nope, v_b = jnp.split(kv, [B_NOPE], axis=-1)
    k_rope = apply_rope(b_kr, cos[None], sin[None])
    k_b = jnp.concatenate([k_nope, jnp.broadcast_to(k_rope[:, :, None, :], (b, s, B_HEADS, B_ROPE))], axis=-1)
    q_b = jnp.concatenate([q_nope, q_rope], axis=-1)
    y_b = mla_attention(q_b, k_b, v_b)

    xc = causal_depthwise_conv(c_x, lru_conv_w, lru_conv_b)
    y_c = rg_lru(xc, lru_w_a, lru_b_a, lru_w_x, lru_b_x, lru_lambda)

    branches = jnp.stack([y_a, y_b, y_c], axis=2)
    proj_b = jnp.einsum('bsjc,jcd->bsjd', branches, w_branch)
    g = jax.nn.sigmoid(gates.reshape(b, s, N_BRANCH, D_MODEL))
    z = jnp.sum(g * proj_b, axis=2)
    x = x + z @ w_out

    x = x + 0.5 * swiglu(rmsnorm(x, ffn2_norm), ffn2_w_gate, ffn2_w_up, ffn2_w_down)
    return x


def setup_inputs(seed: int = 0) -> dict:
    key = jax.random.key(seed)
    ks = jax.random.split(key, 32)
    f32 = jnp.float32
    L = DEPTH

    def nrm(k, shape, fan_in):
        return jax.random.normal(k, shape, f32) * (fan_in ** -0.5)

    def gain(k, shape):
        return 1.0 + 0.01 * jax.random.normal(k, shape, f32)

    f_bias = jnp.linspace(3.0, 6.0, A_HEADS, dtype=f32)[None, :] + 0.01 * jax.random.normal(ks[7], (L, A_HEADS), f32)
    i_bias = 0.1 * jax.random.normal(ks[8], (L, A_HEADS), f32)
    a8 = jax.random.uniform(ks[20], (L, C_WIDTH), f32, 0.9, 0.999)
    a_base = a8 ** (1.0 / C_POW)
    lam = jnp.log(a_base) - jnp.log1p(-a_base)
    return {
        "x": jax.random.normal(ks[0], (BATCH, SEQ, D_MODEL), f32),
        "ffn1_norm": gain(ks[1], (L, D_MODEL)),
        "ffn1_w_gate": nrm(ks[2], (L, D_MODEL, D_FF), D_MODEL),
        "ffn1_w_up": nrm(ks[3], (L, D_MODEL, D_FF), D_MODEL),
        "ffn1_w_down": nrm(ks[4], (L, D_FF, D_MODEL), D_FF),
        "mix_norm": gain(ks[5], (L, D_MODEL)),
        "w_in": nrm(ks[6], (L, D_MODEL, N_IN), D_MODEL),
        "mlstm_gate_bias": jnp.concatenate([i_bias, f_bias], axis=-1),
        "mlstm_out_norm": gain(ks[9], (L, A_WIDTH)),
        "mla_q_norm": gain(ks[10], (L, B_Q_LORA)),
        "mla_w_uq": nrm(ks[11], (L, B_Q_LORA, B_HEADS * (B_NOPE + B_ROPE)), B_Q_LORA),
        "mla_kv_norm": gain(ks[12], (L, B_KV_LORA)),
        "mla_w_ukv": nrm(ks[13], (L, B_KV_LORA, B_HEADS * (B_NOPE + B_DV)), B_KV_LORA),
        "lru_conv_w": nrm(ks[14], (L, C_CONV, C_WIDTH), C_CONV),
        "lru_conv_b": 0.01 * jax.random.normal(ks[15], (L, C_WIDTH), f32),
        "lru_w_a": nrm(ks[16], (L, C_BLOCKS, C_BLOCK_DIM, C_BLOCK_DIM), C_BLOCK_DIM),
        "lru_b_a": 0.01 * jax.random.normal(ks[17], (L, C_WIDTH), f32),
        "lru_w_x": nrm(ks[18], (L, C_BLOCKS, C_BLOCK_DIM, C_BLOCK_DIM), C_BLOCK_DIM),
        "lru_b_x": 0.01 * jax.random.normal(ks[19], (L, C_WIDTH), f32),
        "lru_lambda": lam,
        "w_branch": nrm(ks[21], (L, N_BRANCH, BR_WIDTH, D_MODEL), BR_WIDTH),
        "w_out": nrm(ks[22], (L, D_MODEL, D_MODEL), D_MODEL),
        "ffn2_norm": gain(ks[23], (L, D_MODEL)),
        "ffn2_w_gate": nrm(ks[24], (L, D_MODEL, D_FF), D_MODEL),
        "ffn2_w_up": nrm(ks[25], (L, D_MODEL, D_FF), D_MODEL),
        "ffn2_w_down": nrm(ks[26], (L, D_FF, D_MODEL), D_FF),
        "final_norm": gain(ks[27], (D_MODEL,)),
    }


def reference(x, ffn1_norm, ffn1_w_gate, ffn1_w_up, ffn1_w_down, mix_norm, w_in,
              mlstm_gate_bias, mlstm_out_norm, mla_q_norm, mla_w_uq, mla_kv_norm, mla_w_ukv,
              lru_conv_w, lru_conv_b, lru_w_a, lru_b_a, lru_w_x, lru_b_x, lru_lambda,
              w_branch, w_out, ffn2_norm, ffn2_w_gate, ffn2_w_up, ffn2_w_down, final_norm):
    s = x.shape[1]
    pos = jnp.arange(s, dtype=jnp.float32)
    inv_freq = jnp.power(ROPE_BASE, -jnp.arange(0, B_ROPE, 2, dtype=jnp.float32) / B_ROPE)
    ang = pos[:, None] * inv_freq[None, :]
    cos, sin = jnp.cos(ang), jnp.sin(ang)
    for l in range(DEPTH):
        x = hybrid_layer(x, cos, sin, ffn1_norm[l], ffn1_w_gate[l], ffn1_w_up[l], ffn1_w_down[l],
                         mix_norm[l], w_in[l], mlstm_gate_bias[l], mlstm_out_norm[l],
                         mla_q_norm[l], mla_w_uq[l], mla_kv_norm[l], mla_w_ukv[l],
                         lru_conv_w[l], lru_conv_b[l], lru_w_a[l], lru_b_a[l], lru_w_x[l], lru_b_x[l],
                         lru_lambda[l], w_branch[l], w_out[l],
                         ffn2_norm[l], ffn2_w_gate[l], ffn2_w_up[l], ffn2_w_down[l])
    return rmsnorm(x, final_norm)
```

```cpp
#include <hip/hip_runtime.h>
#include <hip/hip_cooperative_groups.h>
#include <cstdio>
#include <cstdint>
namespace cg = cooperative_groups;

#define DI __device__ __forceinline__
#define LAS __attribute__((address_space(3)))
typedef unsigned short bf16_t;
typedef short bf16x8 __attribute__((ext_vector_type(8)));
typedef short s16x4 __attribute__((ext_vector_type(4)));
typedef float f32x2 __attribute__((ext_vector_type(2)));
typedef float f32x4 __attribute__((ext_vector_type(4)));
typedef float f32x16 __attribute__((ext_vector_type(16)));
typedef unsigned u32x2 __attribute__((ext_vector_type(2)));
typedef unsigned u32x4 __attribute__((ext_vector_type(4)));
typedef __bf16 bf16x2_t __attribute__((ext_vector_type(2)));

constexpr int S = 16384, DM = 2048, FF = 5632, NIN = 10952, NP = 11008;
constexpr float EPS = 1e-6f;
constexpr int PC_Q = 0, PC_K = 512, PC_V = 1024, PC_O = 2048, PC_CQ = 3072, PC_CKV = 3456, PC_KR = 3712, PC_CX = 3776, PC_G = 4800, PC_I = 10944, PC_F = 10948;
constexpr float MQS = 0.08838834764831845f;
constexpr float AQS = 0.07216878364870322f * 1.4426950408889634f;

constexpr size_t MiB = 1u << 20;
constexpr size_t WS_TAB = 0;
constexpr size_t WS_SMALL = 4 * MiB;
constexpr size_t WS_WFFGU = 12 * MiB;
constexpr size_t WS_WFFD = 56 * MiB;
constexpr size_t WS_WIN = 78 * MiB;
constexpr size_t WS_WUQ = 121 * MiB;
constexpr size_t WS_WUKV = 123 * MiB;
constexpr size_t WS_WLRU = 124 * MiB;
constexpr size_t WS_WBR = 125 * MiB;
constexpr size_t WS_WOUT = 137 * MiB;
constexpr size_t WS_XN = 145 * MiB;
constexpr size_t WS_P = 209 * MiB;
constexpr size_t WS_Q = 553 * MiB;
constexpr size_t WS_KN = 601 * MiB;
constexpr size_t WS_VT = 633 * MiB;
constexpr size_t WS_Y = 665 * MiB;
constexpr size_t WS_XC = 761 * MiB;
constexpr size_t WS_CS = 793 * MiB;
constexpr size_t WS_END = 857 * MiB;
constexpr int SM_BT = 0, SM_MC = 1024, SM_MPREV = 2048, SM_DN = 4096  , SM_CA = 4096 + 131072  , SM_CH = SM_CA + 262144, SM_CARRY = SM_CH + 262144, SM_SP = SM_CARRY + 262144;

__device__ const float INVF[32] = {1.0f, 0.7498942613601685f, 0.5623413324356079f, 0.4216965138912201f, 0.3162277638912201f, 0.23713737726211548f, 0.17782793939113617f, 0.133352130651474f, 0.10000000149011612f, 0.07498941570520401f, 0.05623413249850273f, 0.04216965287923813f, 0.03162277489900589f, 0.023713737726211548f, 0.017782794311642647f, 0.01333521492779255f, 0.009999999776482582f, 0.007498941849917173f, 0.005623413249850273f, 0.0042169648222625256f, 0.003162277629598975f, 0.00237137358635664f, 0.0017782794311642647f, 0.0013335214462131262f, 0.0010000000474974513f, 0.0007498942431993783f, 0.000562341301701963f, 0.0004216965171508491f, 0.0003162277571391314f, 0.00023713737027719617f, 0.00017782794020604342f, 0.0001333521504420787f};

DI int opaque_tid() { int t = threadIdx.x; asm volatile("" : "+v"(t)); return t; }
DI float bf2f(bf16_t v) { return __uint_as_float((unsigned)v << 16); }
DI float bflo(unsigned w) { return __uint_as_float(w << 16); }
DI float bfhi(unsigned w) { return __uint_as_float(w & 0xffff0000u); }
DI unsigned pk2(float lo, float hi) { f32x2 v = {lo, hi}; bf16x2_t b = __builtin_convertvector(v, bf16x2_t); return __builtin_bit_cast(unsigned, b); }
DI bf16_t f2bf(float f) { return (bf16_t)(pk2(f, 0.f) & 0xffffu); }
DI float wave_sum(float v) {
#pragma unroll
    for (int o = 1; o < 64; o <<= 1) v += __shfl_xor(v, o);
    return v;
}
DI float wave_max(float v) {
#pragma unroll
    for (int o = 1; o < 64; o <<= 1) v = fmaxf(v, __shfl_xor(v, o));
    return v;
}
DI float wave_incl_scan(float v, int lane) {
#pragma unroll
    for (int o = 1; o < 64; o <<= 1) { const float n = __shfl_up(v, o); if (lane >= o) v += n; }
    return v;
}
DI float sigmoidf_(float x) { return 1.f / (1.f + __expf(-x)); }
DI float logsigmoid_(float x) { return fminf(x, 0.f) - log1pf(expf(-fabsf(x))); }
DI f32x16 mfma32(bf16x8 a, bf16x8 b, f32x16 c) { return __builtin_amdgcn_mfma_f32_32x32x16_bf16(a, b, c, 0, 0, 0); }
DI int crow(int r, int h) { return (r & 3) + 8 * (r >> 2) + 4 * h; }
DI int pi32(int m) { return (m & ~12) | ((m & 4) << 1) | ((m & 8) >> 1); }
typedef short v4i16_t __attribute__((ext_vector_type(4)));
DI s16x4 tr16(LAS const unsigned char* p) { return __builtin_bit_cast(s16x4, __builtin_amdgcn_ds_read_tr16_b64_v4i16((LAS v4i16_t*)p)); }
DI bf16x8 tr_frag(LAS const unsigned char* p, int rs) {
    const s16x4 lo = tr16(p), hi = tr16(p + 4 * rs);
    return __builtin_shufflevector(lo, hi, 0, 1, 2, 3, 4, 5, 6, 7);
}
DI bf16x8 pack8(float a0, float a1, float a2, float a3, float a4, float a5, float a6, float a7) {
    u32x4 w; w.x = pk2(a0, a1); w.y = pk2(a2, a3); w.z = pk2(a4, a5); w.w = pk2(a6, a7); return __builtin_bit_cast(bf16x8, w);
}

namespace pg8 {
constexpr int BM = 256, BK = 64, HALF = 128, HTB = HALF * BK * 2, STAGE_BYTES = 8 * HTB, NXCD = 8, WGM = 8;
DI int lds_byte(int r, int c) { const int st = (r >> 4) * 2 + (c >> 5), rr = r & 15, cc = c & 31, ob = rr * 64 + cc * 2; return st * 1024 + (ob ^ (((ob >> 9) & 1) << 5)); }
DI void stage_rc(int b, int& R, int& C) { const int st = b / 1024, sb = b % 1024, swz = sb ^ (((sb >> 9) & 1) << 5); R = (st >> 1) * 16 + swz / 64; C = (st & 1) * 32 + (swz % 64) / 2; }
DI int perm32(int rho) { const int n = rho >> 4, i = rho & 15; return 8 * (i >> 2) + 4 * n + (i & 3); }
struct Unit { int pm, pn; };
struct Gemm { const bf16_t* A; const bf16_t* Bt; int M, N, K, lda, ldb, apn; };
struct StaticOrder {
    int nM, nN, nwg, G, c;
    DI void init(int M, int N, int G_, int c_) { nM = M / BM; nN = N / BM; nwg = nM * nN; G = G_; c = c_; }
    DI bool next(int i, Unit& u) const {
        const long L = (long)i * G + c; if (L >= nwg) return false;
        int wgid = (int)L; { const int q = nwg / NXCD, r = nwg % NXCD, xcd = wgid % NXCD, off = wgid / NXCD; wgid = (xcd < r ? xcd * (q + 1) : r * (q + 1) + (xcd - r) * q) + off; }
        const int nig = WGM * nN, gid = wgid / nig, fm = gid * WGM, gsz = (nM - fm) < WGM ? (nM - fm) : WGM;
        u.pm = fm + ((wgid % nig) % gsz); u.pn = (wgid % nig) / gsz; return true;
    }
};
template <class Epi>
DI void gemm_phase(LAS unsigned char* lds, const Gemm g, const StaticOrder& S, const Epi& E) {
    const int tid = opaque_tid(), wid = __builtin_amdgcn_readfirstlane(tid >> 6), lane = tid & 63, wr = wid >> 2, wc = wid & 3, fr = lane & 15, fq = lane >> 4;
    int K = g.K; asm volatile("" : "+s"(K)); const int nt = K / BK;
    unsigned voffA[2], voffB[2];
#pragma unroll
    for (int i = 0; i < 2; ++i) { int R, C; stage_rc(tid * 16 + i * 8192, R, C); const int Rb = Epi::PERM ? ((R & ~31) + perm32(R & 31)) : R;
        voffA[i] = (unsigned)(R * g.lda + C) * 2u; voffB[i] = (unsigned)(Rb * g.ldb + C) * 2u; }
    const size_t kstep = (size_t)(BK * 2);
    const size_t hstepA = (size_t)HALF * g.lda * 2, hstepB = (size_t)HALF * g.ldb * 2;
    const unsigned ldsw = (unsigned)wid * 1024u;
    const int aoff = lds_byte(wr * 64 + fr, fq * 8), boff = lds_byte(wc * 32 + fr, fq * 8);
#define PG8_SA(b, h) (((b) * 2 + (h)) * HTB)
#define PG8_SB(b, h) ((4 + (b) * 2 + (h)) * HTB)
#define PG8_STAGE(bufoff, gbase, voff) do { _Pragma("unroll") for (int _i = 0; _i < 2; ++_i) \
        __builtin_amdgcn_global_load_lds((const unsigned*)((const char*)(gbase) + (voff)[_i]), (LAS unsigned*)(lds + (bufoff) + ldsw + _i * 8192), 16, 0, 0); } while (0)
#define PG8_LDA(dst, b, h) do { _Pragma("unroll") for (int m = 0; m < 4; ++m) _Pragma("unroll") for (int k = 0; k < 2; ++k) dst[m][k] = *(const LAS bf16x8*)(lds + PG8_SA(b, h) + aoff + m * 2048 + k * 1024); } while (0)
#define PG8_LDB(dst, b, h) do { _Pragma("unroll") for (int n = 0; n < 2; ++n) _Pragma("unroll") for (int k = 0; k < 2; ++k) dst[n][k] = *(const LAS bf16x8*)(lds + PG8_SB(b, h) + boff + n * 2048 + k * 1024); } while (0)
#define PG8_MMA(ai, bj, At, Bt) do { __builtin_amdgcn_s_setprio(1); _Pragma("unroll") for (int m = 0; m < 4; ++m) _Pragma("unroll") for (int n = 0; n < 2; ++n) _Pragma("unroll") for (int k = 0; k < 2; ++k) \
        acc[ai][bj][m][n] = __builtin_amdgcn_mfma_f32_16x16x32_bf16(Bt[n][k], At[m][k], acc[ai][bj][m][n], 0, 0, 0); __builtin_amdgcn_s_setprio(0); } while (0)
#define PG8_WAIT_V(n) asm volatile("s_waitcnt vmcnt(" #n ")" ::: "memory")
#define PG8_WAIT_L(n) asm volatile("s_waitcnt lgkmcnt(" #n ")" ::: "memory")
#define PG8_BAR __builtin_amdgcn_s_barrier()
#define PG8_SCHED __builtin_amdgcn_sched_barrier(0)
#define PG8_APTR(u) ((const char*)g.A + (size_t)(u).pm * 2 * hstepA + (size_t)(u).pn * (size_t)g.apn * 2)
#define PG8_BPTR(u) ((const char*)g.Bt + (size_t)(u).pn * 2 * hstepB)
    Unit cur, nxt; int ui = 0;
    if (!S.next(0, cur)) return;
    f32x4 acc[2][2][4][2];
#pragma unroll
    for (int a = 0; a < 2; ++a)
#pragma unroll
        for (int b = 0; b < 2; ++b)
#pragma unroll
            for (int m = 0; m < 4; ++m)
#pragma unroll
                for (int n = 0; n < 2; ++n) acc[a][b][m][n] = (f32x4){0.f, 0.f, 0.f, 0.f};
    bf16x8 At[4][2], B0[2][2], B1[2][2];
    const char* cA = PG8_APTR(cur); const char* cB = PG8_BPTR(cur);
    PG8_STAGE(PG8_SB(0, 0), cB, voffB); PG8_STAGE(PG8_SB(0, 1), cB + hstepB, voffB); PG8_STAGE(PG8_SA(0, 0), cA, voffA); PG8_STAGE(PG8_SA(0, 1), cA + hstepA, voffA);
    if (wr == 1) PG8_BAR;
    PG8_WAIT_V(2); PG8_BAR;
    PG8_STAGE(PG8_SB(1, 0), cB + kstep, voffB); PG8_STAGE(PG8_SA(1, 0), cA + kstep, voffA); PG8_STAGE(PG8_SB(1, 1), cB + hstepB + kstep, voffB);
    PG8_WAIT_V(6); PG8_BAR;
    for (;;) {
        const bool has_next = S.next(ui + 1, nxt);
        const char* nA = has_next ? PG8_APTR(nxt) : cA; const char* nB = has_next ? PG8_BPTR(nxt) : cB;
        for (int t = 0; t < nt; t += 2) {
            const bool last = (t == nt - 2);
            const char* a1 = cA + (size_t)(t + 1) * kstep;
            const char* a2 = last ? nA : cA + (size_t)(t + 2) * kstep; const char* b2 = last ? nB : cB + (size_t)(t + 2) * kstep;
            const char* a3 = a2 + kstep; const char* b3 = b2 + kstep;
            PG8_LDB(B0, 0, 0); PG8_LDB(B1, 0, 1); PG8_SCHED; PG8_LDA(At, 0, 0); PG8_STAGE(PG8_SA(1, 1), a1 + hstepA, voffA);
            PG8_WAIT_V(8); PG8_WAIT_L(0); PG8_BAR; PG8_MMA(0, 0, At, B0); PG8_MMA(0, 1, At, B1); PG8_BAR; PG8_SCHED;
            PG8_LDA(At, 0, 1); PG8_STAGE(PG8_SB(0, 0), b2, voffB); PG8_STAGE(PG8_SB(0, 1), b2 + hstepB, voffB); PG8_STAGE(PG8_SA(0, 0), a2, voffA);
            PG8_WAIT_V(8); PG8_WAIT_L(0); PG8_BAR; PG8_MMA(1, 0, At, B0); PG8_MMA(1, 1, At, B1); PG8_BAR; PG8_SCHED;
            PG8_LDB(B0, 1, 0); PG8_LDB(B1, 1, 1); PG8_SCHED; PG8_LDA(At, 1, 0); PG8_STAGE(PG8_SA(0, 1), a2 + hstepA, voffA);
            PG8_WAIT_V(8); PG8_WAIT_L(0); PG8_BAR; PG8_MMA(0, 0, At, B0); PG8_MMA(0, 1, At, B1); PG8_BAR; PG8_SCHED;
            PG8_LDA(At, 1, 1); PG8_STAGE(PG8_SB(1, 0), b3, voffB); PG8_STAGE(PG8_SB(1, 1), b3 + hstepB, voffB); PG8_STAGE(PG8_SA(1, 0), a3, voffA);
            PG8_WAIT_V(8); PG8_WAIT_L(0); PG8_BAR; PG8_MMA(1, 0, At, B0); PG8_MMA(1, 1, At, B1); PG8_BAR; PG8_SCHED;
        }
        if (wr == 0) PG8_BAR;
        E(acc, cur, wr, wc, fr, fq);
        if (!has_next) break;
#pragma unroll
        for (int a = 0; a < 2; ++a)
#pragma unroll
            for (int b = 0; b < 2; ++b)
#pragma unroll
                for (int m = 0; m < 4; ++m)
#pragma unroll
                    for (int n = 0; n < 2; ++n) acc[a][b][m][n] = (f32x4){0.f, 0.f, 0.f, 0.f};
        cur = nxt; cA = nA; cB = nB; ++ui;
        if (wr == 1) PG8_BAR;
    }
    PG8_WAIT_V(0);
    PG8_BAR;
#undef PG8_SA
#undef PG8_SB
#undef PG8_STAGE
#undef PG8_LDA
#undef PG8_LDB
#undef PG8_MMA
#undef PG8_WAIT_V
#undef PG8_WAIT_L
#undef PG8_BAR
#undef PG8_SCHED
#undef PG8_APTR
#undef PG8_BPTR
}

typedef f32x4 Acc[2][2][4][2];
struct EpiStore {
    static constexpr bool PERM = true;
    bf16_t* O; int ldc;
    DI void operator()(const Acc& acc, const Unit& u, int wr, int wc, int fr, int fq) const {
        const int row0 = u.pm * BM + wr * 64 + fr, col0 = u.pn * BM + wc * 32 + 8 * fq;
#pragma unroll
        for (int ai = 0; ai < 2; ++ai)
#pragma unroll
            for (int m = 0; m < 4; ++m) { bf16_t* rowp = O + (size_t)(row0 + ai * HALF + m * 16) * ldc + col0;
#pragma unroll
                for (int bj = 0; bj < 2; ++bj) { const f32x4 v0 = acc[ai][bj][m][0], v1 = acc[ai][bj][m][1];
                    u32x4 w; w.x = pk2(v0[0], v0[1]); w.y = pk2(v0[2], v0[3]); w.z = pk2(v1[0], v1[1]); w.w = pk2(v1[2], v1[3]);
                    *(u32x4*)(rowp + bj * HALF) = w; } }
    }
};
struct EpiSwiglu {
    static constexpr bool PERM = true;
    bf16_t* H;
    DI void operator()(const Acc& acc, const Unit& u, int wr, int wc, int fr, int fq) const {
        const int row0 = u.pm * BM + wr * 64 + fr, col0 = u.pn * HALF + wc * 32 + 8 * fq;
#pragma unroll
        for (int ai = 0; ai < 2; ++ai)
#pragma unroll
            for (int m = 0; m < 4; ++m) { bf16_t* rowp = H + (size_t)(row0 + ai * HALF + m * 16) * FF + col0;
                float o[8];
#pragma unroll
                for (int n = 0; n < 2; ++n)
#pragma unroll
                    for (int j = 0; j < 4; ++j) { const float gt = acc[ai][0][m][n][j], up = acc[ai][1][m][n][j]; o[n * 4 + j] = gt * sigmoidf_(gt) * up; }
                u32x4 w; w.x = pk2(o[0], o[1]); w.y = pk2(o[2], o[3]); w.z = pk2(o[4], o[5]); w.w = pk2(o[6], o[7]);
                *(u32x4*)rowp = w; }
    }
};
struct EpiRes {
    static constexpr bool PERM = false;
    const float* xin; float* xout; float alpha;
    DI void operator()(const Acc& acc, const Unit& u, int wr, int wc, int fr, int fq) const {
        const int col0 = u.pn * BM + wc * 32 + 4 * fq;
#pragma unroll
        for (int ai = 0; ai < 2; ++ai)
#pragma unroll
            for (int m = 0; m < 4; ++m) { const size_t off = (size_t)(u.pm * BM + ai * HALF + wr * 64 + m * 16 + fr) * DM + col0;
#pragma unroll
                for (int bj = 0; bj < 2; ++bj)
#pragma unroll
                    for (int n = 0; n < 2; ++n) { const f32x4 b = *(const f32x4*)(xin + off + bj * HALF + n * 16); *(f32x4*)(xout + off + bj * HALF + n * 16) = b + acc[ai][bj][m][n] * alpha; } }
    }
};
struct EpiQ {
    static constexpr bool PERM = true;
    bf16_t* Q; const f32x2* tab;
    DI void operator()(const Acc& acc, const Unit& u, int wr, int wc, int fr, int fq) const {
        const int row0 = u.pm * BM + wr * 64 + fr;
#pragma unroll
        for (int bj = 0; bj < 2; ++bj) {
            const int c0 = u.pn * BM + bj * HALF + wc * 32 + 8 * fq; const int hh = c0 / 192, dd = c0 - hh * 192; const bool rope = dd >= 128; const int j0 = (dd - 128) >> 1;
#pragma unroll
            for (int ai = 0; ai < 2; ++ai)
#pragma unroll
                for (int m = 0; m < 4; ++m) { const int row = row0 + ai * HALF + m * 16;
                    float v[8];
#pragma unroll
                    for (int n = 0; n < 2; ++n)
#pragma unroll
                        for (int j = 0; j < 4; ++j) v[n * 4 + j] = acc[ai][bj][m][n][j];
                    if (rope) {
#pragma unroll
                        for (int p = 0; p < 4; ++p) { const f32x2 cs = tab[(size_t)row * 32 + j0 + p]; const float x1 = v[2 * p], x2 = v[2 * p + 1]; v[2 * p] = x1 * cs.x - x2 * cs.y; v[2 * p + 1] = x1 * cs.y + x2 * cs.x; }
                    }
                    u32x4 w; w.x = pk2(v[0] * AQS, v[1] * AQS); w.y = pk2(v[2] * AQS, v[3] * AQS); w.z = pk2(v[4] * AQS, v[5] * AQS); w.w = pk2(v[6] * AQS, v[7] * AQS);
                    *(u32x4*)(Q + (size_t)row * 1536 + c0) = w; }
        }
    }
};
struct EpiLru {
    static constexpr bool PERM = true;
    bf16_t* XC; bf16_t* LA; const float* ba; const float* bx; const float* sp;
    DI void operator()(const Acc& acc, const Unit& u, int wr, int wc, int fr, int fq) const {
        const int row0 = u.pm * BM + wr * 64 + fr, ch0 = u.pn * HALF + wc * 32 + 8 * fq;
#pragma unroll
        for (int ai = 0; ai < 2; ++ai)
#pragma unroll
            for (int m = 0; m < 4; ++m) { const int row = row0 + ai * HALF + m * 16;
                const u32x4 xw = *(const u32x4*)(XC + (size_t)row * 1024 + ch0);
                const float xv[8] = {bflo(xw.x), bfhi(xw.x), bflo(xw.y), bfhi(xw.y), bflo(xw.z), bfhi(xw.z), bflo(xw.w), bfhi(xw.w)};
                u32x4 wl, wu;
#pragma unroll
                for (int n = 0; n < 2; ++n) { const f32x4 spv = *(const f32x4*)(sp + ch0 + 4 * n), bav = *(const f32x4*)(ba + ch0 + 4 * n), bxv = *(const f32x4*)(bx + ch0 + 4 * n);
                    float la[4], uu[4];
#pragma unroll
                    for (int j = 0; j < 4; ++j) { const float r = sigmoidf_(acc[ai][0][m][n][j] + bav[j]), gi = sigmoidf_(acc[ai][1][m][n][j] + bxv[j]);
                        const float l = r * spv[j]; la[j] = l; const float a2 = __expf(2.f * l); uu[j] = sqrtf(fmaxf(1.f - a2, 0.f)) * gi * xv[n * 4 + j]; }
                    if (n == 0) { wl.x = pk2(la[0], la[1]); wl.y = pk2(la[2], la[3]); wu.x = pk2(uu[0], uu[1]); wu.y = pk2(uu[2], uu[3]); }
                    else { wl.z = pk2(la[0], la[1]); wl.w = pk2(la[2], la[3]); wu.z = pk2(uu[0], uu[1]); wu.w = pk2(uu[2], uu[3]); } }
                *(u32x4*)(LA + (size_t)row * NP + ch0) = wl;
                *(u32x4*)(XC + (size_t)row * 1024 + ch0) = wu;
                asm volatile("" ::: "memory"); }
    }
};
struct EpiMerge {
    static constexpr bool PERM = true;
    bf16_t* Z; const bf16_t* G; int first;
    DI void operator()(const Acc& acc, const Unit& u, int wr, int wc, int fr, int fq) const {
        const int row0 = u.pm * BM + wr * 64 + fr, col0 = u.pn * BM + wc * 32 + 8 * fq;
#pragma unroll
        for (int ai = 0; ai < 2; ++ai)
#pragma unroll
            for (int m = 0; m < 4; ++m) { const int row = row0 + ai * HALF + m * 16;
#pragma unroll
                for (int bj = 0; bj < 2; ++bj) { const int c = col0 + bj * HALF;
                    const u32x4 gw = *(const u32x4*)(G + (size_t)row * NP + c);
                    const float gv[8] = {bflo(gw.x), bfhi(gw.x), bflo(gw.y), bfhi(gw.y), bflo(gw.z), bfhi(gw.z), bflo(gw.w), bfhi(gw.w)};
                    float o[8];
#pragma unroll
                    for (int n = 0; n < 2; ++n)
#pragma unroll
                        for (int j = 0; j < 4; ++j) o[n * 4 + j] = sigmoidf_(gv[n * 4 + j]) * acc[ai][bj][m][n][j];
                    bf16_t* zp = Z + (size_t)row * DM + c;
                    if (!first) { const u32x4 zw = *(const u32x4*)zp; o[0] += bflo(zw.x); o[1] += bfhi(zw.x); o[2] += bflo(zw.y); o[3] += bfhi(zw.y); o[4] += bflo(zw.z); o[5] += bfhi(zw.z); o[6] += bflo(zw.w); o[7] += bfhi(zw.w); }
                    u32x4 w; w.x = pk2(o[0], o[1]); w.y = pk2(o[2], o[3]); w.z = pk2(o[4], o[5]); w.w = pk2(o[6], o[7]);
                    *(u32x4*)zp = w; } }
    }
};
}

DI int map_row(int map, int n) {
    switch (map) {
        case 1: return ((n >> 7) << 8) + (n & 127);
        case 2: return ((n >> 7) << 8) + 128 + (n & 127);
        case 3: { if (n < 2048) return n; if (n < 2052) return PC_I + n - 2048; if (n < 2056) return PC_F + n - 2052; if (n < 3080) return PC_O + n - 2056; if (n < 3464) return PC_CQ + n - 3080;
                  if (n < 3720) return PC_CKV + n - 3464; if (n < 3784) return PC_KR + n - 3720; if (n < 4808) return PC_CX + n - 3784; return PC_G + n - 4808; }
        case 4: { const int hh = n / 192, dd = n - hh * 192; if (dd < 128) return n; const int jj = dd - 128; return hh * 192 + 128 + (jj < 32 ? 2 * jj : 2 * (jj - 32) + 1); }
        case 5: { const int hh = n >> 8, dd = n & 255; return dd < 128 ? hh * 128 + dd : 1024 + hh * 128 + dd - 128; }
        default: return n;
    }
}
DI void convert_mat(const float* W, int K, int N, bf16_t* WT, int map, LAS unsigned char* smem) {
    const int tid_ = opaque_tid(), lane = tid_ & 63, wid_ = tid_ >> 6, gw = blockIdx.x * 8 + wid_, ngw = gridDim.x * 8; LAS float* scr = (LAS float*)(smem + wid_ * 16384);
    const int nblk = (N + 31) >> 5, nitems = (K >> 6) * nblk;
    for (int it = gw; it < nitems; it += ngw) {
        const int kb = it / nblk, nb = it - kb * nblk, k0 = 64 * kb, n0 = 32 * nb;
        const int nn = n0 + (lane & 31);
#pragma unroll 8
        for (int i = 0; i < 32; ++i) { const int kk = 2 * i + (lane >> 5); scr[kk * 33 + (lane & 31)] = nn < N ? W[(size_t)(k0 + kk) * N + nn] : 0.f; }
        asm volatile("s_waitcnt lgkmcnt(0)" ::: "memory");
        const int c = lane & 7;
#pragma unroll
        for (int j = 0; j < 4; ++j) { const int n = (lane >> 3) + 8 * j; const LAS float* s = scr + (8 * c) * 33 + n;
            u32x4 o; o.x = pk2(s[0 * 33], s[1 * 33]); o.y = pk2(s[2 * 33], s[3 * 33]); o.z = pk2(s[4 * 33], s[5 * 33]); o.w = pk2(s[6 * 33], s[7 * 33]);
            if (n0 + n < N) *(u32x4*)(WT + (size_t)map_row(map, n0 + n) * K + k0 + 8 * c) = o; }
        asm volatile("s_waitcnt lgkmcnt(0)" ::: "memory");
    }
}

DI void rmsnorm_rows(const float* X, const float* g, bf16_t* O) {
    const int tid_ = opaque_tid(), lane = tid_ & 63, gw = blockIdx.x * 8 + (tid_ >> 6), ngw = gridDim.x * 8;
    for (int r = gw; r < S; r += ngw) {
        const f32x4* xr = (const f32x4*)(X + (size_t)r * DM) + lane; f32x4 v[8]; float s = 0.f;
#pragma unroll
        for (int j = 0; j < 8; ++j) { v[j] = xr[64 * j]; s += (v[j].x * v[j].x + v[j].y * v[j].y) + (v[j].z * v[j].z + v[j].w * v[j].w); }
        const float rstd = 1.f / sqrtf(wave_sum(s) * (1.f / DM) + EPS);
        u32x2* o8 = (u32x2*)(O + (size_t)r * DM) + lane;
#pragma unroll
        for (int j = 0; j < 8; ++j) { const f32x4 gv = ((const f32x4*)g)[lane + 64 * j]; u32x2 w; w.x = pk2(v[j].x * rstd * gv.x, v[j].y * rstd * gv.y); w.y = pk2(v[j].z * rstd * gv.z, v[j].w * rstd * gv.w); o8[64 * j] = w; }
    }
}
DI void final_norm_rows(float* X, const float* g) {
    const int tid_ = opaque_tid(), lane = tid_ & 63, gw = blockIdx.x * 8 + (tid_ >> 6), ngw = gridDim.x * 8;
    for (int r = gw; r < S; r += ngw) {
        f32x4* xr = (f32x4*)(X + (size_t)r * DM) + lane; f32x4 v[8]; float s = 0.f;
#pragma unroll
        for (int j = 0; j < 8; ++j) { v[j] = xr[64 * j]; s += (v[j].x * v[j].x + v[j].y * v[j].y) + (v[j].z * v[j].z + v[j].w * v[j].w); }
        const float rstd = 1.f / sqrtf(wave_sum(s) * (1.f / DM) + EPS);
#pragma unroll
        for (int j = 0; j < 8; ++j) { const f32x4 gv = ((const f32x4*)g)[lane + 64 * j]; xr[64 * j] = v[j] * rstd * gv; }
    }
}
DI void prep_rows(bf16_t* P, const float* qn, const float* kvn, const float* cw, const float* cb, const f32x2* tab, bf16_t* XC) {
    const int tid_ = opaque_tid(), lane = tid_ & 63, gw = blockIdx.x * 8 + (tid_ >> 6), ngw = gridDim.x * 8;
    for (int t = gw; t < S; t += ngw) {
        bf16_t* row = P + (size_t)t * NP;
        { unsigned w[3]; float s = 0.f;
#pragma unroll
          for (int k = 0; k < 3; ++k) { w[k] = *(const unsigned*)(row + PC_CQ + 128 * k + 2 * lane); const float a = bflo(w[k]), b = bfhi(w[k]); s += a * a + b * b; }
          const float rstd = 1.f / sqrtf(wave_sum(s) * (1.f / 384.f) + EPS);
#pragma unroll
          for (int k = 0; k < 3; ++k) { const int c = 128 * k + 2 * lane; *(unsigned*)(row + PC_CQ + c) = pk2(bflo(w[k]) * rstd * qn[c], bfhi(w[k]) * rstd * qn[c + 1]); } }
        { unsigned w[2]; float s = 0.f;
#pragma unroll
          for (int k = 0; k < 2; ++k) { w[k] = *(const unsigned*)(row + PC_CKV + 128 * k + 2 * lane); const float a = bflo(w[k]), b = bfhi(w[k]); s += a * a + b * b; }
          const float rstd = 1.f / sqrtf(wave_sum(s) * (1.f / 256.f) + EPS);
#pragma unroll
          for (int k = 0; k < 2; ++k) { const int c = 128 * k + 2 * lane; *(unsigned*)(row + PC_CKV + c) = pk2(bflo(w[k]) * rstd * kvn[c], bfhi(w[k]) * rstd * kvn[c + 1]); } }
        { const int j = lane & 31; const float x1 = bf2f(row[PC_KR + j]), x2 = bf2f(row[PC_KR + 32 + j]); const f32x2 cs = tab[(size_t)t * 32 + j];
          const unsigned o = pk2(x1 * cs.x - x2 * cs.y, x1 * cs.y + x2 * cs.x);
          asm volatile("" ::: "memory");
          if (lane < 32) *(unsigned*)(row + PC_KR + 2 * j) = o; }
#pragma unroll
        for (int k = 0; k < 8; ++k) { const int ch = 128 * k + 2 * lane; float a0 = cb[ch], a1 = cb[ch + 1];
#pragma unroll
            for (int j = 0; j < 4; ++j) { const int tt = t - 3 + j; if (tt >= 0) { const unsigned w = *(const unsigned*)(P + (size_t)tt * NP + PC_CX + ch); a0 += cw[j * 1024 + ch] * bflo(w); a1 += cw[j * 1024 + ch + 1] * bfhi(w); } }
            *(unsigned*)(XC + (size_t)t * 1024 + ch) = pk2(a0, a1); }
    }
}

DI void lru_p1(const bf16_t* LA, const bf16_t* U, float* CA, float* CH) {
    const int tid = opaque_tid();
    for (int c = blockIdx.x; c < 256; c += gridDim.x) {
        float h0 = 0.f, h1 = 0.f, s0 = 0.f, s1 = 0.f;
#pragma unroll 8
        for (int t = 0; t < 64; ++t) { const size_t row = (size_t)c * 64 + t; const unsigned lw = *(const unsigned*)(LA + row * NP + 2 * tid), uw = *(const unsigned*)(U + row * 1024 + 2 * tid);
            const float l0 = bflo(lw), l1 = bfhi(lw); s0 += l0; s1 += l1; h0 = __expf(l0) * h0 + bflo(uw); h1 = __expf(l1) * h1 + bfhi(uw); }
        CA[c * 1024 + 2 * tid] = __expf(s0); CA[c * 1024 + 2 * tid + 1] = __expf(s1); CH[c * 1024 + 2 * tid] = h0; CH[c * 1024 + 2 * tid + 1] = h1;
    }
}
DI void lru_p2(const float* CA, const float* CH, float* CARRY) {
    for (int ch = blockIdx.x * 512 + opaque_tid(); ch < 1024; ch += gridDim.x * 512) {
        float st = 0.f;
#pragma unroll 8
        for (int c = 0; c < 256; ++c) { CARRY[c * 1024 + ch] = st; st = CA[c * 1024 + ch] * st + CH[c * 1024 + ch]; }
    }
}
DI void lru_p3(const bf16_t* LA, const bf16_t* U, const float* CARRY, bf16_t* Y) {
    const int tid = opaque_tid();
    for (int c = blockIdx.x; c < 256; c += gridDim.x) {
        float h0 = CARRY[c * 1024 + 2 * tid], h1 = CARRY[c * 1024 + 2 * tid + 1];
#pragma unroll 8
        for (int t = 0; t < 64; ++t) { const size_t row = (size_t)c * 64 + t; const unsigned lw = *(const unsigned*)(LA + row * NP + 2 * tid), uw = *(const unsigned*)(U + row * 1024 + 2 * tid);
            h0 = __expf(bflo(lw)) * h0 + bflo(uw); h1 = __expf(bfhi(lw)) * h1 + bfhi(uw);
            *(unsigned*)(Y + row * 3072 + 2048 + 2 * tid) = pk2(h0, h1); }
    }
}

DI void mlstm_a(LAS unsigned char* smem, const bf16_t* P, const float* gbias, bf16_t* CS, float* SMALL) {
    const int tid = opaque_tid(), lane = tid & 63, wid = tid >> 6, l31 = lane & 31, h = lane >> 5, q4 = (lane & 15) >> 2, p4 = lane & 3, blk = (lane >> 4) & 1;
    LAS float* sw = (LAS float*)smem;
    LAS unsigned char* Ks = smem + 1024;
    LAS unsigned char* Vs = smem + 1024 + 20480;
    for (int uid = blockIdx.x; uid < 1024; uid += gridDim.x) {
        const int c = uid >> 2, hh = uid & 3; const size_t row0 = (size_t)c * 64;
        if (wid == 0) {
            const bf16_t* r = P + (row0 + lane) * NP;
            const float li = bf2f(r[PC_I + hh]) + gbias[hh], lf = logsigmoid_(bf2f(r[PC_F + hh]) + gbias[4 + hh]);
            const float bc = wave_incl_scan(lf, lane), bt = __shfl(bc, 63), ds = bt - bc + li, M = wave_max(ds);
            sw[lane] = expf(ds - M);
            if (lane == 0) { SMALL[SM_BT + uid] = bt; SMALL[SM_MC + uid] = M; }
        }
        __syncthreads();
#pragma unroll
        for (int i = 0; i < 2; ++i) { const int id = tid + 512 * i, s = id >> 4, d8 = (id & 15) * 8; const u32x4 v = *(const u32x4*)(P + (row0 + s) * NP + PC_K + hh * 128 + d8); const float w = sw[s];
            u32x4 o; o.x = pk2(bflo(v.x) * w, bfhi(v.x) * w); o.y = pk2(bflo(v.y) * w, bfhi(v.y) * w); o.z = pk2(bflo(v.z) * w, bfhi(v.z) * w); o.w = pk2(bflo(v.w) * w, bfhi(v.w) * w);
            *(LAS u32x4*)(Ks + s * 320 + d8 * 2) = o; }
#pragma unroll
        for (int i = 0; i < 4; ++i) { const int id = tid + 512 * i, s = id >> 5, d8 = (id & 31) * 8; *(LAS u32x4*)(Vs + s * 576 + d8 * 2) = *(const u32x4*)(P + (row0 + s) * NP + PC_V + hh * 256 + d8); }
        __syncthreads();
        f32x16 acc[4];
#pragma unroll
        for (int d = 0; d < 4; ++d)
#pragma unroll
            for (int i = 0; i < 16; ++i) acc[d][i] = 0.f;
#pragma unroll
        for (int kk = 0; kk < 4; ++kk) {
            const bf16x8 vf = tr_frag(Vs + (16 * kk + 8 * h + q4) * 576 + (32 * wid + 16 * blk) * 2 + 8 * p4, 576);
#pragma unroll
            for (int d = 0; d < 4; ++d) { const bf16x8 kf = tr_frag(Ks + (16 * kk + 8 * h + q4) * 320 + (32 * d + 16 * blk) * 2 + 8 * p4, 320); acc[d] = mfma32(kf, vf, acc[d]); }
        }
        bf16_t* cs = CS + (size_t)uid * 32768 + (32 * wid + l31) * 128;
#pragma unroll
        for (int d = 0; d < 4; ++d)
#pragma unroll
            for (int g = 0; g < 4; ++g) { u32x2 w; w.x = pk2(acc[d][4 * g], acc[d][4 * g + 1]); w.y = pk2(acc[d][4 * g + 2], acc[d][4 * g + 3]); *(u32x2*)(cs + 32 * d + 8 * g + 4 * h) = w; }
        if (tid < 128) { float s = 0.f;
#pragma unroll 8
            for (int t = 0; t < 64; ++t) s += bf2f(*(LAS const bf16_t*)(Ks + t * 320 + tid * 2));
            SMALL[SM_DN + uid * 128 + tid] = s; }
        __syncthreads();
    }
}
DI void mlstm_b(LAS unsigned char* smem, bf16_t* CS, float* SMALL) {
    const int tid = opaque_tid();
    LAS float* dec = (LAS float*)smem; LAS float* inj = dec + 1024;
    if (tid < 4) { float m = -1e30f;
        for (int c = 0; c < 256; ++c) { const float bt = SMALL[SM_BT + c * 4 + tid], M = SMALL[SM_MC + c * 4 + tid]; if (blockIdx.x == 0) SMALL[SM_MPREV + c * 4 + tid] = m;
            const float mn = fmaxf(bt + m, M); dec[tid * 256 + c] = expf(bt + m - mn); inj[tid * 256 + c] = expf(M - mn); m = mn; } }
    __syncthreads();
    for (int e = blockIdx.x * 512 + tid; e < 131072; e += gridDim.x * 512) {
        const int hh = e >> 15, idx = e & 32767; bf16_t* pp = CS + (size_t)hh * 32768 + idx; float st = 0.f;
#pragma unroll 8
        for (int c = 0; c < 256; ++c) { const float d = bf2f(pp[(size_t)c * 131072]); pp[(size_t)c * 131072] = f2bf(st); st = dec[hh * 256 + c] * st + inj[hh * 256 + c] * d; }
    }
    if (blockIdx.x == gridDim.x - 1) { const int hh = tid >> 7; float* pp = SMALL + SM_DN + tid; float st = 0.f;
#pragma unroll 8
        for (int c = 0; c < 256; ++c) { const float d = pp[c * 512]; pp[c * 512] = st; st = dec[hh * 256 + c] * st + inj[hh * 256 + c] * d; } }
    __syncthreads();
}
DI void mlstm_c(LAS unsigned char* smem, const bf16_t* P, const float* gbias, const float* onorm, const bf16_t* CS, const float* SMALL, bf16_t* Y) {
    const int tid = opaque_tid(), lane = tid & 63, wid = tid >> 6, l31 = lane & 31, h = lane >> 5, q4 = (lane & 15) >> 2, p4 = lane & 3, blk = (lane >> 4) & 1;
    LAS float* sbc = (LAS float*)smem; LAS float* sav = sbc + 64; LAS float* snp = sbc + 128; LAS float* sx = sbc + 256;
    LAS unsigned char* Qs = smem + 2048;
    LAS unsigned char* Ks = Qs + 17408;
    LAS unsigned char* Vs = Ks + 17408;
    const int tb = wid & 1, dvq = wid >> 1, t = 32 * tb + l31, pr = pi32(l31);
    for (int uid = blockIdx.x; uid < 1024; uid += gridDim.x) {
        const int c = uid >> 2, hh = uid & 3; const size_t row0 = (size_t)c * 64;
        if (wid == 0) {
            const bf16_t* r = P + (row0 + lane) * NP;
            const float li = bf2f(r[PC_I + hh]) + gbias[hh], lf = logsigmoid_(bf2f(r[PC_F + hh]) + gbias[4 + hh]);
            const float bc = wave_incl_scan(lf, lane);
            sbc[lane] = bc; sav[lane] = li - bc;
        }
        if (tid >= 64 && tid < 192) snp[tid - 64] = SMALL[SM_DN + uid * 128 + tid - 64];
#pragma unroll
        for (int i = 0; i < 2; ++i) { const int id = tid + 512 * i, s = id >> 4, d8 = (id & 15) * 8;
            *(LAS u32x4*)(Qs + s * 272 + d8 * 2) = *(const u32x4*)(P + (row0 + s) * NP + PC_Q + hh * 128 + d8);
            *(LAS u32x4*)(Ks + s * 272 + d8 * 2) = *(const u32x4*)(P + (row0 + s) * NP + PC_K + hh * 128 + d8); }
#pragma unroll
        for (int i = 0; i < 4; ++i) { const int id = tid + 512 * i, s = id >> 5, d8 = (id & 31) * 8; *(LAS u32x4*)(Vs + s * 576 + d8 * 2) = *(const u32x4*)(P + (row0 + s) * NP + PC_V + hh * 256 + d8); }
        __syncthreads();
        const float mprev = SMALL[SM_MPREV + uid];
        bf16x8 qf[8];
#pragma unroll
        for (int ks = 0; ks < 8; ++ks) qf[ks] = *(const LAS bf16x8*)(Qs + t * 272 + (16 * ks + 8 * h) * 2);
        f32x16 st0, st1;
#pragma unroll
        for (int i = 0; i < 16; ++i) { st0[i] = 0.f; st1[i] = 0.f; }
#pragma unroll
        for (int ks = 0; ks < 8; ++ks) { const bf16x8 a0 = *(const LAS bf16x8*)(Ks + pr * 272 + (16 * ks + 8 * h) * 2); st0 = mfma32(a0, qf[ks], st0);
            if (tb) { const bf16x8 a1 = *(const LAS bf16x8*)(Ks + (32 + pr) * 272 + (16 * ks + 8 * h) * 2); st1 = mfma32(a1, qf[ks], st1); } }
        const float bt = sbc[t];
        float mx = -1e30f;
#pragma unroll
        for (int i = 0; i < 16; ++i) { const int s = 16 * (i >> 3) + 8 * h + (i & 7); if (s <= t) mx = fmaxf(mx, sav[s]); if (tb) mx = fmaxf(mx, (s + 32 <= t) ? sav[s + 32] : -1e30f); }
        mx = fmaxf(mx, __shfl_xor(mx, 32));
        const float mt = bt + fmaxf(mprev, mx);
        float den = 0.f;
#pragma unroll
        for (int i = 0; i < 16; ++i) { const int s = 16 * (i >> 3) + 8 * h + (i & 7);
            const float w0 = (s <= t) ? expf(bt + sav[s] - mt) * MQS : 0.f; st0[i] *= w0; den += st0[i];
            const float w1 = (tb && (s + 32 <= t)) ? expf(bt + sav[s + 32] - mt) * MQS : 0.f; st1[i] *= w1; den += st1[i]; }
        den += __shfl_xor(den, 32);
        float qn = 0.f;
#pragma unroll
        for (int ks = 0; ks < 8; ++ks)
#pragma unroll
            for (int j = 0; j < 8; ++j) qn += bf2f((bf16_t)qf[ks][j]) * snp[16 * ks + 8 * h + j];
        qn += __shfl_xor(qn, 32);
        const float wi = expf(bt + mprev - mt) * MQS;
        den += wi * qn;
        const float dinv = 1.f / fmaxf(fabsf(den), expf(-mt));
        bf16x8 pf[4];
        pf[0] = pack8(st0[0], st0[1], st0[2], st0[3], st0[4], st0[5], st0[6], st0[7]); pf[1] = pack8(st0[8], st0[9], st0[10], st0[11], st0[12], st0[13], st0[14], st0[15]);
        pf[2] = pack8(st1[0], st1[1], st1[2], st1[3], st1[4], st1[5], st1[6], st1[7]); pf[3] = pack8(st1[8], st1[9], st1[10], st1[11], st1[12], st1[13], st1[14], st1[15]);
        float hv[2][16]; float ss = 0.f;
#pragma unroll
        for (int db = 0; db < 2; ++db) { const int dvb = 2 * dvq + db;
            f32x16 a1, a2;
#pragma unroll
            for (int i = 0; i < 16; ++i) { a1[i] = 0.f; a2[i] = 0.f; }
#pragma unroll
            for (int sb = 0; sb < 2; ++sb)
#pragma unroll
                for (int kk = 0; kk < 2; ++kk) { if (sb <= tb) { const bf16x8 vf = tr_frag(Vs + (32 * sb + 16 * kk + 8 * h + q4) * 576 + (32 * dvb + 16 * blk) * 2 + 8 * p4, 576); a1 = mfma32(vf, pf[2 * sb + kk], a1); } }
            const bf16_t* cp = CS + (size_t)uid * 32768 + (32 * dvb + l31) * 128 + 8 * h;
#pragma unroll
            for (int ks = 0; ks < 8; ++ks) { const bf16x8 cf = *(const bf16x8*)(cp + 16 * ks); a2 = mfma32(cf, qf[ks], a2); }
#pragma unroll
            for (int i = 0; i < 16; ++i) { const float v = (a1[i] + wi * a2[i]) * dinv; hv[db][i] = v; ss += v * v; }
        }
        ss += __shfl_xor(ss, 32);
        if (h == 0) sx[(tb * 4 + dvq) * 32 + l31] = ss;
        __syncthreads();
        const float tot = (sx[(tb * 4 + 0) * 32 + l31] + sx[(tb * 4 + 1) * 32 + l31]) + (sx[(tb * 4 + 2) * 32 + l31] + sx[(tb * 4 + 3) * 32 + l31]);
        const float rstd = 1.f / sqrtf(tot * (1.f / 256.f) + EPS);
#pragma unroll
        for (int db = 0; db < 2; ++db)
#pragma unroll
            for (int g = 0; g < 4; ++g) { const int col = hh * 256 + 32 * (2 * dvq + db) + 8 * g + 4 * h;
                const f32x4 gn = *(const f32x4*)(onorm + col); const u32x2 og = *(const u32x2*)(P + (row0 + t) * NP + PC_O + col);
                const float o0 = hv[db][4 * g] * rstd * gn.x * sigmoidf_(bflo(og.x)), o1 = hv[db][4 * g + 1] * rstd * gn.y * sigmoidf_(bfhi(og.x));
                const float o2 = hv[db][4 * g + 2] * rstd * gn.z * sigmoidf_(bflo(og.y)), o3 = hv[db][4 * g + 3] * rstd * gn.w * sigmoidf_(bfhi(og.y));
                u32x2 w; w.x = pk2(o0, o1); w.y = pk2(o2, o3); *(u32x2*)(Y + (row0 + t) * 3072 + col) = w; }
        __syncthreads();
    }
}

DI void attn_unit(LAS unsigned char* smem, int hh, int qb, const bf16_t* Q, const bf16_t* KN, const bf16_t* P, const bf16_t* VT, bf16_t* Y) {
    const int tid = opaque_tid(), lane = tid & 63, wid = __builtin_amdgcn_readfirstlane(tid >> 6), l31 = lane & 31, h = lane >> 5;
    LAS unsigned char* Kb = smem; LAS unsigned char* Vb = smem + 51200;
    const int q0 = qb * 256, qw = q0 + 32 * wid, q = qw + l31, NT = 4 * qb + 4;
    bf16x8 qf[12];
#pragma unroll
    for (int ks = 0; ks < 12; ++ks) qf[ks] = *(const bf16x8*)(Q + (size_t)q * 1536 + hh * 192 + 16 * ks + 8 * h);
    f32x16 o[4];
#pragma unroll
    for (int d = 0; d < 4; ++d)
#pragma unroll
        for (int i = 0; i < 16; ++i) o[d][i] = 0.f;
    float mrun = -1e30f, lrun = 0.f;
    const bf16_t* ksrc[3]; size_t kstr[3]; int kdst[3];
#pragma unroll
    for (int i = 0; i < 3; ++i) { const int id = tid + 512 * i, row = id / 24, ch = id - row * 24;
        if (ch < 16) { ksrc[i] = KN + (size_t)row * 1024 + hh * 128 + 8 * ch; kstr[i] = (size_t)64 * 1024; } else { ksrc[i] = P + (size_t)row * NP + PC_KR + 8 * (ch - 16); kstr[i] = (size_t)64 * NP; }
        kdst[i] = row * 400 + ch * 16; }
    const bf16_t* vsrc[2]; int vdst[2];
#pragma unroll
    for (int i = 0; i < 2; ++i) { const int id = tid + 512 * i, d = id >> 3, ch = id & 7; vsrc[i] = VT + (size_t)(hh * 128 + d) * S + 8 * ch; vdst[i] = d * 144 + ch * 16; }
    u32x4 kr[3], vr[2];
#pragma unroll
    for (int i = 0; i < 3; ++i) kr[i] = *(const u32x4*)(ksrc[i]);
#pragma unroll
    for (int i = 0; i < 2; ++i) vr[i] = *(const u32x4*)(vsrc[i]);
#pragma unroll
    for (int i = 0; i < 3; ++i) *(LAS u32x4*)(Kb + kdst[i]) = kr[i];
#pragma unroll
    for (int i = 0; i < 2; ++i) *(LAS u32x4*)(Vb + vdst[i]) = vr[i];
    __syncthreads();
    const int koff = pi32(l31) * 400 + 16 * h, voff = l31 * 144 + 16 * h;
    for (int t = 0; t < NT; ++t) {
        const int cur = t & 1;
        if (t + 1 < NT) {
#pragma unroll
            for (int i = 0; i < 3; ++i) kr[i] = *(const u32x4*)(ksrc[i] + (size_t)(t + 1) * kstr[i]);
#pragma unroll
            for (int i = 0; i < 2; ++i) vr[i] = *(const u32x4*)(vsrc[i] + (size_t)(t + 1) * 64);
        }
        if (64 * t <= qw + 31) {
            LAS const unsigned char* kb = Kb + cur * 25600 + koff; LAS const unsigned char* vb = Vb + cur * 18432 + voff;
            f32x16 s0, s1;
#pragma unroll
            for (int i = 0; i < 16; ++i) { s0[i] = 0.f; s1[i] = 0.f; }
#pragma unroll
            for (int ks = 0; ks < 12; ++ks) { const bf16x8 a0 = *(const LAS bf16x8*)(kb + ks * 32), a1 = *(const LAS bf16x8*)(kb + 32 * 400 + ks * 32); s0 = mfma32(a0, qf[ks], s0); s1 = mfma32(a1, qf[ks], s1); }
            if (64 * t + 63 > qw) {
#pragma unroll
                for (int i = 0; i < 16; ++i) { const int kv = 64 * t + 16 * (i >> 3) + 8 * h + (i & 7); if (kv > q) s0[i] = -1e30f; if (kv + 32 > q) s1[i] = -1e30f; }
            }
            float mx = fmaxf(s0[0], s1[0]);
#pragma unroll
            for (int i = 1; i < 16; ++i) mx = fmaxf(mx, fmaxf(s0[i], s1[i]));
            mx = fmaxf(mx, __shfl_xor(mx, 32));
            const float mnew = fmaxf(mrun, mx), alpha = __builtin_amdgcn_exp2f(mrun - mnew);
            mrun = mnew;
            float rs = 0.f;
#pragma unroll
            for (int i = 0; i < 16; ++i) { s0[i] = __builtin_amdgcn_exp2f(s0[i] - mnew); s1[i] = __builtin_amdgcn_exp2f(s1[i] - mnew); rs += s0[i] + s1[i]; }
            lrun = lrun * alpha + rs;
#pragma unroll
            for (int d = 0; d < 4; ++d)
#pragma unroll
                for (int i = 0; i < 16; ++i) o[d][i] *= alpha;
            bf16x8 pf[4];
            pf[0] = pack8(s0[0], s0[1], s0[2], s0[3], s0[4], s0[5], s0[6], s0[7]); pf[1] = pack8(s0[8], s0[9], s0[10], s0[11], s0[12], s0[13], s0[14], s0[15]);
            pf[2] = pack8(s1[0], s1[1], s1[2], s1[3], s1[4], s1[5], s1[6], s1[7]); pf[3] = pack8(s1[8], s1[9], s1[10], s1[11], s1[12], s1[13], s1[14], s1[15]);
#pragma unroll
            for (int d = 0; d < 4; ++d)
#pragma unroll
                for (int kk = 0; kk < 4; ++kk) { const bf16x8 vf = *(const LAS bf16x8*)(vb + d * 32 * 144 + kk * 32); o[d] = mfma32(vf, pf[kk], o[d]); }
        }
        if (t + 1 < NT) {
#pragma unroll
            for (int i = 0; i < 3; ++i) *(LAS u32x4*)(Kb + (cur ^ 1) * 25600 + kdst[i]) = kr[i];
#pragma unroll
            for (int i = 0; i < 2; ++i) *(LAS u32x4*)(Vb + (cur ^ 1) * 18432 + vdst[i]) = vr[i];
        }
        __syncthreads();
    }
    lrun += __shfl_xor(lrun, 32);
    const float inv = 1.f / lrun;
    bf16_t* yp = Y + (size_t)q * 3072 + 1024 + hh * 128 + 4 * h;
#pragma unroll
    for (int d = 0; d < 4; ++d)
#pragma unroll
        for (int g = 0; g < 4; ++g) { u32x2 w; w.x = pk2(o[d][4 * g] * inv, o[d][4 * g + 1] * inv); w.y = pk2(o[d][4 * g + 2] * inv, o[d][4 * g + 3] * inv); *(u32x2*)(yp + 32 * d + 8 * g) = w; }
}

struct Params { const float* in[27]; float* out; unsigned char* ws; };

__global__ void __launch_bounds__(512, 2) mega_fwd(Params p) {
    extern __shared__ __attribute__((aligned(16))) unsigned char smem_raw[];
    LAS unsigned char* smem = (LAS unsigned char*)smem_raw;
    cg::grid_group grid = cg::this_grid();
    const int G = gridDim.x, bx = blockIdx.x;
    unsigned char* ws = p.ws;
    f32x2* TAB = (f32x2*)(ws + WS_TAB); float* SMALL = (float*)(ws + WS_SMALL);
    bf16_t* WFFGU = (bf16_t*)(ws + WS_WFFGU); bf16_t* WFFD = (bf16_t*)(ws + WS_WFFD); bf16_t* WIN = (bf16_t*)(ws + WS_WIN); bf16_t* WUQ = (bf16_t*)(ws + WS_WUQ);
    bf16_t* WUKV = (bf16_t*)(ws + WS_WUKV); bf16_t* WLRU = (bf16_t*)(ws + WS_WLRU); bf16_t* WBR = (bf16_t*)(ws + WS_WBR); bf16_t* WOUT = (bf16_t*)(ws + WS_WOUT);
    bf16_t* XN = (bf16_t*)(ws + WS_XN); bf16_t* P = (bf16_t*)(ws + WS_P); bf16_t* Hb = P; bf16_t* Qb = (bf16_t*)(ws + WS_Q); bf16_t* KN = (bf16_t*)(ws + WS_KN);
    bf16_t* VT = (bf16_t*)(ws + WS_VT); bf16_t* Y = (bf16_t*)(ws + WS_Y); bf16_t* XC = (bf16_t*)(ws + WS_XC); bf16_t* CS = (bf16_t*)(ws + WS_CS);

    for (int i = bx * 512 + opaque_tid(); i < S * 32; i += G * 512) { const int t = i >> 5, j = i & 31; const float ang = (float)t * INVF[j];
        double r = (double)ang * 0.15915494309189535; r -= __builtin_floor(r); const float fr = (float)r;
        TAB[i] = (f32x2){__builtin_amdgcn_cosf(fr), __builtin_amdgcn_sinf(fr)}; }

#pragma unroll 1
    for (int hl = 0; hl < 4; ++hl) {
        const int l = hl >> 1, second = hl & 1;
        const float* xin = hl == 0 ? p.in[0] : p.out;
        {
            const int nmat = second ? 3 : 26;
#pragma unroll 1
            for (int mi = 0; mi < nmat; ++mi) {
                const float* src; int K, N, map; bf16_t* dst;
                if (mi == 0) { src = p.in[second ? 23 : 2] + (size_t)l * DM * FF; K = DM; N = FF; map = 1; dst = WFFGU; }
                else if (mi == 1) { src = p.in[second ? 24 : 3] + (size_t)l * DM * FF; K = DM; N = FF; map = 2; dst = WFFGU; }
                else if (mi == 2) { src = p.in[second ? 25 : 4] + (size_t)l * DM * FF; K = FF; N = DM; map = 0; dst = WFFD; }
                else if (mi == 3) { src = p.in[6] + (size_t)l * DM * NIN; K = DM; N = NIN; map = 3; dst = WIN; }
                else if (mi == 4) { src = p.in[10] + (size_t)l * 384 * 1536; K = 384; N = 1536; map = 4; dst = WUQ; }
                else if (mi == 5) { src = p.in[12] + (size_t)l * 256 * 2048; K = 256; N = 2048; map = 5; dst = WUKV; }
                else if (mi < 22) { const int k = mi - 6, n = k >> 1, wx = k & 1; src = p.in[wx ? 17 : 15] + (size_t)l * 131072 + n * 16384; K = 128; N = 128; map = 0; dst = WLRU + (size_t)(n * 256 + wx * 128) * 128; }
                else if (mi < 25) { const int j = mi - 22; src = p.in[20] + (size_t)l * 3 * 1024 * 2048 + (size_t)j * 1024 * 2048; K = 1024; N = 2048; map = 0; dst = WBR + (size_t)j * 2048 * 1024; }
                else { src = p.in[21] + (size_t)l * DM * DM; K = DM; N = DM; map = 0; dst = WOUT; }
                convert_mat(src, K, N, dst, map, smem);
            }
            rmsnorm_rows(xin, p.in[second ? 22 : 1] + l * DM, XN);
        }
        grid.sync();
        { pg8::Gemm g{XN, WFFGU, S, 2 * FF, DM, DM, DM, 0}; pg8::StaticOrder so; so.init(S, 2 * FF, G, bx); pg8::EpiSwiglu E{Hb}; pg8::gemm_phase(smem, g, so, E); }
        grid.sync();
        { pg8::Gemm g{Hb, WFFD, S, DM, FF, FF, FF, 0}; pg8::StaticOrder so; so.init(S, DM, G, bx); pg8::EpiRes E{xin, p.out, 0.5f}; pg8::gemm_phase(smem, g, so, E); }
        grid.sync();
        if (!second) {
            const float* gbias = p.in[7] + l * 8;
            rmsnorm_rows(p.out, p.in[5] + l * DM, XN);
            grid.sync();
            { pg8::Gemm g{XN, WIN, S, NP, DM, DM, DM, 0}; pg8::StaticOrder so; so.init(S, NP, G, bx); pg8::EpiStore E{P, NP}; pg8::gemm_phase(smem, g, so, E); }
            grid.sync();
            if (bx == G - 1) { const float* lam = p.in[19] + l * 1024; for (int ch = opaque_tid(); ch < 1024; ch += 512) SMALL[SM_SP + ch] = -8.f * log1pf(expf(-lam[ch])); }
            mlstm_a(smem, P, gbias, CS, SMALL);
            prep_rows(P, p.in[9] + l * 384, p.in[11] + l * 256, p.in[13] + l * 4096, p.in[14] + l * 1024, TAB, XC);
            grid.sync();
            mlstm_b(smem, CS, SMALL);
            { pg8::Gemm g{P + PC_CQ, WUQ, S, 1536, 384, NP, 384, 0}; pg8::StaticOrder so; so.init(S, 1536, G, bx); pg8::EpiQ E{Qb, TAB}; pg8::gemm_phase(smem, g, so, E); }
#pragma unroll 1
            for (int gi = 0; gi < 2; ++gi) {
                pg8::Gemm g; pg8::StaticOrder so; pg8::EpiStore E;
                if (gi == 0) { g = pg8::Gemm{P + PC_CKV, WUKV, S, 1024, 256, NP, 256, 0}; so.init(S, 1024, G, bx); E = pg8::EpiStore{KN, 1024}; }
                else { g = pg8::Gemm{WUKV + 1024 * 256, P + PC_CKV, 1024, S, 256, 256, NP, 0}; so.init(1024, S, G, bx); E = pg8::EpiStore{VT, S}; }
                pg8::gemm_phase(smem, g, so, E);
            }
            { pg8::Gemm g{XC, WLRU, S, 2048, 128, 1024, 128, 128}; pg8::StaticOrder so; so.init(S, 2048, G, bx); pg8::EpiLru E{XC, P + PC_CX, p.in[16] + l * 1024, p.in[18] + l * 1024, SMALL + SM_SP}; pg8::gemm_phase(smem, g, so, E); }
            grid.sync();
            mlstm_c(smem, P, gbias, p.in[8] + l * 1024, CS, SMALL, Y);
            lru_p1(P + PC_CX, XC, SMALL + SM_CA, SMALL + SM_CH);
            grid.sync();
            lru_p2(SMALL + SM_CA, SMALL + SM_CH, SMALL + SM_CARRY);
            for (int item = bx; item < 256; item += G) { const int hh = item & 7, pp = item >> 3;
#pragma unroll 1
                for (int half = 0; half < 2; ++half) attn_unit(smem, hh, half ? 63 - pp : pp, Qb, KN, P, VT, Y); }
            grid.sync();
            lru_p3(P + PC_CX, XC, SMALL + SM_CARRY, Y);
#pragma unroll 1
            for (int j = 0; j < 3; ++j) {
                if (j == 2) grid.sync();
                pg8::Gemm g{Y + j * 1024, WBR + (size_t)j * 2048 * 1024, S, DM, 1024, 3072, 1024, 0}; pg8::StaticOrder so; so.init(S, DM, G, bx); pg8::EpiMerge E{XN, P + PC_G + j * 2048, j == 0}; pg8::gemm_phase(smem, g, so, E);
            }
            grid.sync();
            { pg8::Gemm g{XN, WOUT, S, DM, DM, DM, DM, 0}; pg8::StaticOrder so; so.init(S, DM, G, bx); pg8::EpiRes E{p.out, p.out, 1.0f}; pg8::gemm_phase(smem, g, so, E); }
            grid.sync();
        }
    }
    final_norm_rows(p.out, p.in[26]);
}

constexpr int LDS_BYTES = 143360;

extern "C" void kernel_launch(void* const* d_in, const int* in_sizes, int n_in, void* d_out, int out_size, void* d_ws, size_t ws_size, hipStream_t stream) {
    static int grid = 0;
    if (grid == 0) {
        if (n_in != 27 || out_size != S * DM || ws_size < WS_END) { fprintf(stderr, "kernel_launch: unexpected problem (n_in %d out %d ws %zu, need %zu)\n", n_in, out_size, ws_size, (size_t)WS_END); grid = -1; return; }
        int dev = 0, cus = 0, per_cu = 0;
        hipGetDevice(&dev); hipDeviceGetAttribute(&cus, hipDeviceAttributeMultiprocessorCount, dev);
        if (hipFuncSetAttribute((const void*)mega_fwd, hipFuncAttributeMaxDynamicSharedMemorySize, LDS_BYTES) != hipSuccess) { fprintf(stderr, "kernel_launch: hipFuncSetAttribute failed\n"); grid = -1; return; }
        if (hipOccupancyMaxActiveBlocksPerMultiprocessor(&per_cu, (const void*)mega_fwd, 512, LDS_BYTES) != hipSuccess || per_cu < 1) { fprintf(stderr, "kernel_launch: occupancy query says %d\n", per_cu); per_cu = 1; }
        (void)hipGetLastError();
        grid = cus * (per_cu > 1 ? 1 : per_cu);
    }
    if (grid < 0) return;
    Params p{};
    for (int i = 0; i < 27; ++i) p.in[i] = (const float*)d_in[i];
    p.out = (float*)d_out; p.ws = (unsigned char*)d_ws;
    void* args[] = {&p};
    hipError_t e = hipLaunchCooperativeKernel((const void*)mega_fwd, dim3(grid), dim3(512), args, LDS_BYTES, stream);
    if (e != hipSuccess) fprintf(stderr, "cooperative launch failed: %s (grid %d)\n", hipGetErrorString(e), grid);
}
```

```cpp
#include <hip/hip_runtime.h>
#include <hip/hip_cooperative_groups.h>
#include <cstdio>
#include <cstdint>
namespace cg = cooperative_groups;

#define DI __device__ __forceinline__
#define LAS __attribute__((address_space(3)))
typedef unsigned short bf16_t;
typedef short bf16x8 __attribute__((ext_vector_type(8)));
typedef short s16x4 __attribute__((ext_vector_type(4)));
typedef float f32x2 __attribute__((ext_vector_type(2)));
typedef float f32x4 __attribute__((ext_vector_type(4)));
typedef float f32x16 __attribute__((ext_vector_type(16)));
typedef unsigned u32x2 __attribute__((ext_vector_type(2)));
typedef unsigned u32x4 __attribute__((ext_vector_type(4)));
typedef __bf16 bf16x2_t __attribute__((ext_vector_type(2)));

constexpr int S = 16384, DM = 2048, FF = 5632, NIN = 10952, NP = 11008;
constexpr float EPS = 1e-6f;
constexpr int PC_Q = 0, PC_K = 512, PC_V = 1024, PC_O = 2048, PC_CQ = 3072, PC_CKV = 3456, PC_KR = 3712, PC_CX = 3776, PC_G = 4800, PC_I = 10944, PC_F = 10948;
constexpr float MQS = 0.08838834764831845f;
constexpr float AQS = 0.07216878364870322f * 1.4426950408889634f;

constexpr size_t MiB = 1u << 20;
constexpr size_t WS_TAB = 0;
constexpr size_t WS_SMALL = 4 * MiB;
constexpr size_t WS_WFFGU = 12 * MiB;
constexpr size_t WS_WFFD = 56 * MiB;
constexpr size_t WS_WIN = 78 * MiB;
constexpr size_t WS_WUQ = 121 * MiB;
constexpr size_t WS_WUKV = 123 * MiB;
constexpr size_t WS_WLRU = 124 * MiB;
constexpr size_t WS_WBR = 125 * MiB;
constexpr size_t WS_WOUT = 137 * MiB;
constexpr size_t WS_XN = 145 * MiB;
constexpr size_t WS_P = 209 * MiB;
constexpr size_t WS_Q = 553 * MiB;
constexpr size_t WS_KN = 601 * MiB;
constexpr size_t WS_VT = 633 * MiB;
constexpr size_t WS_Y = 665 * MiB;
constexpr size_t WS_XC = 761 * MiB;
constexpr size_t WS_CS = 793 * MiB;
constexpr size_t WS_END = 857 * MiB;
constexpr int SM_BT = 0, SM_MC = 1024, SM_MPREV = 2048, SM_DN = 4096  , SM_CA = 4096 + 131072  , SM_CH = SM_CA + 262144, SM_CARRY = SM_CH + 262144, SM_SP = SM_CARRY + 262144;

__device__ const float INVF[32] = {1.0f, 0.7498942613601685f, 0.5623413324356079f, 0.4216965138912201f, 0.3162277638912201f, 0.23713737726211548f, 0.17782793939113617f, 0.133352130651474f, 0.10000000149011612f, 0.07498941570520401f, 0.05623413249850273f, 0.04216965287923813f, 0.03162277489900589f, 0.023713737726211548f, 0.017782794311642647f, 0.01333521492779255f, 0.009999999776482582f, 0.007498941849917173f, 0.005623413249850273f, 0.0042169648222625256f, 0.003162277629598975f, 0.00237137358635664f, 0.0017782794311642647f, 0.0013335214462131262f, 0.0010000000474974513f, 0.0007498942431993783f, 0.000562341301701963f, 0.0004216965171508491f, 0.0003162277571391314f, 0.00023713737027719617f, 0.00017782794020604342f, 0.0001333521504420787f};

DI int opaque_tid() { int t = threadIdx.x; asm volatile("" : "+v"(t)); return t; }
DI float bf2f(bf16_t v) { return __uint_as_float((unsigned)v << 16); }
DI float bflo(unsigned w) { return __uint_as_float(w << 16); }
DI float bfhi(unsigned w) { return __uint_as_float(w & 0xffff0000u); }
DI unsigned pk2(float lo, float hi) { f32x2 v = {lo, hi}; bf16x2_t b = __builtin_convertvector(v, bf16x2_t); return __builtin_bit_cast(unsigned, b); }
DI bf16_t f2bf(float f) { return (bf16_t)(pk2(f, 0.f) & 0xffffu); }
DI float wave_sum(float v) {
#pragma unroll
    for (int o = 1; o < 64; o <<= 1) v += __shfl_xor(v, o);
    return v;
}
DI float wave_max(float v) {
#pragma unroll
    for (int o = 1; o < 64; o <<= 1) v = fmaxf(v, __shfl_xor(v, o));
    return v;
}
DI float wave_incl_scan(float v, int lane) {
#pragma unroll
    for (int o = 1; o < 64; o <<= 1) { const float n = __shfl_up(v, o); if (lane >= o) v += n; }
    return v;
}
DI float sigmoidf_(float x) { return 1.f / (1.f + __expf(-x)); }
DI float logsigmoid_(float x) { return fminf(x, 0.f) - log1pf(expf(-fabsf(x))); }
DI f32x16 mfma32(bf16x8 a, bf16x8 b, f32x16 c) { return __builtin_amdgcn_mfma_f32_32x32x16_bf16(a, b, c, 0, 0, 0); }
DI int crow(int r, int h) { return (r & 3) + 8 * (r >> 2) + 4 * h; }
DI int pi32(int m) { return (m & ~12) | ((m & 4) << 1) | ((m & 8) >> 1); }
typedef short v4i16_t __attribute__((ext_vector_type(4)));
DI s16x4 tr16(LAS const unsigned char* p) { return __builtin_bit_cast(s16x4, __builtin_amdgcn_ds_read_tr16_b64_v4i16((LAS v4i16_t*)p)); }
DI bf16x8 tr_frag(LAS const unsigned char* p, int rs) {
    const s16x4 lo = tr16(p), hi = tr16(p + 4 * rs);
    return __builtin_shufflevector(lo, hi, 0, 1, 2, 3, 4, 5, 6, 7);
}
DI bf16x8 pack8(float a0, float a1, float a2, float a3, float a4, float a5, float a6, float a7) {
    u32x4 w; w.x = pk2(a0, a1); w.y = pk2(a2, a3); w.z = pk2(a4, a5); w.w = pk2(a6, a7); return __builtin_bit_cast(bf16x8, w);
}

namespace pg8 {
constexpr int BM = 256, BK = 64, HALF = 128, HTB = HALF * BK * 2, STAGE_BYTES = 8 * HTB, NXCD = 8, WGM = 8;
DI int lds_byte(int r, int c) { const int st = (r >> 4) * 2 + (c >> 5), rr = r & 15, cc = c & 31, ob = rr * 64 + cc * 2; return st * 1024 + (ob ^ (((ob >> 9) & 1) << 5)); }
DI void stage_rc(int b, int& R, int& C) { const int st = b / 1024, sb = b % 1024, swz = sb ^ (((sb >> 9) & 1) << 5); R = (st >> 1) * 16 + swz / 64; C = (st & 1) * 32 + (swz % 64) / 2; }
DI int perm32(int rho) { const int n = rho >> 4, i = rho & 15; return 8 * (i >> 2) + 4 * n + (i & 3); }
struct Unit { int pm, pn; };
struct Gemm { const bf16_t* A; const bf16_t* Bt; int M, N, K, lda, ldb, apn; };
struct StaticOrder {
    int nM, nN, nwg, G, c;
    DI void init(int M, int N, int G_, int c_) { nM = M / BM; nN = N / BM; nwg = nM * nN; G = G_; c = c_; }
    DI bool next(int i, Unit& u) const {
        const long L = (long)i * G + c; if (L >= nwg) return false;
        int wgid = (int)L; { const int q = nwg / NXCD, r = nwg % NXCD, xcd = wgid % NXCD, off = wgid / NXCD; wgid = (xcd < r ? xcd * (q + 1) : r * (q + 1) + (xcd - r) * q) + off; }
        const int nig = WGM * nN, gid = wgid / nig, fm = gid * WGM, gsz = (nM - fm) < WGM ? (nM - fm) : WGM;
        u.pm = fm + ((wgid % nig) % gsz); u.pn = (wgid % nig) / gsz; return true;
    }
};
template <class Epi>
DI void gemm_phase(LAS unsigned char* lds, const Gemm g, const StaticOrder& S, const Epi& E) {
    const int tid = opaque_tid(), wid = __builtin_amdgcn_readfirstlane(tid >> 6), lane = tid & 63, wr = wid >> 2, wc = wid & 3, fr = lane & 15, fq = lane >> 4;
    int K = g.K; asm volatile("" : "+s"(K)); const int nt = K / BK;
    unsigned voffA[2], voffB[2];
#pragma unroll
    for (int i = 0; i < 2; ++i) { int R, C; stage_rc(tid * 16 + i * 8192, R, C); const int Rb = Epi::PERM ? ((R & ~31) + perm32(R & 31)) : R;
        voffA[i] = (unsigned)(R * g.lda + C) * 2u; voffB[i] = (unsigned)(Rb * g.ldb + C) * 2u; }
    const size_t kstep = (size_t)(BK * 2);
    const size_t hstepA = (size_t)HALF * g.lda * 2, hstepB = (size_t)HALF * g.ldb * 2;
    const unsigned ldsw = (unsigned)wid * 1024u;
    const int aoff = lds_byte(wr * 64 + fr, fq * 8), boff = lds_byte(wc * 32 + fr, fq * 8);
#define PG8_SA(b, h) (((b) * 2 + (h)) * HTB)
#define PG8_SB(b, h) ((4 + (b) * 2 + (h)) * HTB)
#define PG8_STAGE(bufoff, gbase, voff) do { _Pragma("unroll") for (int _i = 0; _i < 2; ++_i) \
        __builtin_amdgcn_global_load_lds((const unsigned*)((const char*)(gbase) + (voff)[_i]), (LAS unsigned*)(lds + (bufoff) + ldsw + _i * 8192), 16, 0, 0); } while (0)
#define PG8_LDA(dst, b, h) do { _Pragma("unroll") for (int m = 0; m < 4; ++m) _Pragma("unroll") for (int k = 0; k < 2; ++k) dst[m][k] = *(const LAS bf16x8*)(lds + PG8_SA(b, h) + aoff + m * 2048 + k * 1024); } while (0)
#define PG8_LDB(dst, b, h) do { _Pragma("unroll") for (int n = 0; n < 2; ++n) _Pragma("unroll") for (int k = 0; k < 2; ++k) dst[n][k] = *(const LAS bf16x8*)(lds + PG8_SB(b, h) + boff + n * 2048 + k * 1024); } while (0)
#define PG8_MMA(ai, bj, At, Bt) do { __builtin_amdgcn_s_setprio(1); _Pragma("unroll") for (int m = 0; m < 4; ++m) _Pragma("unroll") for (int n = 0; n < 2; ++n) _Pragma("unroll") for (int k = 0; k < 2; ++k) \
        acc[ai][bj][m][n] = __builtin_amdgcn_mfma_f32_16x16x32_bf16(Bt[n][k], At[m][k], acc[ai][bj][m][n], 0, 0, 0); __builtin_amdgcn_s_setprio(0); } while (0)
#define PG8_WAIT_V(n) asm volatile("s_waitcnt vmcnt(" #n ")" ::: "memory")
#define PG8_WAIT_L(n) asm volatile("s_waitcnt lgkmcnt(" #n ")" ::: "memory")
#define PG8_BAR __builtin_amdgcn_s_barrier()
#define PG8_SCHED __builtin_amdgcn_sched_barrier(0)
#define PG8_APTR(u) ((const char*)g.A + (size_t)(u).pm * 2 * hstepA + (size_t)(u).pn * (size_t)g.apn * 2)
#define PG8_BPTR(u) ((const char*)g.Bt + (size_t)(u).pn * 2 * hstepB)
    Unit cur, nxt; int ui = 0;
    if (!S.next(0, cur)) return;
    f32x4 acc[2][2][4][2];
#pragma unroll
    for (int a = 0; a < 2; ++a)
#pragma unroll
        for (int b = 0; b < 2; ++b)
#pragma unroll
            for (int m = 0; m < 4; ++m)
#pragma unroll
                for (int n = 0; n < 2; ++n) acc[a][b][m][n] = (f32x4){0.f, 0.f, 0.f, 0.f};
    bf16x8 At[4][2], B0[2][2], B1[2][2];
    const char* cA = PG8_APTR(cur); const char* cB = PG8_BPTR(cur);
    PG8_STAGE(PG8_SB(0, 0), cB, voffB); PG8_STAGE(PG8_SB(0, 1), cB + hstepB, voffB); PG8_STAGE(PG8_SA(0, 0), cA, voffA); PG8_STAGE(PG8_SA(0, 1), cA + hstepA, voffA);
    if (wr == 1) PG8_BAR;
    PG8_WAIT_V(2); PG8_BAR;
    PG8_STAGE(PG8_SB(1, 0), cB + kstep, voffB); PG8_STAGE(PG8_SA(1, 0), cA + kstep, voffA); PG8_STAGE(PG8_SB(1, 1), cB + hstepB + kstep, voffB);
    PG8_WAIT_V(6); PG8_BAR;
    for (;;) {
        const bool has_next = S.next(ui + 1, nxt);
        const char* nA = has_next ? PG8_APTR(nxt) : cA; const char* nB = has_next ? PG8_BPTR(nxt) : cB;
        for (int t = 0; t < nt; t += 2) {
            const bool last = (t == nt - 2);
            const char* a1 = cA + (size_t)(t + 1) * kstep;
            const char* a2 = last ? nA : cA + (size_t)(t + 2) * kstep; const char* b2 = last ? nB : cB + (size_t)(t + 2) * kstep;
            const char* a3 = a2 + kstep; const char* b3 = b2 + kstep;
            PG8_LDB(B0, 0, 0); PG8_LDB(B1, 0, 1); PG8_SCHED; PG8_LDA(At, 0, 0); PG8_STAGE(PG8_SA(1, 1), a1 + hstepA, voffA);
            PG8_WAIT_V(8); PG8_WAIT_L(0); PG8_BAR; PG8_MMA(0, 0, At, B0); PG8_MMA(0, 1, At, B1); PG8_BAR; PG8_SCHED;
            PG8_LDA(At, 0, 1); PG8_STAGE(PG8_SB(0, 0), b2, voffB); PG8_STAGE(PG8_SB(0, 1), b2 + hstepB, voffB); PG8_STAGE(PG8_SA(0, 0), a2, voffA);
            PG8_WAIT_V(8); PG8_WAIT_L(0); PG8_BAR; PG8_MMA(1, 0, At, B0); PG8_MMA(1, 1, At, B1); PG8_BAR; PG8_SCHED;
            PG8_LDB(B0, 1, 0); PG8_LDB(B1, 1, 1); PG8_SCHED; PG8_LDA(At, 1, 0); PG8_STAGE(PG8_SA(0, 1), a2 + hstepA, voffA);
            PG8_WAIT_V(8); PG8_WAIT_L(0); PG8_BAR; PG8_MMA(0, 0, At, B0); PG8_MMA(0, 1, At, B1); PG8_BAR; PG8_SCHED;
            PG8_LDA(At, 1, 1); PG8_STAGE(PG8_SB(1, 0), b3, voffB); PG8_STAGE(PG8_SB(1, 1), b3 + hstepB, voffB); PG8_STAGE(PG8_SA(1, 0), a3, voffA);
            PG8_WAIT_V(8); PG8_WAIT_L(0); PG8_BAR; PG8_MMA(1, 0, At, B0); PG8_MMA(1, 1, At, B1); PG8_BAR; PG8_SCHED;
        }
        if (wr == 0) PG8_BAR;
        E(acc, cur, wr, wc, fr, fq);
        if (!has_next) break;
#pragma unroll
        for (int a = 0; a < 2; ++a)
#pragma unroll
            for (int b = 0; b < 2; ++b)
#pragma unroll
                for (int m = 0; m < 4; ++m)
#pragma unroll
                    for (int n = 0; n < 2; ++n) acc[a][b][m][n] = (f32x4){0.f, 0.f, 0.f, 0.f};
        cur = nxt; cA = nA; cB = nB; ++ui;
        if (wr == 1) PG8_BAR;
    }
    PG8_WAIT_V(0);
    PG8_BAR;
#undef PG8_SA
#undef PG8_SB
#undef PG8_STAGE
#undef PG8_LDA
#undef PG8_LDB
#undef PG8_MMA
#undef PG8_WAIT_V
#undef PG8_WAIT_L
#undef PG8_BAR
#undef PG8_SCHED
#undef PG8_APTR
#undef PG8_BPTR
}

typedef f32x4 Acc[2][2][4][2];
struct EpiStore {
    static constexpr bool PERM = true;
    bf16_t* O; int ldc;
    DI void operator()(const Acc& acc, const Unit& u, int wr, int wc, int fr, int fq) const {
        const int row0 = u.pm * BM + wr * 64 + fr, col0 = u.pn * BM + wc * 32 + 8 * fq;
#pragma unroll
        for (int ai = 0; ai < 2; ++ai)
#pragma unroll
            for (int m = 0; m < 4; ++m) { bf16_t* rowp = O + (size_t)(row0 + ai * HALF + m * 16) * ldc + col0;
#pragma unroll
                for (int bj = 0; bj < 2; ++bj) { const f32x4 v0 = acc[ai][bj][m][0], v1 = acc[ai][bj][m][1];
                    u32x4 w; w.x = pk2(v0[0], v0[1]); w.y = pk2(v0[2], v0[3]); w.z = pk2(v1[0], v1[1]); w.w = pk2(v1[2], v1[3]);
                    *(u32x4*)(rowp + bj * HALF) = w; } }
    }
};
struct EpiSwiglu {
    static constexpr bool PERM = true;
    bf16_t* H;
    DI void operator()(const Acc& acc, const Unit& u, int wr, int wc, int fr, int fq) const {
        const int row0 = u.pm * BM + wr * 64 + fr, col0 = u.pn * HALF + wc * 32 + 8 * fq;
#pragma unroll
        for (int ai = 0; ai < 2; ++ai)
#pragma unroll
            for (int m = 0; m < 4; ++m) { bf16_t* rowp = H + (size_t)(row0 + ai * HALF + m * 16) * FF + col0;
                float o[8];
#pragma unroll
                for (int n = 0; n < 2; ++n)
#pragma unroll
                    for (int j = 0; j < 4; ++j) { const float gt = acc[ai][0][m][n][j], up = acc[ai][1][m][n][j]; o[n * 4 + j] = gt * sigmoidf_(gt) * up; }
                u32x4 w; w.x = pk2(o[0], o[1]); w.y = pk2(o[2], o[3]); w.z = pk2(o[4], o[5]); w.w = pk2(o[6], o[7]);
                *(u32x4*)rowp = w; }
    }
};
struct EpiRes {
    static constexpr bool PERM = false;
    const float* xin; float* xout; float alpha;
    DI void operator()(const Acc& acc, const Unit& u, int wr, int wc, int fr, int fq) const {
        const int col0 = u.pn * BM + wc * 32 + 4 * fq;
#pragma unroll
        for (int ai = 0; ai < 2; ++ai)
#pragma unroll
            for (int m = 0; m < 4; ++m) { const size_t off = (size_t)(u.pm * BM + ai * HALF + wr * 64 + m * 16 + fr) * DM + col0;
#pragma unroll
                for (int bj = 0; bj < 2; ++bj)
#pragma unroll
                    for (int n = 0; n < 2; ++n) { const f32x4 b = *(const f32x4*)(xin + off + bj * HALF + n * 16); *(f32x4*)(xout + off + bj * HALF + n * 16) = b + acc[ai][bj][m][n] * alpha; } }
    }
};
struct EpiQ {
    static constexpr bool PERM = true;
    bf16_t* Q; const f32x2* tab;
    DI void operator()(const Acc& acc, const Unit& u, int wr, int wc, int fr, int fq) const {
        const int row0 = u.pm * BM + wr * 64 + fr;
#pragma unroll
        for (int bj = 0; bj < 2; ++bj) {
            const int c0 = u.pn * BM + bj * HALF + wc * 32 + 8 * fq; const int hh = c0 / 192, dd = c0 - hh * 192; const bool rope = dd >= 128; const int j0 = (dd - 128) >> 1;
#pragma unroll
            for (int ai = 0; ai < 2; ++ai)
#pragma unroll
                for (int m = 0; m < 4; ++m) { const int row = row0 + ai * HALF + m * 16;
                    float v[8];
#pragma unroll
                    for (int n = 0; n < 2; ++n)
#pragma unroll
                        for (int j = 0; j < 4; ++j) v[n * 4 + j] = acc[ai][bj][m][n][j];
                    if (rope) {
#pragma unroll
                        for (int p = 0; p < 4; ++p) { const f32x2 cs = tab[(size_t)row * 32 + j0 + p]; const float x1 = v[2 * p], x2 = v[2 * p + 1]; v[2 * p] = x1 * cs.x - x2 * cs.y; v[2 * p + 1] = x1 * cs.y + x2 * cs.x; }
                    }
                    u32x4 w; w.x = pk2(v[0] * AQS, v[1] * AQS); w.y = pk2(v[2] * AQS, v[3] * AQS); w.z = pk2(v[4] * AQS, v[5] * AQS); w.w = pk2(v[6] * AQS, v[7] * AQS);
                    *(u32x4*)(Q + (size_t)row * 1536 + c0) = w; }
        }
    }
};
struct EpiLru {
    static constexpr bool PERM = true;
    bf16_t* XC; bf16_t* LA; const float* ba; const float* bx; const float* sp;
    DI void operator()(const Acc& acc, const Unit& u, int wr, int wc, int fr, int fq) const {
        const int row0 = u.pm * BM + wr * 64 + fr, ch0 = u.pn * HALF + wc * 32 + 8 * fq;
#pragma unroll
        for (int ai = 0; ai < 2; ++ai)
#pragma unroll
            for (int m = 0; m < 4; ++m) { const int row = row0 + ai * HALF + m * 16;
                const u32x4 xw = *(const u32x4*)(XC + (size_t)row * 1024 + ch0);
                const float xv[8] = {bflo(xw.x), bfhi(xw.x), bflo(xw.y), bfhi(xw.y), bflo(xw.z), bfhi(xw.z), bflo(xw.w), bfhi(xw.w)};
                u32x4 wl, wu;
#pragma unroll
                for (int n = 0; n < 2; ++n) { const f32x4 spv = *(const f32x4*)(sp + ch0 + 4 * n), bav = *(const f32x4*)(ba + ch0 + 4 * n), bxv = *(const f32x4*)(bx + ch0 + 4 * n);
                    float la[4], uu[4];
#pragma unroll
                    for (int j = 0; j < 4; ++j) { const float r = sigmoidf_(acc[ai][0][m][n][j] + bav[j]), gi = sigmoidf_(acc[ai][1][m][n][j] + bxv[j]);
                        const float l = r * spv[j]; la[j] = l; const float a2 = __expf(2.f * l); uu[j] = sqrtf(fmaxf(1.f - a2, 0.f)) * gi * xv[n * 4 + j]; }
                    if (n == 0) { wl.x = pk2(la[0], la[1]); wl.y = pk2(la[2], la[3]); wu.x = pk2(uu[0], uu[1]); wu.y = pk2(uu[2], uu[3]); }
                    else { wl.z = pk2(la[0], la[1]); wl.w = pk2(la[2], la[3]); wu.z = pk2(uu[0], uu[1]); wu.w = pk2(uu[2], uu[3]); } }
                *(u32x4*)(LA + (size_t)row * NP + ch0) = wl;
                *(u32x4*)(XC + (size_t)row * 1024 + ch0) = wu;
                asm volatile("" ::: "memory"); }
    }
};
struct EpiMerge {
    static constexpr bool PERM = true;
    bf16_t* Z; const bf16_t* G; int first;
    DI void operator()(const Acc& acc, const Unit& u, int wr, int wc, int fr, int fq) const {
        const int row0 = u.pm * BM + wr * 64 + fr, col0 = u.pn * BM + wc * 32 + 8 * fq;
#pragma unroll
        for (int ai = 0; ai < 2; ++ai)
#pragma unroll
            for (int m = 0; m < 4; ++m) { const int row = row0 + ai * HALF + m * 16;
#pragma unroll
                for (int bj = 0; bj < 2; ++bj) { const int c = col0 + bj * HALF;
                    const u32x4 gw = *(const u32x4*)(G + (size_t)row * NP + c);
                    const float gv[8] = {bflo(gw.x), bfhi(gw.x), bflo(gw.y), bfhi(gw.y), bflo(gw.z), bfhi(gw.z), bflo(gw.w), bfhi(gw.w)};
                    float o[8];
#pragma unroll
                    for (int n = 0; n < 2; ++n)
#pragma unroll
                        for (int j = 0; j < 4; ++j) o[n * 4 + j] = sigmoidf_(gv[n * 4 + j]) * acc[ai][bj][m][n][j];
                    bf16_t* zp = Z + (size_t)row * DM + c;
                    if (!first) { const u32x4 zw = *(const u32x4*)zp; o[0] += bflo(zw.x); o[1] += bfhi(zw.x); o[2] += bflo(zw.y); o[3] += bfhi(zw.y); o[4] += bflo(zw.z); o[5] += bfhi(zw.z); o[6] += bflo(zw.w); o[7] += bfhi(zw.w); }
                    u32x4 w; w.x = pk2(o[0], o[1]); w.y = pk2(o[2], o[3]); w.z = pk2(o[4], o[5]); w.w = pk2(o[6], o[7]);
                    *(u32x4*)zp = w; } }
    }
};
}

DI int map_row(int map, int n) {
    switch (map) {
        case 1: return ((n >> 7) << 8) + (n & 127);
        case 2: return ((n >> 7) << 8) + 128 + (n & 127);
        case 3: { if (n < 2048) return n; if (n < 2052) return PC_I + n - 2048; if (n < 2056) return PC_F + n - 2052; if (n < 3080) return PC_O + n - 2056; if (n < 3464) return PC_CQ + n - 3080;
                  if (n < 3720) return PC_CKV + n - 3464; if (n < 3784) return PC_KR + n - 3720; if (n < 4808) return PC_CX + n - 3784; return PC_G + n - 4808; }
        case 4: { const int hh = n / 192, dd = n - hh * 192; if (dd < 128) return n; const int jj = dd - 128; return hh * 192 + 128 + (jj < 32 ? 2 * jj : 2 * (jj - 32) + 1); }
        case 5: { const int hh = n >> 8, dd = n & 255; return dd < 128 ? hh * 128 + dd : 1024 + hh * 128 + dd - 128; }
        default: return n;
    }
}
DI void convert_mat(const float* W, int K, int N, bf16_t* WT, int map, int& rot) {
    const int tid_ = opaque_tid(), lane = tid_ & 63, gw = blockIdx.x * 8 + (tid_ >> 6), ngw = gridDim.x * 8;
    const int nch = (N + 255) >> 8, nkb = K >> 5, nitems = nch * nkb;
    int it = gw - rot; if (it < 0) it += ngw;
    for (; it < nitems; it += ngw) {
        const int nc = it / nkb, kb = it - nc * nkb, n0 = nc * 256 + lane * 4, k0 = kb * 32;
        if (n0 < N) {
            const float* src = W + (size_t)k0 * N + n0;
            bf16_t* d0 = WT + (size_t)map_row(map, n0) * K + k0; bf16_t* d1 = WT + (size_t)map_row(map, n0 + 1) * K + k0;
            bf16_t* d2 = WT + (size_t)map_row(map, n0 + 2) * K + k0; bf16_t* d3 = WT + (size_t)map_row(map, n0 + 3) * K + k0;
#pragma unroll 2
            for (int kk = 0; kk < 4; ++kk) {
                f32x4 v[8];
#pragma unroll
                for (int i = 0; i < 8; ++i) v[i] = *(const f32x4*)(src + (size_t)(kk * 8 + i) * N);
                u32x4 o;
                o.x = pk2(v[0].x, v[1].x); o.y = pk2(v[2].x, v[3].x); o.z = pk2(v[4].x, v[5].x); o.w = pk2(v[6].x, v[7].x); *(u32x4*)(d0 + kk * 8) = o;
                o.x = pk2(v[0].y, v[1].y); o.y = pk2(v[2].y, v[3].y); o.z = pk2(v[4].y, v[5].y); o.w = pk2(v[6].y, v[7].y); *(u32x4*)(d1 + kk * 8) = o;
                o.x = pk2(v[0].z, v[1].z); o.y = pk2(v[2].z, v[3].z); o.z = pk2(v[4].z, v[5].z); o.w = pk2(v[6].z, v[7].z); *(u32x4*)(d2 + kk * 8) = o;
                o.x = pk2(v[0].w, v[1].w); o.y = pk2(v[2].w, v[3].w); o.z = pk2(v[4].w, v[5].w); o.w = pk2(v[6].w, v[7].w); *(u32x4*)(d3 + kk * 8) = o;
            }
        }
    }
    rot = (rot + nitems) % ngw;
}

DI void rmsnorm_rows(const float* X, const float* g, bf16_t* O) {
    const int tid_ = opaque_tid(), lane = tid_ & 63, gw = blockIdx.x * 8 + (tid_ >> 6), ngw = gridDim.x * 8;
    for (int r = gw; r < S; r += ngw) {
        const f32x4* xr = (const f32x4*)(X + (size_t)r * DM) + lane; f32x4 v[8]; float s = 0.f;
#pragma unroll
        for (int j = 0; j < 8; ++j) { v[j] = xr[64 * j]; s += (v[j].x * v[j].x + v[j].y * v[j].y) + (v[j].z * v[j].z + v[j].w * v[j].w); }
        const float rstd = 1.f / sqrtf(wave_sum(s) * (1.f / DM) + EPS);
        u32x2* o8 = (u32x2*)(O + (size_t)r * DM) + lane;
#pragma unroll
        for (int j = 0; j < 8; ++j) { const f32x4 gv = ((const f32x4*)g)[lane + 64 * j]; u32x2 w; w.x = pk2(v[j].x * rstd * gv.x, v[j].y * rstd * gv.y); w.y = pk2(v[j].z * rstd * gv.z, v[j].w * rstd * gv.w); o8[64 * j] = w; }
    }
}
DI void final_norm_rows(float* X, const float* g) {
    const int tid_ = opaque_tid(), lane = tid_ & 63, gw = blockIdx.x * 8 + (tid_ >> 6), ngw = gridDim.x * 8;
    for (int r = gw; r < S; r += ngw) {
        f32x4* xr = (f32x4*)(X + (size_t)r * DM) + lane; f32x4 v[8]; float s = 0.f;
#pragma unroll
        for (int j = 0; j < 8; ++j) { v[j] = xr[64 * j]; s += (v[j].x * v[j].x + v[j].y * v[j].y) + (v[j].z * v[j].z + v[j].w * v[j].w); }
        const float rstd = 1.f / sqrtf(wave_sum(s) * (1.f / DM) + EPS);
#pragma unroll
        for (int j = 0; j < 8; ++j) { const f32x4 gv = ((const f32x4*)g)[lane + 64 * j]; xr[64 * j] = v[j] * rstd * gv; }
    }
}
DI void prep_rows(bf16_t* P, const float* qn, const float* kvn, const float* cw, const float* cb, const f32x2* tab, bf16_t* XC) {
    const int tid_ = opaque_tid(), lane = tid_ & 63, gw = blockIdx.x * 8 + (tid_ >> 6), ngw = gridDim.x * 8;
    for (int t = gw; t < S; t += ngw) {
        bf16_t* row = P + (size_t)t * NP;
        { unsigned w[3]; float s = 0.f;
#pragma unroll
          for (int k = 0; k < 3; ++k) { w[k] = *(const unsigned*)(row + PC_CQ + 128 * k + 2 * lane); const float a = bflo(w[k]), b = bfhi(w[k]); s += a * a + b * b; }
          const float rstd = 1.f / sqrtf(wave_sum(s) * (1.f / 384.f) + EPS);
#pragma unroll
          for (int k = 0; k < 3; ++k) { const int c = 128 * k + 2 * lane; *(unsigned*)(row + PC_CQ + c) = pk2(bflo(w[k]) * rstd * qn[c], bfhi(w[k]) * rstd * qn[c + 1]); } }
        { unsigned w[2]; float s = 0.f;
#pragma unroll
          for (int k = 0; k < 2; ++k) { w[k] = *(const unsigned*)(row + PC_CKV + 128 * k + 2 * lane); const float a = bflo(w[k]), b = bfhi(w[k]); s += a * a + b * b; }
          const float rstd = 1.f / sqrtf(wave_sum(s) * (1.f / 256.f) + EPS);
#pragma unroll
          for (int k = 0; k < 2; ++k) { const int c = 128 * k + 2 * lane; *(unsigned*)(row + PC_CKV + c) = pk2(bflo(w[k]) * rstd * kvn[c], bfhi(w[k]) * rstd * kvn[c + 1]); } }
        { const int j = lane & 31; const float x1 = bf2f(row[PC_KR + j]), x2 = bf2f(row[PC_KR + 32 + j]); const f32x2 cs = tab[(size_t)t * 32 + j];
          const unsigned o = pk2(x1 * cs.x - x2 * cs.y, x1 * cs.y + x2 * cs.x);
          asm volatile("" ::: "memory");
          if (lane < 32) *(unsigned*)(row + PC_KR + 2 * j) = o; }
#pragma unroll
        for (int k = 0; k < 8; ++k) { const int ch = 128 * k + 2 * lane; float a0 = cb[ch], a1 = cb[ch + 1];
#pragma unroll
            for (int j = 0; j < 4; ++j) { const int tt = t - 3 + j; if (tt >= 0) { const unsigned w = *(const unsigned*)(P + (size_t)tt * NP + PC_CX + ch); a0 += cw[j * 1024 + ch] * bflo(w); a1 += cw[j * 1024 + ch + 1] * bfhi(w); } }
            *(unsigned*)(XC + (size_t)t * 1024 + ch) = pk2(a0, a1); }
    }
}

DI void lru_p1(const bf16_t* LA, const bf16_t* U, float* CA, float* CH) {
    const int tid = opaque_tid();
    for (int c = blockIdx.x; c < 256; c += gridDim.x) {
        float h0 = 0.f, h1 = 0.f, s0 = 0.f, s1 = 0.f;
#pragma unroll 8
        for (int t = 0; t < 64; ++t) { const size_t row = (size_t)c * 64 + t; const unsigned lw = *(const unsigned*)(LA + row * NP + 2 * tid), uw = *(const unsigned*)(U + row * 1024 + 2 * tid);
            const float l0 = bflo(lw), l1 = bfhi(lw); s0 += l0; s1 += l1; h0 = __expf(l0) * h0 + bflo(uw); h1 = __expf(l1) * h1 + bfhi(uw); }
        CA[c * 1024 + 2 * tid] = __expf(s0); CA[c * 1024 + 2 * tid + 1] = __expf(s1); CH[c * 1024 + 2 * tid] = h0; CH[c * 1024 + 2 * tid + 1] = h1;
    }
}
DI void lru_p2(const float* CA, const float* CH, float* CARRY) {
    const int tid = opaque_tid(), lane = tid & 63, gw = blockIdx.x * 8 + (tid >> 6), ngw = gridDim.x * 8;
    for (int ch = gw; ch < 1024; ch += ngw) {
        float a[4], hh[4];
#pragma unroll
        for (int i = 0; i < 4; ++i) { a[i] = CA[(4 * lane + i) * 1024 + ch]; hh[i] = CH[(4 * lane + i) * 1024 + ch]; }
        float A = a[0], H = hh[0];
#pragma unroll
        for (int i = 1; i < 4; ++i) { H = a[i] * H + hh[i]; A = A * a[i]; }
#pragma unroll
        for (int o = 1; o < 64; o <<= 1) { const float Ap = __shfl_up(A, o), Hp = __shfl_up(H, o); if (lane >= o) { H = A * Hp + H; A = A * Ap; } }
        float st = __shfl_up(H, 1); if (lane == 0) st = 0.f;
#pragma unroll
        for (int i = 0; i < 4; ++i) { CARRY[(4 * lane + i) * 1024 + ch] = st; st = a[i] * st + hh[i]; }
    }
}
DI void lru_p3(const bf16_t* LA, const bf16_t* U, const float* CARRY, bf16_t* Y) {
    const int tid = opaque_tid();
    for (int c = blockIdx.x; c < 256; c += gridDim.x) {
        float h0 = CARRY[c * 1024 + 2 * tid], h1 = CARRY[c * 1024 + 2 * tid + 1];
#pragma unroll 8
        for (int t = 0; t < 64; ++t) { const size_t row = (size_t)c * 64 + t; const unsigned lw = *(const unsigned*)(LA + row * NP + 2 * tid), uw = *(const unsigned*)(U + row * 1024 + 2 * tid);
            h0 = __expf(bflo(lw)) * h0 + bflo(uw); h1 = __expf(bfhi(lw)) * h1 + bfhi(uw);
            *(unsigned*)(Y + row * 3072 + 2048 + 2 * tid) = pk2(h0, h1); }
    }
}

DI void mlstm_a(LAS unsigned char* smem, const bf16_t* P, const float* gbias, bf16_t* CS, float* SMALL) {
    const int tid = opaque_tid(), lane = tid & 63, wid = tid >> 6, l31 = lane & 31, h = lane >> 5, q4 = (lane & 15) >> 2, p4 = lane & 3, blk = (lane >> 4) & 1;
    LAS float* sw = (LAS float*)smem;
    LAS unsigned char* Ks = smem + 1024;
    LAS unsigned char* Vs = smem + 1024 + 20480;
    for (int uid = blockIdx.x; uid < 1024; uid += gridDim.x) {
        const int c = uid >> 2, hh = uid & 3; const size_t row0 = (size_t)c * 64;
        if (wid == 0) {
            const bf16_t* r = P + (row0 + lane) * NP;
            const float li = bf2f(r[PC_I + hh]) + gbias[hh], lf = logsigmoid_(bf2f(r[PC_F + hh]) + gbias[4 + hh]);
            const float bc = wave_incl_scan(lf, lane), bt = __shfl(bc, 63), ds = bt - bc + li, M = wave_max(ds);
            sw[lane] = expf(ds - M);
            if (lane == 0) { SMALL[SM_BT + uid] = bt; SMALL[SM_MC + uid] = M; }
        }
        __syncthreads();
#pragma unroll
        for (int i = 0; i < 2; ++i) { const int id = tid + 512 * i, s = id >> 4, d8 = (id & 15) * 8; const u32x4 v = *(const u32x4*)(P + (row0 + s) * NP + PC_K + hh * 128 + d8); const float w = sw[s];
            u32x4 o; o.x = pk2(bflo(v.x) * w, bfhi(v.x) * w); o.y = pk2(bflo(v.y) * w, bfhi(v.y) * w); o.z = pk2(bflo(v.z) * w, bfhi(v.z) * w); o.w = pk2(bflo(v.w) * w, bfhi(v.w) * w);
            *(LAS u32x4*)(Ks + s * 320 + d8 * 2) = o; }
#pragma unroll
        for (int i = 0; i < 4; ++i) { const int id = tid + 512 * i, s = id >> 5, d8 = (id & 31) * 8; *(LAS u32x4*)(Vs + s * 576 + d8 * 2) = *(const u32x4*)(P + (row0 + s) * NP + PC_V + hh * 256 + d8); }
        __syncthreads();
        f32x16 acc[4];
#pragma unroll
        for (int d = 0; d < 4; ++d)
#pragma unroll
            for (int i = 0; i < 16; ++i) acc[d][i] = 0.f;
#pragma unroll
        for (int kk = 0; kk < 4; ++kk) {
            const bf16x8 vf = tr_frag(Vs + (16 * kk + 8 * h + q4) * 576 + (32 * wid + 16 * blk) * 2 + 8 * p4, 576);
#pragma unroll
            for (int d = 0; d < 4; ++d) { const bf16x8 kf = tr_frag(Ks + (16 * kk + 8 * h + q4) * 320 + (32 * d + 16 * blk) * 2 + 8 * p4, 320); acc[d] = mfma32(kf, vf, acc[d]); }
        }
        bf16_t* cs = CS + (size_t)uid * 32768 + (32 * wid + l31) * 128;
#pragma unroll
        for (int d = 0; d < 4; ++d)
#pragma unroll
            for (int g = 0; g < 4; ++g) { u32x2 w; w.x = pk2(acc[d][4 * g], acc[d][4 * g + 1]); w.y = pk2(acc[d][4 * g + 2], acc[d][4 * g + 3]); *(u32x2*)(cs + 32 * d + 8 * g + 4 * h) = w; }
        if (tid < 128) { float s = 0.f;
#pragma unroll 8
            for (int t = 0; t < 64; ++t) s += bf2f(*(LAS const bf16_t*)(Ks + t * 320 + tid * 2));
            SMALL[SM_DN + uid * 128 + tid] = s; }
        __syncthreads();
    }
}
DI void mlstm_b(LAS unsigned char* smem, bf16_t* CS, float* SMALL) {
    const int tid = opaque_tid();
    LAS float* dec = (LAS float*)smem; LAS float* inj = dec + 1024;
    LAS float* sbt = inj + 1024; LAS float* smc = sbt + 1024;
    sbt[tid] = SMALL[SM_BT + tid]; sbt[tid + 512] = SMALL[SM_BT + tid + 512]; smc[tid] = SMALL[SM_MC + tid]; smc[tid + 512] = SMALL[SM_MC + tid + 512];
    __syncthreads();
    if (tid < 4) { float m = -1e30f;
        for (int c = 0; c < 256; ++c) { const float bt = sbt[c * 4 + tid], M = smc[c * 4 + tid]; sbt[c * 4 + tid] = m;
            const float mn = fmaxf(bt + m, M); dec[tid * 256 + c] = __expf(bt + m - mn); inj[tid * 256 + c] = __expf(M - mn); m = mn; } }
    __syncthreads();
    if (blockIdx.x == 0) { SMALL[SM_MPREV + tid] = sbt[tid]; SMALL[SM_MPREV + tid + 512] = sbt[tid + 512]; }
    for (int e = blockIdx.x * 512 + tid; e < 131072; e += gridDim.x * 512) {
        const int hh = e >> 15, idx = e & 32767; bf16_t* pp = CS + (size_t)hh * 32768 + idx; float st = 0.f;
#pragma unroll 8
        for (int c = 0; c < 256; ++c) { const float d = bf2f(pp[(size_t)c * 131072]); pp[(size_t)c * 131072] = f2bf(st); st = dec[hh * 256 + c] * st + inj[hh * 256 + c] * d; }
    }
    if (blockIdx.x == gridDim.x - 1) { const int hh = tid >> 7; float* pp = SMALL + SM_DN + tid; float st = 0.f;
#pragma unroll 8
        for (int c = 0; c < 256; ++c) { const float d = pp[c * 512]; pp[c * 512] = st; st = dec[hh * 256 + c] * st + inj[hh * 256 + c] * d; } }
    __syncthreads();
}
DI void mlstm_c(LAS unsigned char* smem, const bf16_t* P, const float* gbias, const float* onorm, const bf16_t* CS, const float* SMALL, bf16_t* Y) {
    const int tid = opaque_tid(), lane = tid & 63, wid = tid >> 6, l31 = lane & 31, h = lane >> 5, q4 = (lane & 15) >> 2, p4 = lane & 3, blk = (lane >> 4) & 1;
    LAS float* sbc = (LAS float*)smem; LAS float* sav = sbc + 64; LAS float* snp = sbc + 128; LAS float* sx = sbc + 256;
    LAS unsigned char* Qs = smem + 2048;
    LAS unsigned char* Ks = Qs + 17408;
    LAS unsigned char* Vs = Ks + 17408;
    const int tb = wid & 1, dvq = wid >> 1, t = 32 * tb + l31, pr = pi32(l31);
    for (int uid = blockIdx.x; uid < 1024; uid += gridDim.x) {
        const int c = uid >> 2, hh = uid & 3; const size_t row0 = (size_t)c * 64;
        if (wid == 0) {
            const bf16_t* r = P + (row0 + lane) * NP;
            const float li = bf2f(r[PC_I + hh]) + gbias[hh], lf = logsigmoid_(bf2f(r[PC_F + hh]) + gbias[4 + hh]);
            const float bc = wave_incl_scan(lf, lane);
            sbc[lane] = bc; sav[lane] = li - bc;
        }
        if (tid >= 64 && tid < 192) snp[tid - 64] = SMALL[SM_DN + uid * 128 + tid - 64];
#pragma unroll
        for (int i = 0; i < 2; ++i) { const int id = tid + 512 * i, s = id >> 4, d8 = (id & 15) * 8;
            *(LAS u32x4*)(Qs + s * 272 + d8 * 2) = *(const u32x4*)(P + (row0 + s) * NP + PC_Q + hh * 128 + d8);
            *(LAS u32x4*)(Ks + s * 272 + d8 * 2) = *(const u32x4*)(P + (row0 + s) * NP + PC_K + hh * 128 + d8); }
#pragma unroll
        for (int i = 0; i < 4; ++i) { const int id = tid + 512 * i, s = id >> 5, d8 = (id & 31) * 8; *(LAS u32x4*)(Vs + s * 576 + d8 * 2) = *(const u32x4*)(P + (row0 + s) * NP + PC_V + hh * 256 + d8); }
        __syncthreads();
        const float mprev = SMALL[SM_MPREV + uid];
        bf16x8 qf[8];
#pragma unroll
        for (int ks = 0; ks < 8; ++ks) qf[ks] = *(const LAS bf16x8*)(Qs + t * 272 + (16 * ks + 8 * h) * 2);
        f32x16 st0, st1;
#pragma unroll
        for (int i = 0; i < 16; ++i) { st0[i] = 0.f; st1[i] = 0.f; }
#pragma unroll
        for (int ks = 0; ks < 8; ++ks) { const bf16x8 a0 = *(const LAS bf16x8*)(Ks + pr * 272 + (16 * ks + 8 * h) * 2); st0 = mfma32(a0, qf[ks], st0);
            if (tb) { const bf16x8 a1 = *(const LAS bf16x8*)(Ks + (32 + pr) * 272 + (16 * ks + 8 * h) * 2); st1 = mfma32(a1, qf[ks], st1); } }
        const float bt = sbc[t];
        float mx = -1e30f;
#pragma unroll
        for (int i = 0; i < 16; ++i) { const int s = 16 * (i >> 3) + 8 * h + (i & 7); if (s <= t) mx = fmaxf(mx, sav[s]); if (tb) mx = fmaxf(mx, (s + 32 <= t) ? sav[s + 32] : -1e30f); }
        mx = fmaxf(mx, __shfl_xor(mx, 32));
        const float mt = bt + fmaxf(mprev, mx);
        float den = 0.f;
#pragma unroll
        for (int i = 0; i < 16; ++i) { const int s = 16 * (i >> 3) + 8 * h + (i & 7);
            const float w0 = (s <= t) ? expf(bt + sav[s] - mt) * MQS : 0.f; st0[i] *= w0; den += st0[i];
            const float w1 = (tb && (s + 32 <= t)) ? expf(bt + sav[s + 32] - mt) * MQS : 0.f; st1[i] *= w1; den += st1[i]; }
        den += __shfl_xor(den, 32);
        float qn = 0.f;
#pragma unroll
        for (int ks = 0; ks < 8; ++ks)
#pragma unroll
            for (int j = 0; j < 8; ++j) qn += bf2f((bf16_t)qf[ks][j]) * snp[16 * ks + 8 * h + j];
        qn += __shfl_xor(qn, 32);
        const float wi = expf(bt + mprev - mt) * MQS;
        den += wi * qn;
        const float dinv = 1.f / fmaxf(fabsf(den), expf(-mt));
        bf16x8 pf[4];
        pf[0] = pack8(st0[0], st0[1], st0[2], st0[3], st0[4], st0[5], st0[6], st0[7]); pf[1] = pack8(st0[8], st0[9], st0[10], st0[11], st0[12], st0[13], st0[14], st0[15]);
        pf[2] = pack8(st1[0], st1[1], st1[2], st1[3], st1[4], st1[5], st1[6], st1[7]); pf[3] = pack8(st1[8], st1[9], st1[10], st1[11], st1[12], st1[13], st1[14], st1[15]);
        float hv[2][16]; float ss = 0.f;
#pragma unroll
        for (int db = 0; db < 2; ++db) { const int dvb = 2 * dvq + db;
            f32x16 a1, a2;
#pragma unroll
            for (int i = 0; i < 16; ++i) { a1[i] = 0.f; a2[i] = 0.f; }
#pragma unroll
            for (int sb = 0; sb < 2; ++sb)
#pragma unroll
                for (int kk = 0; kk < 2; ++kk) { if (sb <= tb) { const bf16x8 vf = tr_frag(Vs + (32 * sb + 16 * kk + 8 * h + q4) * 576 + (32 * dvb + 16 * blk) * 2 + 8 * p4, 576); a1 = mfma32(vf, pf[2 * sb + kk], a1); } }
            const bf16_t* cp = CS + (size_t)uid * 32768 + (32 * dvb + l31) * 128 + 8 * h;
#pragma unroll
            for (int ks = 0; ks < 8; ++ks) { const bf16x8 cf = *(const bf16x8*)(cp + 16 * ks); a2 = mfma32(cf, qf[ks], a2); }
#pragma unroll
            for (int i = 0; i < 16; ++i) { const float v = (a1[i] + wi * a2[i]) * dinv; hv[db][i] = v; ss += v * v; }
        }
        ss += __shfl_xor(ss, 32);
        if (h == 0) sx[(tb * 4 + dvq) * 32 + l31] = ss;
        __syncthreads();
        const float tot = (sx[(tb * 4 + 0) * 32 + l31] + sx[(tb * 4 + 1) * 32 + l31]) + (sx[(tb * 4 + 2) * 32 + l31] + sx[(tb * 4 + 3) * 32 + l31]);
        const float rstd = 1.f / sqrtf(tot * (1.f / 256.f) + EPS);
#pragma unroll
        for (int db = 0; db < 2; ++db)
#pragma unroll
            for (int g = 0; g < 4; ++g) { const int col = hh * 256 + 32 * (2 * dvq + db) + 8 * g + 4 * h;
                const f32x4 gn = *(const f32x4*)(onorm + col); const u32x2 og = *(const u32x2*)(P + (row0 + t) * NP + PC_O + col);
                const float o0 = hv[db][4 * g] * rstd * gn.x * sigmoidf_(bflo(og.x)), o1 = hv[db][4 * g + 1] * rstd * gn.y * sigmoidf_(bfhi(og.x));
                const float o2 = hv[db][4 * g + 2] * rstd * gn.z * sigmoidf_(bflo(og.y)), o3 = hv[db][4 * g + 3] * rstd * gn.w * sigmoidf_(bfhi(og.y));
                u32x2 w; w.x = pk2(o0, o1); w.y = pk2(o2, o3); *(u32x2*)(Y + (row0 + t) * 3072 + col) = w; }
        __syncthreads();
    }
}

DI void attn_unit(LAS unsigned char* smem, int hh, int qb, const bf16_t* Q, const bf16_t* KN, const bf16_t* P, const bf16_t* VT, bf16_t* Y) {
    const int tid = opaque_tid(), lane = tid & 63, wid = __builtin_amdgcn_readfirstlane(tid >> 6), l31 = lane & 31, h = lane >> 5;
    LAS unsigned char* Kb = smem; LAS unsigned char* Vb = smem + 51200;
    const int q0 = qb * 256, qw = q0 + 32 * wid, q = qw + l31, NT = 4 * qb + 4;
    bf16x8 qf[12];
#pragma unroll
    for (int ks = 0; ks < 12; ++ks) qf[ks] = *(const bf16x8*)(Q + (size_t)q * 1536 + hh * 192 + 16 * ks + 8 * h);
    f32x16 o[4];
#pragma unroll
    for (int d = 0; d < 4; ++d)
#pragma unroll
        for (int i = 0; i < 16; ++i) o[d][i] = 0.f;
    float mrun = -1e30f, lrun = 0.f;
    const bf16_t* ksrc[3]; size_t kstr[3]; int kdst[3];
#pragma unroll
    for (int i = 0; i < 3; ++i) { const int id = tid + 512 * i, row = id / 24, ch = id - row * 24;
        if (ch < 16) { ksrc[i] = KN + (size_t)row * 1024 + hh * 128 + 8 * ch; kstr[i] = (size_t)64 * 1024; } else { ksrc[i] = P + (size_t)row * NP + PC_KR + 8 * (ch - 16); kstr[i] = (size_t)64 * NP; }
        kdst[i] = row * 400 + ch * 16; }
    const bf16_t* vsrc[2]; int vdst[2];
#pragma unroll
    for (int i = 0; i < 2; ++i) { const int id = tid + 512 * i, d = id >> 3, ch = id & 7; vsrc[i] = VT + (size_t)(hh * 128 + d) * S + 8 * ch; vdst[i] = d * 144 + ch * 16; }
    u32x4 kr[3], vr[2];
#pragma unroll
    for (int i = 0; i < 3; ++i) kr[i] = *(const u32x4*)(ksrc[i]);
#pragma unroll
    for (int i = 0; i < 2; ++i) vr[i] = *(const u32x4*)(vsrc[i]);
#pragma unroll
    for (int i = 0; i < 3; ++i) *(LAS u32x4*)(Kb + kdst[i]) = kr[i];
#pragma unroll
    for (int i = 0; i < 2; ++i) *(LAS u32x4*)(Vb + vdst[i]) = vr[i];
    __syncthreads();
    const int koff = pi32(l31) * 400 + 16 * h, voff = l31 * 144 + 16 * h;
    for (int t = 0; t < NT; ++t) {
        const int cur = t & 1;
        if (t + 1 < NT) {
#pragma unroll
            for (int i = 0; i < 3; ++i) kr[i] = *(const u32x4*)(ksrc[i] + (size_t)(t + 1) * kstr[i]);
#pragma unroll
            for (int i = 0; i < 2; ++i) vr[i] = *(const u32x4*)(vsrc[i] + (size_t)(t + 1) * 64);
        }
        if (64 * t <= qw + 31) {
            LAS const unsigned char* kb = Kb + cur * 25600 + koff; LAS const unsigned char* vb = Vb + cur * 18432 + voff;
            f32x16 s0, s1;
#pragma unroll
            for (int i = 0; i < 16; ++i) { s0[i] = 0.f; s1[i] = 0.f; }
#pragma unroll
            for (int ks = 0; ks < 12; ++ks) { const bf16x8 a0 = *(const LAS bf16x8*)(kb + ks * 32), a1 = *(const LAS bf16x8*)(kb + 32 * 400 + ks * 32); s0 = mfma32(a0, qf[ks], s0); s1 = mfma32(a1, qf[ks], s1); }
            if (64 * t + 63 > qw) {
#pragma unroll
                for (int i = 0; i < 16; ++i) { const int kv = 64 * t + 16 * (i >> 3) + 8 * h + (i & 7); if (kv > q) s0[i] = -1e30f; if (kv + 32 > q) s1[i] = -1e30f; }
            }
            float mx = fmaxf(s0[0], s1[0]);
#pragma unroll
            for (int i = 1; i < 16; ++i) mx = fmaxf(mx, fmaxf(s0[i], s1[i]));
            mx = fmaxf(mx, __shfl_xor(mx, 32));
            const float mnew = fmaxf(mrun, mx), alpha = __builtin_amdgcn_exp2f(mrun - mnew);
            mrun = mnew;
            float rs = 0.f;
#pragma unroll
            for (int i = 0; i < 16; ++i) { s0[i] = __builtin_amdgcn_exp2f(s0[i] - mnew); s1[i] = __builtin_amdgcn_exp2f(s1[i] - mnew); rs += s0[i] + s1[i]; }
            lrun = lrun * alpha + rs;
#pragma unroll
            for (int d = 0; d < 4; ++d)
#pragma unroll
                for (int i = 0; i < 16; ++i) o[d][i] *= alpha;
            bf16x8 pf[4];
            pf[0] = pack8(s0[0], s0[1], s0[2], s0[3], s0[4], s0[5], s0[6], s0[7]); pf[1] = pack8(s0[8], s0[9], s0[10], s0[11], s0[12], s0[13], s0[14], s0[15]);
            pf[2] = pack8(s1[0], s1[1], s1[2], s1[3], s1[4], s1[5], s1[6], s1[7]); pf[3] = pack8(s1[8], s1[9], s1[10], s1[11], s1[12], s1[13], s1[14], s1[15]);
#pragma unroll
            for (int d = 0; d < 4; ++d)
#pragma unroll
                for (int kk = 0; kk < 4; ++kk) { const bf16x8 vf = *(const LAS bf16x8*)(vb + d * 32 * 144 + kk * 32); o[d] = mfma32(vf, pf[kk], o[d]); }
        }
        if (t + 1 < NT) {
#pragma unroll
            for (int i = 0; i < 3; ++i) *(LAS u32x4*)(Kb + (cur ^ 1) * 25600 + kdst[i]) = kr[i];
#pragma unroll
            for (int i = 0; i < 2; ++i) *(LAS u32x4*)(Vb + (cur ^ 1) * 18432 + vdst[i]) = vr[i];
        }
        __syncthreads();
    }
    lrun += __shfl_xor(lrun, 32);
    const float inv = 1.f / lrun;
    bf16_t* yp = Y + (size_t)q * 3072 + 1024 + hh * 128 + 4 * h;
#pragma unroll
    for (int d = 0; d < 4; ++d)
#pragma unroll
        for (int g = 0; g < 4; ++g) { u32x2 w; w.x = pk2(o[d][4 * g] * inv, o[d][4 * g + 1] * inv); w.y = pk2(o[d][4 * g + 2] * inv, o[d][4 * g + 3] * inv); *(u32x2*)(yp + 32 * d + 8 * g) = w; }
}

struct Params { const float* in[27]; float* out; unsigned char* ws; };

__global__ void __launch_bounds__(512, 2) mega_fwd(Params p) {
    extern __shared__ __attribute__((aligned(16))) unsigned char smem_raw[];
    LAS unsigned char* smem = (LAS unsigned char*)smem_raw;
    cg::grid_group grid = cg::this_grid();
    const int G = gridDim.x, bx = blockIdx.x;
    unsigned char* ws = p.ws;
    f32x2* TAB = (f32x2*)(ws + WS_TAB); float* SMALL = (float*)(ws + WS_SMALL);
    bf16_t* WFFGU = (bf16_t*)(ws + WS_WFFGU); bf16_t* WFFD = (bf16_t*)(ws + WS_WFFD); bf16_t* WIN = (bf16_t*)(ws + WS_WIN); bf16_t* WUQ = (bf16_t*)(ws + WS_WUQ);
    bf16_t* WUKV = (bf16_t*)(ws + WS_WUKV); bf16_t* WLRU = (bf16_t*)(ws + WS_WLRU); bf16_t* WBR = (bf16_t*)(ws + WS_WBR); bf16_t* WOUT = (bf16_t*)(ws + WS_WOUT);
    bf16_t* XN = (bf16_t*)(ws + WS_XN); bf16_t* P = (bf16_t*)(ws + WS_P); bf16_t* Hb = P; bf16_t* Qb = (bf16_t*)(ws + WS_Q); bf16_t* KN = (bf16_t*)(ws + WS_KN);
    bf16_t* VT = (bf16_t*)(ws + WS_VT); bf16_t* Y = (bf16_t*)(ws + WS_Y); bf16_t* XC = (bf16_t*)(ws + WS_XC); bf16_t* CS = (bf16_t*)(ws + WS_CS);

    for (int i = bx * 512 + opaque_tid(); i < S * 32; i += G * 512) { const int t = i >> 5, j = i & 31; const float ang = (float)t * INVF[j];
        double r = (double)ang * 0.15915494309189535; r -= __builtin_floor(r); const float fr = (float)r;
        TAB[i] = (f32x2){__builtin_amdgcn_cosf(fr), __builtin_amdgcn_sinf(fr)}; }

#pragma unroll 1
    for (int hl = 0; hl < 4; ++hl) {
        const int l = hl >> 1, second = hl & 1;
        const float* xin = hl == 0 ? p.in[0] : p.out;
        {
            const int nmat = second ? 3 : 26; int rot = 0;
#pragma unroll 1
            for (int mi = 0; mi < nmat; ++mi) {
                const float* src; int K, N, map; bf16_t* dst;
                if (mi == 0) { src = p.in[second ? 23 : 2] + (size_t)l * DM * FF; K = DM; N = FF; map = 1; dst = WFFGU; }
                else if (mi == 1) { src = p.in[second ? 24 : 3] + (size_t)l * DM * FF; K = DM; N = FF; map = 2; dst = WFFGU; }
                else if (mi == 2) { src = p.in[second ? 25 : 4] + (size_t)l * DM * FF; K = FF; N = DM; map = 0; dst = WFFD; }
                else if (mi == 3) { src = p.in[6] + (size_t)l * DM * NIN; K = DM; N = NIN; map = 3; dst = WIN; }
                else if (mi == 4) { src = p.in[10] + (size_t)l * 384 * 1536; K = 384; N = 1536; map = 4; dst = WUQ; }
                else if (mi == 5) { src = p.in[12] + (size_t)l * 256 * 2048; K = 256; N = 2048; map = 5; dst = WUKV; }
                else if (mi < 22) { const int k = mi - 6, n = k >> 1, wx = k & 1; src = p.in[wx ? 17 : 15] + (size_t)l * 131072 + n * 16384; K = 128; N = 128; map = 0; dst = WLRU + (size_t)(n * 256 + wx * 128) * 128; }
                else if (mi < 25) { const int j = mi - 22; src = p.in[20] + (size_t)l * 3 * 1024 * 2048 + (size_t)j * 1024 * 2048; K = 1024; N = 2048; map = 0; dst = WBR + (size_t)j * 2048 * 1024; }
                else { src = p.in[21] + (size_t)l * DM * DM; K = DM; N = DM; map = 0; dst = WOUT; }
                convert_mat(src, K, N, dst, map, rot);
            }
            rmsnorm_rows(xin, p.in[second ? 22 : 1] + l * DM, XN);
        }
        grid.sync();
        { pg8::Gemm g{XN, WFFGU, S, 2 * FF, DM, DM, DM, 0}; pg8::StaticOrder so; so.init(S, 2 * FF, G, bx); pg8::EpiSwiglu E{Hb}; pg8::gemm_phase(smem, g, so, E); }
        grid.sync();
        { pg8::Gemm g{Hb, WFFD, S, DM, FF, FF, FF, 0}; pg8::StaticOrder so; so.init(S, DM, G, bx); pg8::EpiRes E{xin, p.out, 0.5f}; pg8::gemm_phase(smem, g, so, E); }
        grid.sync();
        if (!second) {
            const float* gbias = p.in[7] + l * 8;
            rmsnorm_rows(p.out, p.in[5] + l * DM, XN);
            grid.sync();
            { pg8::Gemm g{XN, WIN, S, NP, DM, DM, DM, 0}; pg8::StaticOrder so; so.init(S, NP, G, bx); pg8::EpiStore E{P, NP}; pg8::gemm_phase(smem, g, so, E); }
            grid.sync();
            if (bx == G - 1) { const float* lam = p.in[19] + l * 1024; for (int ch = opaque_tid(); ch < 1024; ch += 512) SMALL[SM_SP + ch] = -8.f * log1pf(expf(-lam[ch])); }
            mlstm_a(smem, P, gbias, CS, SMALL);
            prep_rows(P, p.in[9] + l * 384, p.in[11] + l * 256, p.in[13] + l * 4096, p.in[14] + l * 1024, TAB, XC);
            grid.sync();
            mlstm_b(smem, CS, SMALL);
            { pg8::Gemm g{P + PC_CQ, WUQ, S, 1536, 384, NP, 384, 0}; pg8::StaticOrder so; so.init(S, 1536, G, bx); pg8::EpiQ E{Qb, TAB}; pg8::gemm_phase(smem, g, so, E); }
#pragma unroll 1
            for (int gi = 0; gi < 2; ++gi) {
                pg8::Gemm g; pg8::StaticOrder so; pg8::EpiStore E;
                if (gi == 0) { g = pg8::Gemm{P + PC_CKV, WUKV, S, 1024, 256, NP, 256, 0}; so.init(S, 1024, G, bx); E = pg8::EpiStore{KN, 1024}; }
                else { g = pg8::Gemm{WUKV + 1024 * 256, P + PC_CKV, 1024, S, 256, 256, NP, 0}; so.init(1024, S, G, bx); E = pg8::EpiStore{VT, S}; }
                pg8::gemm_phase(smem, g, so, E);
            }
            { pg8::Gemm g{XC, WLRU, S, 2048, 128, 1024, 128, 128}; pg8::StaticOrder so; so.init(S, 2048, G, bx); pg8::EpiLru E{XC, P + PC_CX, p.in[16] + l * 1024, p.in[18] + l * 1024, SMALL + SM_SP}; pg8::gemm_phase(smem, g, so, E); }
            grid.sync();
            mlstm_c(smem, P, gbias, p.in[8] + l * 1024, CS, SMALL, Y);
            lru_p1(P + PC_CX, XC, SMALL + SM_CA, SMALL + SM_CH);
            grid.sync();
            lru_p2(SMALL + SM_CA, SMALL + SM_CH, SMALL + SM_CARRY);
            for (int item = bx; item < 256; item += G) { const int hh = item & 7, pp = item >> 3;
#pragma unroll 1
                for (int half = 0; half < 2; ++half) attn_unit(smem, hh, half ? 63 - pp : pp, Qb, KN, P, VT, Y); }
            grid.sync();
            lru_p3(P + PC_CX, XC, SMALL + SM_CARRY, Y);
#pragma unroll 1
            for (int j = 0; j < 3; ++j) {
                if (j == 2) grid.sync();
                pg8::Gemm g{Y + j * 1024, WBR + (size_t)j * 2048 * 1024, S, DM, 1024, 3072, 1024, 0}; pg8::StaticOrder so; so.init(S, DM, G, bx); pg8::EpiMerge E{XN, P + PC_G + j * 2048, j == 0}; pg8::gemm_phase(smem, g, so, E);
            }
            grid.sync();
            { pg8::Gemm g{XN, WOUT, S, DM, DM, DM, DM, 0}; pg8::StaticOrder so; so.init(S, DM, G, bx); pg8::EpiRes E{p.out, p.out, 1.0f}; pg8::gemm_phase(smem, g, so, E); }
            grid.sync();
        }
    }
    final_norm_rows(p.out, p.in[26]);
}

constexpr int LDS_BYTES = 143360;

extern "C" void kernel_launch(void* const* d_in, const int* in_sizes, int n_in, void* d_out, int out_size, void* d_ws, size_t ws_size, hipStream_t stream) {
    static int grid = 0;
    if (grid == 0) {
        if (n_in != 27 || out_size != S * DM || ws_size < WS_END) { fprintf(stderr, "kernel_launch: unexpected problem (n_in %d out %d ws %zu, need %zu)\n", n_in, out_size, ws_size, (size_t)WS_END); grid = -1; return; }
        int dev = 0, cus = 0, per_cu = 0;
        hipGetDevice(&dev); hipDeviceGetAttribute(&cus, hipDeviceAttributeMultiprocessorCount, dev);
        if (hipFuncSetAttribute((const void*)mega_fwd, hipFuncAttributeMaxDynamicSharedMemorySize, LDS_BYTES) != hipSuccess) { fprintf(stderr, "kernel_launch: hipFuncSetAttribute failed\n"); grid = -1; return; }
        if (hipOccupancyMaxActiveBlocksPerMultiprocessor(&per_cu, (const void*)mega_fwd, 512, LDS_BYTES) != hipSuccess || per_cu < 1) { fprintf(stderr, "kernel_launch: occupancy query says %d\n", per_cu); per_cu = 1; }
        (void)hipGetLastError();
        grid = cus * (per_cu > 1 ? 1 : per_cu);
    }
    if (grid < 0) return;
    Params p{};
    for (int i = 0; i < 27; ++i) p.in[i] = (const float*)d_in[i];
    p.out = (float*)d_out; p.ws = (unsigned char*)d_ws;
    void* args[] = {&p};
    hipError_t e = hipLaunchCooperativeKernel((const void*)mega_fwd, dim3(grid), dim3(512), args, LDS_BYTES, stream);
    if (e != hipSuccess) fprintf(stderr, "cooperative launch failed: %s (grid %d)\n", hipGetErrorString(e), grid);
}
```

```cpp
#include <hip/hip_runtime.h>
#include <hip/hip_cooperative_groups.h>
#include <cstdio>
#include <cstdint>
namespace cg = cooperative_groups;

#define DI __device__ __forceinline__
#define LAS __attribute__((address_space(3)))
typedef unsigned short bf16_t;
typedef short bf16x8 __attribute__((ext_vector_type(8)));
typedef short s16x4 __attribute__((ext_vector_type(4)));
typedef float f32x2 __attribute__((ext_vector_type(2)));
typedef float f32x4 __attribute__((ext_vector_type(4)));
typedef float f32x16 __attribute__((ext_vector_type(16)));
typedef unsigned u32x2 __attribute__((ext_vector_type(2)));
typedef unsigned u32x4 __attribute__((ext_vector_type(4)));
typedef __bf16 bf16x2_t __attribute__((ext_vector_type(2)));

constexpr int S = 16384, DM = 2048, FF = 5632, NIN = 10952, NP = 11008;
constexpr float EPS = 1e-6f;
constexpr int PC_Q = 0, PC_K = 512, PC_V = 1024, PC_O = 2048, PC_CQ = 3072, PC_CKV = 3456, PC_KR = 3712, PC_CX = 3776, PC_G = 4800, PC_I = 10944, PC_F = 10948;
constexpr float MQS = 0.08838834764831845f;
constexpr float AQS = 0.07216878364870322f * 1.4426950408889634f;

constexpr size_t MiB = 1u << 20;
constexpr size_t WS_TAB = 0;
constexpr size_t WS_SMALL = 4 * MiB;
constexpr size_t WS_WFFGU = 12 * MiB;
constexpr size_t WS_WFFD = 56 * MiB;
constexpr size_t WS_WIN = 78 * MiB;
constexpr size_t WS_WUQ = 121 * MiB;
constexpr size_t WS_WUKV = 123 * MiB;
constexpr size_t WS_WLRU = 124 * MiB;
constexpr size_t WS_WBR = 125 * MiB;
constexpr size_t WS_WOUT = 137 * MiB;
constexpr size_t WS_XN = 145 * MiB;
constexpr size_t WS_P = 209 * MiB;
constexpr size_t WS_Q = 553 * MiB;
constexpr size_t WS_KN = 601 * MiB;
constexpr size_t WS_VT = 633 * MiB;
constexpr size_t WS_Y = 665 * MiB;
constexpr size_t WS_XC = 761 * MiB;
constexpr size_t WS_CS = 793 * MiB;
constexpr size_t WS_END = 857 * MiB;
constexpr size_t WS_CTL = 11 * MiB, CTL_BYTES = 16384;
constexpr int SM_BT = 0, SM_MC = 1024, SM_MPREV = 2048, SM_DN = 4096  , SM_CA = 4096 + 131072  , SM_CH = SM_CA + 262144, SM_CARRY = SM_CH + 262144, SM_SP = SM_CARRY + 262144;

__device__ const float INVF[32] = {1.0f, 0.7498942613601685f, 0.5623413324356079f, 0.4216965138912201f, 0.3162277638912201f, 0.23713737726211548f, 0.17782793939113617f, 0.133352130651474f, 0.10000000149011612f, 0.07498941570520401f, 0.05623413249850273f, 0.04216965287923813f, 0.03162277489900589f, 0.023713737726211548f, 0.017782794311642647f, 0.01333521492779255f, 0.009999999776482582f, 0.007498941849917173f, 0.005623413249850273f, 0.0042169648222625256f, 0.003162277629598975f, 0.00237137358635664f, 0.0017782794311642647f, 0.0013335214462131262f, 0.0010000000474974513f, 0.0007498942431993783f, 0.000562341301701963f, 0.0004216965171508491f, 0.0003162277571391314f, 0.00023713737027719617f, 0.00017782794020604342f, 0.0001333521504420787f};

DI int opaque_tid() { int t = threadIdx.x; asm volatile("" : "+v"(t)); return t; }
DI float bf2f(bf16_t v) { return __uint_as_float((unsigned)v << 16); }
DI float bflo(unsigned w) { return __uint_as_float(w << 16); }
DI float bfhi(unsigned w) { return __uint_as_float(w & 0xffff0000u); }
DI unsigned pk2(float lo, float hi) { f32x2 v = {lo, hi}; bf16x2_t b = __builtin_convertvector(v, bf16x2_t); return __builtin_bit_cast(unsigned, b); }
DI bf16_t f2bf(float f) { return (bf16_t)(pk2(f, 0.f) & 0xffffu); }
DI float wave_sum(float v) {
#pragma unroll
    for (int o = 1; o < 64; o <<= 1) v += __shfl_xor(v, o);
    return v;
}
DI float wave_max(float v) {
#pragma unroll
    for (int o = 1; o < 64; o <<= 1) v = fmaxf(v, __shfl_xor(v, o));
    return v;
}
DI float wave_incl_scan(float v, int lane) {
#pragma unroll
    for (int o = 1; o < 64; o <<= 1) { const float n = __shfl_up(v, o); if (lane >= o) v += n; }
    return v;
}
DI float sigmoidf_(float x) { return 1.f / (1.f + __expf(-x)); }
DI float logsigmoid_(float x) { return fminf(x, 0.f) - log1pf(expf(-fabsf(x))); }
DI f32x16 mfma32(bf16x8 a, bf16x8 b, f32x16 c) { return __builtin_amdgcn_mfma_f32_32x32x16_bf16(a, b, c, 0, 0, 0); }
DI int crow(int r, int h) { return (r & 3) + 8 * (r >> 2) + 4 * h; }
DI int pi32(int m) { return (m & ~12) | ((m & 4) << 1) | ((m & 8) >> 1); }
typedef short v4i16_t __attribute__((ext_vector_type(4)));
DI s16x4 tr16(LAS const unsigned char* p) { return __builtin_bit_cast(s16x4, __builtin_amdgcn_ds_read_tr16_b64_v4i16((LAS v4i16_t*)p)); }
DI bf16x8 tr_frag(LAS const unsigned char* p, int rs) {
    const s16x4 lo = tr16(p), hi = tr16(p + 4 * rs);
    return __builtin_shufflevector(lo, hi, 0, 1, 2, 3, 4, 5, 6, 7);
}
DI bf16x8 pack8(float a0, float a1, float a2, float a3, float a4, float a5, float a6, float a7) {
    u32x4 w; w.x = pk2(a0, a1); w.y = pk2(a2, a3); w.z = pk2(a4, a5); w.w = pk2(a6, a7); return __builtin_bit_cast(bf16x8, w);
}

namespace pg8 {
constexpr int BM = 256, BK = 64, HALF = 128, HTB = HALF * BK * 2, STAGE_BYTES = 8 * HTB, NXCD = 8, WGM = 8;
DI int lds_byte(int r, int c) { const int st = (r >> 4) * 2 + (c >> 5), rr = r & 15, cc = c & 31, ob = rr * 64 + cc * 2; return st * 1024 + (ob ^ (((ob >> 9) & 1) << 5)); }
DI void stage_rc(int b, int& R, int& C) { const int st = b / 1024, sb = b % 1024, swz = sb ^ (((sb >> 9) & 1) << 5); R = (st >> 1) * 16 + swz / 64; C = (st & 1) * 32 + (swz % 64) / 2; }
DI int perm32(int rho) { const int n = rho >> 4, i = rho & 15; return 8 * (i >> 2) + 4 * n + (i & 3); }
struct Unit { int pm, pn; };
struct Gemm { const bf16_t* A; const bf16_t* Bt; int M, N, K, lda, ldb, apn; };
struct StaticOrder {
    int nM, nN, nwg, G, c;
    DI void init(int M, int N, int G_, int c_) { nM = M / BM; nN = N / BM; nwg = nM * nN; G = G_; c = c_; }
    DI bool next(int i, Unit& u) const {
        const long L = (long)i * G + c; if (L >= nwg) return false;
        int wgid = (int)L; { const int q = nwg / NXCD, r = nwg % NXCD, xcd = wgid % NXCD, off = wgid / NXCD; wgid = (xcd < r ? xcd * (q + 1) : r * (q + 1) + (xcd - r) * q) + off; }
        const int nig = WGM * nN, gid = wgid / nig, fm = gid * WGM, gsz = (nM - fm) < WGM ? (nM - fm) : WGM;
        u.pm = fm + ((wgid % nig) % gsz); u.pn = (wgid % nig) / gsz; return true;
    }
};
template <class Epi>
DI void gemm_phase(LAS unsigned char* lds, const Gemm g, const StaticOrder& S, const Epi& E) {
    const int tid = opaque_tid(), wid = __builtin_amdgcn_readfirstlane(tid >> 6), lane = tid & 63, wr = wid >> 2, wc = wid & 3, fr = lane & 15, fq = lane >> 4;
    int K = g.K; asm volatile("" : "+s"(K)); const int nt = K / BK;
    unsigned voffA[2], voffB[2];
#pragma unroll
    for (int i = 0; i < 2; ++i) { int R, C; stage_rc(tid * 16 + i * 8192, R, C); const int Rb = Epi::PERM ? ((R & ~31) + perm32(R & 31)) : R;
        voffA[i] = (unsigned)(R * g.lda + C) * 2u; voffB[i] = (unsigned)(Rb * g.ldb + C) * 2u; }
    const size_t kstep = (size_t)(BK * 2);
    const size_t hstepA = (size_t)HALF * g.lda * 2, hstepB = (size_t)HALF * g.ldb * 2;
    const unsigned ldsw = (unsigned)wid * 1024u;
    const int aoff = lds_byte(wr * 64 + fr, fq * 8), boff = lds_byte(wc * 32 + fr, fq * 8);
#define PG8_SA(b, h) (((b) * 2 + (h)) * HTB)
#define PG8_SB(b, h) ((4 + (b) * 2 + (h)) * HTB)
#define PG8_STAGE(bufoff, gbase, voff) do { _Pragma("unroll") for (int _i = 0; _i < 2; ++_i) \
        __builtin_amdgcn_global_load_lds((const unsigned*)((const char*)(gbase) + (voff)[_i]), (LAS unsigned*)(lds + (bufoff) + ldsw + _i * 8192), 16, 0, 0); } while (0)
#define PG8_LDA(dst, b, h) do { _Pragma("unroll") for (int m = 0; m < 4; ++m) _Pragma("unroll") for (int k = 0; k < 2; ++k) dst[m][k] = *(const LAS bf16x8*)(lds + PG8_SA(b, h) + aoff + m * 2048 + k * 1024); } while (0)
#define PG8_LDB(dst, b, h) do { _Pragma("unroll") for (int n = 0; n < 2; ++n) _Pragma("unroll") for (int k = 0; k < 2; ++k) dst[n][k] = *(const LAS bf16x8*)(lds + PG8_SB(b, h) + boff + n * 2048 + k * 1024); } while (0)
#define PG8_MMA(ai, bj, At, Bt) do { __builtin_amdgcn_s_setprio(1); _Pragma("unroll") for (int m = 0; m < 4; ++m) _Pragma("unroll") for (int n = 0; n < 2; ++n) _Pragma("unroll") for (int k = 0; k < 2; ++k) \
        acc[ai][bj][m][n] = __builtin_amdgcn_mfma_f32_16x16x32_bf16(Bt[n][k], At[m][k], acc[ai][bj][m][n], 0, 0, 0); __builtin_amdgcn_s_setprio(0); } while (0)
#define PG8_WAIT_V(n) asm volatile("s_waitcnt vmcnt(" #n ")" ::: "memory")
#define PG8_WAIT_L(n) asm volatile("s_waitcnt lgkmcnt(" #n ")" ::: "memory")
#define PG8_BAR __builtin_amdgcn_s_barrier()
#define PG8_SCHED __builtin_amdgcn_sched_barrier(0)
#define PG8_APTR(u) ((const char*)g.A + (size_t)(u).pm * 2 * hstepA + (size_t)(u).pn * (size_t)g.apn * 2)
#define PG8_BPTR(u) ((const char*)g.Bt + (size_t)(u).pn * 2 * hstepB)
    Unit cur, nxt; int ui = 0;
    if (!S.next(0, cur)) return;
    f32x4 acc[2][2][4][2];
#pragma unroll
    for (int a = 0; a < 2; ++a)
#pragma unroll
        for (int b = 0; b < 2; ++b)
#pragma unroll
            for (int m = 0; m < 4; ++m)
#pragma unroll
                for (int n = 0; n < 2; ++n) acc[a][b][m][n] = (f32x4){0.f, 0.f, 0.f, 0.f};
    bf16x8 At[4][2], B0[2][2], B1[2][2];
    const char* cA = PG8_APTR(cur); const char* cB = PG8_BPTR(cur);
    PG8_STAGE(PG8_SB(0, 0), cB, voffB); PG8_STAGE(PG8_SB(0, 1), cB + hstepB, voffB); PG8_STAGE(PG8_SA(0, 0), cA, voffA); PG8_STAGE(PG8_SA(0, 1), cA + hstepA, voffA);
    if (wr == 1) PG8_BAR;
    PG8_WAIT_V(2); PG8_BAR;
    PG8_STAGE(PG8_SB(1, 0), cB + kstep, voffB); PG8_STAGE(PG8_SA(1, 0), cA + kstep, voffA); PG8_STAGE(PG8_SB(1, 1), cB + hstepB + kstep, voffB);
    PG8_WAIT_V(6); PG8_BAR;
    for (;;) {
        const bool has_next = S.next(ui + 1, nxt);
        const char* nA = has_next ? PG8_APTR(nxt) : cA; const char* nB = has_next ? PG8_BPTR(nxt) : cB;
        for (int t = 0; t < nt; t += 2) {
            const bool last = (t == nt - 2);
            const char* a1 = cA + (size_t)(t + 1) * kstep;
            const char* a2 = last ? nA : cA + (size_t)(t + 2) * kstep; const char* b2 = last ? nB : cB + (size_t)(t + 2) * kstep;
            const char* a3 = a2 + kstep; const char* b3 = b2 + kstep;
            PG8_LDB(B0, 0, 0); PG8_LDB(B1, 0, 1); PG8_SCHED; PG8_LDA(At, 0, 0); PG8_STAGE(PG8_SA(1, 1), a1 + hstepA, voffA);
            PG8_WAIT_V(8); PG8_WAIT_L(0); PG8_BAR; PG8_MMA(0, 0, At, B0); PG8_MMA(0, 1, At, B1); PG8_BAR; PG8_SCHED;
            PG8_LDA(At, 0, 1); PG8_STAGE(PG8_SB(0, 0), b2, voffB); PG8_STAGE(PG8_SB(0, 1), b2 + hstepB, voffB); PG8_STAGE(PG8_SA(0, 0), a2, voffA);
            PG8_WAIT_V(8); PG8_WAIT_L(0); PG8_BAR; PG8_MMA(1, 0, At, B0); PG8_MMA(1, 1, At, B1); PG8_BAR; PG8_SCHED;
            PG8_LDB(B0, 1, 0); PG8_LDB(B1, 1, 1); PG8_SCHED; PG8_LDA(At, 1, 0); PG8_STAGE(PG8_SA(0, 1), a2 + hstepA, voffA);
            PG8_WAIT_V(8); PG8_WAIT_L(0); PG8_BAR; PG8_MMA(0, 0, At, B0); PG8_MMA(0, 1, At, B1); PG8_BAR; PG8_SCHED;
            PG8_LDA(At, 1, 1); PG8_STAGE(PG8_SB(1, 0), b3, voffB); PG8_STAGE(PG8_SB(1, 1), b3 + hstepB, voffB); PG8_STAGE(PG8_SA(1, 0), a3, voffA);
            PG8_WAIT_V(8); PG8_WAIT_L(0); PG8_BAR; PG8_MMA(1, 0, At, B0); PG8_MMA(1, 1, At, B1); PG8_BAR; PG8_SCHED;
        }
        if (wr == 0) PG8_BAR;
        E(acc, cur, wr, wc, fr, fq);
        if (!has_next) break;
#pragma unroll
        for (int a = 0; a < 2; ++a)
#pragma unroll
            for (int b = 0; b < 2; ++b)
#pragma unroll
                for (int m = 0; m < 4; ++m)
#pragma unroll
                    for (int n = 0; n < 2; ++n) acc[a][b][m][n] = (f32x4){0.f, 0.f, 0.f, 0.f};
        cur = nxt; cA = nA; cB = nB; ++ui;
        if (wr == 1) PG8_BAR;
    }
    PG8_WAIT_V(0);
    PG8_BAR;
#undef PG8_SA
#undef PG8_SB
#undef PG8_STAGE
#undef PG8_LDA
#undef PG8_LDB
#undef PG8_MMA
#undef PG8_WAIT_V
#undef PG8_WAIT_L
#undef PG8_BAR
#undef PG8_SCHED
#undef PG8_APTR
#undef PG8_BPTR
}

typedef f32x4 Acc[2][2][4][2];
struct EpiStore {
    static constexpr bool PERM = true;
    bf16_t* O; int ldc;
    DI void operator()(const Acc& acc, const Unit& u, int wr, int wc, int fr, int fq) const {
        const int row0 = u.pm * BM + wr * 64 + fr, col0 = u.pn * BM + wc * 32 + 8 * fq;
#pragma unroll
        for (int ai = 0; ai < 2; ++ai)
#pragma unroll
            for (int m = 0; m < 4; ++m) { bf16_t* rowp = O + (size_t)(row0 + ai * HALF + m * 16) * ldc + col0;
#pragma unroll
                for (int bj = 0; bj < 2; ++bj) { const f32x4 v0 = acc[ai][bj][m][0], v1 = acc[ai][bj][m][1];
                    u32x4 w; w.x = pk2(v0[0], v0[1]); w.y = pk2(v0[2], v0[3]); w.z = pk2(v1[0], v1[1]); w.w = pk2(v1[2], v1[3]);
                    *(u32x4*)(rowp + bj * HALF) = w; } }
    }
};
struct EpiSwiglu {
    static constexpr bool PERM = true;
    bf16_t* H;
    DI void operator()(const Acc& acc, const Unit& u, int wr, int wc, int fr, int fq) const {
        const int row0 = u.pm * BM + wr * 64 + fr, col0 = u.pn * HALF + wc * 32 + 8 * fq;
#pragma unroll
        for (int ai = 0; ai < 2; ++ai)
#pragma unroll
            for (int m = 0; m < 4; ++m) { bf16_t* rowp = H + (size_t)(row0 + ai * HALF + m * 16) * FF + col0;
                float o[8];
#pragma unroll
                for (int n = 0; n < 2; ++n)
#pragma unroll
                    for (int j = 0; j < 4; ++j) { const float gt = acc[ai][0][m][n][j], up = acc[ai][1][m][n][j]; o[n * 4 + j] = gt * sigmoidf_(gt) * up; }
                u32x4 w; w.x = pk2(o[0], o[1]); w.y = pk2(o[2], o[3]); w.z = pk2(o[4], o[5]); w.w = pk2(o[6], o[7]);
                *(u32x4*)rowp = w; }
    }
};
struct EpiRes {
    static constexpr bool PERM = false;
    const float* xin; float* xout; float alpha;
    DI void operator()(const Acc& acc, const Unit& u, int wr, int wc, int fr, int fq) const {
        const int col0 = u.pn * BM + wc * 32 + 4 * fq;
#pragma unroll
        for (int ai = 0; ai < 2; ++ai)
#pragma unroll
            for (int m = 0; m < 4; ++m) { const size_t off = (size_t)(u.pm * BM + ai * HALF + wr * 64 + m * 16 + fr) * DM + col0;
#pragma unroll
                for (int bj = 0; bj < 2; ++bj)
#pragma unroll
                    for (int n = 0; n < 2; ++n) { const f32x4 b = *(const f32x4*)(xin + off + bj * HALF + n * 16); *(f32x4*)(xout + off + bj * HALF + n * 16) = b + acc[ai][bj][m][n] * alpha; } }
    }
};
struct EpiQ {
    static constexpr bool PERM = true;
    bf16_t* Q; const f32x2* tab;
    DI void operator()(const Acc& acc, const Unit& u, int wr, int wc, int fr, int fq) const {
        const int row0 = u.pm * BM + wr * 64 + fr;
#pragma unroll
        for (int bj = 0; bj < 2; ++bj) {
            const int c0 = u.pn * BM + bj * HALF + wc * 32 + 8 * fq; const int hh = c0 / 192, dd = c0 - hh * 192; const bool rope = dd >= 128; const int j0 = (dd - 128) >> 1;
#pragma unroll
            for (int ai = 0; ai < 2; ++ai)
#pragma unroll
                for (int m = 0; m < 4; ++m) { const int row = row0 + ai * HALF + m * 16;
                    float v[8];
#pragma unroll
                    for (int n = 0; n < 2; ++n)
#pragma unroll
                        for (int j = 0; j < 4; ++j) v[n * 4 + j] = acc[ai][bj][m][n][j];
                    if (rope) {
#pragma unroll
                        for (int p = 0; p < 4; ++p) { const f32x2 cs = tab[(size_t)row * 32 + j0 + p]; const float x1 = v[2 * p], x2 = v[2 * p + 1]; v[2 * p] = x1 * cs.x - x2 * cs.y; v[2 * p + 1] = x1 * cs.y + x2 * cs.x; }
                    }
                    u32x4 w; w.x = pk2(v[0] * AQS, v[1] * AQS); w.y = pk2(v[2] * AQS, v[3] * AQS); w.z = pk2(v[4] * AQS, v[5] * AQS); w.w = pk2(v[6] * AQS, v[7] * AQS);
                    *(u32x4*)(Q + (size_t)row * 1536 + c0) = w; }
        }
    }
};
struct EpiLru {
    static constexpr bool PERM = true;
    bf16_t* XC; bf16_t* LA; const float* ba; const float* bx; const float* sp;
    DI void operator()(const Acc& acc, const Unit& u, int wr, int wc, int fr, int fq) const {
        const int row0 = u.pm * BM + wr * 64 + fr, ch0 = u.pn * HALF + wc * 32 + 8 * fq;
#pragma unroll
        for (int ai = 0; ai < 2; ++ai)
#pragma unroll
            for (int m = 0; m < 4; ++m) { const int row = row0 + ai * HALF + m * 16;
                const u32x4 xw = *(const u32x4*)(XC + (size_t)row * 1024 + ch0);
                const float xv[8] = {bflo(xw.x), bfhi(xw.x), bflo(xw.y), bfhi(xw.y), bflo(xw.z), bfhi(xw.z), bflo(xw.w), bfhi(xw.w)};
                u32x4 wl, wu;
#pragma unroll
                for (int n = 0; n < 2; ++n) { const f32x4 spv = *(const f32x4*)(sp + ch0 + 4 * n), bav = *(const f32x4*)(ba + ch0 + 4 * n), bxv = *(const f32x4*)(bx + ch0 + 4 * n);
                    float la[4], uu[4];
#pragma unroll
                    for (int j = 0; j < 4; ++j) { const float r = sigmoidf_(acc[ai][0][m][n][j] + bav[j]), gi = sigmoidf_(acc[ai][1][m][n][j] + bxv[j]);
                        const float l = r * spv[j]; la[j] = l; const float a2 = __expf(2.f * l); uu[j] = sqrtf(fmaxf(1.f - a2, 0.f)) * gi * xv[n * 4 + j]; }
                    if (n == 0) { wl.x = pk2(la[0], la[1]); wl.y = pk2(la[2], la[3]); wu.x = pk2(uu[0], uu[1]); wu.y = pk2(uu[2], uu[3]); }
                    else { wl.z = pk2(la[0], la[1]); wl.w = pk2(la[2], la[3]); wu.z = pk2(uu[0], uu[1]); wu.w = pk2(uu[2], uu[3]); } }
                *(u32x4*)(LA + (size_t)row * NP + ch0) = wl;
                *(u32x4*)(XC + (size_t)row * 1024 + ch0) = wu;
                asm volatile("" ::: "memory"); }
    }
};
struct EpiMerge {
    static constexpr bool PERM = true;
    bf16_t* Z; const bf16_t* G; int first;
    DI void operator()(const Acc& acc, const Unit& u, int wr, int wc, int fr, int fq) const {
        const int row0 = u.pm * BM + wr * 64 + fr, col0 = u.pn * BM + wc * 32 + 8 * fq;
#pragma unroll
        for (int ai = 0; ai < 2; ++ai)
#pragma unroll
            for (int m = 0; m < 4; ++m) { const int row = row0 + ai * HALF + m * 16;
#pragma unroll
                for (int bj = 0; bj < 2; ++bj) { const int c = col0 + bj * HALF;
                    const u32x4 gw = *(const u32x4*)(G + (size_t)row * NP + c);
                    const float gv[8] = {bflo(gw.x), bfhi(gw.x), bflo(gw.y), bfhi(gw.y), bflo(gw.z), bfhi(gw.z), bflo(gw.w), bfhi(gw.w)};
                    float o[8];
#pragma unroll
                    for (int n = 0; n < 2; ++n)
#pragma unroll
                        for (int j = 0; j < 4; ++j) o[n * 4 + j] = sigmoidf_(gv[n * 4 + j]) * acc[ai][bj][m][n][j];
                    bf16_t* zp = Z + (size_t)row * DM + c;
                    if (!first) { const u32x4 zw = *(const u32x4*)zp; o[0] += bflo(zw.x); o[1] += bfhi(zw.x); o[2] += bflo(zw.y); o[3] += bfhi(zw.y); o[4] += bflo(zw.z); o[5] += bfhi(zw.z); o[6] += bflo(zw.w); o[7] += bfhi(zw.w); }
                    u32x4 w; w.x = pk2(o[0], o[1]); w.y = pk2(o[2], o[3]); w.z = pk2(o[4], o[5]); w.w = pk2(o[6], o[7]);
                    *(u32x4*)zp = w; } }
    }
};
}

DI int map_row(int map, int n) {
    switch (map) {
        case 1: return ((n >> 7) << 8) + (n & 127);
        case 2: return ((n >> 7) << 8) + 128 + (n & 127);
        case 3: { if (n < 2048) return n; if (n < 2052) return PC_I + n - 2048; if (n < 2056) return PC_F + n - 2052; if (n < 3080) return PC_O + n - 2056; if (n < 3464) return PC_CQ + n - 3080;
                  if (n < 3720) return PC_CKV + n - 3464; if (n < 3784) return PC_KR + n - 3720; if (n < 4808) return PC_CX + n - 3784; return PC_G + n - 4808; }
        case 4: { const int hh = n / 192, dd = n - hh * 192; if (dd < 128) return n; const int jj = dd - 128; return hh * 192 + 128 + (jj < 32 ? 2 * jj : 2 * (jj - 32) + 1); }
        case 5: { const int hh = n >> 8, dd = n & 255; return dd < 128 ? hh * 128 + dd : 1024 + hh * 128 + dd - 128; }
        default: return n;
    }
}
DI void convert_mat(const float* W, int K, int N, bf16_t* WT, int map, int& rot) {
    const int tid_ = opaque_tid(), lane = tid_ & 63, gw = blockIdx.x * 8 + (tid_ >> 6), ngw = gridDim.x * 8;
    const int nch = (N + 255) >> 8, nkb = K >> 5, nitems = nch * nkb;
    int it = gw - rot; if (it < 0) it += ngw;
    for (; it < nitems; it += ngw) {
        const int nc = it / nkb, kb = it - nc * nkb, n0 = nc * 256 + lane * 4, k0 = kb * 32;
        if (n0 < N) {
            const float* src = W + (size_t)k0 * N + n0;
            bf16_t* d0 = WT + (size_t)map_row(map, n0) * K + k0; bf16_t* d1 = WT + (size_t)map_row(map, n0 + 1) * K + k0;
            bf16_t* d2 = WT + (size_t)map_row(map, n0 + 2) * K + k0; bf16_t* d3 = WT + (size_t)map_row(map, n0 + 3) * K + k0;
#pragma unroll 2
            for (int kk = 0; kk < 4; ++kk) {
                f32x4 v[8];
#pragma unroll
                for (int i = 0; i < 8; ++i) v[i] = *(const f32x4*)(src + (size_t)(kk * 8 + i) * N);
                u32x4 o;
                o.x = pk2(v[0].x, v[1].x); o.y = pk2(v[2].x, v[3].x); o.z = pk2(v[4].x, v[5].x); o.w = pk2(v[6].x, v[7].x); *(u32x4*)(d0 + kk * 8) = o;
                o.x = pk2(v[0].y, v[1].y); o.y = pk2(v[2].y, v[3].y); o.z = pk2(v[4].y, v[5].y); o.w = pk2(v[6].y, v[7].y); *(u32x4*)(d1 + kk * 8) = o;
                o.x = pk2(v[0].z, v[1].z); o.y = pk2(v[2].z, v[3].z); o.z = pk2(v[4].z, v[5].z); o.w = pk2(v[6].z, v[7].z); *(u32x4*)(d2 + kk * 8) = o;
                o.x = pk2(v[0].w, v[1].w); o.y = pk2(v[2].w, v[3].w); o.z = pk2(v[4].w, v[5].w); o.w = pk2(v[6].w, v[7].w); *(u32x4*)(d3 + kk * 8) = o;
            }
        }
    }
    rot = (rot + nitems) % ngw;
}

DI void rmsnorm_rows(const float* X, const float* g, bf16_t* O) {
    const int tid_ = opaque_tid(), lane = tid_ & 63, gw = blockIdx.x * 8 + (tid_ >> 6), ngw = gridDim.x * 8;
    for (int r = gw; r < S; r += ngw) {
        const f32x4* xr = (const f32x4*)(X + (size_t)r * DM) + lane; f32x4 v[8]; float s = 0.f;
#pragma unroll
        for (int j = 0; j < 8; ++j) { v[j] = xr[64 * j]; s += (v[j].x * v[j].x + v[j].y * v[j].y) + (v[j].z * v[j].z + v[j].w * v[j].w); }
        const float rstd = 1.f / sqrtf(wave_sum(s) * (1.f / DM) + EPS);
        u32x2* o8 = (u32x2*)(O + (size_t)r * DM) + lane;
#pragma unroll
        for (int j = 0; j < 8; ++j) { const f32x4 gv = ((const f32x4*)g)[lane + 64 * j]; u32x2 w; w.x = pk2(v[j].x * rstd * gv.x, v[j].y * rstd * gv.y); w.y = pk2(v[j].z * rstd * gv.z, v[j].w * rstd * gv.w); o8[64 * j] = w; }
    }
}
DI void final_norm_rows(float* X, const float* g) {
    const int tid_ = opaque_tid(), lane = tid_ & 63, gw = blockIdx.x * 8 + (tid_ >> 6), ngw = gridDim.x * 8;
    for (int r = gw; r < S; r += ngw) {
        f32x4* xr = (f32x4*)(X + (size_t)r * DM) + lane; f32x4 v[8]; float s = 0.f;
#pragma unroll
        for (int j = 0; j < 8; ++j) { v[j] = xr[64 * j]; s += (v[j].x * v[j].x + v[j].y * v[j].y) + (v[j].z * v[j].z + v[j].w * v[j].w); }
        const float rstd = 1.f / sqrtf(wave_sum(s) * (1.f / DM) + EPS);
#pragma unroll
        for (int j = 0; j < 8; ++j) { const f32x4 gv = ((const f32x4*)g)[lane + 64 * j]; xr[64 * j] = v[j] * rstd * gv; }
    }
}
DI void prep_rows(bf16_t* P, const float* qn, const float* kvn, const float* cw, const float* cb, const f32x2* tab, bf16_t* XC) {
    const int tid_ = opaque_tid(), lane = tid_ & 63, gw = blockIdx.x * 8 + (tid_ >> 6), ngw = gridDim.x * 8;
    for (int t = gw; t < S; t += ngw) {
        bf16_t* row = P + (size_t)t * NP;
        { unsigned w[3]; float s = 0.f;
#pragma unroll
          for (int k = 0; k < 3; ++k) { w[k] = *(const unsigned*)(row + PC_CQ + 128 * k + 2 * lane); const float a = bflo(w[k]), b = bfhi(w[k]); s += a * a + b * b; }
          const float rstd = 1.f / sqrtf(wave_sum(s) * (1.f / 384.f) + EPS);
#pragma unroll
          for (int k = 0; k < 3; ++k) { const int c = 128 * k + 2 * lane; *(unsigned*)(row + PC_CQ + c) = pk2(bflo(w[k]) * rstd * qn[c], bfhi(w[k]) * rstd * qn[c + 1]); } }
        { unsigned w[2]; float s = 0.f;
#pragma unroll
          for (int k = 0; k < 2; ++k) { w[k] = *(const unsigned*)(row + PC_CKV + 128 * k + 2 * lane); const float a = bflo(w[k]), b = bfhi(w[k]); s += a * a + b * b; }
          const float rstd = 1.f / sqrtf(wave_sum(s) * (1.f / 256.f) + EPS);
#pragma unroll
          for (int k = 0; k < 2; ++k) { const int c = 128 * k + 2 * lane; *(unsigned*)(row + PC_CKV + c) = pk2(bflo(w[k]) * rstd * kvn[c], bfhi(w[k]) * rstd * kvn[c + 1]); } }
        { const int j = lane & 31; const float x1 = bf2f(row[PC_KR + j]), x2 = bf2f(row[PC_KR + 32 + j]); const f32x2 cs = tab[(size_t)t * 32 + j];
          const unsigned o = pk2(x1 * cs.x - x2 * cs.y, x1 * cs.y + x2 * cs.x);
          asm volatile("" ::: "memory");
          if (lane < 32) *(unsigned*)(row + PC_KR + 2 * j) = o; }
#pragma unroll
        for (int k = 0; k < 8; ++k) { const int ch = 128 * k + 2 * lane; float a0 = cb[ch], a1 = cb[ch + 1];
#pragma unroll
            for (int j = 0; j < 4; ++j) { const int tt = t - 3 + j; if (tt >= 0) { const unsigned w = *(const unsigned*)(P + (size_t)tt * NP + PC_CX + ch); a0 += cw[j * 1024 + ch] * bflo(w); a1 += cw[j * 1024 + ch + 1] * bfhi(w); } }
            *(unsigned*)(XC + (size_t)t * 1024 + ch) = pk2(a0, a1); }
    }
}

DI void lru_p1(const bf16_t* LA, const bf16_t* U, float* CA, float* CH) {
    const int tid = opaque_tid();
    for (int c = blockIdx.x; c < 256; c += gridDim.x) {
        float h0 = 0.f, h1 = 0.f, s0 = 0.f, s1 = 0.f;
#pragma unroll 8
        for (int t = 0; t < 64; ++t) { const size_t row = (size_t)c * 64 + t; const unsigned lw = *(const unsigned*)(LA + row * NP + 2 * tid), uw = *(const unsigned*)(U + row * 1024 + 2 * tid);
            const float l0 = bflo(lw), l1 = bfhi(lw); s0 += l0; s1 += l1; h0 = __expf(l0) * h0 + bflo(uw); h1 = __expf(l1) * h1 + bfhi(uw); }
        CA[c * 1024 + 2 * tid] = __expf(s0); CA[c * 1024 + 2 * tid + 1] = __expf(s1); CH[c * 1024 + 2 * tid] = h0; CH[c * 1024 + 2 * tid + 1] = h1;
    }
}
DI void lru_p2(const float* CA, const float* CH, float* CARRY) {
    const int tid = opaque_tid(), lane = tid & 63, gw = blockIdx.x * 8 + (tid >> 6), ngw = gridDim.x * 8;
    for (int ch = gw; ch < 1024; ch += ngw) {
        float a[4], hh[4];
#pragma unroll
        for (int i = 0; i < 4; ++i) { a[i] = CA[(4 * lane + i) * 1024 + ch]; hh[i] = CH[(4 * lane + i) * 1024 + ch]; }
        float A = a[0], H = hh[0];
#pragma unroll
        for (int i = 1; i < 4; ++i) { H = a[i] * H + hh[i]; A = A * a[i]; }
#pragma unroll
        for (int o = 1; o < 64; o <<= 1) { const float Ap = __shfl_up(A, o), Hp = __shfl_up(H, o); if (lane >= o) { H = A * Hp + H; A = A * Ap; } }
        float st = __shfl_up(H, 1); if (lane == 0) st = 0.f;
#pragma unroll
        for (int i = 0; i < 4; ++i) { CARRY[(4 * lane + i) * 1024 + ch] = st; st = a[i] * st + hh[i]; }
    }
}
DI void lru_p3(const bf16_t* LA, const bf16_t* U, const float* CARRY, bf16_t* Y) {
    const int tid = opaque_tid();
    for (int c = blockIdx.x; c < 256; c += gridDim.x) {
        float h0 = CARRY[c * 1024 + 2 * tid], h1 = CARRY[c * 1024 + 2 * tid + 1];
#pragma unroll 8
        for (int t = 0; t < 64; ++t) { const size_t row = (size_t)c * 64 + t; const unsigned lw = *(const unsigned*)(LA + row * NP + 2 * tid), uw = *(const unsigned*)(U + row * 1024 + 2 * tid);
            h0 = __expf(bflo(lw)) * h0 + bflo(uw); h1 = __expf(bfhi(lw)) * h1 + bfhi(uw);
            *(unsigned*)(Y + row * 3072 + 2048 + 2 * tid) = pk2(h0, h1); }
    }
}

DI void mlstm_a(LAS unsigned char* smem, const bf16_t* P, const float* gbias, bf16_t* CS, float* SMALL) {
    const int tid = opaque_tid(), lane = tid & 63, wid = tid >> 6, l31 = lane & 31, h = lane >> 5, q4 = (lane & 15) >> 2, p4 = lane & 3, blk = (lane >> 4) & 1;
    LAS float* sw = (LAS float*)smem;
    LAS unsigned char* Ks = smem + 1024;
    LAS unsigned char* Vs = smem + 1024 + 20480;
    for (int uid = blockIdx.x; uid < 1024; uid += gridDim.x) {
        const int c = uid >> 2, hh = uid & 3; const size_t row0 = (size_t)c * 64;
        if (wid == 0) {
            const bf16_t* r = P + (row0 + lane) * NP;
            const float li = bf2f(r[PC_I + hh]) + gbias[hh], lf = logsigmoid_(bf2f(r[PC_F + hh]) + gbias[4 + hh]);
            const float bc = wave_incl_scan(lf, lane), bt = __shfl(bc, 63), ds = bt - bc + li, M = wave_max(ds);
            sw[lane] = expf(ds - M);
            if (lane == 0) { SMALL[SM_BT + uid] = bt; SMALL[SM_MC + uid] = M; }
        }
        __syncthreads();
#pragma unroll
        for (int i = 0; i < 2; ++i) { const int id = tid + 512 * i, s = id >> 4, d8 = (id & 15) * 8; const u32x4 v = *(const u32x4*)(P + (row0 + s) * NP + PC_K + hh * 128 + d8); const float w = sw[s];
            u32x4 o; o.x = pk2(bflo(v.x) * w, bfhi(v.x) * w); o.y = pk2(bflo(v.y) * w, bfhi(v.y) * w); o.z = pk2(bflo(v.z) * w, bfhi(v.z) * w); o.w = pk2(bflo(v.w) * w, bfhi(v.w) * w);
            *(LAS u32x4*)(Ks + s * 320 + d8 * 2) = o; }
#pragma unroll
        for (int i = 0; i < 4; ++i) { const int id = tid + 512 * i, s = id >> 5, d8 = (id & 31) * 8; *(LAS u32x4*)(Vs + s * 576 + d8 * 2) = *(const u32x4*)(P + (row0 + s) * NP + PC_V + hh * 256 + d8); }
        __syncthreads();
        f32x16 acc[4];
#pragma unroll
        for (int d = 0; d < 4; ++d)
#pragma unroll
            for (int i = 0; i < 16; ++i) acc[d][i] = 0.f;
#pragma unroll
        for (int kk = 0; kk < 4; ++kk) {
            const bf16x8 vf = tr_frag(Vs + (16 * kk + 8 * h + q4) * 576 + (32 * wid + 16 * blk) * 2 + 8 * p4, 576);
#pragma unroll
            for (int d = 0; d < 4; ++d) { const bf16x8 kf = tr_frag(Ks + (16 * kk + 8 * h + q4) * 320 + (32 * d + 16 * blk) * 2 + 8 * p4, 320); acc[d] = mfma32(kf, vf, acc[d]); }
        }
        bf16_t* cs = CS + (size_t)uid * 32768 + (32 * wid + l31) * 128;
#pragma unroll
        for (int d = 0; d < 4; ++d)
#pragma unroll
            for (int g = 0; g < 4; ++g) { u32x2 w; w.x = pk2(acc[d][4 * g], acc[d][4 * g + 1]); w.y = pk2(acc[d][4 * g + 2], acc[d][4 * g + 3]); *(u32x2*)(cs + 32 * d + 8 * g + 4 * h) = w; }
        if (tid < 128) { float s = 0.f;
#pragma unroll 8
            for (int t = 0; t < 64; ++t) s += bf2f(*(LAS const bf16_t*)(Ks + t * 320 + tid * 2));
            SMALL[SM_DN + uid * 128 + tid] = s; }
        __syncthreads();
    }
}
DI void mlstm_b(LAS unsigned char* smem, bf16_t* CS, float* SMALL) {
    const int tid = opaque_tid();
    LAS float* dec = (LAS float*)smem; LAS float* inj = dec + 1024;
    LAS float* sbt = inj + 1024; LAS float* smc = sbt + 1024;
    sbt[tid] = SMALL[SM_BT + tid]; sbt[tid + 512] = SMALL[SM_BT + tid + 512]; smc[tid] = SMALL[SM_MC + tid]; smc[tid + 512] = SMALL[SM_MC + tid + 512];
    __syncthreads();
    if (tid < 4) { float m = -1e30f;
        for (int c = 0; c < 256; ++c) { const float bt = sbt[c * 4 + tid], M = smc[c * 4 + tid]; sbt[c * 4 + tid] = m;
            const float mn = fmaxf(bt + m, M); dec[tid * 256 + c] = __expf(bt + m - mn); inj[tid * 256 + c] = __expf(M - mn); m = mn; } }
    __syncthreads();
    if (blockIdx.x == 0) { SMALL[SM_MPREV + tid] = sbt[tid]; SMALL[SM_MPREV + tid + 512] = sbt[tid + 512]; }
    for (int e = blockIdx.x * 512 + tid; e < 131072; e += gridDim.x * 512) {
        const int hh = e >> 15, idx = e & 32767; bf16_t* pp = CS + (size_t)hh * 32768 + idx; float st = 0.f;
#pragma unroll 8
        for (int c = 0; c < 256; ++c) { const float d = bf2f(pp[(size_t)c * 131072]); pp[(size_t)c * 131072] = f2bf(st); st = dec[hh * 256 + c] * st + inj[hh * 256 + c] * d; }
    }
    if (blockIdx.x == gridDim.x - 1) { const int hh = tid >> 7; float* pp = SMALL + SM_DN + tid; float st = 0.f;
#pragma unroll 8
        for (int c = 0; c < 256; ++c) { const float d = pp[c * 512]; pp[c * 512] = st; st = dec[hh * 256 + c] * st + inj[hh * 256 + c] * d; } }
    __syncthreads();
}
DI void mlstm_c(LAS unsigned char* smem, const bf16_t* P, const float* gbias, const float* onorm, const bf16_t* CS, const float* SMALL, bf16_t* Y) {
    const int tid = opaque_tid(), lane = tid & 63, wid = tid >> 6, l31 = lane & 31, h = lane >> 5, q4 = (lane & 15) >> 2, p4 = lane & 3, blk = (lane >> 4) & 1;
    LAS float* sbc = (LAS float*)smem; LAS float* sav = sbc + 64; LAS float* snp = sbc + 128; LAS float* sx = sbc + 256;
    LAS unsigned char* Qs = smem + 2048;
    LAS unsigned char* Ks = Qs + 17408;
    LAS unsigned char* Vs = Ks + 17408;
    const int tb = wid & 1, dvq = wid >> 1, t = 32 * tb + l31, pr = pi32(l31);
    for (int uid = blockIdx.x; uid < 1024; uid += gridDim.x) {
        const int c = uid >> 2, hh = uid & 3; const size_t row0 = (size_t)c * 64;
        if (wid == 0) {
            const bf16_t* r = P + (row0 + lane) * NP;
            const float li = bf2f(r[PC_I + hh]) + gbias[hh], lf = logsigmoid_(bf2f(r[PC_F + hh]) + gbias[4 + hh]);
            const float bc = wave_incl_scan(lf, lane);
            sbc[lane] = bc; sav[lane] = li - bc;
        }
        if (tid >= 64 && tid < 192) snp[tid - 64] = SMALL[SM_DN + uid * 128 + tid - 64];
#pragma unroll
        for (int i = 0; i < 2; ++i) { const int id = tid + 512 * i, s = id >> 4, d8 = (id & 15) * 8;
            *(LAS u32x4*)(Qs + s * 272 + d8 * 2) = *(const u32x4*)(P + (row0 + s) * NP + PC_Q + hh * 128 + d8);
            *(LAS u32x4*)(Ks + s * 272 + d8 * 2) = *(const u32x4*)(P + (row0 + s) * NP + PC_K + hh * 128 + d8); }
#pragma unroll
        for (int i = 0; i < 4; ++i) { const int id = tid + 512 * i, s = id >> 5, d8 = (id & 31) * 8; *(LAS u32x4*)(Vs + s * 576 + d8 * 2) = *(const u32x4*)(P + (row0 + s) * NP + PC_V + hh * 256 + d8); }
        __syncthreads();
        const float mprev = SMALL[SM_MPREV + uid];
        bf16x8 qf[8];
#pragma unroll
        for (int ks = 0; ks < 8; ++ks) qf[ks] = *(const LAS bf16x8*)(Qs + t * 272 + (16 * ks + 8 * h) * 2);
        f32x16 st0, st1;
#pragma unroll
        for (int i = 0; i < 16; ++i) { st0[i] = 0.f; st1[i] = 0.f; }
#pragma unroll
        for (int ks = 0; ks < 8; ++ks) { const bf16x8 a0 = *(const LAS bf16x8*)(Ks + pr * 272 + (16 * ks + 8 * h) * 2); st0 = mfma32(a0, qf[ks], st0);
            if (tb) { const bf16x8 a1 = *(const LAS bf16x8*)(Ks + (32 + pr) * 272 + (16 * ks + 8 * h) * 2); st1 = mfma32(a1, qf[ks], st1); } }
        const float bt = sbc[t];
        float mx = -1e30f;
#pragma unroll
        for (int i = 0; i < 16; ++i) { const int s = 16 * (i >> 3) + 8 * h + (i & 7); if (s <= t) mx = fmaxf(mx, sav[s]); if (tb) mx = fmaxf(mx, (s + 32 <= t) ? sav[s + 32] : -1e30f); }
        mx = fmaxf(mx, __shfl_xor(mx, 32));
        const float mt = bt + fmaxf(mprev, mx);
        float den = 0.f;
#pragma unroll
        for (int i = 0; i < 16; ++i) { const int s = 16 * (i >> 3) + 8 * h + (i & 7);
            const float w0 = (s <= t) ? expf(bt + sav[s] - mt) * MQS : 0.f; st0[i] *= w0; den += st0[i];
            const float w1 = (tb && (s + 32 <= t)) ? expf(bt + sav[s + 32] - mt) * MQS : 0.f; st1[i] *= w1; den += st1[i]; }
        den += __shfl_xor(den, 32);
        float qn = 0.f;
#pragma unroll
        for (int ks = 0; ks < 8; ++ks)
#pragma unroll
            for (int j = 0; j < 8; ++j) qn += bf2f((bf16_t)qf[ks][j]) * snp[16 * ks + 8 * h + j];
        qn += __shfl_xor(qn, 32);
        const float wi = expf(bt + mprev - mt) * MQS;
        den += wi * qn;
        const float dinv = 1.f / fmaxf(fabsf(den), expf(-mt));
        bf16x8 pf[4];
        pf[0] = pack8(st0[0], st0[1], st0[2], st0[3], st0[4], st0[5], st0[6], st0[7]); pf[1] = pack8(st0[8], st0[9], st0[10], st0[11], st0[12], st0[13], st0[14], st0[15]);
        pf[2] = pack8(st1[0], st1[1], st1[2], st1[3], st1[4], st1[5], st1[6], st1[7]); pf[3] = pack8(st1[8], st1[9], st1[10], st1[11], st1[12], st1[13], st1[14], st1[15]);
        float hv[2][16]; float ss = 0.f;
#pragma unroll
        for (int db = 0; db < 2; ++db) { const int dvb = 2 * dvq + db;
            f32x16 a1, a2;
#pragma unroll
            for (int i = 0; i < 16; ++i) { a1[i] = 0.f; a2[i] = 0.f; }
#pragma unroll
            for (int sb = 0; sb < 2; ++sb)
#pragma unroll
                for (int kk = 0; kk < 2; ++kk) { if (sb <= tb) { const bf16x8 vf = tr_frag(Vs + (32 * sb + 16 * kk + 8 * h + q4) * 576 + (32 * dvb + 16 * blk) * 2 + 8 * p4, 576); a1 = mfma32(vf, pf[2 * sb + kk], a1); } }
            const bf16_t* cp = CS + (size_t)uid * 32768 + (32 * dvb + l31) * 128 + 8 * h;
#pragma unroll
            for (int ks = 0; ks < 8; ++ks) { const bf16x8 cf = *(const bf16x8*)(cp + 16 * ks); a2 = mfma32(cf, qf[ks], a2); }
#pragma unroll
            for (int i = 0; i < 16; ++i) { const float v = (a1[i] + wi * a2[i]) * dinv; hv[db][i] = v; ss += v * v; }
        }
        ss += __shfl_xor(ss, 32);
        if (h == 0) sx[(tb * 4 + dvq) * 32 + l31] = ss;
        __syncthreads();
        const float tot = (sx[(tb * 4 + 0) * 32 + l31] + sx[(tb * 4 + 1) * 32 + l31]) + (sx[(tb * 4 + 2) * 32 + l31] + sx[(tb * 4 + 3) * 32 + l31]);
        const float rstd = 1.f / sqrtf(tot * (1.f / 256.f) + EPS);
#pragma unroll
        for (int db = 0; db < 2; ++db)
#pragma unroll
            for (int g = 0; g < 4; ++g) { const int col = hh * 256 + 32 * (2 * dvq + db) + 8 * g + 4 * h;
                const f32x4 gn = *(const f32x4*)(onorm + col); const u32x2 og = *(const u32x2*)(P + (row0 + t) * NP + PC_O + col);
                const float o0 = hv[db][4 * g] * rstd * gn.x * sigmoidf_(bflo(og.x)), o1 = hv[db][4 * g + 1] * rstd * gn.y * sigmoidf_(bfhi(og.x));
                const float o2 = hv[db][4 * g + 2] * rstd * gn.z * sigmoidf_(bflo(og.y)), o3 = hv[db][4 * g + 3] * rstd * gn.w * sigmoidf_(bfhi(og.y));
                u32x2 w; w.x = pk2(o0, o1); w.y = pk2(o2, o3); *(u32x2*)(Y + (row0 + t) * 3072 + col) = w; }
        __syncthreads();
    }
}

DI void attn_unit(LAS unsigned char* smem, int hh, int qb, const bf16_t* Q, const bf16_t* KN, const bf16_t* P, const bf16_t* VT, bf16_t* Y) {
    const int tid = opaque_tid(), lane = tid & 63, wid = __builtin_amdgcn_readfirstlane(tid >> 6), l31 = lane & 31, h = lane >> 5;
    LAS unsigned char* Kb = smem; LAS unsigned char* Vb = smem + 51200;
    const int q0 = qb * 256, qw = q0 + 32 * wid, q = qw + l31, NT = 4 * qb + 4;
    bf16x8 qf[12];
#pragma unroll
    for (int ks = 0; ks < 12; ++ks) qf[ks] = *(const bf16x8*)(Q + (size_t)q * 1536 + hh * 192 + 16 * ks + 8 * h);
    f32x16 o[4];
#pragma unroll
    for (int d = 0; d < 4; ++d)
#pragma unroll
        for (int i = 0; i < 16; ++i) o[d][i] = 0.f;
    float mrun = -1e30f, lrun = 0.f;
    const bf16_t* ksrc[3]; size_t kstr[3]; int kdst[3];
#pragma unroll
    for (int i = 0; i < 3; ++i) { const int id = tid + 512 * i, row = id / 24, ch = id - row * 24;
        if (ch < 16) { ksrc[i] = KN + (size_t)row * 1024 + hh * 128 + 8 * ch; kstr[i] = (size_t)64 * 1024; } else { ksrc[i] = P + (size_t)row * NP + PC_KR + 8 * (ch - 16); kstr[i] = (size_t)64 * NP; }
        kdst[i] = row * 400 + ch * 16; }
    const bf16_t* vsrc[2]; int vdst[2];
#pragma unroll
    for (int i = 0; i < 2; ++i) { const int id = tid + 512 * i, d = id >> 3, ch = id & 7; vsrc[i] = VT + (size_t)(hh * 128 + d) * S + 8 * ch; vdst[i] = d * 144 + ch * 16; }
    u32x4 kr[3], vr[2];
#pragma unroll
    for (int i = 0; i < 3; ++i) kr[i] = *(const u32x4*)(ksrc[i]);
#pragma unroll
    for (int i = 0; i < 2; ++i) vr[i] = *(const u32x4*)(vsrc[i]);
#pragma unroll
    for (int i = 0; i < 3; ++i) *(LAS u32x4*)(Kb + kdst[i]) = kr[i];
#pragma unroll
    for (int i = 0; i < 2; ++i) *(LAS u32x4*)(Vb + vdst[i]) = vr[i];
    __syncthreads();
    const int koff = pi32(l31) * 400 + 16 * h, voff = l31 * 144 + 16 * h;
    for (int t = 0; t < NT; ++t) {
        const int cur = t & 1;
        if (t + 1 < NT) {
#pragma unroll
            for (int i = 0; i < 3; ++i) kr[i] = *(const u32x4*)(ksrc[i] + (size_t)(t + 1) * kstr[i]);
#pragma unroll
            for (int i = 0; i < 2; ++i) vr[i] = *(const u32x4*)(vsrc[i] + (size_t)(t + 1) * 64);
        }
        if (64 * t <= qw + 31) {
            LAS const unsigned char* kb = Kb + cur * 25600 + koff; LAS const unsigned char* vb = Vb + cur * 18432 + voff;
            f32x16 s0, s1;
#pragma unroll
            for (int i = 0; i < 16; ++i) { s0[i] = 0.f; s1[i] = 0.f; }
#pragma unroll
            for (int ks = 0; ks < 12; ++ks) { const bf16x8 a0 = *(const LAS bf16x8*)(kb + ks * 32), a1 = *(const LAS bf16x8*)(kb + 32 * 400 + ks * 32); s0 = mfma32(a0, qf[ks], s0); s1 = mfma32(a1, qf[ks], s1); }
            if (64 * t + 63 > qw) {
#pragma unroll
                for (int i = 0; i < 16; ++i) { const int kv = 64 * t + 16 * (i >> 3) + 8 * h + (i & 7); if (kv > q) s0[i] = -1e30f; if (kv + 32 > q) s1[i] = -1e30f; }
            }
            float mx = fmaxf(s0[0], s1[0]);
#pragma unroll
            for (int i = 1; i < 16; ++i) mx = fmaxf(mx, fmaxf(s0[i], s1[i]));
            mx = fmaxf(mx, __shfl_xor(mx, 32));
            const float mnew = fmaxf(mrun, mx), alpha = __builtin_amdgcn_exp2f(mrun - mnew);
            mrun = mnew;
            float rs = 0.f;
#pragma unroll
            for (int i = 0; i < 16; ++i) { s0[i] = __builtin_amdgcn_exp2f(s0[i] - mnew); s1[i] = __builtin_amdgcn_exp2f(s1[i] - mnew); rs += s0[i] + s1[i]; }
            lrun = lrun * alpha + rs;
#pragma unroll
            for (int d = 0; d < 4; ++d)
#pragma unroll
                for (int i = 0; i < 16; ++i) o[d][i] *= alpha;
            bf16x8 pf[4];
            pf[0] = pack8(s0[0], s0[1], s0[2], s0[3], s0[4], s0[5], s0[6], s0[7]); pf[1] = pack8(s0[8], s0[9], s0[10], s0[11], s0[12], s0[13], s0[14], s0[15]);
            pf[2] = pack8(s1[0], s1[1], s1[2], s1[3], s1[4], s1[5], s1[6], s1[7]); pf[3] = pack8(s1[8], s1[9], s1[10], s1[11], s1[12], s1[13], s1[14], s1[15]);
#pragma unroll
            for (int d = 0; d < 4; ++d)
#pragma unroll
                for (int kk = 0; kk < 4; ++kk) { const bf16x8 vf = *(const LAS bf16x8*)(vb + d * 32 * 144 + kk * 32); o[d] = mfma32(vf, pf[kk], o[d]); }
        }
        if (t + 1 < NT) {
#pragma unroll
            for (int i = 0; i < 3; ++i) *(LAS u32x4*)(Kb + (cur ^ 1) * 25600 + kdst[i]) = kr[i];
#pragma unroll
            for (int i = 0; i < 2; ++i) *(LAS u32x4*)(Vb + (cur ^ 1) * 18432 + vdst[i]) = vr[i];
        }
        __syncthreads();
    }
    lrun += __shfl_xor(lrun, 32);
    const float inv = 1.f / lrun;
    bf16_t* yp = Y + (size_t)q * 3072 + 1024 + hh * 128 + 4 * h;
#pragma unroll
    for (int d = 0; d < 4; ++d)
#pragma unroll
        for (int g = 0; g < 4; ++g) { u32x2 w; w.x = pk2(o[d][4 * g] * inv, o[d][4 * g + 1] * inv); w.y = pk2(o[d][4 * g + 2] * inv, o[d][4 * g + 3] * inv); *(u32x2*)(yp + 32 * d + 8 * g) = w; }
}


#define XB_TMO      128
#define XB_XCNT(j)  (256  + 64 * (j))
#define XB_XSUB(j)  (1280 + 64 * (j))
#define XB_XGEN(j)  (2304 + 64 * (j))
#define XB_TOP      3328
#define XB_TOPGEN   3392
#define XCD_BAR_WORDS 3456
#define XB_SPIN_CAP (1u << 23)
DI unsigned xb_ld(unsigned* p)              { return __hip_atomic_load(p, __ATOMIC_RELAXED, __HIP_MEMORY_SCOPE_AGENT); }
DI unsigned xb_add(unsigned* p, unsigned v) { return __hip_atomic_fetch_add(p, v, __ATOMIC_RELAXED, __HIP_MEMORY_SCOPE_AGENT); }
DI unsigned xb_xcc_id() { return (unsigned)__builtin_amdgcn_s_getreg((3 << 11) | 20) & 0xFu; }
#define XB_SPIN(cond, bar) do { unsigned _sp = 0; while (cond) { __builtin_amdgcn_s_sleep(1); \
    if ((++_sp & 255u) == 0u) { if (xb_ld(&(bar)[XB_TMO])) break; if (_sp > XB_SPIN_CAP) { atomicAdd(&(bar)[XB_TMO], 1u); break; } } } } while (0)
struct XcdBarrier { unsigned* bar; unsigned x; volatile LAS unsigned* st; };
DI XcdBarrier xcd_barrier_post(unsigned* bar, volatile LAS unsigned* st) {
    XcdBarrier b; b.bar = bar; b.x = xb_xcc_id(); b.st = st;
    if (threadIdx.x == 0) (void)xb_add(&bar[XB_XCNT(b.x)], 1u);
    return b;
}
DI void xcd_barrier_complete(unsigned* bar, unsigned x, unsigned& nloc, unsigned& nx) {
    const unsigned G = gridDim.x * gridDim.y * gridDim.z;
    unsigned sum, cnt, mine, sp = 0u;
    for (;;) {
        sum = 0u; cnt = 0u; mine = 0u;
#pragma unroll
        for (unsigned j = 0; j < 16; ++j) { const unsigned c = xb_ld(&bar[XB_XCNT(j)]); sum += c; cnt += (c > 0u) ? 1u : 0u; mine = (j == x) ? c : mine; }
        if (sum == G) break;
        __builtin_amdgcn_s_sleep(1);
        if ((++sp & 255u) == 0u) { if (xb_ld(&bar[XB_TMO])) break; if (sp > XB_SPIN_CAP) { atomicAdd(&bar[XB_TMO], 1u); break; } }
    }
    nloc = mine > 0u ? mine : 1u; nx = cnt > 0u ? cnt : 1u;
}
DI void xcd_barrier(const XcdBarrier& b) {
    asm volatile("s_waitcnt vmcnt(0)" ::: "memory");
    __syncthreads();
    if (threadIdx.x == 0) {
        unsigned* bar = b.bar;
        __builtin_amdgcn_s_waitcnt(0);
        unsigned nloc = b.st[0], nx = b.st[1];
        if (nloc == 0u) { xcd_barrier_complete(bar, b.x, nloc, nx); b.st[0] = nloc; b.st[1] = nx; }
        const unsigned old = xb_add(&bar[XB_XSUB(b.x)], 1u);
        const unsigned gen = old / nloc;
        if (old + 1u == (gen + 1u) * nloc) {
            __builtin_amdgcn_fence(__ATOMIC_RELEASE, "agent");
            asm volatile("s_waitcnt vmcnt(0)" ::: "memory");
            const unsigned og = xb_add(&bar[XB_TOP], 1u);
            const unsigned tg = og / nx;
            if (og + 1u == (tg + 1u) * nx) xb_add(&bar[XB_TOPGEN], 1u);
            else XB_SPIN(xb_ld(&bar[XB_TOPGEN]) == tg, bar);
            __builtin_amdgcn_fence(__ATOMIC_ACQUIRE, "agent");
            xb_add(&bar[XB_XGEN(b.x)], 1u);
            asm volatile("s_waitcnt vmcnt(0)" ::: "memory");
        } else {
            XB_SPIN(xb_ld(&bar[XB_XGEN(b.x)]) == gen, bar);
            __builtin_amdgcn_fence(__ATOMIC_ACQUIRE, "agent");
            asm volatile("s_waitcnt vmcnt(0)" ::: "memory");
        }
    }
    __syncthreads();
}

struct Params { const float* in[27]; float* out; unsigned char* ws; };

__global__ void __launch_bounds__(512, 2) mega_fwd(Params p) {
    extern __shared__ __attribute__((aligned(16))) unsigned char smem_raw[];
    LAS unsigned char* smem = (LAS unsigned char*)smem_raw;
    cg::grid_group grid = cg::this_grid();
    const int G = gridDim.x, bx = blockIdx.x;
    { const int t0 = opaque_tid(); if (t0 < 128) ((LAS unsigned*)(smem + 131072))[t0] = 0u; }
    __syncthreads();
    XcdBarrier bar = xcd_barrier_post((unsigned*)(p.ws + WS_CTL), (volatile LAS unsigned*)(smem + 131072) + 8);
    unsigned char* ws = p.ws;
    f32x2* TAB = (f32x2*)(ws + WS_TAB); float* SMALL = (float*)(ws + WS_SMALL);
    bf16_t* WFFGU = (bf16_t*)(ws + WS_WFFGU); bf16_t* WFFD = (bf16_t*)(ws + WS_WFFD); bf16_t* WIN = (bf16_t*)(ws + WS_WIN); bf16_t* WUQ = (bf16_t*)(ws + WS_WUQ);
    bf16_t* WUKV = (bf16_t*)(ws + WS_WUKV); bf16_t* WLRU = (bf16_t*)(ws + WS_WLRU); bf16_t* WBR = (bf16_t*)(ws + WS_WBR); bf16_t* WOUT = (bf16_t*)(ws + WS_WOUT);
    bf16_t* XN = (bf16_t*)(ws + WS_XN); bf16_t* P = (bf16_t*)(ws + WS_P); bf16_t* Hb = P; bf16_t* Qb = (bf16_t*)(ws + WS_Q); bf16_t* KN = (bf16_t*)(ws + WS_KN);
    bf16_t* VT = (bf16_t*)(ws + WS_VT); bf16_t* Y = (bf16_t*)(ws + WS_Y); bf16_t* XC = (bf16_t*)(ws + WS_XC); bf16_t* CS = (bf16_t*)(ws + WS_CS);

    for (int i = bx * 512 + opaque_tid(); i < S * 32; i += G * 512) { const int t = i >> 5, j = i & 31; const float ang = (float)t * INVF[j];
        double r = (double)ang * 0.15915494309189535; r -= __builtin_floor(r); const float fr = (float)r;
        TAB[i] = (f32x2){__builtin_amdgcn_cosf(fr), __builtin_amdgcn_sinf(fr)}; }

#pragma unroll 1
    for (int hl = 0; hl < 4; ++hl) {
        const int l = hl >> 1, second = hl & 1;
        const float* xin = hl == 0 ? p.in[0] : p.out;
        {
            const int nmat = second ? 3 : 26; int rot = 0;
#pragma unroll 1
            for (int mi = 0; mi < nmat; ++mi) {
                const float* src; int K, N, map; bf16_t* dst;
                if (mi == 0) { src = p.in[second ? 23 : 2] + (size_t)l * DM * FF; K = DM; N = FF; map = 1; dst = WFFGU; }
                else if (mi == 1) { src = p.in[second ? 24 : 3] + (size_t)l * DM * FF; K = DM; N = FF; map = 2; dst = WFFGU; }
                else if (mi == 2) { src = p.in[second ? 25 : 4] + (size_t)l * DM * FF; K = FF; N = DM; map = 0; dst = WFFD; }
                else if (mi == 3) { src = p.in[6] + (size_t)l * DM * NIN; K = DM; N = NIN; map = 3; dst = WIN; }
                else if (mi == 4) { src = p.in[10] + (size_t)l * 384 * 1536; K = 384; N = 1536; map = 4; dst = WUQ; }
                else if (mi == 5) { src = p.in[12] + (size_t)l * 256 * 2048; K = 256; N = 2048; map = 5; dst = WUKV; }
                else if (mi < 22) { const int k = mi - 6, n = k >> 1, wx = k & 1; src = p.in[wx ? 17 : 15] + (size_t)l * 131072 + n * 16384; K = 128; N = 128; map = 0; dst = WLRU + (size_t)(n * 256 + wx * 128) * 128; }
                else if (mi < 25) { const int j = mi - 22; src = p.in[20] + (size_t)l * 3 * 1024 * 2048 + (size_t)j * 1024 * 2048; K = 1024; N = 2048; map = 0; dst = WBR + (size_t)j * 2048 * 1024; }
                else { src = p.in[21] + (size_t)l * DM * DM; K = DM; N = DM; map = 0; dst = WOUT; }
                convert_mat(src, K, N, dst, map, rot);
            }
            rmsnorm_rows(xin, p.in[second ? 22 : 1] + l * DM, XN);
        }
        if (hl == 0) grid.sync(); else xcd_barrier(bar);
        { pg8::Gemm g{XN, WFFGU, S, 2 * FF, DM, DM, DM, 0}; pg8::StaticOrder so; so.init(S, 2 * FF, G, bx); pg8::EpiSwiglu E{Hb}; pg8::gemm_phase(smem, g, so, E); }
        xcd_barrier(bar);
        { pg8::Gemm g{Hb, WFFD, S, DM, FF, FF, FF, 0}; pg8::StaticOrder so; so.init(S, DM, G, bx); pg8::EpiRes E{xin, p.out, 0.5f}; pg8::gemm_phase(smem, g, so, E); }
        xcd_barrier(bar);
        if (!second) {
            const float* gbias = p.in[7] + l * 8;
            rmsnorm_rows(p.out, p.in[5] + l * DM, XN);
            xcd_barrier(bar);
            { pg8::Gemm g{XN, WIN, S, NP, DM, DM, DM, 0}; pg8::StaticOrder so; so.init(S, NP, G, bx); pg8::EpiStore E{P, NP}; pg8::gemm_phase(smem, g, so, E); }
            xcd_barrier(bar);
            if (bx == G - 1) { const float* lam = p.in[19] + l * 1024; for (int ch = opaque_tid(); ch < 1024; ch += 512) SMALL[SM_SP + ch] = -8.f * log1pf(expf(-lam[ch])); }
            mlstm_a(smem, P, gbias, CS, SMALL);
            prep_rows(P, p.in[9] + l * 384, p.in[11] + l * 256, p.in[13] + l * 4096, p.in[14] + l * 1024, TAB, XC);
            xcd_barrier(bar);
            mlstm_b(smem, CS, SMALL);
            { pg8::Gemm g{P + PC_CQ, WUQ, S, 1536, 384, NP, 384, 0}; pg8::StaticOrder so; so.init(S, 1536, G, bx); pg8::EpiQ E{Qb, TAB}; pg8::gemm_phase(smem, g, so, E); }
#pragma unroll 1
            for (int gi = 0; gi < 2; ++gi) {
                pg8::Gemm g; pg8::StaticOrder so; pg8::EpiStore E;
                if (gi == 0) { g = pg8::Gemm{P + PC_CKV, WUKV, S, 1024, 256, NP, 256, 0}; so.init(S, 1024, G, bx); E = pg8::EpiStore{KN, 1024}; }
                else { g = pg8::Gemm{WUKV + 1024 * 256, P + PC_CKV, 1024, S, 256, 256, NP, 0}; so.init(1024, S, G, bx); E = pg8::EpiStore{VT, S}; }
                pg8::gemm_phase(smem, g, so, E);
            }
            { pg8::Gemm g{XC, WLRU, S, 2048, 128, 1024, 128, 128}; pg8::StaticOrder so; so.init(S, 2048, G, bx); pg8::EpiLru E{XC, P + PC_CX, p.in[16] + l * 1024, p.in[18] + l * 1024, SMALL + SM_SP}; pg8::gemm_phase(smem, g, so, E); }
            xcd_barrier(bar);
            mlstm_c(smem, P, gbias, p.in[8] + l * 1024, CS, SMALL, Y);
            lru_p1(P + PC_CX, XC, SMALL + SM_CA, SMALL + SM_CH);
            xcd_barrier(bar);
            lru_p2(SMALL + SM_CA, SMALL + SM_CH, SMALL + SM_CARRY);
            for (int item = bx; item < 256; item += G) { const int hh = item & 7, pp = item >> 3;
#pragma unroll 1
                for (int half = 0; half < 2; ++half) attn_unit(smem, hh, half ? 63 - pp : pp, Qb, KN, P, VT, Y); }
            xcd_barrier(bar);
            lru_p3(P + PC_CX, XC, SMALL + SM_CARRY, Y);
#pragma unroll 1
            for (int j = 0; j < 3; ++j) {
                if (j == 2) xcd_barrier(bar);
                pg8::Gemm g{Y + j * 1024, WBR + (size_t)j * 2048 * 1024, S, DM, 1024, 3072, 1024, 0}; pg8::StaticOrder so; so.init(S, DM, G, bx); pg8::EpiMerge E{XN, P + PC_G + j * 2048, j == 0}; pg8::gemm_phase(smem, g, so, E);
            }
            xcd_barrier(bar);
            { pg8::Gemm g{XN, WOUT, S, DM, DM, DM, DM, 0}; pg8::StaticOrder so; so.init(S, DM, G, bx); pg8::EpiRes E{p.out, p.out, 1.0f}; pg8::gemm_phase(smem, g, so, E); }
            xcd_barrier(bar);
        }
    }
    final_norm_rows(p.out, p.in[26]);
}

constexpr int LDS_BYTES = 143360;

extern "C" void kernel_launch(void* const* d_in, const int* in_sizes, int n_in, void* d_out, int out_size, void* d_ws, size_t ws_size, hipStream_t stream) {
    static int grid = 0;
    if (grid == 0) {
        if (n_in != 27 || out_size != S * DM || ws_size < WS_END) { fprintf(stderr, "kernel_launch: unexpected problem (n_in %d out %d ws %zu, need %zu)\n", n_in, out_size, ws_size, (size_t)WS_END); grid = -1; return; }
        int dev = 0, cus = 0, per_cu = 0;
        hipGetDevice(&dev); hipDeviceGetAttribute(&cus, hipDeviceAttributeMultiprocessorCount, dev);
        if (hipFuncSetAttribute((const void*)mega_fwd, hipFuncAttributeMaxDynamicSharedMemorySize, LDS_BYTES) != hipSuccess) { fprintf(stderr, "kernel_launch: hipFuncSetAttribute failed\n"); grid = -1; return; }
        if (hipOccupancyMaxActiveBlocksPerMultiprocessor(&per_cu, (const void*)mega_fwd, 512, LDS_BYTES) != hipSuccess || per_cu < 1) { fprintf(stderr, "kernel_launch: occupancy query says %d\n", per_cu); per_cu = 1; }
        (void)hipGetLastError();
        grid = cus * (per_cu > 1 ? 1 : per_cu);
    }
    if (grid < 0) return;
    if (hipMemsetAsync((char*)d_ws + WS_CTL, 0, CTL_BYTES, stream) != hipSuccess) { fprintf(stderr, "kernel_launch: memset failed\n"); return; }
    Params p{};
    for (int i = 0; i < 27; ++i) p.in[i] = (const float*)d_in[i];
    p.out = (float*)d_out; p.ws = (unsigned char*)d_ws;
    void* args[] = {&p};
    hipError_t e = hipLaunchCooperativeKernel((const void*)mega_fwd, dim3(grid), dim3(512), args, LDS_BYTES, stream);
    if (e != hipSuccess) fprintf(stderr, "cooperative launch failed: %s (grid %d)\n", hipGetErrorString(e), grid);
}
```

```cpp
#include <hip/hip_runtime.h>
#include <hip/hip_cooperative_groups.h>
#include <cstdio>
#include <cstdint>
namespace cg = cooperative_groups;

#define DI __device__ __forceinline__
#define LAS __attribute__((address_space(3)))
typedef unsigned short bf16_t;
typedef short bf16x8 __attribute__((ext_vector_type(8)));
typedef short s16x4 __attribute__((ext_vector_type(4)));
typedef float f32x2 __attribute__((ext_vector_type(2)));
typedef float f32x4 __attribute__((ext_vector_type(4)));
typedef float f32x16 __attribute__((ext_vector_type(16)));
typedef unsigned u32x2 __attribute__((ext_vector_type(2)));
typedef unsigned u32x4 __attribute__((ext_vector_type(4)));
typedef __bf16 bf16x2_t __attribute__((ext_vector_type(2)));

constexpr int S = 16384, DM = 2048, FF = 5632, NIN = 10952, NP = 11008;
constexpr float EPS = 1e-6f;
constexpr int PC_Q = 0, PC_K = 512, PC_V = 1024, PC_O = 2048, PC_CQ = 3072, PC_CKV = 3456, PC_KR = 3712, PC_CX = 3776, PC_G = 4800, PC_I = 10944, PC_F = 10948;
constexpr float MQS = 0.08838834764831845f;
constexpr float AQS = 0.07216878364870322f * 1.4426950408889634f;

constexpr size_t MiB = 1u << 20;
constexpr size_t WS_TAB = 0;
constexpr size_t WS_SMALL = 4 * MiB;
constexpr size_t WS_WFFGU = 12 * MiB;
constexpr size_t WS_WFFD = 56 * MiB;
constexpr size_t WS_WIN = 78 * MiB;
constexpr size_t WS_WUQ = 121 * MiB;
constexpr size_t WS_WUKV = 123 * MiB;
constexpr size_t WS_WLRU = 124 * MiB;
constexpr size_t WS_WBR = 125 * MiB;
constexpr size_t WS_WOUT = 137 * MiB;
constexpr size_t WS_XN = 145 * MiB;
constexpr size_t WS_P = 209 * MiB;
constexpr size_t WS_Q = 553 * MiB;
constexpr size_t WS_KN = 601 * MiB;
constexpr size_t WS_VT = 633 * MiB;
constexpr size_t WS_Y = 665 * MiB;
constexpr size_t WS_XC = 761 * MiB;
constexpr size_t WS_CS = 793 * MiB;
constexpr size_t WS_END = 857 * MiB;
constexpr size_t WS_CTL = 11 * MiB, CTL_BYTES = 16384;
constexpr int SM_BT = 0, SM_MC = 1024, SM_MPREV = 2048, SM_DN = 4096  , SM_CA = 4096 + 131072  , SM_CH = SM_CA + 262144, SM_CARRY = SM_CH + 262144, SM_SP = SM_CARRY + 262144;

__device__ const float INVF[32] = {1.0f, 0.7498942613601685f, 0.5623413324356079f, 0.4216965138912201f, 0.3162277638912201f, 0.23713737726211548f, 0.17782793939113617f, 0.133352130651474f, 0.10000000149011612f, 0.07498941570520401f, 0.05623413249850273f, 0.04216965287923813f, 0.03162277489900589f, 0.023713737726211548f, 0.017782794311642647f, 0.01333521492779255f, 0.009999999776482582f, 0.007498941849917173f, 0.005623413249850273f, 0.0042169648222625256f, 0.003162277629598975f, 0.00237137358635664f, 0.0017782794311642647f, 0.0013335214462131262f, 0.0010000000474974513f, 0.0007498942431993783f, 0.000562341301701963f, 0.0004216965171508491f, 0.0003162277571391314f, 0.00023713737027719617f, 0.00017782794020604342f, 0.0001333521504420787f};

DI int opaque_tid() { int t = threadIdx.x; asm volatile("" : "+v"(t)); return t; }
DI float bf2f(bf16_t v) { return __uint_as_float((unsigned)v << 16); }
DI float bflo(unsigned w) { return __uint_as_float(w << 16); }
DI float bfhi(unsigned w) { return __uint_as_float(w & 0xffff0000u); }
DI unsigned pk2(float lo, float hi) { f32x2 v = {lo, hi}; bf16x2_t b = __builtin_convertvector(v, bf16x2_t); return __builtin_bit_cast(unsigned, b); }
DI bf16_t f2bf(float f) { return (bf16_t)(pk2(f, 0.f) & 0xffffu); }
DI float wave_sum(float v) {
#pragma unroll
    for (int o = 1; o < 64; o <<= 1) v += __shfl_xor(v, o);
    return v;
}
DI float wave_max(float v) {
#pragma unroll
    for (int o = 1; o < 64; o <<= 1) v = fmaxf(v, __shfl_xor(v, o));
    return v;
}
DI float wave_incl_scan(float v, int lane) {
#pragma unroll
    for (int o = 1; o < 64; o <<= 1) { const float n = __shfl_up(v, o); if (lane >= o) v += n; }
    return v;
}
DI float sigmoidf_(float x) { return 1.f / (1.f + __expf(-x)); }
DI float logsigmoid_(float x) { return fminf(x, 0.f) - log1pf(expf(-fabsf(x))); }
DI f32x16 mfma32(bf16x8 a, bf16x8 b, f32x16 c) { return __builtin_amdgcn_mfma_f32_32x32x16_bf16(a, b, c, 0, 0, 0); }
DI int crow(int r, int h) { return (r & 3) + 8 * (r >> 2) + 4 * h; }
DI int pi32(int m) { return (m & ~12) | ((m & 4) << 1) | ((m & 8) >> 1); }
typedef short v4i16_t __attribute__((ext_vector_type(4)));
DI s16x4 tr16(LAS const unsigned char* p) { return __builtin_bit_cast(s16x4, __builtin_amdgcn_ds_read_tr16_b64_v4i16((LAS v4i16_t*)p)); }
DI bf16x8 tr_frag(LAS const unsigned char* p, int rs) {
    const s16x4 lo = tr16(p), hi = tr16(p + 4 * rs);
    return __builtin_shufflevector(lo, hi, 0, 1, 2, 3, 4, 5, 6, 7);
}
DI bf16x8 pack8(float a0, float a1, float a2, float a3, float a4, float a5, float a6, float a7) {
    u32x4 w; w.x = pk2(a0, a1); w.y = pk2(a2, a3); w.z = pk2(a4, a5); w.w = pk2(a6, a7); return __builtin_bit_cast(bf16x8, w);
}

namespace pg8 {
constexpr int BM = 256, BK = 64, HALF = 128, HTB = HALF * BK * 2, STAGE_BYTES = 8 * HTB, NXCD = 8, WGM = 8;
DI int lds_byte(int r, int c) { const int st = (r >> 4) * 2 + (c >> 5), rr = r & 15, cc = c & 31, ob = rr * 64 + cc * 2; return st * 1024 + (ob ^ (((ob >> 9) & 1) << 5)); }
DI void stage_rc(int b, int& R, int& C) { const int st = b / 1024, sb = b % 1024, swz = sb ^ (((sb >> 9) & 1) << 5); R = (st >> 1) * 16 + swz / 64; C = (st & 1) * 32 + (swz % 64) / 2; }
DI int perm32(int rho) { const int n = rho >> 4, i = rho & 15; return 8 * (i >> 2) + 4 * n + (i & 3); }
struct Unit { int pm, pn; };
struct Gemm { const bf16_t* A; const bf16_t* Bt; int M, N, K, lda, ldb, apn; };
struct StaticOrder {
    int nM, nN, nwg, G, c;
    DI void init(int M, int N, int G_, int c_) { nM = M / BM; nN = N / BM; nwg = nM * nN; G = G_; c = c_; }
    DI bool next(int i, Unit& u) const {
        const long L = (long)i * G + c; if (L >= nwg) return false;
        int wgid = (int)L; { const int q = nwg / NXCD, r = nwg % NXCD, xcd = wgid % NXCD, off = wgid / NXCD; wgid = (xcd < r ? xcd * (q + 1) : r * (q + 1) + (xcd - r) * q) + off; }
        const int nig = WGM * nN, gid = wgid / nig, fm = gid * WGM, gsz = (nM - fm) < WGM ? (nM - fm) : WGM;
        u.pm = fm + ((wgid % nig) % gsz); u.pn = (wgid % nig) / gsz; return true;
    }
};
template <class Epi>
DI void gemm_phase(LAS unsigned char* lds, const Gemm g, const StaticOrder& S, const Epi& E) {
    const int tid = opaque_tid(), wid = __builtin_amdgcn_readfirstlane(tid >> 6), lane = tid & 63, wr = wid >> 2, wc = wid & 3, fr = lane & 15, fq = lane >> 4;
    int K = g.K; asm volatile("" : "+s"(K)); const int nt = K / BK;
    unsigned voffA[2], voffB[2];
#pragma unroll
    for (int i = 0; i < 2; ++i) { int R, C; stage_rc(tid * 16 + i * 8192, R, C); const int Rb = Epi::PERM ? ((R & ~31) + perm32(R & 31)) : R;
        voffA[i] = (unsigned)(R * g.lda + C) * 2u; voffB[i] = (unsigned)(Rb * g.ldb + C) * 2u; }
    const size_t kstep = (size_t)(BK * 2);
    const size_t hstepA = (size_t)HALF * g.lda * 2, hstepB = (size_t)HALF * g.ldb * 2;
    const unsigned ldsw = (unsigned)wid * 1024u;
    const int aoff = lds_byte(wr * 64 + fr, fq * 8), boff = lds_byte(wc * 32 + fr, fq * 8);
#define PG8_SA(b, h) (((b) * 2 + (h)) * HTB)
#define PG8_SB(b, h) ((4 + (b) * 2 + (h)) * HTB)
#define PG8_STAGE(bufoff, gbase, voff) do { _Pragma("unroll") for (int _i = 0; _i < 2; ++_i) \
        __builtin_amdgcn_global_load_lds((const unsigned*)((const char*)(gbase) + (voff)[_i]), (LAS unsigned*)(lds + (bufoff) + ldsw + _i * 8192), 16, 0, 0); } while (0)
#define PG8_LDA(dst, b, h) do { _Pragma("unroll") for (int m = 0; m < 4; ++m) _Pragma("unroll") for (int k = 0; k < 2; ++k) dst[m][k] = *(const LAS bf16x8*)(lds + PG8_SA(b, h) + aoff + m * 2048 + k * 1024); } while (0)
#define PG8_LDB(dst, b, h) do { _Pragma("unroll") for (int n = 0; n < 2; ++n) _Pragma("unroll") for (int k = 0; k < 2; ++k) dst[n][k] = *(const LAS bf16x8*)(lds + PG8_SB(b, h) + boff + n * 2048 + k * 1024); } while (0)
#define PG8_MMA(ai, bj, At, Bt) do { __builtin_amdgcn_s_setprio(1); _Pragma("unroll") for (int m = 0; m < 4; ++m) _Pragma("unroll") for (int n = 0; n < 2; ++n) _Pragma("unroll") for (int k = 0; k < 2; ++k) \
        acc[ai][bj][m][n] = __builtin_amdgcn_mfma_f32_16x16x32_bf16(Bt[n][k], At[m][k], acc[ai][bj][m][n], 0, 0, 0); __builtin_amdgcn_s_setprio(0); } while (0)
#define PG8_WAIT_V(n) asm volatile("s_waitcnt vmcnt(" #n ")" ::: "memory")
#define PG8_WAIT_L(n) asm volatile("s_waitcnt lgkmcnt(" #n ")" ::: "memory")
#define PG8_BAR __builtin_amdgcn_s_barrier()
#define PG8_SCHED __builtin_amdgcn_sched_barrier(0)
#define PG8_APTR(u) ((const char*)g.A + (size_t)(u).pm * 2 * hstepA + (size_t)(u).pn * (size_t)g.apn * 2)
#define PG8_BPTR(u) ((const char*)g.Bt + (size_t)(u).pn * 2 * hstepB)
    Unit cur, nxt; int ui = 0;
    if (!S.next(0, cur)) return;
    f32x4 acc[2][2][4][2];
#pragma unroll
    for (int a = 0; a < 2; ++a)
#pragma unroll
        for (int b = 0; b < 2; ++b)
#pragma unroll
            for (int m = 0; m < 4; ++m)
#pragma unroll
                for (int n = 0; n < 2; ++n) acc[a][b][m][n] = (f32x4){0.f, 0.f, 0.f, 0.f};
    bf16x8 At[4][2], B0[2][2], B1[2][2];
    const char* cA = PG8_APTR(cur); const char* cB = PG8_BPTR(cur);
    PG8_STAGE(PG8_SB(0, 0), cB, voffB); PG8_STAGE(PG8_SB(0, 1), cB + hstepB, voffB); PG8_STAGE(PG8_SA(0, 0), cA, voffA); PG8_STAGE(PG8_SA(0, 1), cA + hstepA, voffA);
    if (wr == 1) PG8_BAR;
    PG8_WAIT_V(2); PG8_BAR;
    PG8_STAGE(PG8_SB(1, 0), cB + kstep, voffB); PG8_STAGE(PG8_SA(1, 0), cA + kstep, voffA); PG8_STAGE(PG8_SB(1, 1), cB + hstepB + kstep, voffB);
    PG8_WAIT_V(6); PG8_BAR;
    for (;;) {
        const bool has_next = S.next(ui + 1, nxt);
        const char* nA = has_next ? PG8_APTR(nxt) : cA; const char* nB = has_next ? PG8_BPTR(nxt) : cB;
        for (int t = 0; t < nt; t += 2) {
            const bool last = (t == nt - 2);
            const char* a1 = cA + (size_t)(t + 1) * kstep;
            const char* a2 = last ? nA : cA + (size_t)(t + 2) * kstep; const char* b2 = last ? nB : cB + (size_t)(t + 2) * kstep;
            const char* a3 = a2 + kstep; const char* b3 = b2 + kstep;
            PG8_LDB(B0, 0, 0); PG8_LDB(B1, 0, 1); PG8_SCHED; PG8_LDA(At, 0, 0); PG8_STAGE(PG8_SA(1, 1), a1 + hstepA, voffA);
            PG8_WAIT_V(8); PG8_WAIT_L(0); PG8_BAR; PG8_MMA(0, 0, At, B0); PG8_MMA(0, 1, At, B1); PG8_BAR; PG8_SCHED;
            PG8_LDA(At, 0, 1); PG8_STAGE(PG8_SB(0, 0), b2, voffB); PG8_STAGE(PG8_SB(0, 1), b2 + hstepB, voffB); PG8_STAGE(PG8_SA(0, 0), a2, voffA);
            PG8_WAIT_V(8); PG8_WAIT_L(0); PG8_BAR; PG8_MMA(1, 0, At, B0); PG8_MMA(1, 1, At, B1); PG8_BAR; PG8_SCHED;
            PG8_LDB(B0, 1, 0); PG8_LDB(B1, 1, 1); PG8_SCHED; PG8_LDA(At, 1, 0); PG8_STAGE(PG8_SA(0, 1), a2 + hstepA, voffA);
            PG8_WAIT_V(8); PG8_WAIT_L(0); PG8_BAR; PG8_MMA(0, 0, At, B0); PG8_MMA(0, 1, At, B1); PG8_BAR; PG8_SCHED;
            PG8_LDA(At, 1, 1); PG8_STAGE(PG8_SB(1, 0), b3, voffB); PG8_STAGE(PG8_SB(1, 1), b3 + hstepB, voffB); PG8_STAGE(PG8_SA(1, 0), a3, voffA);
            PG8_WAIT_V(8); PG8_WAIT_L(0); PG8_BAR; PG8_MMA(1, 0, At, B0); PG8_MMA(1, 1, At, B1); PG8_BAR; PG8_SCHED;
        }
        if (wr == 0) PG8_BAR;
        E(acc, cur, wr, wc, fr, fq);
        if (!has_next) break;
#pragma unroll
        for (int a = 0; a < 2; ++a)
#pragma unroll
            for (int b = 0; b < 2; ++b)
#pragma unroll
                for (int m = 0; m < 4; ++m)
#pragma unroll
                    for (int n = 0; n < 2; ++n) acc[a][b][m][n] = (f32x4){0.f, 0.f, 0.f, 0.f};
        cur = nxt; cA = nA; cB = nB; ++ui;
        if (wr == 1) PG8_BAR;
    }
    PG8_WAIT_V(0);
    PG8_BAR;
#undef PG8_SA
#undef PG8_SB
#undef PG8_STAGE
#undef PG8_LDA
#undef PG8_LDB
#undef PG8_MMA
#undef PG8_WAIT_V
#undef PG8_WAIT_L
#undef PG8_BAR
#undef PG8_SCHED
#undef PG8_APTR
#undef PG8_BPTR
}

typedef f32x4 Acc[2][2][4][2];
struct EpiStore {
    static constexpr bool PERM = true;
    bf16_t* O; int ldc;
    DI void operator()(const Acc& acc, const Unit& u, int wr, int wc, int fr, int fq) const {
        const int row0 = u.pm * BM + wr * 64 + fr, col0 = u.pn * BM + wc * 32 + 8 * fq;
#pragma unroll
        for (int ai = 0; ai < 2; ++ai)
#pragma unroll
            for (int m = 0; m < 4; ++m) { bf16_t* rowp = O + (size_t)(row0 + ai * HALF + m * 16) * ldc + col0;
#pragma unroll
                for (int bj = 0; bj < 2; ++bj) { const f32x4 v0 = acc[ai][bj][m][0], v1 = acc[ai][bj][m][1];
                    u32x4 w; w.x = pk2(v0[0], v0[1]); w.y = pk2(v0[2], v0[3]); w.z = pk2(v1[0], v1[1]); w.w = pk2(v1[2], v1[3]);
                    *(u32x4*)(rowp + bj * HALF) = w; } }
    }
};
struct EpiSwiglu {
    static constexpr bool PERM = true;
    bf16_t* H;
    DI void operator()(const Acc& acc, const Unit& u, int wr, int wc, int fr, int fq) const {
        const int row0 = u.pm * BM + wr * 64 + fr, col0 = u.pn * HALF + wc * 32 + 8 * fq;
#pragma unroll
        for (int ai = 0; ai < 2; ++ai)
#pragma unroll
            for (int m = 0; m < 4; ++m) { bf16_t* rowp = H + (size_t)(row0 + ai * HALF + m * 16) * FF + col0;
                float o[8];
#pragma unroll
                for (int n = 0; n < 2; ++n)
#pragma unroll
                    for (int j = 0; j < 4; ++j) { const float gt = acc[ai][0][m][n][j], up = acc[ai][1][m][n][j]; o[n * 4 + j] = gt * sigmoidf_(gt) * up; }
                u32x4 w; w.x = pk2(o[0], o[1]); w.y = pk2(o[2], o[3]); w.z = pk2(o[4], o[5]); w.w = pk2(o[6], o[7]);
                *(u32x4*)rowp = w; }
    }
};
struct EpiRes {
    static constexpr bool PERM = false;
    const float* xin; float* xout; float alpha;
    DI void operator()(const Acc& acc, const Unit& u, int wr, int wc, int fr, int fq) const {
        const int col0 = u.pn * BM + wc * 32 + 4 * fq;
#pragma unroll
        for (int ai = 0; ai < 2; ++ai)
#pragma unroll
            for (int m = 0; m < 4; ++m) { const size_t off = (size_t)(u.pm * BM + ai * HALF + wr * 64 + m * 16 + fr) * DM + col0;
#pragma unroll
                for (int bj = 0; bj < 2; ++bj)
#pragma unroll
                    for (int n = 0; n < 2; ++n) { const f32x4 b = *(const f32x4*)(xin + off + bj * HALF + n * 16); *(f32x4*)(xout + off + bj * HALF + n * 16) = b + acc[ai][bj][m][n] * alpha; } }
    }
};
struct EpiQ {
    static constexpr bool PERM = true;
    bf16_t* Q; const f32x2* tab;
    DI void operator()(const Acc& acc, const Unit& u, int wr, int wc, int fr, int fq) const {
        const int row0 = u.pm * BM + wr * 64 + fr;
#pragma unroll
        for (int bj = 0; bj < 2; ++bj) {
            const int c0 = u.pn * BM + bj * HALF + wc * 32 + 8 * fq; const int hh = c0 / 192, dd = c0 - hh * 192; const bool rope = dd >= 128; const int j0 = (dd - 128) >> 1;
#pragma unroll
            for (int ai = 0; ai < 2; ++ai)
#pragma unroll
                for (int m = 0; m < 4; ++m) { const int row = row0 + ai * HALF + m * 16;
                    float v[8];
#pragma unroll
                    for (int n = 0; n < 2; ++n)
#pragma unroll
                        for (int j = 0; j < 4; ++j) v[n * 4 + j] = acc[ai][bj][m][n][j];
                    if (rope) {
#pragma unroll
                        for (int p = 0; p < 4; ++p) { const f32x2 cs = tab[(size_t)row * 32 + j0 + p]; const float x1 = v[2 * p], x2 = v[2 * p + 1]; v[2 * p] = x1 * cs.x - x2 * cs.y; v[2 * p + 1] = x1 * cs.y + x2 * cs.x; }
                    }
                    u32x4 w; w.x = pk2(v[0] * AQS, v[1] * AQS); w.y = pk2(v[2] * AQS, v[3] * AQS); w.z = pk2(v[4] * AQS, v[5] * AQS); w.w = pk2(v[6] * AQS, v[7] * AQS);
                    *(u32x4*)(Q + (size_t)row * 1536 + c0) = w; }
        }
    }
};
struct EpiLru {
    static constexpr bool PERM = true;
    bf16_t* XC; bf16_t* LA; const float* ba; const float* bx; const float* sp;
    DI void operator()(const Acc& acc, const Unit& u, int wr, int wc, int fr, int fq) const {
        const int row0 = u.pm * BM + wr * 64 + fr, ch0 = u.pn * HALF + wc * 32 + 8 * fq;
#pragma unroll
        for (int ai = 0; ai < 2; ++ai)
#pragma unroll
            for (int m = 0; m < 4; ++m) { const int row = row0 + ai * HALF + m * 16;
                const u32x4 xw = *(const u32x4*)(XC + (size_t)row * 1024 + ch0);
                const float xv[8] = {bflo(xw.x), bfhi(xw.x), bflo(xw.y), bfhi(xw.y), bflo(xw.z), bfhi(xw.z), bflo(xw.w), bfhi(xw.w)};
                u32x4 wl, wu;
#pragma unroll
                for (int n = 0; n < 2; ++n) { const f32x4 spv = *(const f32x4*)(sp + ch0 + 4 * n), bav = *(const f32x4*)(ba + ch0 + 4 * n), bxv = *(const f32x4*)(bx + ch0 + 4 * n);
                    float la[4], uu[4];
#pragma unroll
                    for (int j = 0; j < 4; ++j) { const float r = sigmoidf_(acc[ai][0][m][n][j] + bav[j]), gi = sigmoidf_(acc[ai][1][m][n][j] + bxv[j]);
                        const float l = r * spv[j]; la[j] = l; const float a2 = __expf(2.f * l); uu[j] = sqrtf(fmaxf(1.f - a2, 0.f)) * gi * xv[n * 4 + j]; }
                    if (n == 0) { wl.x = pk2(la[0], la[1]); wl.y = pk2(la[2], la[3]); wu.x = pk2(uu[0], uu[1]); wu.y = pk2(uu[2], uu[3]); }
                    else { wl.z = pk2(la[0], la[1]); wl.w = pk2(la[2], la[3]); wu.z = pk2(uu[0], uu[1]); wu.w = pk2(uu[2], uu[3]); } }
                *(u32x4*)(LA + (size_t)row * NP + ch0) = wl;
                *(u32x4*)(XC + (size_t)row * 1024 + ch0) = wu;
                asm volatile("" ::: "memory"); }
    }
};
struct EpiMerge {
    static constexpr bool PERM = true;
    bf16_t* Z; const bf16_t* G; int first;
    DI void operator()(const Acc& acc, const Unit& u, int wr, int wc, int fr, int fq) const {
        const int row0 = u.pm * BM + wr * 64 + fr, col0 = u.pn * BM + wc * 32 + 8 * fq;
#pragma unroll
        for (int ai = 0; ai < 2; ++ai)
#pragma unroll
            for (int m = 0; m < 4; ++m) { const int row = row0 + ai * HALF + m * 16;
#pragma unroll
                for (int bj = 0; bj < 2; ++bj) { const int c = col0 + bj * HALF;
                    const u32x4 gw = *(const u32x4*)(G + (size_t)row * NP + c);
                    const float gv[8] = {bflo(gw.x), bfhi(gw.x), bflo(gw.y), bfhi(gw.y), bflo(gw.z), bfhi(gw.z), bflo(gw.w), bfhi(gw.w)};
                    float o[8];
#pragma unroll
                    for (int n = 0; n < 2; ++n)
#pragma unroll
                        for (int j = 0; j < 4; ++j) o[n * 4 + j] = sigmoidf_(gv[n * 4 + j]) * acc[ai][bj][m][n][j];
                    bf16_t* zp = Z + (size_t)row * DM + c;
                    if (!first) { const u32x4 zw = *(const u32x4*)zp; o[0] += bflo(zw.x); o[1] += bfhi(zw.x); o[2] += bflo(zw.y); o[3] += bfhi(zw.y); o[4] += bflo(zw.z); o[5] += bfhi(zw.z); o[6] += bflo(zw.w); o[7] += bfhi(zw.w); }
                    u32x4 w; w.x = pk2(o[0], o[1]); w.y = pk2(o[2], o[3]); w.z = pk2(o[4], o[5]); w.w = pk2(o[6], o[7]);
                    *(u32x4*)zp = w; } }
    }
};
}

DI int map_row(int map, int n) {
    switch (map) {
        case 1: return ((n >> 7) << 8) + (n & 127);
        case 2: return ((n >> 7) << 8) + 128 + (n & 127);
        case 3: { if (n < 2048) return n; if (n < 2052) return PC_I + n - 2048; if (n < 2056) return PC_F + n - 2052; if (n < 3080) return PC_O + n - 2056; if (n < 3464) return PC_CQ + n - 3080;
                  if (n < 3720) return PC_CKV + n - 3464; if (n < 3784) return PC_KR + n - 3720; if (n < 4808) return PC_CX + n - 3784; return PC_G + n - 4808; }
        case 4: { const int hh = n / 192, dd = n - hh * 192; if (dd < 128) return n; const int jj = dd - 128; return hh * 192 + 128 + (jj < 32 ? 2 * jj : 2 * (jj - 32) + 1); }
        case 5: { const int hh = n >> 8, dd = n & 255; return dd < 128 ? hh * 128 + dd : 1024 + hh * 128 + dd - 128; }
        default: return n;
    }
}
DI void convert_mat(const float* W, int K, int N, bf16_t* WT, int map, int& rot) {
    const int tid_ = opaque_tid(), lane = tid_ & 63, gw = blockIdx.x * 8 + (tid_ >> 6), ngw = gridDim.x * 8;
    const int nch = (N + 255) >> 8, nkb = K >> 5, nitems = nch * nkb;
    int it = gw - rot; if (it < 0) it += ngw;
    for (; it < nitems; it += ngw) {
        const int nc = it / nkb, kb = it - nc * nkb, n0 = nc * 256 + lane * 4, k0 = kb * 32;
        if (n0 < N) {
            const float* src = W + (size_t)k0 * N + n0;
            bf16_t* d0 = WT + (size_t)map_row(map, n0) * K + k0; bf16_t* d1 = WT + (size_t)map_row(map, n0 + 1) * K + k0;
            bf16_t* d2 = WT + (size_t)map_row(map, n0 + 2) * K + k0; bf16_t* d3 = WT + (size_t)map_row(map, n0 + 3) * K + k0;
#pragma unroll 2
            for (int kk = 0; kk < 4; ++kk) {
                f32x4 v[8];
#pragma unroll
                for (int i = 0; i < 8; ++i) v[i] = *(const f32x4*)(src + (size_t)(kk * 8 + i) * N);
                u32x4 o;
                o.x = pk2(v[0].x, v[1].x); o.y = pk2(v[2].x, v[3].x); o.z = pk2(v[4].x, v[5].x); o.w = pk2(v[6].x, v[7].x); *(u32x4*)(d0 + kk * 8) = o;
                o.x = pk2(v[0].y, v[1].y); o.y = pk2(v[2].y, v[3].y); o.z = pk2(v[4].y, v[5].y); o.w = pk2(v[6].y, v[7].y); *(u32x4*)(d1 + kk * 8) = o;
                o.x = pk2(v[0].z, v[1].z); o.y = pk2(v[2].z, v[3].z); o.z = pk2(v[4].z, v[5].z); o.w = pk2(v[6].z, v[7].z); *(u32x4*)(d2 + kk * 8) = o;
                o.x = pk2(v[0].w, v[1].w); o.y = pk2(v[2].w, v[3].w); o.z = pk2(v[4].w, v[5].w); o.w = pk2(v[6].w, v[7].w); *(u32x4*)(d3 + kk * 8) = o;
            }
        }
    }
    rot = (rot + nitems) % ngw;
}

DI void rmsnorm_rows(const float* X, const float* g, bf16_t* O) {
    const int tid_ = opaque_tid(), lane = tid_ & 63, gw = blockIdx.x * 8 + (tid_ >> 6), ngw = gridDim.x * 8;
    for (int r = gw; r < S; r += ngw) {
        const f32x4* xr = (const f32x4*)(X + (size_t)r * DM) + lane; f32x4 v[8]; float s = 0.f;
#pragma unroll
        for (int j = 0; j < 8; ++j) { v[j] = xr[64 * j]; s += (v[j].x * v[j].x + v[j].y * v[j].y) + (v[j].z * v[j].z + v[j].w * v[j].w); }
        const float rstd = 1.f / sqrtf(wave_sum(s) * (1.f / DM) + EPS);
        u32x2* o8 = (u32x2*)(O + (size_t)r * DM) + lane;
#pragma unroll
        for (int j = 0; j < 8; ++j) { const f32x4 gv = ((const f32x4*)g)[lane + 64 * j]; u32x2 w; w.x = pk2(v[j].x * rstd * gv.x, v[j].y * rstd * gv.y); w.y = pk2(v[j].z * rstd * gv.z, v[j].w * rstd * gv.w); o8[64 * j] = w; }
    }
}
DI void final_norm_rows(float* X, const float* g) {
    const int tid_ = opaque_tid(), lane = tid_ & 63, gw = blockIdx.x * 8 + (tid_ >> 6), ngw = gridDim.x * 8;
    for (int r = gw; r < S; r += ngw) {
        f32x4* xr = (f32x4*)(X + (size_t)r * DM) + lane; f32x4 v[8]; float s = 0.f;
#pragma unroll
        for (int j = 0; j < 8; ++j) { v[j] = xr[64 * j]; s += (v[j].x * v[j].x + v[j].y * v[j].y) + (v[j].z * v[j].z + v[j].w * v[j].w); }
        const float rstd = 1.f / sqrtf(wave_sum(s) * (1.f / DM) + EPS);
#pragma unroll
        for (int j = 0; j < 8; ++j) { const f32x4 gv = ((const f32x4*)g)[lane + 64 * j]; xr[64 * j] = v[j] * rstd * gv; }
    }
}
DI void prep_rows(bf16_t* P, const float* qn, const float* kvn, const float* cw, const float* cb, const f32x2* tab, bf16_t* XC) {
    const int tid_ = opaque_tid(), lane = tid_ & 63, gw = blockIdx.x * 8 + (tid_ >> 6), ngw = gridDim.x * 8;
    for (int t = gw; t < S; t += ngw) {
        bf16_t* row = P + (size_t)t * NP;
        unsigned wq[3], wk[2], wc[8][4];
#pragma unroll
        for (int k = 0; k < 3; ++k) wq[k] = *(const unsigned*)(row + PC_CQ + 128 * k + 2 * lane);
#pragma unroll
        for (int k = 0; k < 2; ++k) wk[k] = *(const unsigned*)(row + PC_CKV + 128 * k + 2 * lane);
        const int j = lane & 31; const float x1 = bf2f(row[PC_KR + j]), x2 = bf2f(row[PC_KR + 32 + j]); const f32x2 cs = tab[(size_t)t * 32 + j];
#pragma unroll
        for (int k = 0; k < 8; ++k)
#pragma unroll
            for (int jj = 0; jj < 4; ++jj) { const int tt = t - 3 + jj; wc[k][jj] = tt >= 0 ? *(const unsigned*)(P + (size_t)tt * NP + PC_CX + 128 * k + 2 * lane) : 0u; }
        asm volatile("" ::: "memory");
        { float s = 0.f;
#pragma unroll
          for (int k = 0; k < 3; ++k) { const float a = bflo(wq[k]), b = bfhi(wq[k]); s += a * a + b * b; }
          const float rstd = 1.f / sqrtf(wave_sum(s) * (1.f / 384.f) + EPS);
#pragma unroll
          for (int k = 0; k < 3; ++k) { const int c = 128 * k + 2 * lane; *(unsigned*)(row + PC_CQ + c) = pk2(bflo(wq[k]) * rstd * qn[c], bfhi(wq[k]) * rstd * qn[c + 1]); } }
        { float s = 0.f;
#pragma unroll
          for (int k = 0; k < 2; ++k) { const float a = bflo(wk[k]), b = bfhi(wk[k]); s += a * a + b * b; }
          const float rstd = 1.f / sqrtf(wave_sum(s) * (1.f / 256.f) + EPS);
#pragma unroll
          for (int k = 0; k < 2; ++k) { const int c = 128 * k + 2 * lane; *(unsigned*)(row + PC_CKV + c) = pk2(bflo(wk[k]) * rstd * kvn[c], bfhi(wk[k]) * rstd * kvn[c + 1]); } }
        { const unsigned o = pk2(x1 * cs.x - x2 * cs.y, x1 * cs.y + x2 * cs.x); if (lane < 32) *(unsigned*)(row + PC_KR + 2 * j) = o; }
#pragma unroll
        for (int k = 0; k < 8; ++k) { const int ch = 128 * k + 2 * lane; float a0 = cb[ch], a1 = cb[ch + 1];
#pragma unroll
            for (int jj = 0; jj < 4; ++jj) { a0 += cw[jj * 1024 + ch] * bflo(wc[k][jj]); a1 += cw[jj * 1024 + ch + 1] * bfhi(wc[k][jj]); }
            *(unsigned*)(XC + (size_t)t * 1024 + ch) = pk2(a0, a1); }
    }
}

DI void lru_p1(const bf16_t* LA, const bf16_t* U, float* CA, float* CH) {
    const int tid = opaque_tid();
    for (int c = blockIdx.x; c < 256; c += gridDim.x) {
        float h0 = 0.f, h1 = 0.f, s0 = 0.f, s1 = 0.f;
#pragma unroll 1
        for (int t0 = 0; t0 < 64; t0 += 16) {
            unsigned lw[16], uw[16];
#pragma unroll
            for (int i = 0; i < 16; ++i) { const size_t row = (size_t)c * 64 + t0 + i; lw[i] = *(const unsigned*)(LA + row * NP + 2 * tid); uw[i] = *(const unsigned*)(U + row * 1024 + 2 * tid); }
#pragma unroll
            for (int i = 0; i < 16; ++i) { const float l0 = bflo(lw[i]), l1 = bfhi(lw[i]); s0 += l0; s1 += l1; h0 = __expf(l0) * h0 + bflo(uw[i]); h1 = __expf(l1) * h1 + bfhi(uw[i]); }
        }
        CA[c * 1024 + 2 * tid] = __expf(s0); CA[c * 1024 + 2 * tid + 1] = __expf(s1); CH[c * 1024 + 2 * tid] = h0; CH[c * 1024 + 2 * tid + 1] = h1;
    }
}
DI void lru_p2(const float* CA, const float* CH, float* CARRY) {
    const int tid = opaque_tid(), lane = tid & 63, gw = blockIdx.x * 8 + (tid >> 6), ngw = gridDim.x * 8;
    for (int ch = gw; ch < 1024; ch += ngw) {
        float a[4], hh[4];
#pragma unroll
        for (int i = 0; i < 4; ++i) { a[i] = CA[(4 * lane + i) * 1024 + ch]; hh[i] = CH[(4 * lane + i) * 1024 + ch]; }
        float A = a[0], H = hh[0];
#pragma unroll
        for (int i = 1; i < 4; ++i) { H = a[i] * H + hh[i]; A = A * a[i]; }
#pragma unroll
        for (int o = 1; o < 64; o <<= 1) { const float Ap = __shfl_up(A, o), Hp = __shfl_up(H, o); if (lane >= o) { H = A * Hp + H; A = A * Ap; } }
        float st = __shfl_up(H, 1); if (lane == 0) st = 0.f;
#pragma unroll
        for (int i = 0; i < 4; ++i) { CARRY[(4 * lane + i) * 1024 + ch] = st; st = a[i] * st + hh[i]; }
    }
}
DI void lru_p3(const bf16_t* LA, const bf16_t* U, const float* CARRY, bf16_t* Y) {
    const int tid = opaque_tid();
    for (int c = blockIdx.x; c < 256; c += gridDim.x) {
        float h0 = CARRY[c * 1024 + 2 * tid], h1 = CARRY[c * 1024 + 2 * tid + 1];
#pragma unroll 1
        for (int t0 = 0; t0 < 64; t0 += 16) {
            unsigned lw[16], uw[16];
#pragma unroll
            for (int i = 0; i < 16; ++i) { const size_t row = (size_t)c * 64 + t0 + i; lw[i] = *(const unsigned*)(LA + row * NP + 2 * tid); uw[i] = *(const unsigned*)(U + row * 1024 + 2 * tid); }
            asm volatile("" ::: "memory");
#pragma unroll
            for (int i = 0; i < 16; ++i) { const size_t row = (size_t)c * 64 + t0 + i; h0 = __expf(bflo(lw[i])) * h0 + bflo(uw[i]); h1 = __expf(bfhi(lw[i])) * h1 + bfhi(uw[i]);
                *(unsigned*)(Y + row * 3072 + 2048 + 2 * tid) = pk2(h0, h1); }
            asm volatile("" ::: "memory");
        }
    }
}

DI void mlstm_a(LAS unsigned char* smem, const bf16_t* P, const float* gbias, bf16_t* CS, float* SMALL) {
    const int tid = opaque_tid(), lane = tid & 63, wid = tid >> 6, l31 = lane & 31, h = lane >> 5, q4 = (lane & 15) >> 2, p4 = lane & 3, blk = (lane >> 4) & 1;
    LAS float* sw = (LAS float*)smem;
    LAS unsigned char* Ks = smem + 1024;
    LAS unsigned char* Vs = smem + 1024 + 20480;
    for (int uid = blockIdx.x; uid < 1024; uid += gridDim.x) {
        const int c = uid >> 2, hh = uid & 3; const size_t row0 = (size_t)c * 64;
        if (wid == 0) {
            const bf16_t* r = P + (row0 + lane) * NP;
            const float li = bf2f(r[PC_I + hh]) + gbias[hh], lf = logsigmoid_(bf2f(r[PC_F + hh]) + gbias[4 + hh]);
            const float bc = wave_incl_scan(lf, lane), bt = __shfl(bc, 63), ds = bt - bc + li, M = wave_max(ds);
            sw[lane] = expf(ds - M);
            if (lane == 0) { SMALL[SM_BT + uid] = bt; SMALL[SM_MC + uid] = M; }
        }
        __syncthreads();
#pragma unroll
        for (int i = 0; i < 2; ++i) { const int id = tid + 512 * i, s = id >> 4, d8 = (id & 15) * 8; const u32x4 v = *(const u32x4*)(P + (row0 + s) * NP + PC_K + hh * 128 + d8); const float w = sw[s];
            u32x4 o; o.x = pk2(bflo(v.x) * w, bfhi(v.x) * w); o.y = pk2(bflo(v.y) * w, bfhi(v.y) * w); o.z = pk2(bflo(v.z) * w, bfhi(v.z) * w); o.w = pk2(bflo(v.w) * w, bfhi(v.w) * w);
            *(LAS u32x4*)(Ks + s * 320 + d8 * 2) = o; }
#pragma unroll
        for (int i = 0; i < 4; ++i) { const int id = tid + 512 * i, s = id >> 5, d8 = (id & 31) * 8; *(LAS u32x4*)(Vs + s * 576 + d8 * 2) = *(const u32x4*)(P + (row0 + s) * NP + PC_V + hh * 256 + d8); }
        __syncthreads();
        f32x16 acc[4];
#pragma unroll
        for (int d = 0; d < 4; ++d)
#pragma unroll
            for (int i = 0; i < 16; ++i) acc[d][i] = 0.f;
#pragma unroll
        for (int kk = 0; kk < 4; ++kk) {
            const bf16x8 vf = tr_frag(Vs + (16 * kk + 8 * h + q4) * 576 + (32 * wid + 16 * blk) * 2 + 8 * p4, 576);
#pragma unroll
            for (int d = 0; d < 4; ++d) { const bf16x8 kf = tr_frag(Ks + (16 * kk + 8 * h + q4) * 320 + (32 * d + 16 * blk) * 2 + 8 * p4, 320); acc[d] = mfma32(kf, vf, acc[d]); }
        }
        bf16_t* cs = CS + (size_t)uid * 32768 + (32 * wid + l31) * 128;
#pragma unroll
        for (int d = 0; d < 4; ++d)
#pragma unroll
            for (int g = 0; g < 4; ++g) { u32x2 w; w.x = pk2(acc[d][4 * g], acc[d][4 * g + 1]); w.y = pk2(acc[d][4 * g + 2], acc[d][4 * g + 3]); *(u32x2*)(cs + 32 * d + 8 * g + 4 * h) = w; }
        if (tid < 128) { float s = 0.f;
#pragma unroll 8
            for (int t = 0; t < 64; ++t) s += bf2f(*(LAS const bf16_t*)(Ks + t * 320 + tid * 2));
            SMALL[SM_DN + uid * 128 + tid] = s; }
        __syncthreads();
    }
}
DI void mlstm_b(LAS unsigned char* smem, bf16_t* CS, float* SMALL) {
    const int tid = opaque_tid();
    LAS float* dec = (LAS float*)smem; LAS float* inj = dec + 1024;
    LAS float* sbt = inj + 1024; LAS float* smc = sbt + 1024;
    sbt[tid] = SMALL[SM_BT + tid]; sbt[tid + 512] = SMALL[SM_BT + tid + 512]; smc[tid] = SMALL[SM_MC + tid]; smc[tid + 512] = SMALL[SM_MC + tid + 512];
    __syncthreads();
    if (tid < 4) { float m = -1e30f;
        for (int c = 0; c < 256; ++c) { const float bt = sbt[c * 4 + tid], M = smc[c * 4 + tid]; sbt[c * 4 + tid] = m;
            const float mn = fmaxf(bt + m, M); dec[tid * 256 + c] = __expf(bt + m - mn); inj[tid * 256 + c] = __expf(M - mn); m = mn; } }
    __syncthreads();
    if (blockIdx.x == 0) { SMALL[SM_MPREV + tid] = sbt[tid]; SMALL[SM_MPREV + tid + 512] = sbt[tid + 512]; }
    for (int e = blockIdx.x * 512 + tid; e < 131072; e += gridDim.x * 512) {
        const int hh = e >> 15, idx = e & 32767; bf16_t* pp = CS + (size_t)hh * 32768 + idx; float st = 0.f;
        bf16_t d[32];
#pragma unroll
        for (int i = 0; i < 32; ++i) d[i] = pp[(size_t)i * 131072];
#pragma unroll 1
        for (int c0 = 0; c0 < 256; c0 += 32) {
            bf16_t dn[32];
            const int cn = c0 + 32 < 256 ? c0 + 32 : c0;
#pragma unroll
            for (int i = 0; i < 32; ++i) dn[i] = pp[(size_t)(cn + i) * 131072];
            asm volatile("" ::: "memory");
#pragma unroll
            for (int i = 0; i < 32; ++i) { pp[(size_t)(c0 + i) * 131072] = f2bf(st); st = dec[hh * 256 + c0 + i] * st + inj[hh * 256 + c0 + i] * bf2f(d[i]); }
            asm volatile("" ::: "memory");
#pragma unroll
            for (int i = 0; i < 32; ++i) d[i] = dn[i];
        }
    }
    if (blockIdx.x == gridDim.x - 1) { const int hh = tid >> 7; float* pp = SMALL + SM_DN + tid; float st = 0.f;
#pragma unroll 1
        for (int c0 = 0; c0 < 256; c0 += 32) {
            float d[32];
#pragma unroll
            for (int i = 0; i < 32; ++i) d[i] = pp[(c0 + i) * 512];
            asm volatile("" ::: "memory");
#pragma unroll
            for (int i = 0; i < 32; ++i) { pp[(c0 + i) * 512] = st; st = dec[hh * 256 + c0 + i] * st + inj[hh * 256 + c0 + i] * d[i]; }
            asm volatile("" ::: "memory");
        } }
    __syncthreads();
}
DI void mlstm_c(LAS unsigned char* smem, const bf16_t* P, const float* gbias, const float* onorm, const bf16_t* CS, const float* SMALL, bf16_t* Y) {
    const int tid = opaque_tid(), lane = tid & 63, wid = tid >> 6, l31 = lane & 31, h = lane >> 5, q4 = (lane & 15) >> 2, p4 = lane & 3, blk = (lane >> 4) & 1;
    LAS float* sbc = (LAS float*)smem; LAS float* sav = sbc + 64; LAS float* snp = sbc + 128; LAS float* sx = sbc + 256;
    LAS unsigned char* Qs = smem + 2048;
    LAS unsigned char* Ks = Qs + 17408;
    LAS unsigned char* Vs = Ks + 17408;
    const int tb = wid & 1, dvq = wid >> 1, t = 32 * tb + l31, pr = pi32(l31);
    for (int uid = blockIdx.x; uid < 1024; uid += gridDim.x) {
        const int c = uid >> 2, hh = uid & 3; const size_t row0 = (size_t)c * 64;
        if (wid == 0) {
            const bf16_t* r = P + (row0 + lane) * NP;
            const float li = bf2f(r[PC_I + hh]) + gbias[hh], lf = logsigmoid_(bf2f(r[PC_F + hh]) + gbias[4 + hh]);
            const float bc = wave_incl_scan(lf, lane);
            sbc[lane] = bc; sav[lane] = li - bc;
        }
        if (tid >= 64 && tid < 192) snp[tid - 64] = SMALL[SM_DN + uid * 128 + tid - 64];
#pragma unroll
        for (int i = 0; i < 2; ++i) { const int id = tid + 512 * i, s = id >> 4, d8 = (id & 15) * 8;
            *(LAS u32x4*)(Qs + s * 272 + d8 * 2) = *(const u32x4*)(P + (row0 + s) * NP + PC_Q + hh * 128 + d8);
            *(LAS u32x4*)(Ks + s * 272 + d8 * 2) = *(const u32x4*)(P + (row0 + s) * NP + PC_K + hh * 128 + d8); }
#pragma unroll
        for (int i = 0; i < 4; ++i) { const int id = tid + 512 * i, s = id >> 5, d8 = (id & 31) * 8; *(LAS u32x4*)(Vs + s * 576 + d8 * 2) = *(const u32x4*)(P + (row0 + s) * NP + PC_V + hh * 256 + d8); }
        __syncthreads();
        const float mprev = SMALL[SM_MPREV + uid];
        bf16x8 qf[8];
#pragma unroll
        for (int ks = 0; ks < 8; ++ks) qf[ks] = *(const LAS bf16x8*)(Qs + t * 272 + (16 * ks + 8 * h) * 2);
        f32x16 st0, st1;
#pragma unroll
        for (int i = 0; i < 16; ++i) { st0[i] = 0.f; st1[i] = 0.f; }
#pragma unroll
        for (int ks = 0; ks < 8; ++ks) { const bf16x8 a0 = *(const LAS bf16x8*)(Ks + pr * 272 + (16 * ks + 8 * h) * 2); st0 = mfma32(a0, qf[ks], st0);
            if (tb) { const bf16x8 a1 = *(const LAS bf16x8*)(Ks + (32 + pr) * 272 + (16 * ks + 8 * h) * 2); st1 = mfma32(a1, qf[ks], st1); } }
        const float bt = sbc[t];
        float mx = -1e30f;
#pragma unroll
        for (int i = 0; i < 16; ++i) { const int s = 16 * (i >> 3) + 8 * h + (i & 7); if (s <= t) mx = fmaxf(mx, sav[s]); if (tb) mx = fmaxf(mx, (s + 32 <= t) ? sav[s + 32] : -1e30f); }
        mx = fmaxf(mx, __shfl_xor(mx, 32));
        const float mt = bt + fmaxf(mprev, mx);
        float den = 0.f;
#pragma unroll
        for (int i = 0; i < 16; ++i) { const int s = 16 * (i >> 3) + 8 * h + (i & 7);
            const float w0 = (s <= t) ? expf(bt + sav[s] - mt) * MQS : 0.f; st0[i] *= w0; den += st0[i];
            const float w1 = (tb && (s + 32 <= t)) ? expf(bt + sav[s + 32] - mt) * MQS : 0.f; st1[i] *= w1; den += st1[i]; }
        den += __shfl_xor(den, 32);
        float qn = 0.f;
#pragma unroll
        for (int ks = 0; ks < 8; ++ks)
#pragma unroll
            for (int j = 0; j < 8; ++j) qn += bf2f((bf16_t)qf[ks][j]) * snp[16 * ks + 8 * h + j];
        qn += __shfl_xor(qn, 32);
        const float wi = expf(bt + mprev - mt) * MQS;
        den += wi * qn;
        const float dinv = 1.f / fmaxf(fabsf(den), expf(-mt));
        bf16x8 pf[4];
        pf[0] = pack8(st0[0], st0[1], st0[2], st0[3], st0[4], st0[5], st0[6], st0[7]); pf[1] = pack8(st0[8], st0[9], st0[10], st0[11], st0[12], st0[13], st0[14], st0[15]);
        pf[2] = pack8(st1[0], st1[1], st1[2], st1[3], st1[4], st1[5], st1[6], st1[7]); pf[3] = pack8(st1[8], st1[9], st1[10], st1[11], st1[12], st1[13], st1[14], st1[15]);
        float hv[2][16]; float ss = 0.f;
#pragma unroll
        for (int db = 0; db < 2; ++db) { const int dvb = 2 * dvq + db;
            f32x16 a1, a2;
#pragma unroll
            for (int i = 0; i < 16; ++i) { a1[i] = 0.f; a2[i] = 0.f; }
#pragma unroll
            for (int sb = 0; sb < 2; ++sb)
#pragma unroll
                for (int kk = 0; kk < 2; ++kk) { if (sb <= tb) { const bf16x8 vf = tr_frag(Vs + (32 * sb + 16 * kk + 8 * h + q4) * 576 + (32 * dvb + 16 * blk) * 2 + 8 * p4, 576); a1 = mfma32(vf, pf[2 * sb + kk], a1); } }
            const bf16_t* cp = CS + (size_t)uid * 32768 + (32 * dvb + l31) * 128 + 8 * h;
#pragma unroll
            for (int ks = 0; ks < 8; ++ks) { const bf16x8 cf = *(const bf16x8*)(cp + 16 * ks); a2 = mfma32(cf, qf[ks], a2); }
#pragma unroll
            for (int i = 0; i < 16; ++i) { const float v = (a1[i] + wi * a2[i]) * dinv; hv[db][i] = v; ss += v * v; }
        }
        ss += __shfl_xor(ss, 32);
        if (h == 0) sx[(tb * 4 + dvq) * 32 + l31] = ss;
        __syncthreads();
        const float tot = (sx[(tb * 4 + 0) * 32 + l31] + sx[(tb * 4 + 1) * 32 + l31]) + (sx[(tb * 4 + 2) * 32 + l31] + sx[(tb * 4 + 3) * 32 + l31]);
        const float rstd = 1.f / sqrtf(tot * (1.f / 256.f) + EPS);
#pragma unroll
        for (int db = 0; db < 2; ++db)
#pragma unroll
            for (int g = 0; g < 4; ++g) { const int col = hh * 256 + 32 * (2 * dvq + db) + 8 * g + 4 * h;
                const f32x4 gn = *(const f32x4*)(onorm + col); const u32x2 og = *(const u32x2*)(P + (row0 + t) * NP + PC_O + col);
                const float o0 = hv[db][4 * g] * rstd * gn.x * sigmoidf_(bflo(og.x)), o1 = hv[db][4 * g + 1] * rstd * gn.y * sigmoidf_(bfhi(og.x));
                const float o2 = hv[db][4 * g + 2] * rstd * gn.z * sigmoidf_(bflo(og.y)), o3 = hv[db][4 * g + 3] * rstd * gn.w * sigmoidf_(bfhi(og.y));
                u32x2 w; w.x = pk2(o0, o1); w.y = pk2(o2, o3); *(u32x2*)(Y + (row0 + t) * 3072 + col) = w; }
        __syncthreads();
    }
}

DI void attn_unit(LAS unsigned char* smem, int hh, int qb, const bf16_t* Q, const bf16_t* KN, const bf16_t* P, const bf16_t* VT, bf16_t* Y) {
    const int tid = opaque_tid(), lane = tid & 63, wid = __builtin_amdgcn_readfirstlane(tid >> 6), l31 = lane & 31, h = lane >> 5;
    LAS unsigned char* Kb = smem; LAS unsigned char* Vb = smem + 51200;
    const int q0 = qb * 256, qw = q0 + 32 * wid, q = qw + l31, NT = 4 * qb + 4;
    bf16x8 qf[12];
#pragma unroll
    for (int ks = 0; ks < 12; ++ks) qf[ks] = *(const bf16x8*)(Q + (size_t)q * 1536 + hh * 192 + 16 * ks + 8 * h);
    f32x16 o[4];
#pragma unroll
    for (int d = 0; d < 4; ++d)
#pragma unroll
        for (int i = 0; i < 16; ++i) o[d][i] = 0.f;
    float mrun = -1e30f, lrun = 0.f;
    const bf16_t* ksrc[3]; size_t kstr[3]; int kdst[3];
#pragma unroll
    for (int i = 0; i < 3; ++i) { const int id = tid + 512 * i, row = id / 24, ch = id - row * 24;
        if (ch < 16) { ksrc[i] = KN + (size_t)row * 1024 + hh * 128 + 8 * ch; kstr[i] = (size_t)64 * 1024; } else { ksrc[i] = P + (size_t)row * NP + PC_KR + 8 * (ch - 16); kstr[i] = (size_t)64 * NP; }
        kdst[i] = row * 400 + ch * 16; }
    const bf16_t* vsrc[2]; int vdst[2];
#pragma unroll
    for (int i = 0; i < 2; ++i) { const int id = tid + 512 * i, d = id >> 3, ch = id & 7; vsrc[i] = VT + (size_t)(hh * 128 + d) * S + 8 * ch; vdst[i] = d * 144 + ch * 16; }
    u32x4 kr[3], vr[2];
#pragma unroll
    for (int i = 0; i < 3; ++i) kr[i] = *(const u32x4*)(ksrc[i]);
#pragma unroll
    for (int i = 0; i < 2; ++i) vr[i] = *(const u32x4*)(vsrc[i]);
#pragma unroll
    for (int i = 0; i < 3; ++i) *(LAS u32x4*)(Kb + kdst[i]) = kr[i];
#pragma unroll
    for (int i = 0; i < 2; ++i) *(LAS u32x4*)(Vb + vdst[i]) = vr[i];
    __syncthreads();
    const int koff = pi32(l31) * 400 + 16 * h, voff = l31 * 144 + 16 * h;
    for (int t = 0; t < NT; ++t) {
        const int cur = t & 1;
        if (t + 1 < NT) {
#pragma unroll
            for (int i = 0; i < 3; ++i) kr[i] = *(const u32x4*)(ksrc[i] + (size_t)(t + 1) * kstr[i]);
#pragma unroll
            for (int i = 0; i < 2; ++i) vr[i] = *(const u32x4*)(vsrc[i] + (size_t)(t + 1) * 64);
        }
        if (64 * t <= qw + 31) {
            LAS const unsigned char* kb = Kb + cur * 25600 + koff; LAS const unsigned char* vb = Vb + cur * 18432 + voff;
            f32x16 s0, s1;
#pragma unroll
            for (int i = 0; i < 16; ++i) { s0[i] = 0.f; s1[i] = 0.f; }
#pragma unroll
            for (int ks = 0; ks < 12; ++ks) { const bf16x8 a0 = *(const LAS bf16x8*)(kb + ks * 32), a1 = *(const LAS bf16x8*)(kb + 32 * 400 + ks * 32); s0 = mfma32(a0, qf[ks], s0); s1 = mfma32(a1, qf[ks], s1); }
            if (64 * t + 63 > qw) {
#pragma unroll
                for (int i = 0; i < 16; ++i) { const int kv = 64 * t + 16 * (i >> 3) + 8 * h + (i & 7); if (kv > q) s0[i] = -1e30f; if (kv + 32 > q) s1[i] = -1e30f; }
            }
            float mx = fmaxf(s0[0], s1[0]);
#pragma unroll
            for (int i = 1; i < 16; ++i) mx = fmaxf(mx, fmaxf(s0[i], s1[i]));
            mx = fmaxf(mx, __shfl_xor(mx, 32));
            const float mnew = fmaxf(mrun, mx), alpha = __builtin_amdgcn_exp2f(mrun - mnew);
            mrun = mnew;
            float rs = 0.f;
#pragma unroll
            for (int i = 0; i < 16; ++i) { s0[i] = __builtin_amdgcn_exp2f(s0[i] - mnew); s1[i] = __builtin_amdgcn_exp2f(s1[i] - mnew); rs += s0[i] + s1[i]; }
            lrun = lrun * alpha + rs;
#pragma unroll
            for (int d = 0; d < 4; ++d)
#pragma unroll
                for (int i = 0; i < 16; ++i) o[d][i] *= alpha;
            bf16x8 pf[4];
            pf[0] = pack8(s0[0], s0[1], s0[2], s0[3], s0[4], s0[5], s0[6], s0[7]); pf[1] = pack8(s0[8], s0[9], s0[10], s0[11], s0[12], s0[13], s0[14], s0[15]);
            pf[2] = pack8(s1[0], s1[1], s1[2], s1[3], s1[4], s1[5], s1[6], s1[7]); pf[3] = pack8(s1[8], s1[9], s1[10], s1[11], s1[12], s1[13], s1[14], s1[15]);
#pragma unroll
            for (int d = 0; d < 4; ++d)
#pragma unroll
                for (int kk = 0; kk < 4; ++kk) { const bf16x8 vf = *(const LAS bf16x8*)(vb + d * 32 * 144 + kk * 32); o[d] = mfma32(vf, pf[kk], o[d]); }
        }
        if (t + 1 < NT) {
#pragma unroll
            for (int i = 0; i < 3; ++i) *(LAS u32x4*)(Kb + (cur ^ 1) * 25600 + kdst[i]) = kr[i];
#pragma unroll
            for (int i = 0; i < 2; ++i) *(LAS u32x4*)(Vb + (cur ^ 1) * 18432 + vdst[i]) = vr[i];
        }
        __syncthreads();
    }
    lrun += __shfl_xor(lrun, 32);
    const float inv = 1.f / lrun;
    bf16_t* yp = Y + (size_t)q * 3072 + 1024 + hh * 128 + 4 * h;
#pragma unroll
    for (int d = 0; d < 4; ++d)
#pragma unroll
        for (int g = 0; g < 4; ++g) { u32x2 w; w.x = pk2(o[d][4 * g] * inv, o[d][4 * g + 1] * inv); w.y = pk2(o[d][4 * g + 2] * inv, o[d][4 * g + 3] * inv); *(u32x2*)(yp + 32 * d + 8 * g) = w; }
}


#define XB_TMO      128
#define XB_XCNT(j)  (256  + 64 * (j))
#define XB_XSUB(j)  (1280 + 64 * (j))
#define XB_XGEN(j)  (2304 + 64 * (j))
#define XB_TOP      3328
#define XB_TOPGEN   3392
#define XCD_BAR_WORDS 3456
#define XB_SPIN_CAP (1u << 23)
DI unsigned xb_ld(unsigned* p)              { return __hip_atomic_load(p, __ATOMIC_RELAXED, __HIP_MEMORY_SCOPE_AGENT); }
DI unsigned xb_add(unsigned* p, unsigned v) { return __hip_atomic_fetch_add(p, v, __ATOMIC_RELAXED, __HIP_MEMORY_SCOPE_AGENT); }
DI unsigned xb_xcc_id() { return (unsigned)__builtin_amdgcn_s_getreg((3 << 11) | 20) & 0xFu; }
#define XB_SPIN(cond, bar) do { unsigned _sp = 0; while (cond) { __builtin_amdgcn_s_sleep(1); \
    if ((++_sp & 255u) == 0u) { if (xb_ld(&(bar)[XB_TMO])) break; if (_sp > XB_SPIN_CAP) { atomicAdd(&(bar)[XB_TMO], 1u); break; } } } } while (0)
struct XcdBarrier { unsigned* bar; unsigned x; volatile LAS unsigned* st; };
DI XcdBarrier xcd_barrier_post(unsigned* bar, volatile LAS unsigned* st) {
    XcdBarrier b; b.bar = bar; b.x = xb_xcc_id(); b.st = st;
    if (threadIdx.x == 0) (void)xb_add(&bar[XB_XCNT(b.x)], 1u);
    return b;
}
DI void xcd_barrier_complete(unsigned* bar, unsigned x, unsigned& nloc, unsigned& nx) {
    const unsigned G = gridDim.x * gridDim.y * gridDim.z;
    unsigned sum, cnt, mine, sp = 0u;
    for (;;) {
        sum = 0u; cnt = 0u; mine = 0u;
#pragma unroll
        for (unsigned j = 0; j < 16; ++j) { const unsigned c = xb_ld(&bar[XB_XCNT(j)]); sum += c; cnt += (c > 0u) ? 1u : 0u; mine = (j == x) ? c : mine; }
        if (sum == G) break;
        __builtin_amdgcn_s_sleep(1);
        if ((++sp & 255u) == 0u) { if (xb_ld(&bar[XB_TMO])) break; if (sp > XB_SPIN_CAP) { atomicAdd(&bar[XB_TMO], 1u); break; } }
    }
    nloc = mine > 0u ? mine : 1u; nx = cnt > 0u ? cnt : 1u;
}
DI void xcd_barrier(const XcdBarrier& b) {
    asm volatile("s_waitcnt vmcnt(0)" ::: "memory");
    __syncthreads();
    if (threadIdx.x == 0) {
        unsigned* bar = b.bar;
        __builtin_amdgcn_s_waitcnt(0);
        unsigned nloc = b.st[0], nx = b.st[1];
        if (nloc == 0u) { xcd_barrier_complete(bar, b.x, nloc, nx); b.st[0] = nloc; b.st[1] = nx; }
        const unsigned old = xb_add(&bar[XB_XSUB(b.x)], 1u);
        const unsigned gen = old / nloc;
        if (old + 1u == (gen + 1u) * nloc) {
            __builtin_amdgcn_fence(__ATOMIC_RELEASE, "agent");
            asm volatile("s_waitcnt vmcnt(0)" ::: "memory");
            const unsigned og = xb_add(&bar[XB_TOP], 1u);
            const unsigned tg = og / nx;
            if (og + 1u == (tg + 1u) * nx) xb_add(&bar[XB_TOPGEN], 1u);
            else XB_SPIN(xb_ld(&bar[XB_TOPGEN]) == tg, bar);
            __builtin_amdgcn_fence(__ATOMIC_ACQUIRE, "agent");
            xb_add(&bar[XB_XGEN(b.x)], 1u);
            asm volatile("s_waitcnt vmcnt(0)" ::: "memory");
        } else {
            XB_SPIN(xb_ld(&bar[XB_XGEN(b.x)]) == gen, bar);
            __builtin_amdgcn_fence(__ATOMIC_ACQUIRE, "agent");
            asm volatile("s_waitcnt vmcnt(0)" ::: "memory");
        }
    }
    __syncthreads();
}

struct Params { const float* in[27]; float* out; unsigned char* ws; };

__global__ void __launch_bounds__(512, 2) mega_fwd(Params p) {
    extern __shared__ __attribute__((aligned(16))) unsigned char smem_raw[];
    LAS unsigned char* smem = (LAS unsigned char*)smem_raw;
    cg::grid_group grid = cg::this_grid();
    const int G = gridDim.x, bx = blockIdx.x;
    { const int t0 = opaque_tid(); if (t0 < 128) ((LAS unsigned*)(smem + 131072))[t0] = 0u; }
    __syncthreads();
    XcdBarrier bar = xcd_barrier_post((unsigned*)(p.ws + WS_CTL), (volatile LAS unsigned*)(smem + 131072) + 8);
    unsigned char* ws = p.ws;
    f32x2* TAB = (f32x2*)(ws + WS_TAB); float* SMALL = (float*)(ws + WS_SMALL);
    bf16_t* WFFGU = (bf16_t*)(ws + WS_WFFGU); bf16_t* WFFD = (bf16_t*)(ws + WS_WFFD); bf16_t* WIN = (bf16_t*)(ws + WS_WIN); bf16_t* WUQ = (bf16_t*)(ws + WS_WUQ);
    bf16_t* WUKV = (bf16_t*)(ws + WS_WUKV); bf16_t* WLRU = (bf16_t*)(ws + WS_WLRU); bf16_t* WBR = (bf16_t*)(ws + WS_WBR); bf16_t* WOUT = (bf16_t*)(ws + WS_WOUT);
    bf16_t* XN = (bf16_t*)(ws + WS_XN); bf16_t* P = (bf16_t*)(ws + WS_P); bf16_t* Hb = P; bf16_t* Qb = (bf16_t*)(ws + WS_Q); bf16_t* KN = (bf16_t*)(ws + WS_KN);
    bf16_t* VT = (bf16_t*)(ws + WS_VT); bf16_t* Y = (bf16_t*)(ws + WS_Y); bf16_t* XC = (bf16_t*)(ws + WS_XC); bf16_t* CS = (bf16_t*)(ws + WS_CS);

    for (int i = bx * 512 + opaque_tid(); i < S * 32; i += G * 512) { const int t = i >> 5, j = i & 31; const float ang = (float)t * INVF[j];
        double r = (double)ang * 0.15915494309189535; r -= __builtin_floor(r); const float fr = (float)r;
        TAB[i] = (f32x2){__builtin_amdgcn_cosf(fr), __builtin_amdgcn_sinf(fr)}; }

#pragma unroll 1
    for (int hl = 0; hl < 4; ++hl) {
        const int l = hl >> 1, second = hl & 1;
        const float* xin = hl == 0 ? p.in[0] : p.out;
        {
            const int nmat = second ? 3 : 26; int rot = 0;
#pragma unroll 1
            for (int mi = 0; mi < nmat; ++mi) {
                const float* src; int K, N, map; bf16_t* dst;
                if (mi == 0) { src = p.in[second ? 23 : 2] + (size_t)l * DM * FF; K = DM; N = FF; map = 1; dst = WFFGU; }
                else if (mi == 1) { src = p.in[second ? 24 : 3] + (size_t)l * DM * FF; K = DM; N = FF; map = 2; dst = WFFGU; }
                else if (mi == 2) { src = p.in[second ? 25 : 4] + (size_t)l * DM * FF; K = FF; N = DM; map = 0; dst = WFFD; }
                else if (mi == 3) { src = p.in[6] + (size_t)l * DM * NIN; K = DM; N = NIN; map = 3; dst = WIN; }
                else if (mi == 4) { src = p.in[10] + (size_t)l * 384 * 1536; K = 384; N = 1536; map = 4; dst = WUQ; }
                else if (mi == 5) { src = p.in[12] + (size_t)l * 256 * 2048; K = 256; N = 2048; map = 5; dst = WUKV; }
                else if (mi < 22) { const int k = mi - 6, n = k >> 1, wx = k & 1; src = p.in[wx ? 17 : 15] + (size_t)l * 131072 + n * 16384; K = 128; N = 128; map = 0; dst = WLRU + (size_t)(n * 256 + wx * 128) * 128; }
                else if (mi < 25) { const int j = mi - 22; src = p.in[20] + (size_t)l * 3 * 1024 * 2048 + (size_t)j * 1024 * 2048; K = 1024; N = 2048; map = 0; dst = WBR + (size_t)j * 2048 * 1024; }
                else { src = p.in[21] + (size_t)l * DM * DM; K = DM; N = DM; map = 0; dst = WOUT; }
                convert_mat(src, K, N, dst, map, rot);
            }
            rmsnorm_rows(xin, p.in[second ? 22 : 1] + l * DM, XN);
        }
        if (hl == 0) grid.sync(); else xcd_barrier(bar);
        { pg8::Gemm g{XN, WFFGU, S, 2 * FF, DM, DM, DM, 0}; pg8::StaticOrder so; so.init(S, 2 * FF, G, bx); pg8::EpiSwiglu E{Hb}; pg8::gemm_phase(smem, g, so, E); }
        xcd_barrier(bar);
        { pg8::Gemm g{Hb, WFFD, S, DM, FF, FF, FF, 0}; pg8::StaticOrder so; so.init(S, DM, G, bx); pg8::EpiRes E{xin, p.out, 0.5f}; pg8::gemm_phase(smem, g, so, E); }
        xcd_barrier(bar);
        if (!second) {
            const float* gbias = p.in[7] + l * 8;
            rmsnorm_rows(p.out, p.in[5] + l * DM, XN);
            xcd_barrier(bar);
            { pg8::Gemm g{XN, WIN, S, NP, DM, DM, DM, 0}; pg8::StaticOrder so; so.init(S, NP, G, bx); pg8::EpiStore E{P, NP}; pg8::gemm_phase(smem, g, so, E); }
            xcd_barrier(bar);
            if (bx == G - 1) { const float* lam = p.in[19] + l * 1024; for (int ch = opaque_tid(); ch < 1024; ch += 512) SMALL[SM_SP + ch] = -8.f * log1pf(expf(-lam[ch])); }
            mlstm_a(smem, P, gbias, CS, SMALL);
            prep_rows(P, p.in[9] + l * 384, p.in[11] + l * 256, p.in[13] + l * 4096, p.in[14] + l * 1024, TAB, XC);
            xcd_barrier(bar);
            mlstm_b(smem, CS, SMALL);
            { pg8::Gemm g{P + PC_CQ, WUQ, S, 1536, 384, NP, 384, 0}; pg8::StaticOrder so; so.init(S, 1536, G, bx); pg8::EpiQ E{Qb, TAB}; pg8::gemm_phase(smem, g, so, E); }
#pragma unroll 1
            for (int gi = 0; gi < 2; ++gi) {
                pg8::Gemm g; pg8::StaticOrder so; pg8::EpiStore E;
                if (gi == 0) { g = pg8::Gemm{P + PC_CKV, WUKV, S, 1024, 256, NP, 256, 0}; so.init(S, 1024, G, bx); E = pg8::EpiStore{KN, 1024}; }
                else { g = pg8::Gemm{WUKV + 1024 * 256, P + PC_CKV, 1024, S, 256, 256, NP, 0}; so.init(1024, S, G, bx); E = pg8::EpiStore{VT, S}; }
                pg8::gemm_phase(smem, g, so, E);
            }
            { pg8::Gemm g{XC, WLRU, S, 2048, 128, 1024, 128, 128}; pg8::StaticOrder so; so.init(S, 2048, G, bx); pg8::EpiLru E{XC, P + PC_CX, p.in[16] + l * 1024, p.in[18] + l * 1024, SMALL + SM_SP}; pg8::gemm_phase(smem, g, so, E); }
            xcd_barrier(bar);
            mlstm_c(smem, P, gbias, p.in[8] + l * 1024, CS, SMALL, Y);
            lru_p1(P + PC_CX, XC, SMALL + SM_CA, SMALL + SM_CH);
            xcd_barrier(bar);
            lru_p2(SMALL + SM_CA, SMALL + SM_CH, SMALL + SM_CARRY);
            for (int item = bx; item < 256; item += G) { const int hh = item & 7, pp = item >> 3;
#pragma unroll 1
                for (int half = 0; half < 2; ++half) attn_unit(smem, hh, half ? 63 - pp : pp, Qb, KN, P, VT, Y); }
            xcd_barrier(bar);
            lru_p3(P + PC_CX, XC, SMALL + SM_CARRY, Y);
#pragma unroll 1
            for (int j = 0; j < 3; ++j) {
                if (j == 2) xcd_barrier(bar);
                pg8::Gemm g{Y + j * 1024, WBR + (size_t)j * 2048 * 1024, S, DM, 1024, 3072, 1024, 0}; pg8::StaticOrder so; so.init(S, DM, G, bx); pg8::EpiMerge E{XN, P + PC_G + j * 2048, j == 0}; pg8::gemm_phase(smem, g, so, E);
            }
            xcd_barrier(bar);
            { pg8::Gemm g{XN, WOUT, S, DM, DM, DM, DM, 0}; pg8::StaticOrder so; so.init(S, DM, G, bx); pg8::EpiRes E{p.out, p.out, 1.0f}; pg8::gemm_phase(smem, g, so, E); }
            xcd_barrier(bar);
        }
    }
    final_norm_rows(p.out, p.in[26]);
}

constexpr int LDS_BYTES = 143360;

extern "C" void kernel_launch(void* const* d_in, const int* in_sizes, int n_in, void* d_out, int out_size, void* d_ws, size_t ws_size, hipStream_t stream) {
    static int grid = 0;
    if (grid == 0) {
        if (n_in != 27 || out_size != S * DM || ws_size < WS_END) { fprintf(stderr, "kernel_launch: unexpected problem (n_in %d out %d ws %zu, need %zu)\n", n_in, out_size, ws_size, (size_t)WS_END); grid = -1; return; }
        int dev = 0, cus = 0, per_cu = 0;
        hipGetDevice(&dev); hipDeviceGetAttribute(&cus, hipDeviceAttributeMultiprocessorCount, dev);
        if (hipFuncSetAttribute((const void*)mega_fwd, hipFuncAttributeMaxDynamicSharedMemorySize, LDS_BYTES) != hipSuccess) { fprintf(stderr, "kernel_launch: hipFuncSetAttribute failed\n"); grid = -1; return; }
        if (hipOccupancyMaxActiveBlocksPerMultiprocessor(&per_cu, (const void*)mega_fwd, 512, LDS_BYTES) != hipSuccess || per_cu < 1) { fprintf(stderr, "kernel_launch: occupancy query says %d\n", per_cu); per_cu = 1; }
        (void)hipGetLastError();
        grid = cus * (per_cu > 1 ? 1 : per_cu);
    }
    if (grid < 0) return;
    if (hipMemsetAsync((char*)d_ws + WS_CTL, 0, CTL_BYTES, stream) != hipSuccess) { fprintf(stderr, "kernel_launch: memset failed\n"); return; }
    Params p{};
    for (int i = 0; i < 27; ++i) p.in[i] = (const float*)d_in[i];
    p.out = (float*)d_out; p.ws = (unsigned char*)d_ws;
    void* args[] = {&p};
    hipError_t e = hipLaunchCooperativeKernel((const void*)mega_fwd, dim3(grid), dim3(512), args, LDS_BYTES, stream);
    if (e != hipSuccess) fprintf(stderr, "cooperative launch failed: %s (grid %d)\n", hipGetErrorString(e), grid);
}
```

```cpp
#include <hip/hip_runtime.h>
#include <hip/hip_cooperative_groups.h>
#include <cstdio>
#include <cstdint>
namespace cg = cooperative_groups;

#define DI __device__ __forceinline__
#define LAS __attribute__((address_space(3)))
typedef unsigned short bf16_t;
typedef short bf16x8 __attribute__((ext_vector_type(8)));
typedef short s16x4 __attribute__((ext_vector_type(4)));
typedef float f32x2 __attribute__((ext_vector_type(2)));
typedef float f32x4 __attribute__((ext_vector_type(4)));
typedef float f32x16 __attribute__((ext_vector_type(16)));
typedef unsigned u32x2 __attribute__((ext_vector_type(2)));
typedef unsigned u32x4 __attribute__((ext_vector_type(4)));
typedef __bf16 bf16x2_t __attribute__((ext_vector_type(2)));

constexpr int S = 16384, DM = 2048, FF = 5632, NIN = 10952, NP = 11008;
constexpr float EPS = 1e-6f;
constexpr int PC_Q = 0, PC_K = 512, PC_V = 1024, PC_O = 2048, PC_CQ = 3072, PC_CKV = 3456, PC_KR = 3712, PC_CX = 3776, PC_G = 4800, PC_I = 10944, PC_F = 10948;
constexpr float MQS = 0.08838834764831845f;
constexpr float AQS = 0.07216878364870322f * 1.4426950408889634f;

constexpr size_t MiB = 1u << 20;
constexpr size_t WS_TAB = 0;
constexpr size_t WS_SMALL = 4 * MiB;
constexpr size_t WS_WFFGU = 12 * MiB;
constexpr size_t WS_WFFD = 56 * MiB;
constexpr size_t WS_WIN = 78 * MiB;
constexpr size_t WS_WUQ = 121 * MiB;
constexpr size_t WS_WUKV = 123 * MiB;
constexpr size_t WS_WLRU = 124 * MiB;
constexpr size_t WS_WBR = 125 * MiB;
constexpr size_t WS_WOUT = 137 * MiB;
constexpr size_t WS_XN = 145 * MiB;
constexpr size_t WS_P = 209 * MiB;
constexpr size_t WS_Q = 553 * MiB;
constexpr size_t WS_KN = 601 * MiB;
constexpr size_t WS_VT = 633 * MiB;
constexpr size_t WS_Y = 665 * MiB;
constexpr size_t WS_XC = 761 * MiB;
constexpr size_t WS_CS = 793 * MiB;
constexpr size_t WS_END = 857 * MiB;
constexpr size_t WS_CTL = 11 * MiB, CTL_BYTES = 16384;
constexpr int SM_BT = 0, SM_MC = 1024, SM_MPREV = 2048, SM_DN = 4096  , SM_CA = 4096 + 131072  , SM_CH = SM_CA + 262144, SM_CARRY = SM_CH + 262144, SM_SP = SM_CARRY + 262144;

__device__ const float INVF[32] = {1.0f, 0.7498942613601685f, 0.5623413324356079f, 0.4216965138912201f, 0.3162277638912201f, 0.23713737726211548f, 0.17782793939113617f, 0.133352130651474f, 0.10000000149011612f, 0.07498941570520401f, 0.05623413249850273f, 0.04216965287923813f, 0.03162277489900589f, 0.023713737726211548f, 0.017782794311642647f, 0.01333521492779255f, 0.009999999776482582f, 0.007498941849917173f, 0.005623413249850273f, 0.0042169648222625256f, 0.003162277629598975f, 0.00237137358635664f, 0.0017782794311642647f, 0.0013335214462131262f, 0.0010000000474974513f, 0.0007498942431993783f, 0.000562341301701963f, 0.0004216965171508491f, 0.0003162277571391314f, 0.00023713737027719617f, 0.00017782794020604342f, 0.0001333521504420787f};

DI int opaque_tid() { int t = threadIdx.x; asm volatile("" : "+v"(t)); return t; }
DI float bf2f(bf16_t v) { return __uint_as_float((unsigned)v << 16); }
DI float bflo(unsigned w) { return __uint_as_float(w << 16); }
DI float bfhi(unsigned w) { return __uint_as_float(w & 0xffff0000u); }
DI unsigned pk2(float lo, float hi) { f32x2 v = {lo, hi}; bf16x2_t b = __builtin_convertvector(v, bf16x2_t); return __builtin_bit_cast(unsigned, b); }
DI bf16_t f2bf(float f) { return (bf16_t)(pk2(f, 0.f) & 0xffffu); }
DI float wave_sum(float v) {
#pragma unroll
    for (int o = 1; o < 64; o <<= 1) v += __shfl_xor(v, o);
    return v;
}
DI float wave_max(float v) {
#pragma unroll
    for (int o = 1; o < 64; o <<= 1) v = fmaxf(v, __shfl_xor(v, o));
    return v;
}
DI float wave_incl_scan(float v, int lane) {
#pragma unroll
    for (int o = 1; o < 64; o <<= 1) { const float n = __shfl_up(v, o); if (lane >= o) v += n; }
    return v;
}
DI float sigmoidf_(float x) { return 1.f / (1.f + __expf(-x)); }
DI float logsigmoid_(float x) { return fminf(x, 0.f) - log1pf(expf(-fabsf(x))); }
DI f32x16 mfma32(bf16x8 a, bf16x8 b, f32x16 c) { return __builtin_amdgcn_mfma_f32_32x32x16_bf16(a, b, c, 0, 0, 0); }
DI int crow(int r, int h) { return (r & 3) + 8 * (r >> 2) + 4 * h; }
DI int pi32(int m) { return (m & ~12) | ((m & 4) << 1) | ((m & 8) >> 1); }
typedef short v4i16_t __attribute__((ext_vector_type(4)));
DI s16x4 tr16(LAS const unsigned char* p) { return __builtin_bit_cast(s16x4, __builtin_amdgcn_ds_read_tr16_b64_v4i16((LAS v4i16_t*)p)); }
DI bf16x8 tr_frag(LAS const unsigned char* p, int rs) {
    const s16x4 lo = tr16(p), hi = tr16(p + 4 * rs);
    return __builtin_shufflevector(lo, hi, 0, 1, 2, 3, 4, 5, 6, 7);
}
DI bf16x8 pack8(float a0, float a1, float a2, float a3, float a4, float a5, float a6, float a7) {
    u32x4 w; w.x = pk2(a0, a1); w.y = pk2(a2, a3); w.z = pk2(a4, a5); w.w = pk2(a6, a7); return __builtin_bit_cast(bf16x8, w);
}

namespace pg8 {
constexpr int BM = 256, BK = 64, HALF = 128, HTB = HALF * BK * 2, STAGE_BYTES = 8 * HTB, NXCD = 8, WGM = 8;
DI int lds_byte(int r, int c) { const int st = (r >> 4) * 2 + (c >> 5), rr = r & 15, cc = c & 31, ob = rr * 64 + cc * 2; return st * 1024 + (ob ^ (((ob >> 9) & 1) << 5)); }
DI void stage_rc(int b, int& R, int& C) { const int st = b / 1024, sb = b % 1024, swz = sb ^ (((sb >> 9) & 1) << 5); R = (st >> 1) * 16 + swz / 64; C = (st & 1) * 32 + (swz % 64) / 2; }
DI int perm32(int rho) { const int n = rho >> 4, i = rho & 15; return 8 * (i >> 2) + 4 * n + (i & 3); }
struct Unit { int pm, pn; };
struct Gemm { const bf16_t* A; const bf16_t* Bt; int M, N, K, lda, ldb, apn; };
struct StaticOrder {
    int nM, nN, nwg, G, c;
    DI void init(int M, int N, int G_, int c_) { nM = M / BM; nN = N / BM; nwg = nM * nN; G = G_; c = c_; }
    DI bool next(int i, Unit& u) const {
        const long L = (long)i * G + c; if (L >= nwg) return false;
        int wgid = (int)L; { const int q = nwg / NXCD, r = nwg % NXCD, xcd = wgid % NXCD, off = wgid / NXCD; wgid = (xcd < r ? xcd * (q + 1) : r * (q + 1) + (xcd - r) * q) + off; }
        const int nig = WGM * nN, gid = wgid / nig, fm = gid * WGM, gsz = (nM - fm) < WGM ? (nM - fm) : WGM;
        u.pm = fm + ((wgid % nig) % gsz); u.pn = (wgid % nig) / gsz; return true;
    }
};
template <class Epi>
DI void gemm_phase(LAS unsigned char* lds, const Gemm g, const StaticOrder& S, const Epi& E) {
    const int tid = opaque_tid(), wid = __builtin_amdgcn_readfirstlane(tid >> 6), lane = tid & 63, wr = wid >> 2, wc = wid & 3, fr = lane & 15, fq = lane >> 4;
    int K = g.K; asm volatile("" : "+s"(K)); const int nt = K / BK;
    unsigned voffA[2], voffB[2];
#pragma unroll
    for (int i = 0; i < 2; ++i) { int R, C; stage_rc(tid * 16 + i * 8192, R, C); const int Rb = Epi::PERM ? ((R & ~31) + perm32(R & 31)) : R;
        voffA[i] = (unsigned)(R * g.lda + C) * 2u; voffB[i] = (unsigned)(Rb * g.ldb + C) * 2u; }
    const size_t kstep = (size_t)(BK * 2);
    const size_t hstepA = (size_t)HALF * g.lda * 2, hstepB = (size_t)HALF * g.ldb * 2;
    const unsigned ldsw = (unsigned)wid * 1024u;
    const int aoff = lds_byte(wr * 64 + fr, fq * 8), boff = lds_byte(wc * 32 + fr, fq * 8);
#define PG8_SA(b, h) (((b) * 2 + (h)) * HTB)
#define PG8_SB(b, h) ((4 + (b) * 2 + (h)) * HTB)
#define PG8_STAGE(bufoff, gbase, voff) do { _Pragma("unroll") for (int _i = 0; _i < 2; ++_i) \
        __builtin_amdgcn_global_load_lds((const unsigned*)((const char*)(gbase) + (voff)[_i]), (LAS unsigned*)(lds + (bufoff) + ldsw + _i * 8192), 16, 0, 0); } while (0)
#define PG8_LDA(dst, b, h) do { _Pragma("unroll") for (int m = 0; m < 4; ++m) _Pragma("unroll") for (int k = 0; k < 2; ++k) dst[m][k] = *(const LAS bf16x8*)(lds + PG8_SA(b, h) + aoff + m * 2048 + k * 1024); } while (0)
#define PG8_LDB(dst, b, h) do { _Pragma("unroll") for (int n = 0; n < 2; ++n) _Pragma("unroll") for (int k = 0; k < 2; ++k) dst[n][k] = *(const LAS bf16x8*)(lds + PG8_SB(b, h) + boff + n * 2048 + k * 1024); } while (0)
#define PG8_MMA(ai, bj, At, Bt) do { __builtin_amdgcn_s_setprio(1); _Pragma("unroll") for (int m = 0; m < 4; ++m) _Pragma("unroll") for (int n = 0; n < 2; ++n) _Pragma("unroll") for (int k = 0; k < 2; ++k) \
        acc[ai][bj][m][n] = __builtin_amdgcn_mfma_f32_16x16x32_bf16(Bt[n][k], At[m][k], acc[ai][bj][m][n], 0, 0, 0); __builtin_amdgcn_s_setprio(0); } while (0)
#define PG8_WAIT_V(n) asm volatile("s_waitcnt vmcnt(" #n ")" ::: "memory")
#define PG8_WAIT_L(n) asm volatile("s_waitcnt lgkmcnt(" #n ")" ::: "memory")
#define PG8_BAR __builtin_amdgcn_s_barrier()
#define PG8_SCHED __builtin_amdgcn_sched_barrier(0)
#define PG8_APTR(u) ((const char*)g.A + (size_t)(u).pm * 2 * hstepA + (size_t)(u).pn * (size_t)g.apn * 2)
#define PG8_BPTR(u) ((const char*)g.Bt + (size_t)(u).pn * 2 * hstepB)
    Unit cur, nxt; int ui = 0;
    if (!S.next(0, cur)) return;
    f32x4 acc[2][2][4][2];
#pragma unroll
    for (int a = 0; a < 2; ++a)
#pragma unroll
        for (int b = 0; b < 2; ++b)
#pragma unroll
            for (int m = 0; m < 4; ++m)
#pragma unroll
                for (int n = 0; n < 2; ++n) acc[a][b][m][n] = (f32x4){0.f, 0.f, 0.f, 0.f};
    bf16x8 At[4][2], B0[2][2], B1[2][2];
    const char* cA = PG8_APTR(cur); const char* cB = PG8_BPTR(cur);
    PG8_STAGE(PG8_SB(0, 0), cB, voffB); PG8_STAGE(PG8_SB(0, 1), cB + hstepB, voffB); PG8_STAGE(PG8_SA(0, 0), cA, voffA); PG8_STAGE(PG8_SA(0, 1), cA + hstepA, voffA);
    if (wr == 1) PG8_BAR;
    PG8_WAIT_V(2); PG8_BAR;
    PG8_STAGE(PG8_SB(1, 0), cB + kstep, voffB); PG8_STAGE(PG8_SA(1, 0), cA + kstep, voffA); PG8_STAGE(PG8_SB(1, 1), cB + hstepB + kstep, voffB);
    PG8_WAIT_V(6); PG8_BAR;
    for (;;) {
        const bool has_next = S.next(ui + 1, nxt);
        const char* nA = has_next ? PG8_APTR(nxt) : cA; const char* nB = has_next ? PG8_BPTR(nxt) : cB;
        for (int t = 0; t < nt; t += 2) {
            const bool last = (t == nt - 2);
            const char* a1 = cA + (size_t)(t + 1) * kstep;
            const char* a2 = last ? nA : cA + (size_t)(t + 2) * kstep; const char* b2 = last ? nB : cB + (size_t)(t + 2) * kstep;
            const char* a3 = a2 + kstep; const char* b3 = b2 + kstep;
            PG8_LDB(B0, 0, 0); PG8_LDB(B1, 0, 1); PG8_SCHED; PG8_LDA(At, 0, 0); PG8_STAGE(PG8_SA(1, 1), a1 + hstepA, voffA);
            PG8_WAIT_V(8); PG8_WAIT_L(0); PG8_BAR; PG8_MMA(0, 0, At, B0); PG8_MMA(0, 1, At, B1); PG8_BAR; PG8_SCHED;
            PG8_LDA(At, 0, 1); PG8_STAGE(PG8_SB(0, 0), b2, voffB); PG8_STAGE(PG8_SB(0, 1), b2 + hstepB, voffB); PG8_STAGE(PG8_SA(0, 0), a2, voffA);
            PG8_WAIT_V(8); PG8_WAIT_L(0); PG8_BAR; PG8_MMA(1, 0, At, B0); PG8_MMA(1, 1, At, B1); PG8_BAR; PG8_SCHED;
            PG8_LDB(B0, 1, 0); PG8_LDB(B1, 1, 1); PG8_SCHED; PG8_LDA(At, 1, 0); PG8_STAGE(PG8_SA(0, 1), a2 + hstepA, voffA);
            PG8_WAIT_V(8); PG8_WAIT_L(0); PG8_BAR; PG8_MMA(0, 0, At, B0); PG8_MMA(0, 1, At, B1); PG8_BAR; PG8_SCHED;
            PG8_LDA(At, 1, 1); PG8_STAGE(PG8_SB(1, 0), b3, voffB); PG8_STAGE(PG8_SB(1, 1), b3 + hstepB, voffB); PG8_STAGE(PG8_SA(1, 0), a3, voffA);
            PG8_WAIT_V(8); PG8_WAIT_L(0); PG8_BAR; PG8_MMA(1, 0, At, B0); PG8_MMA(1, 1, At, B1); PG8_BAR; PG8_SCHED;
        }
        if (wr == 0) PG8_BAR;
        E(acc, cur, wr, wc, fr, fq);
        if (!has_next) break;
#pragma unroll
        for (int a = 0; a < 2; ++a)
#pragma unroll
            for (int b = 0; b < 2; ++b)
#pragma unroll
                for (int m = 0; m < 4; ++m)
#pragma unroll
                    for (int n = 0; n < 2; ++n) acc[a][b][m][n] = (f32x4){0.f, 0.f, 0.f, 0.f};
        cur = nxt; cA = nA; cB = nB; ++ui;
        if (wr == 1) PG8_BAR;
    }
    PG8_WAIT_V(0);
    PG8_BAR;
#undef PG8_SA
#undef PG8_SB
#undef PG8_STAGE
#undef PG8_LDA
#undef PG8_LDB
#undef PG8_MMA
#undef PG8_WAIT_V
#undef PG8_WAIT_L
#undef PG8_BAR
#undef PG8_SCHED
#undef PG8_APTR
#undef PG8_BPTR
}

typedef f32x4 Acc[2][2][4][2];
struct EpiStore {
    static constexpr bool PERM = true;
    bf16_t* O; int ldc;
    DI void operator()(const Acc& acc, const Unit& u, int wr, int wc, int fr, int fq) const {
        const int row0 = u.pm * BM + wr * 64 + fr, col0 = u.pn * BM + wc * 32 + 8 * fq;
#pragma unroll
        for (int ai = 0; ai < 2; ++ai)
#pragma unroll
            for (int m = 0; m < 4; ++m) { bf16_t* rowp = O + (size_t)(row0 + ai * HALF + m * 16) * ldc + col0;
#pragma unroll
                for (int bj = 0; bj < 2; ++bj) { const f32x4 v0 = acc[ai][bj][m][0], v1 = acc[ai][bj][m][1];
                    u32x4 w; w.x = pk2(v0[0], v0[1]); w.y = pk2(v0[2], v0[3]); w.z = pk2(v1[0], v1[1]); w.w = pk2(v1[2], v1[3]);
                    *(u32x4*)(rowp + bj * HALF) = w; } }
    }
};
struct EpiSwiglu {
    static constexpr bool PERM = true;
    bf16_t* H;
    DI void operator()(const Acc& acc, const Unit& u, int wr, int wc, int fr, int fq) const {
        const int row0 = u.pm * BM + wr * 64 + fr, col0 = u.pn * HALF + wc * 32 + 8 * fq;
#pragma unroll
        for (int ai = 0; ai < 2; ++ai)
#pragma unroll
            for (int m = 0; m < 4; ++m) { bf16_t* rowp = H + (size_t)(row0 + ai * HALF + m * 16) * FF + col0;
                float o[8];
#pragma unroll
                for (int n = 0; n < 2; ++n)
#pragma unroll
                    for (int j = 0; j < 4; ++j) { const float gt = acc[ai][0][m][n][j], up = acc[ai][1][m][n][j]; o[n * 4 + j] = gt * sigmoidf_(gt) * up; }
                u32x4 w; w.x = pk2(o[0], o[1]); w.y = pk2(o[2], o[3]); w.z = pk2(o[4], o[5]); w.w = pk2(o[6], o[7]);
                *(u32x4*)rowp = w; }
    }
};
struct EpiRes {
    static constexpr bool PERM = false;
    const float* xin; float* xout; float alpha;
    DI void operator()(const Acc& acc, const Unit& u, int wr, int wc, int fr, int fq) const {
        const int col0 = u.pn * BM + wc * 32 + 4 * fq;
#pragma unroll
        for (int ai = 0; ai < 2; ++ai)
#pragma unroll
            for (int m = 0; m < 4; ++m) { const size_t off = (size_t)(u.pm * BM + ai * HALF + wr * 64 + m * 16 + fr) * DM + col0;
#pragma unroll
                for (int bj = 0; bj < 2; ++bj)
#pragma unroll
                    for (int n = 0; n < 2; ++n) { const f32x4 b = *(const f32x4*)(xin + off + bj * HALF + n * 16); *(f32x4*)(xout + off + bj * HALF + n * 16) = b + acc[ai][bj][m][n] * alpha; } }
    }
};
struct EpiQ {
    static constexpr bool PERM = true;
    bf16_t* Q; const f32x2* tab;
    DI void operator()(const Acc& acc, const Unit& u, int wr, int wc, int fr, int fq) const {
        const int row0 = u.pm * BM + wr * 64 + fr;
#pragma unroll
        for (int bj = 0; bj < 2; ++bj) {
            const int c0 = u.pn * BM + bj * HALF + wc * 32 + 8 * fq; const int hh = c0 / 192, dd = c0 - hh * 192; const bool rope = dd >= 128; const int j0 = (dd - 128) >> 1;
#pragma unroll
            for (int ai = 0; ai < 2; ++ai)
#pragma unroll
                for (int m = 0; m < 4; ++m) { const int row = row0 + ai * HALF + m * 16;
                    float v[8];
#pragma unroll
                    for (int n = 0; n < 2; ++n)
#pragma unroll
                        for (int j = 0; j < 4; ++j) v[n * 4 + j] = acc[ai][bj][m][n][j];
                    if (rope) {
#pragma unroll
                        for (int p = 0; p < 4; ++p) { const f32x2 cs = tab[(size_t)row * 32 + j0 + p]; const float x1 = v[2 * p], x2 = v[2 * p + 1]; v[2 * p] = x1 * cs.x - x2 * cs.y; v[2 * p + 1] = x1 * cs.y + x2 * cs.x; }
                    }
                    u32x4 w; w.x = pk2(v[0] * AQS, v[1] * AQS); w.y = pk2(v[2] * AQS, v[3] * AQS); w.z = pk2(v[4] * AQS, v[5] * AQS); w.w = pk2(v[6] * AQS, v[7] * AQS);
                    *(u32x4*)(Q + (size_t)row * 1536 + c0) = w; }
        }
    }
};
struct EpiLru {
    static constexpr bool PERM = true;
    bf16_t* XC; bf16_t* LA; const float* ba; const float* bx; const float* sp;
    DI void operator()(const Acc& acc, const Unit& u, int wr, int wc, int fr, int fq) const {
        const int row0 = u.pm * BM + wr * 64 + fr, ch0 = u.pn * HALF + wc * 32 + 8 * fq;
#pragma unroll
        for (int ai = 0; ai < 2; ++ai)
#pragma unroll
            for (int m = 0; m < 4; ++m) { const int row = row0 + ai * HALF + m * 16;
                const u32x4 xw = *(const u32x4*)(XC + (size_t)row * 1024 + ch0);
                const float xv[8] = {bflo(xw.x), bfhi(xw.x), bflo(xw.y), bfhi(xw.y), bflo(xw.z), bfhi(xw.z), bflo(xw.w), bfhi(xw.w)};
                u32x4 wl, wu;
#pragma unroll
                for (int n = 0; n < 2; ++n) { const f32x4 spv = *(const f32x4*)(sp + ch0 + 4 * n), bav = *(const f32x4*)(ba + ch0 + 4 * n), bxv = *(const f32x4*)(bx + ch0 + 4 * n);
                    float la[4], uu[4];
#pragma unroll
                    for (int j = 0; j < 4; ++j) { const float r = sigmoidf_(acc[ai][0][m][n][j] + bav[j]), gi = sigmoidf_(acc[ai][1][m][n][j] + bxv[j]);
                        const float l = r * spv[j]; la[j] = l; const float a2 = __expf(2.f * l); uu[j] = sqrtf(fmaxf(1.f - a2, 0.f)) * gi * xv[n * 4 + j]; }
                    if (n == 0) { wl.x = pk2(la[0], la[1]); wl.y = pk2(la[2], la[3]); wu.x = pk2(uu[0], uu[1]); wu.y = pk2(uu[2], uu[3]); }
                    else { wl.z = pk2(la[0], la[1]); wl.w = pk2(la[2], la[3]); wu.z = pk2(uu[0], uu[1]); wu.w = pk2(uu[2], uu[3]); } }
                *(u32x4*)(LA + (size_t)row * NP + ch0) = wl;
                *(u32x4*)(XC + (size_t)row * 1024 + ch0) = wu;
                asm volatile("" ::: "memory"); }
    }
};
struct EpiMerge {
    static constexpr bool PERM = true;
    bf16_t* Z; const bf16_t* G; int first;
    DI void operator()(const Acc& acc, const Unit& u, int wr, int wc, int fr, int fq) const {
        const int row0 = u.pm * BM + wr * 64 + fr, col0 = u.pn * BM + wc * 32 + 8 * fq;
#pragma unroll
        for (int ai = 0; ai < 2; ++ai)
#pragma unroll
            for (int m = 0; m < 4; ++m) { const int row = row0 + ai * HALF + m * 16;
#pragma unroll
                for (int bj = 0; bj < 2; ++bj) { const int c = col0 + bj * HALF;
                    const u32x4 gw = *(const u32x4*)(G + (size_t)row * NP + c);
                    const float gv[8] = {bflo(gw.x), bfhi(gw.x), bflo(gw.y), bfhi(gw.y), bflo(gw.z), bfhi(gw.z), bflo(gw.w), bfhi(gw.w)};
                    float o[8];
#pragma unroll
                    for (int n = 0; n < 2; ++n)
#pragma unroll
                        for (int j = 0; j < 4; ++j) o[n * 4 + j] = sigmoidf_(gv[n * 4 + j]) * acc[ai][bj][m][n][j];
                    bf16_t* zp = Z + (size_t)row * DM + c;
                    if (!first) { const u32x4 zw = *(const u32x4*)zp; o[0] += bflo(zw.x); o[1] += bfhi(zw.x); o[2] += bflo(zw.y); o[3] += bfhi(zw.y); o[4] += bflo(zw.z); o[5] += bfhi(zw.z); o[6] += bflo(zw.w); o[7] += bfhi(zw.w); }
                    u32x4 w; w.x = pk2(o[0], o[1]); w.y = pk2(o[2], o[3]); w.z = pk2(o[4], o[5]); w.w = pk2(o[6], o[7]);
                    *(u32x4*)zp = w; } }
    }
};
}

DI int map_row(int map, int n) {
    switch (map) {
        case 1: return ((n >> 7) << 8) + (n & 127);
        case 2: return ((n >> 7) << 8) + 128 + (n & 127);
        case 3: { if (n < 2048) return n; if (n < 2052) return PC_I + n - 2048; if (n < 2056) return PC_F + n - 2052; if (n < 3080) return PC_O + n - 2056; if (n < 3464) return PC_CQ + n - 3080;
                  if (n < 3720) return PC_CKV + n - 3464; if (n < 3784) return PC_KR + n - 3720; if (n < 4808) return PC_CX + n - 3784; return PC_G + n - 4808; }
        case 4: { const int hh = n / 192, dd = n - hh * 192; if (dd < 128) return n; const int jj = dd - 128; return hh * 192 + 128 + (jj < 32 ? 2 * jj : 2 * (jj - 32) + 1); }
        case 5: { const int hh = n >> 8, dd = n & 255; return dd < 128 ? hh * 128 + dd : 1024 + hh * 128 + dd - 128; }
        default: return n;
    }
}
DI void convert_mat(const float* W, int K, int N, bf16_t* WT, int map, int& rot) {
    const int tid_ = opaque_tid(), lane = tid_ & 63, gw = blockIdx.x * 8 + (tid_ >> 6), ngw = gridDim.x * 8;
    const int nch = (N + 255) >> 8, nkb = K >> 5, nitems = nch * nkb;
    int it = gw - rot; if (it < 0) it += ngw;
    for (; it < nitems; it += ngw) {
        const int nc = it / nkb, kb = it - nc * nkb, n0 = nc * 256 + lane * 4, k0 = kb * 32;
        if (n0 < N) {
            const float* src = W + (size_t)k0 * N + n0;
            bf16_t* d0 = WT + (size_t)map_row(map, n0) * K + k0; bf16_t* d1 = WT + (size_t)map_row(map, n0 + 1) * K + k0;
            bf16_t* d2 = WT + (size_t)map_row(map, n0 + 2) * K + k0; bf16_t* d3 = WT + (size_t)map_row(map, n0 + 3) * K + k0;
#pragma unroll 2
            for (int kk = 0; kk < 4; ++kk) {
                f32x4 v[8];
#pragma unroll
                for (int i = 0; i < 8; ++i) v[i] = *(const f32x4*)(src + (size_t)(kk * 8 + i) * N);
                u32x4 o;
                o.x = pk2(v[0].x, v[1].x); o.y = pk2(v[2].x, v[3].x); o.z = pk2(v[4].x, v[5].x); o.w = pk2(v[6].x, v[7].x); *(u32x4*)(d0 + kk * 8) = o;
                o.x = pk2(v[0].y, v[1].y); o.y = pk2(v[2].y, v[3].y); o.z = pk2(v[4].y, v[5].y); o.w = pk2(v[6].y, v[7].y); *(u32x4*)(d1 + kk * 8) = o;
                o.x = pk2(v[0].z, v[1].z); o.y = pk2(v[2].z, v[3].z); o.z = pk2(v[4].z, v[5].z); o.w = pk2(v[6].z, v[7].z); *(u32x4*)(d2 + kk * 8) = o;
                o.x = pk2(v[0].w, v[1].w); o.y = pk2(v[2].w, v[3].w); o.z = pk2(v[4].w, v[5].w); o.w = pk2(v[6].w, v[7].w); *(u32x4*)(d3 + kk * 8) = o;
            }
        }
    }
    rot = (rot + nitems) % ngw;
}

DI void rmsnorm_rows(const float* X, const float* g, bf16_t* O) {
    const int tid_ = opaque_tid(), lane = tid_ & 63, gw = blockIdx.x * 8 + (tid_ >> 6), ngw = gridDim.x * 8;
    for (int r = gw; r < S; r += ngw) {
        const f32x4* xr = (const f32x4*)(X + (size_t)r * DM) + lane; f32x4 v[8]; float s = 0.f;
#pragma unroll
        for (int j = 0; j < 8; ++j) { v[j] = xr[64 * j]; s += (v[j].x * v[j].x + v[j].y * v[j].y) + (v[j].z * v[j].z + v[j].w * v[j].w); }
        const float rstd = 1.f / sqrtf(wave_sum(s) * (1.f / DM) + EPS);
        u32x2* o8 = (u32x2*)(O + (size_t)r * DM) + lane;
#pragma unroll
        for (int j = 0; j < 8; ++j) { const f32x4 gv = ((const f32x4*)g)[lane + 64 * j]; u32x2 w; w.x = pk2(v[j].x * rstd * gv.x, v[j].y * rstd * gv.y); w.y = pk2(v[j].z * rstd * gv.z, v[j].w * rstd * gv.w); o8[64 * j] = w; }
    }
}
DI void final_norm_rows(float* X, const float* g) {
    const int tid_ = opaque_tid(), lane = tid_ & 63, gw = blockIdx.x * 8 + (tid_ >> 6), ngw = gridDim.x * 8;
    for (int r = gw; r < S; r += ngw) {
        f32x4* xr = (f32x4*)(X + (size_t)r * DM) + lane; f32x4 v[8]; float s = 0.f;
#pragma unroll
        for (int j = 0; j < 8; ++j) { v[j] = xr[64 * j]; s += (v[j].x * v[j].x + v[j].y * v[j].y) + (v[j].z * v[j].z + v[j].w * v[j].w); }
        const float rstd = 1.f / sqrtf(wave_sum(s) * (1.f / DM) + EPS);
#pragma unroll
        for (int j = 0; j < 8; ++j) { const f32x4 gv = ((const f32x4*)g)[lane + 64 * j]; xr[64 * j] = v[j] * rstd * gv; }
    }
}
DI void prep_rows(bf16_t* P, const float* qn, const float* kvn, const float* cw, const float* cb, const f32x2* tab, bf16_t* XC) {
    const int tid_ = opaque_tid(), lane = tid_ & 63, gw = blockIdx.x * 8 + (tid_ >> 6), ngw = gridDim.x * 8;
    for (int t = gw; t < S; t += ngw) {
        bf16_t* row = P + (size_t)t * NP;
        unsigned wq[3], wk[2], wc[8][4];
#pragma unroll
        for (int k = 0; k < 3; ++k) wq[k] = *(const unsigned*)(row + PC_CQ + 128 * k + 2 * lane);
#pragma unroll
        for (int k = 0; k < 2; ++k) wk[k] = *(const unsigned*)(row + PC_CKV + 128 * k + 2 * lane);
        const int j = lane & 31; const float x1 = bf2f(row[PC_KR + j]), x2 = bf2f(row[PC_KR + 32 + j]); const f32x2 cs = tab[(size_t)t * 32 + j];
#pragma unroll
        for (int k = 0; k < 8; ++k)
#pragma unroll
            for (int jj = 0; jj < 4; ++jj) { const int tt = t - 3 + jj; wc[k][jj] = tt >= 0 ? *(const unsigned*)(P + (size_t)tt * NP + PC_CX + 128 * k + 2 * lane) : 0u; }
        asm volatile("" ::: "memory");
        { float s = 0.f;
#pragma unroll
          for (int k = 0; k < 3; ++k) { const float a = bflo(wq[k]), b = bfhi(wq[k]); s += a * a + b * b; }
          const float rstd = 1.f / sqrtf(wave_sum(s) * (1.f / 384.f) + EPS);
#pragma unroll
          for (int k = 0; k < 3; ++k) { const int c = 128 * k + 2 * lane; *(unsigned*)(row + PC_CQ + c) = pk2(bflo(wq[k]) * rstd * qn[c], bfhi(wq[k]) * rstd * qn[c + 1]); } }
        { float s = 0.f;
#pragma unroll
          for (int k = 0; k < 2; ++k) { const float a = bflo(wk[k]), b = bfhi(wk[k]); s += a * a + b * b; }
          const float rstd = 1.f / sqrtf(wave_sum(s) * (1.f / 256.f) + EPS);
#pragma unroll
          for (int k = 0; k < 2; ++k) { const int c = 128 * k + 2 * lane; *(unsigned*)(row + PC_CKV + c) = pk2(bflo(wk[k]) * rstd * kvn[c], bfhi(wk[k]) * rstd * kvn[c + 1]); } }
        { const unsigned o = pk2(x1 * cs.x - x2 * cs.y, x1 * cs.y + x2 * cs.x); if (lane < 32) *(unsigned*)(row + PC_KR + 2 * j) = o; }
#pragma unroll
        for (int k = 0; k < 8; ++k) { const int ch = 128 * k + 2 * lane; float a0 = cb[ch], a1 = cb[ch + 1];
#pragma unroll
            for (int jj = 0; jj < 4; ++jj) { a0 += cw[jj * 1024 + ch] * bflo(wc[k][jj]); a1 += cw[jj * 1024 + ch + 1] * bfhi(wc[k][jj]); }
            *(unsigned*)(XC + (size_t)t * 1024 + ch) = pk2(a0, a1); }
    }
}

DI void lru_p1(const bf16_t* LA, const bf16_t* U, float* CA, float* CH) {
    const int tid = opaque_tid();
    for (int c = blockIdx.x; c < 256; c += gridDim.x) {
        float h0 = 0.f, h1 = 0.f, s0 = 0.f, s1 = 0.f;
#pragma unroll 1
        for (int t0 = 0; t0 < 64; t0 += 16) {
            unsigned lw[16], uw[16];
#pragma unroll
            for (int i = 0; i < 16; ++i) { const size_t row = (size_t)c * 64 + t0 + i; lw[i] = *(const unsigned*)(LA + row * NP + 2 * tid); uw[i] = *(const unsigned*)(U + row * 1024 + 2 * tid); }
#pragma unroll
            for (int i = 0; i < 16; ++i) { const float l0 = bflo(lw[i]), l1 = bfhi(lw[i]); s0 += l0; s1 += l1; h0 = __expf(l0) * h0 + bflo(uw[i]); h1 = __expf(l1) * h1 + bfhi(uw[i]); }
        }
        CA[c * 1024 + 2 * tid] = __expf(s0); CA[c * 1024 + 2 * tid + 1] = __expf(s1); CH[c * 1024 + 2 * tid] = h0; CH[c * 1024 + 2 * tid + 1] = h1;
    }
}
DI void lru_p2(const float* CA, const float* CH, float* CARRY) {
    const int tid = opaque_tid(), lane = tid & 63, gw = blockIdx.x * 8 + (tid >> 6), ngw = gridDim.x * 8;
    for (int ch = gw; ch < 1024; ch += ngw) {
        float a[4], hh[4];
#pragma unroll
        for (int i = 0; i < 4; ++i) { a[i] = CA[(4 * lane + i) * 1024 + ch]; hh[i] = CH[(4 * lane + i) * 1024 + ch]; }
        float A = a[0], H = hh[0];
#pragma unroll
        for (int i = 1; i < 4; ++i) { H = a[i] * H + hh[i]; A = A * a[i]; }
#pragma unroll
        for (int o = 1; o < 64; o <<= 1) { const float Ap = __shfl_up(A, o), Hp = __shfl_up(H, o); if (lane >= o) { H = A * Hp + H; A = A * Ap; } }
        float st = __shfl_up(H, 1); if (lane == 0) st = 0.f;
#pragma unroll
        for (int i = 0; i < 4; ++i) { CARRY[(4 * lane + i) * 1024 + ch] = st; st = a[i] * st + hh[i]; }
    }
}
DI void lru_p3(const bf16_t* LA, const bf16_t* U, const float* CARRY, bf16_t* Y) {
    const int tid = opaque_tid();
    for (int c = blockIdx.x; c < 256; c += gridDim.x) {
        float h0 = CARRY[c * 1024 + 2 * tid], h1 = CARRY[c * 1024 + 2 * tid + 1];
#pragma unroll 1
        for (int t0 = 0; t0 < 64; t0 += 16) {
            unsigned lw[16], uw[16];
#pragma unroll
            for (int i = 0; i < 16; ++i) { const size_t row = (size_t)c * 64 + t0 + i; lw[i] = *(const unsigned*)(LA + row * NP + 2 * tid); uw[i] = *(const unsigned*)(U + row * 1024 + 2 * tid); }
            asm volatile("" ::: "memory");
#pragma unroll
            for (int i = 0; i < 16; ++i) { const size_t row = (size_t)c * 64 + t0 + i; h0 = __expf(bflo(lw[i])) * h0 + bflo(uw[i]); h1 = __expf(bfhi(lw[i])) * h1 + bfhi(uw[i]);
                *(unsigned*)(Y + row * 3072 + 2048 + 2 * tid) = pk2(h0, h1); }
            asm volatile("" ::: "memory");
        }
    }
}

DI void mlstm_a(LAS unsigned char* smem, const bf16_t* P, const float* gbias, bf16_t* CS, float* SMALL) {
    const int tid = opaque_tid(), lane = tid & 63, wid = tid >> 6, l31 = lane & 31, h = lane >> 5, q4 = (lane & 15) >> 2, p4 = lane & 3, blk = (lane >> 4) & 1;
    LAS float* sw = (LAS float*)smem;
    LAS unsigned char* Ks = smem + 1024;
    LAS unsigned char* Vs = smem + 1024 + 20480;
    for (int uid = blockIdx.x; uid < 1024; uid += gridDim.x) {
        const int c = uid >> 2, hh = uid & 3; const size_t row0 = (size_t)c * 64;
        if (wid == 0) {
            const bf16_t* r = P + (row0 + lane) * NP;
            const float li = bf2f(r[PC_I + hh]) + gbias[hh], lf = logsigmoid_(bf2f(r[PC_F + hh]) + gbias[4 + hh]);
            const float bc = wave_incl_scan(lf, lane), bt = __shfl(bc, 63), ds = bt - bc + li, M = wave_max(ds);
            sw[lane] = expf(ds - M);
            if (lane == 0) { SMALL[SM_BT + uid] = bt; SMALL[SM_MC + uid] = M; }
        }
        __syncthreads();
#pragma unroll
        for (int i = 0; i < 2; ++i) { const int id = tid + 512 * i, s = id >> 4, d8 = (id & 15) * 8; const u32x4 v = *(const u32x4*)(P + (row0 + s) * NP + PC_K + hh * 128 + d8); const float w = sw[s];
            u32x4 o; o.x = pk2(bflo(v.x) * w, bfhi(v.x) * w); o.y = pk2(bflo(v.y) * w, bfhi(v.y) * w); o.z = pk2(bflo(v.z) * w, bfhi(v.z) * w); o.w = pk2(bflo(v.w) * w, bfhi(v.w) * w);
            *(LAS u32x4*)(Ks + s * 320 + d8 * 2) = o; }
#pragma unroll
        for (int i = 0; i < 4; ++i) { const int id = tid + 512 * i, s = id >> 5, d8 = (id & 31) * 8; *(LAS u32x4*)(Vs + s * 576 + d8 * 2) = *(const u32x4*)(P + (row0 + s) * NP + PC_V + hh * 256 + d8); }
        __syncthreads();
        f32x16 acc[4];
#pragma unroll
        for (int d = 0; d < 4; ++d)
#pragma unroll
            for (int i = 0; i < 16; ++i) acc[d][i] = 0.f;
#pragma unroll
        for (int kk = 0; kk < 4; ++kk) {
            const bf16x8 vf = tr_frag(Vs + (16 * kk + 8 * h + q4) * 576 + (32 * wid + 16 * blk) * 2 + 8 * p4, 576);
#pragma unroll
            for (int d = 0; d < 4; ++d) { const bf16x8 kf = tr_frag(Ks + (16 * kk + 8 * h + q4) * 320 + (32 * d + 16 * blk) * 2 + 8 * p4, 320); acc[d] = mfma32(kf, vf, acc[d]); }
        }
        bf16_t* cs = CS + (size_t)uid * 32768 + (32 * wid + l31) * 128;
#pragma unroll
        for (int d = 0; d < 4; ++d)
#pragma unroll
            for (int g = 0; g < 4; ++g) { u32x2 w; w.x = pk2(acc[d][4 * g], acc[d][4 * g + 1]); w.y = pk2(acc[d][4 * g + 2], acc[d][4 * g + 3]); *(u32x2*)(cs + 32 * d + 8 * g + 4 * h) = w; }
        if (tid < 128) { float s = 0.f;
#pragma unroll 8
            for (int t = 0; t < 64; ++t) s += bf2f(*(LAS const bf16_t*)(Ks + t * 320 + tid * 2));
            SMALL[SM_DN + uid * 128 + tid] = s; }
        __syncthreads();
    }
}
DI void mlstm_b(LAS unsigned char* smem, bf16_t* CS, float* SMALL) {
    const int tid = opaque_tid();
    LAS float* dec = (LAS float*)smem; LAS float* inj = dec + 1024;
    LAS float* sbt = inj + 1024; LAS float* smc = sbt + 1024;
    sbt[tid] = SMALL[SM_BT + tid]; sbt[tid + 512] = SMALL[SM_BT + tid + 512]; smc[tid] = SMALL[SM_MC + tid]; smc[tid + 512] = SMALL[SM_MC + tid + 512];
    __syncthreads();
    if (tid < 4) { float m = -1e30f;
        for (int c = 0; c < 256; ++c) { const float bt = sbt[c * 4 + tid], M = smc[c * 4 + tid]; sbt[c * 4 + tid] = m;
            const float mn = fmaxf(bt + m, M); dec[tid * 256 + c] = __expf(bt + m - mn); inj[tid * 256 + c] = __expf(M - mn); m = mn; } }
    __syncthreads();
    if (blockIdx.x == 0) { SMALL[SM_MPREV + tid] = sbt[tid]; SMALL[SM_MPREV + tid + 512] = sbt[tid + 512]; }
    for (int e = blockIdx.x * 512 + tid; e < 131072; e += gridDim.x * 512) {
        const int hh = e >> 15, idx = e & 32767; bf16_t* pp = CS + (size_t)hh * 32768 + idx; float st = 0.f;
        bf16_t d[32];
#pragma unroll
        for (int i = 0; i < 32; ++i) d[i] = pp[(size_t)i * 131072];
#pragma unroll 1
        for (int c0 = 0; c0 < 256; c0 += 32) {
            bf16_t dn[32];
            const int cn = c0 + 32 < 256 ? c0 + 32 : c0;
#pragma unroll
            for (int i = 0; i < 32; ++i) dn[i] = pp[(size_t)(cn + i) * 131072];
            asm volatile("" ::: "memory");
#pragma unroll
            for (int i = 0; i < 32; ++i) { pp[(size_t)(c0 + i) * 131072] = f2bf(st); st = dec[hh * 256 + c0 + i] * st + inj[hh * 256 + c0 + i] * bf2f(d[i]); }
            asm volatile("" ::: "memory");
#pragma unroll
            for (int i = 0; i < 32; ++i) d[i] = dn[i];
        }
    }
    if (blockIdx.x == gridDim.x - 1) { const int hh = tid >> 7; float* pp = SMALL + SM_DN + tid; float st = 0.f;
#pragma unroll 1
        for (int c0 = 0; c0 < 256; c0 += 32) {
            float d[32];
#pragma unroll
            for (int i = 0; i < 32; ++i) d[i] = pp[(c0 + i) * 512];
            asm volatile("" ::: "memory");
#pragma unroll
            for (int i = 0; i < 32; ++i) { pp[(c0 + i) * 512] = st; st = dec[hh * 256 + c0 + i] * st + inj[hh * 256 + c0 + i] * d[i]; }
            asm volatile("" ::: "memory");
        } }
    __syncthreads();
}
DI void mlstm_c(LAS unsigned char* smem, const bf16_t* P, const float* gbias, const float* onorm, const bf16_t* CS, const float* SMALL, bf16_t* Y) {
    const int tid = opaque_tid(), lane = tid & 63, wid = tid >> 6, l31 = lane & 31, h = lane >> 5, q4 = (lane & 15) >> 2, p4 = lane & 3, blk = (lane >> 4) & 1;
    LAS float* sbc = (LAS float*)smem; LAS float* sav = sbc + 64; LAS float* snp = sbc + 128; LAS float* sx = sbc + 256;
    LAS unsigned char* Qs = smem + 2048;
    LAS unsigned char* Ks = Qs + 17408;
    LAS unsigned char* Vs = Ks + 17408;
    const int tb = wid & 1, dvq = wid >> 1, t = 32 * tb + l31, pr = pi32(l31);
    for (int uid = blockIdx.x; uid < 1024; uid += gridDim.x) {
        const int c = uid >> 2, hh = uid & 3; const size_t row0 = (size_t)c * 64;
        if (wid == 0) {
            const bf16_t* r = P + (row0 + lane) * NP;
            const float li = bf2f(r[PC_I + hh]) + gbias[hh], lf = logsigmoid_(bf2f(r[PC_F + hh]) + gbias[4 + hh]);
            const float bc = wave_incl_scan(lf, lane);
            sbc[lane] = bc; sav[lane] = li - bc;
        }
        if (tid >= 64 && tid < 192) snp[tid - 64] = SMALL[SM_DN + uid * 128 + tid - 64];
#pragma unroll
        for (int i = 0; i < 2; ++i) { const int id = tid + 512 * i, s = id >> 4, d8 = (id & 15) * 8;
            *(LAS u32x4*)(Qs + s * 272 + d8 * 2) = *(const u32x4*)(P + (row0 + s) * NP + PC_Q + hh * 128 + d8);
            *(LAS u32x4*)(Ks + s * 272 + d8 * 2) = *(const u32x4*)(P + (row0 + s) * NP + PC_K + hh * 128 + d8); }
#pragma unroll
        for (int i = 0; i < 4; ++i) { const int id = tid + 512 * i, s = id >> 5, d8 = (id & 31) * 8; *(LAS u32x4*)(Vs + s * 576 + d8 * 2) = *(const u32x4*)(P + (row0 + s) * NP + PC_V + hh * 256 + d8); }
        __syncthreads();
        const float mprev = SMALL[SM_MPREV + uid];
        bf16x8 qf[8];
#pragma unroll
        for (int ks = 0; ks < 8; ++ks) qf[ks] = *(const LAS bf16x8*)(Qs + t * 272 + (16 * ks + 8 * h) * 2);
        f32x16 st0, st1;
#pragma unroll
        for (int i = 0; i < 16; ++i) { st0[i] = 0.f; st1[i] = 0.f; }
#pragma unroll
        for (int ks = 0; ks < 8; ++ks) { const bf16x8 a0 = *(const LAS bf16x8*)(Ks + pr * 272 + (16 * ks + 8 * h) * 2); st0 = mfma32(a0, qf[ks], st0);
            if (tb) { const bf16x8 a1 = *(const LAS bf16x8*)(Ks + (32 + pr) * 272 + (16 * ks + 8 * h) * 2); st1 = mfma32(a1, qf[ks], st1); } }
        const float bt = sbc[t];
        float mx = -1e30f;
#pragma unroll
        for (int i = 0; i < 16; ++i) { const int s = 16 * (i >> 3) + 8 * h + (i & 7); if (s <= t) mx = fmaxf(mx, sav[s]); if (tb) mx = fmaxf(mx, (s + 32 <= t) ? sav[s + 32] : -1e30f); }
        mx = fmaxf(mx, __shfl_xor(mx, 32));
        const float mt = bt + fmaxf(mprev, mx);
        float den = 0.f;
#pragma unroll
        for (int i = 0; i < 16; ++i) { const int s = 16 * (i >> 3) + 8 * h + (i & 7);
            const float w0 = (s <= t) ? expf(bt + sav[s] - mt) * MQS : 0.f; st0[i] *= w0; den += st0[i];
            const float w1 = (tb && (s + 32 <= t)) ? expf(bt + sav[s + 32] - mt) * MQS : 0.f; st1[i] *= w1; den += st1[i]; }
        den += __shfl_xor(den, 32);
        float qn = 0.f;
#pragma unroll
        for (int ks = 0; ks < 8; ++ks)
#pragma unroll
            for (int j = 0; j < 8; ++j) qn += bf2f((bf16_t)qf[ks][j]) * snp[16 * ks + 8 * h + j];
        qn += __shfl_xor(qn, 32);
        const float wi = expf(bt + mprev - mt) * MQS;
        den += wi * qn;
        const float dinv = 1.f / fmaxf(fabsf(den), expf(-mt));
        bf16x8 pf[4];
        pf[0] = pack8(st0[0], st0[1], st0[2], st0[3], st0[4], st0[5], st0[6], st0[7]); pf[1] = pack8(st0[8], st0[9], st0[10], st0[11], st0[12], st0[13], st0[14], st0[15]);
        pf[2] = pack8(st1[0], st1[1], st1[2], st1[3], st1[4], st1[5], st1[6], st1[7]); pf[3] = pack8(st1[8], st1[9], st1[10], st1[11], st1[12], st1[13], st1[14], st1[15]);
        float hv[2][16]; float ss = 0.f;
#pragma unroll
        for (int db = 0; db < 2; ++db) { const int dvb = 2 * dvq + db;
            f32x16 a1, a2;
#pragma unroll
            for (int i = 0; i < 16; ++i) { a1[i] = 0.f; a2[i] = 0.f; }
#pragma unroll
            for (int sb = 0; sb < 2; ++sb)
#pragma unroll
                for (int kk = 0; kk < 2; ++kk) { if (sb <= tb) { const bf16x8 vf = tr_frag(Vs + (32 * sb + 16 * kk + 8 * h + q4) * 576 + (32 * dvb + 16 * blk) * 2 + 8 * p4, 576); a1 = mfma32(vf, pf[2 * sb + kk], a1); } }
            const bf16_t* cp = CS + (size_t)uid * 32768 + (32 * dvb + l31) * 128 + 8 * h;
#pragma unroll
            for (int ks = 0; ks < 8; ++ks) { const bf16x8 cf = *(const bf16x8*)(cp + 16 * ks); a2 = mfma32(cf, qf[ks], a2); }
#pragma unroll
            for (int i = 0; i < 16; ++i) { const float v = (a1[i] + wi * a2[i]) * dinv; hv[db][i] = v; ss += v * v; }
        }
        ss += __shfl_xor(ss, 32);
        if (h == 0) sx[(tb * 4 + dvq) * 32 + l31] = ss;
        __syncthreads();
        const float tot = (sx[(tb * 4 + 0) * 32 + l31] + sx[(tb * 4 + 1) * 32 + l31]) + (sx[(tb * 4 + 2) * 32 + l31] + sx[(tb * 4 + 3) * 32 + l31]);
        const float rstd = 1.f / sqrtf(tot * (1.f / 256.f) + EPS);
#pragma unroll
        for (int db = 0; db < 2; ++db)
#pragma unroll
            for (int g = 0; g < 4; ++g) { const int col = hh * 256 + 32 * (2 * dvq + db) + 8 * g + 4 * h;
                const f32x4 gn = *(const f32x4*)(onorm + col); const u32x2 og = *(const u32x2*)(P + (row0 + t) * NP + PC_O + col);
                const float o0 = hv[db][4 * g] * rstd * gn.x * sigmoidf_(bflo(og.x)), o1 = hv[db][4 * g + 1] * rstd * gn.y * sigmoidf_(bfhi(og.x));
                const float o2 = hv[db][4 * g + 2] * rstd * gn.z * sigmoidf_(bflo(og.y)), o3 = hv[db][4 * g + 3] * rstd * gn.w * sigmoidf_(bfhi(og.y));
                u32x2 w; w.x = pk2(o0, o1); w.y = pk2(o2, o3); *(u32x2*)(Y + (row0 + t) * 3072 + col) = w; }
        __syncthreads();
    }
}

DI void attn_unit(LAS unsigned char* smem, int hh, int qb, const bf16_t* Q, const bf16_t* KN, const bf16_t* P, const bf16_t* VT, bf16_t* Y) {
    const int tid = opaque_tid(), lane = tid & 63, wid = __builtin_amdgcn_readfirstlane(tid >> 6), l31 = lane & 31, h = lane >> 5;
    LAS unsigned char* Kb = smem; LAS unsigned char* Vb = smem + 51200;
    const int q0 = qb * 256, qw = q0 + 32 * wid, q = qw + l31, NT = 4 * qb + 4;
    bf16x8 qf[12];
#pragma unroll
    for (int ks = 0; ks < 12; ++ks) qf[ks] = *(const bf16x8*)(Q + (size_t)q * 1536 + hh * 192 + 16 * ks + 8 * h);
    f32x16 o[4];
#pragma unroll
    for (int d = 0; d < 4; ++d)
#pragma unroll
        for (int i = 0; i < 16; ++i) o[d][i] = 0.f;
    float mref = 0.f, lrun = 0.f; bool first = true;
    const bf16_t* ksrc0; const bf16_t* ksrc2; const bf16_t* vsrc0; int kdst0, kdst2, vdst0;
    { const int row = tid >> 4, ch = tid & 15; ksrc0 = KN + (size_t)row * 1024 + hh * 128 + 8 * ch; kdst0 = row * 400 + ch * 16; }
    { const int row = tid >> 3, ch = tid & 7; ksrc2 = P + (size_t)row * NP + PC_KR + 8 * ch; kdst2 = row * 400 + 256 + ch * 16; }
    { const int d = tid >> 3, ch = tid & 7; vsrc0 = VT + (size_t)(hh * 128 + d) * S + 8 * ch; vdst0 = d * 144 + ch * 16; }
    u32x4 kr[3], vr[2];
#define ATT_LOAD(tt) do { kr[0] = *(const u32x4*)(ksrc0 + (size_t)(tt) * 65536); kr[1] = *(const u32x4*)(ksrc0 + (size_t)(tt) * 65536 + 32 * 1024); kr[2] = *(const u32x4*)(ksrc2 + (size_t)(tt) * (64 * NP)); \
        vr[0] = *(const u32x4*)(vsrc0 + (size_t)(tt) * 64); vr[1] = *(const u32x4*)(vsrc0 + (size_t)(tt) * 64 + (size_t)64 * S); } while (0)
#define ATT_WRITE(kbuf, vslot) do { *(LAS u32x4*)(Kb + (kbuf) * 25600 + kdst0) = kr[0]; *(LAS u32x4*)(Kb + (kbuf) * 25600 + kdst0 + 32 * 400) = kr[1]; *(LAS u32x4*)(Kb + (kbuf) * 25600 + kdst2) = kr[2]; \
        *(LAS u32x4*)(Vb + (vslot) * 18432 + vdst0) = vr[0]; *(LAS u32x4*)(Vb + (vslot) * 18432 + vdst0 + 64 * 144) = vr[1]; } while (0)
#define ATT_BAR() do { asm volatile("s_waitcnt lgkmcnt(0)" ::: "memory"); __builtin_amdgcn_s_barrier(); asm volatile("" ::: "memory"); } while (0)
    ATT_LOAD(0);
    ATT_WRITE(0, 0);
    ATT_BAR();
    const int koff = pi32(l31) * 400 + 16 * h, voff = l31 * 144 + 16 * h;
#define SB() __builtin_amdgcn_sched_barrier(0)
#define KFR(kb, ks, b) (*(const LAS bf16x8*)((kb) + (b) * 32 * 400 + (ks) * 32))
#define VFR(vb, d, kk) (*(const LAS bf16x8*)((vb) + (d) * 32 * 144 + (kk) * 32))
    int vs = 0;
    for (int t = 0; t < NT; ++t) {
        const int kc = t & 1, vn = vs == 2 ? 0 : vs + 1;
        if (t + 1 < NT) ATT_LOAD(t + 1);
        if (64 * t <= qw + 31) {
            LAS const unsigned char* kb = Kb + kc * 25600 + koff; LAS const unsigned char* vb = Vb + vs * 18432 + voff;
            f32x16 s0, s1;
#pragma unroll
            for (int i = 0; i < 16; ++i) { s0[i] = 0.f; s1[i] = 0.f; }
            bf16x8 fa[4], fb[4];
            fa[0] = KFR(kb, 0, 0); fa[1] = KFR(kb, 0, 1); fa[2] = KFR(kb, 1, 0); fa[3] = KFR(kb, 1, 1); SB();
#pragma unroll
            for (int st = 0; st < 6; st += 2) {
                fb[0] = KFR(kb, 2 * st + 2, 0); fb[1] = KFR(kb, 2 * st + 2, 1); fb[2] = KFR(kb, 2 * st + 3, 0); fb[3] = KFR(kb, 2 * st + 3, 1); SB();
                s0 = mfma32(fa[0], qf[2 * st], s0); s1 = mfma32(fa[1], qf[2 * st], s1); s0 = mfma32(fa[2], qf[2 * st + 1], s0); s1 = mfma32(fa[3], qf[2 * st + 1], s1); SB();
                if (st + 2 < 6) { fa[0] = KFR(kb, 2 * st + 4, 0); fa[1] = KFR(kb, 2 * st + 4, 1); fa[2] = KFR(kb, 2 * st + 5, 0); fa[3] = KFR(kb, 2 * st + 5, 1); }
                else { fa[0] = VFR(vb, 0, 0); fa[1] = VFR(vb, 0, 1); fa[2] = VFR(vb, 0, 2); fa[3] = VFR(vb, 0, 3); }
                SB();
                s0 = mfma32(fb[0], qf[2 * st + 2], s0); s1 = mfma32(fb[1], qf[2 * st + 2], s1); s0 = mfma32(fb[2], qf[2 * st + 3], s0); s1 = mfma32(fb[3], qf[2 * st + 3], s1); SB();
            }
            if (64 * t + 63 > qw) {
#pragma unroll
                for (int i = 0; i < 16; ++i) { const int kv = 64 * t + 16 * (i >> 3) + 8 * h + (i & 7); if (kv > q) s0[i] = -1e30f; if (kv + 32 > q) s1[i] = -1e30f; }
            }
            float mx = fmaxf(s0[0], s1[0]);
#pragma unroll
            for (int i = 1; i < 16; ++i) mx = fmaxf(mx, fmaxf(s0[i], s1[i]));
            mx = fmaxf(mx, __shfl_xor(mx, 32));
            if (first || __any(mx - mref > 8.f)) {
                const float dl = first ? mx : fmaxf(mx - mref, 0.f);
                mref += dl;
                if (!first) { const float f = __builtin_amdgcn_exp2f(-dl); lrun *= f;
#pragma unroll
                    for (int d = 0; d < 4; ++d)
#pragma unroll
                        for (int i = 0; i < 16; ++i) o[d][i] *= f; }
                first = false; }
            float rs = 0.f;
#pragma unroll
            for (int i = 0; i < 16; ++i) { s0[i] = __builtin_amdgcn_exp2f(s0[i] - mref); s1[i] = __builtin_amdgcn_exp2f(s1[i] - mref); rs += s0[i] + s1[i]; }
            lrun += rs;
            bf16x8 pf[4];
            pf[0] = pack8(s0[0], s0[1], s0[2], s0[3], s0[4], s0[5], s0[6], s0[7]); pf[1] = pack8(s0[8], s0[9], s0[10], s0[11], s0[12], s0[13], s0[14], s0[15]);
            pf[2] = pack8(s1[0], s1[1], s1[2], s1[3], s1[4], s1[5], s1[6], s1[7]); pf[3] = pack8(s1[8], s1[9], s1[10], s1[11], s1[12], s1[13], s1[14], s1[15]);
            SB();
            fb[0] = VFR(vb, 1, 0); fb[1] = VFR(vb, 1, 1); fb[2] = VFR(vb, 1, 2); fb[3] = VFR(vb, 1, 3); SB();
            o[0] = mfma32(fa[0], pf[0], o[0]); o[0] = mfma32(fa[1], pf[1], o[0]); o[0] = mfma32(fa[2], pf[2], o[0]); o[0] = mfma32(fa[3], pf[3], o[0]); SB();
            fa[0] = VFR(vb, 2, 0); fa[1] = VFR(vb, 2, 1); fa[2] = VFR(vb, 2, 2); fa[3] = VFR(vb, 2, 3); SB();
            o[1] = mfma32(fb[0], pf[0], o[1]); o[1] = mfma32(fb[1], pf[1], o[1]); o[1] = mfma32(fb[2], pf[2], o[1]); o[1] = mfma32(fb[3], pf[3], o[1]); SB();
            fb[0] = VFR(vb, 3, 0); fb[1] = VFR(vb, 3, 1); fb[2] = VFR(vb, 3, 2); fb[3] = VFR(vb, 3, 3); SB();
            o[2] = mfma32(fa[0], pf[0], o[2]); o[2] = mfma32(fa[1], pf[1], o[2]); o[2] = mfma32(fa[2], pf[2], o[2]); o[2] = mfma32(fa[3], pf[3], o[2]); SB();
            o[3] = mfma32(fb[0], pf[0], o[3]); o[3] = mfma32(fb[1], pf[1], o[3]); o[3] = mfma32(fb[2], pf[2], o[3]); o[3] = mfma32(fb[3], pf[3], o[3]); SB();
        }
        if (t + 1 < NT) ATT_WRITE(kc ^ 1, vn);
        ATT_BAR();
        vs = vn;
    }
#undef SB
#undef KFR
#undef VFR
#undef ATT_LOAD
#undef ATT_WRITE
#undef ATT_BAR
    lrun += __shfl_xor(lrun, 32);
    const float inv = 1.f / lrun;
    bf16_t* yp = Y + (size_t)q * 3072 + 1024 + hh * 128 + 4 * h;
#pragma unroll
    for (int d = 0; d < 4; ++d)
#pragma unroll
        for (int g = 0; g < 4; ++g) { u32x2 w; w.x = pk2(o[d][4 * g] * inv, o[d][4 * g + 1] * inv); w.y = pk2(o[d][4 * g + 2] * inv, o[d][4 * g + 3] * inv); *(u32x2*)(yp + 32 * d + 8 * g) = w; }
}

#define XB_TMO      128
#define XB_XCNT(j)  (256  + 64 * (j))
#define XB_XSUB(j)  (1280 + 64 * (j))
#define XB_XGEN(j)  (2304 + 64 * (j))
#define XB_TOP      3328
#define XB_TOPGEN   3392
#define XCD_BAR_WORDS 3456
#define XB_SPIN_CAP (1u << 23)
DI unsigned xb_ld(unsigned* p)              { return __hip_atomic_load(p, __ATOMIC_RELAXED, __HIP_MEMORY_SCOPE_AGENT); }
DI unsigned xb_add(unsigned* p, unsigned v) { return __hip_atomic_fetch_add(p, v, __ATOMIC_RELAXED, __HIP_MEMORY_SCOPE_AGENT); }
DI unsigned xb_xcc_id() { return (unsigned)__builtin_amdgcn_s_getreg((3 << 11) | 20) & 0xFu; }
#define XB_SPIN(cond, bar) do { unsigned _sp = 0; while (cond) { __builtin_amdgcn_s_sleep(1); \
    if ((++_sp & 255u) == 0u) { if (xb_ld(&(bar)[XB_TMO])) break; if (_sp > XB_SPIN_CAP) { atomicAdd(&(bar)[XB_TMO], 1u); break; } } } } while (0)
struct XcdBarrier { unsigned* bar; unsigned x; volatile LAS unsigned* st; };
DI XcdBarrier xcd_barrier_post(unsigned* bar, volatile LAS unsigned* st) {
    XcdBarrier b; b.bar = bar; b.x = xb_xcc_id(); b.st = st;
    if (threadIdx.x == 0) (void)xb_add(&bar[XB_XCNT(b.x)], 1u);
    return b;
}
DI void xcd_barrier_complete(unsigned* bar, unsigned x, unsigned& nloc, unsigned& nx) {
    const unsigned G = gridDim.x * gridDim.y * gridDim.z;
    unsigned sum, cnt, mine, sp = 0u;
    for (;;) {
        sum = 0u; cnt = 0u; mine = 0u;
#pragma unroll
        for (unsigned j = 0; j < 16; ++j) { const unsigned c = xb_ld(&bar[XB_XCNT(j)]); sum += c; cnt += (c > 0u) ? 1u : 0u; mine = (j == x) ? c : mine; }
        if (sum == G) break;
        __builtin_amdgcn_s_sleep(1);
        if ((++sp & 255u) == 0u) { if (xb_ld(&bar[XB_TMO])) break; if (sp > XB_SPIN_CAP) { atomicAdd(&bar[XB_TMO], 1u); break; } }
    }
    nloc = mine > 0u ? mine : 1u; nx = cnt > 0u ? cnt : 1u;
}
DI void xcd_barrier(const XcdBarrier& b) {
    asm volatile("s_waitcnt vmcnt(0)" ::: "memory");
    __syncthreads();
    if (threadIdx.x == 0) {
        unsigned* bar = b.bar;
        __builtin_amdgcn_s_waitcnt(0);
        unsigned nloc = b.st[0], nx = b.st[1];
        if (nloc == 0u) { xcd_barrier_complete(bar, b.x, nloc, nx); b.st[0] = nloc; b.st[1] = nx; }
        const unsigned old = xb_add(&bar[XB_XSUB(b.x)], 1u);
        const unsigned gen = old / nloc;
        if (old + 1u == (gen + 1u) * nloc) {
            __builtin_amdgcn_fence(__ATOMIC_RELEASE, "agent");
            asm volatile("s_waitcnt vmcnt(0)" ::: "memory");
            const unsigned og = xb_add(&bar[XB_TOP], 1u);
            const unsigned tg = og / nx;
            if (og + 1u == (tg + 1u) * nx) xb_add(&bar[XB_TOPGEN], 1u);
            else XB_SPIN(xb_ld(&bar[XB_TOPGEN]) == tg, bar);
            __builtin_amdgcn_fence(__ATOMIC_ACQUIRE, "agent");
            xb_add(&bar[XB_XGEN(b.x)], 1u);
            asm volatile("s_waitcnt vmcnt(0)" ::: "memory");
        } else {
            XB_SPIN(xb_ld(&bar[XB_XGEN(b.x)]) == gen, bar);
            __builtin_amdgcn_fence(__ATOMIC_ACQUIRE, "agent");
            asm volatile("s_waitcnt vmcnt(0)" ::: "memory");
        }
    }
    __syncthreads();
}

struct Params { const float* in[27]; float* out; unsigned char* ws; };

__global__ void __launch_bounds__(512, 2) mega_fwd(Params p) {
    extern __shared__ __attribute__((aligned(16))) unsigned char smem_raw[];
    LAS unsigned char* smem = (LAS unsigned char*)smem_raw;
    cg::grid_group grid = cg::this_grid();
    const int G = gridDim.x, bx = blockIdx.x;
    { const int t0 = opaque_tid(); if (t0 < 128) ((LAS unsigned*)(smem + 131072))[t0] = 0u; }
    __syncthreads();
    XcdBarrier bar = xcd_barrier_post((unsigned*)(p.ws + WS_CTL), (volatile LAS unsigned*)(smem + 131072) + 8);
    unsigned char* ws = p.ws;
    f32x2* TAB = (f32x2*)(ws + WS_TAB); float* SMALL = (float*)(ws + WS_SMALL);
    bf16_t* WFFGU = (bf16_t*)(ws + WS_WFFGU); bf16_t* WFFD = (bf16_t*)(ws + WS_WFFD); bf16_t* WIN = (bf16_t*)(ws + WS_WIN); bf16_t* WUQ = (bf16_t*)(ws + WS_WUQ);
    bf16_t* WUKV = (bf16_t*)(ws + WS_WUKV); bf16_t* WLRU = (bf16_t*)(ws + WS_WLRU); bf16_t* WBR = (bf16_t*)(ws + WS_WBR); bf16_t* WOUT = (bf16_t*)(ws + WS_WOUT);
    bf16_t* XN = (bf16_t*)(ws + WS_XN); bf16_t* P = (bf16_t*)(ws + WS_P); bf16_t* Hb = P; bf16_t* Qb = (bf16_t*)(ws + WS_Q); bf16_t* KN = (bf16_t*)(ws + WS_KN);
    bf16_t* VT = (bf16_t*)(ws + WS_VT); bf16_t* Y = (bf16_t*)(ws + WS_Y); bf16_t* XC = (bf16_t*)(ws + WS_XC); bf16_t* CS = (bf16_t*)(ws + WS_CS);

    for (int i = bx * 512 + opaque_tid(); i < S * 32; i += G * 512) { const int t = i >> 5, j = i & 31; const float ang = (float)t * INVF[j];
        double r = (double)ang * 0.15915494309189535; r -= __builtin_floor(r); const float fr = (float)r;
        TAB[i] = (f32x2){__builtin_amdgcn_cosf(fr), __builtin_amdgcn_sinf(fr)}; }

#pragma unroll 1
    for (int hl = 0; hl < 4; ++hl) {
        const int l = hl >> 1, second = hl & 1;
        const float* xin = hl == 0 ? p.in[0] : p.out;
        {
            const int nmat = second ? 3 : 26; int rot = 0;
#pragma unroll 1
            for (int mi = 0; mi < nmat; ++mi) {
                const float* src; int K, N, map; bf16_t* dst;
                if (mi == 0) { src = p.in[second ? 23 : 2] + (size_t)l * DM * FF; K = DM; N = FF; map = 1; dst = WFFGU; }
                else if (mi == 1) { src = p.in[second ? 24 : 3] + (size_t)l * DM * FF; K = DM; N = FF; map = 2; dst = WFFGU; }
                else if (mi == 2) { src = p.in[second ? 25 : 4] + (size_t)l * DM * FF; K = FF; N = DM; map = 0; dst = WFFD; }
                else if (mi == 3) { src = p.in[6] + (size_t)l * DM * NIN; K = DM; N = NIN; map = 3; dst = WIN; }
                else if (mi == 4) { src = p.in[10] + (size_t)l * 384 * 1536; K = 384; N = 1536; map = 4; dst = WUQ; }
                else if (mi == 5) { src = p.in[12] + (size_t)l * 256 * 2048; K = 256; N = 2048; map = 5; dst = WUKV; }
                else if (mi < 22) { const int k = mi - 6, n = k >> 1, wx = k & 1; src = p.in[wx ? 17 : 15] + (size_t)l * 131072 + n * 16384; K = 128; N = 128; map = 0; dst = WLRU + (size_t)(n * 256 + wx * 128) * 128; }
                else if (mi < 25) { const int j = mi - 22; src = p.in[20] + (size_t)l * 3 * 1024 * 2048 + (size_t)j * 1024 * 2048; K = 1024; N = 2048; map = 0; dst = WBR + (size_t)j * 2048 * 1024; }
                else { src = p.in[21] + (size_t)l * DM * DM; K = DM; N = DM; map = 0; dst = WOUT; }
                convert_mat(src, K, N, dst, map, rot);
            }
            rmsnorm_rows(xin, p.in[second ? 22 : 1] + l * DM, XN);
        }
        if (hl == 0) grid.sync(); else xcd_barrier(bar);
        { pg8::Gemm g{XN, WFFGU, S, 2 * FF, DM, DM, DM, 0}; pg8::StaticOrder so; so.init(S, 2 * FF, G, bx); pg8::EpiSwiglu E{Hb}; pg8::gemm_phase(smem, g, so, E); }
        xcd_barrier(bar);
        { pg8::Gemm g{Hb, WFFD, S, DM, FF, FF, FF, 0}; pg8::StaticOrder so; so.init(S, DM, G, bx); pg8::EpiRes E{xin, p.out, 0.5f}; pg8::gemm_phase(smem, g, so, E); }
        xcd_barrier(bar);
        if (!second) {
            const float* gbias = p.in[7] + l * 8;
            rmsnorm_rows(p.out, p.in[5] + l * DM, XN);
            xcd_barrier(bar);
            { pg8::Gemm g{XN, WIN, S, NP, DM, DM, DM, 0}; pg8::StaticOrder so; so.init(S, NP, G, bx); pg8::EpiStore E{P, NP}; pg8::gemm_phase(smem, g, so, E); }
            xcd_barrier(bar);
            if (bx == G - 1) { const float* lam = p.in[19] + l * 1024; for (int ch = opaque_tid(); ch < 1024; ch += 512) SMALL[SM_SP + ch] = -8.f * log1pf(expf(-lam[ch])); }
            mlstm_a(smem, P, gbias, CS, SMALL);
            prep_rows(P, p.in[9] + l * 384, p.in[11] + l * 256, p.in[13] + l * 4096, p.in[14] + l * 1024, TAB, XC);
            xcd_barrier(bar);
            mlstm_b(smem, CS, SMALL);
            { pg8::Gemm g{P + PC_CQ, WUQ, S, 1536, 384, NP, 384, 0}; pg8::StaticOrder so; so.init(S, 1536, G, bx); pg8::EpiQ E{Qb, TAB}; pg8::gemm_phase(smem, g, so, E); }
#pragma unroll 1
            for (int gi = 0; gi < 2; ++gi) {
                pg8::Gemm g; pg8::StaticOrder so; pg8::EpiStore E;
                if (gi == 0) { g = pg8::Gemm{P + PC_CKV, WUKV, S, 1024, 256, NP, 256, 0}; so.init(S, 1024, G, bx); E = pg8::EpiStore{KN, 1024}; }
                else { g = pg8::Gemm{WUKV + 1024 * 256, P + PC_CKV, 1024, S, 256, 256, NP, 0}; so.init(1024, S, G, bx); E = pg8::EpiStore{VT, S}; }
                pg8::gemm_phase(smem, g, so, E);
            }
            { pg8::Gemm g{XC, WLRU, S, 2048, 128, 1024, 128, 128}; pg8::StaticOrder so; so.init(S, 2048, G, bx); pg8::EpiLru E{XC, P + PC_CX, p.in[16] + l * 1024, p.in[18] + l * 1024, SMALL + SM_SP}; pg8::gemm_phase(smem, g, so, E); }
            xcd_barrier(bar);
            mlstm_c(smem, P, gbias, p.in[8] + l * 1024, CS, SMALL, Y);
            lru_p1(P + PC_CX, XC, SMALL + SM_CA, SMALL + SM_CH);
            xcd_barrier(bar);
            lru_p2(SMALL + SM_CA, SMALL + SM_CH, SMALL + SM_CARRY);
            for (int item = bx; item < 256; item += G) { const int hh = item & 7, pp = item >> 3;
#pragma unroll 1
                for (int half = 0; half < 2; ++half) attn_unit(smem, hh, half ? 63 - pp : pp, Qb, KN, P, VT, Y); }
            xcd_barrier(bar);
            lru_p3(P + PC_CX, XC, SMALL + SM_CARRY, Y);
#pragma unroll 1
            for (int j = 0; j < 3; ++j) {
                if (j == 2) xcd_barrier(bar);
                pg8::Gemm g{Y + j * 1024, WBR + (size_t)j * 2048 * 1024, S, DM, 1024, 3072, 1024, 0}; pg8::StaticOrder so; so.init(S, DM, G, bx); pg8::EpiMerge E{XN, P + PC_G + j * 2048, j == 0}; pg8::gemm_phase(smem, g, so, E);
            }
            xcd_barrier(bar);
            { pg8::Gemm g{XN, WOUT, S, DM, DM, DM, DM, 0}; pg8::StaticOrder so; so.init(S, DM, G, bx); pg8::EpiRes E{p.out, p.out, 1.0f}; pg8::gemm_phase(smem, g, so, E); }
            xcd_barrier(bar);
        }
    }
    final_norm_rows(p.out, p.in[26]);
}

constexpr int LDS_BYTES = 143360;

extern "C" void kernel_launch(void* const* d_in, const int* in_sizes, int n_in, void* d_out, int out_size, void* d_ws, size_t ws_size, hipStream_t stream) {
    static int grid = 0;
    if (grid == 0) {
        if (n_in != 27 || out_size != S * DM || ws_size < WS_END) { fprintf(stderr, "kernel_launch: unexpected problem (n_in %d out %d ws %zu, need %zu)\n", n_in, out_size, ws_size, (size_t)WS_END); grid = -1; return; }
        int dev = 0, cus = 0, per_cu = 0;
        hipGetDevice(&dev); hipDeviceGetAttribute(&cus, hipDeviceAttributeMultiprocessorCount, dev);
        if (hipFuncSetAttribute((const void*)mega_fwd, hipFuncAttributeMaxDynamicSharedMemorySize, LDS_BYTES) != hipSuccess) { fprintf(stderr, "kernel_launch: hipFuncSetAttribute failed\n"); grid = -1; return; }
        if (hipOccupancyMaxActiveBlocksPerMultiprocessor(&per_cu, (const void*)mega_fwd, 512, LDS_BYTES) != hipSuccess || per_cu < 1) { fprintf(stderr, "kernel_launch: occupancy query says %d\n", per_cu); per_cu = 1; }
        (void)hipGetLastError();
        grid = cus * (per_cu > 1 ? 1 : per_cu);
    }
    if (grid < 0) return;
    if (hipMemsetAsync((char*)d_ws + WS_CTL, 0, CTL_BYTES, stream) != hipSuccess) { fprintf(stderr, "kernel_launch: memset failed\n"); return; }
    Params p{};
    for (int i = 0; i < 27; ++i) p.in[i] = (const float*)d_in[i];
    p.out = (float*)d_out; p.ws = (unsigned char*)d_ws;
    void* args[] = {&p};
    hipError_t e = hipLaunchCooperativeKernel((const void*)mega_fwd, dim3(grid), dim3(512), args, LDS_BYTES, stream);
    if (e != hipSuccess) fprintf(stderr, "cooperative launch failed: %s (grid %d)\n", hipGetErrorString(e), grid);
}
```

```cpp
#include <hip/hip_runtime.h>
#include <hip/hip_cooperative_groups.h>
#include <cstdio>
#include <cstdint>
namespace cg = cooperative_groups;

#define DI __device__ __forceinline__
#define LAS __attribute__((address_space(3)))
typedef unsigned short bf16_t;
typedef short bf16x8 __attribute__((ext_vector_type(8)));
typedef short s16x4 __attribute__((ext_vector_type(4)));
typedef float f32x2 __attribute__((ext_vector_type(2)));
typedef float f32x4 __attribute__((ext_vector_type(4)));
typedef float f32x16 __attribute__((ext_vector_type(16)));
typedef unsigned u32x2 __attribute__((ext_vector_type(2)));
typedef unsigned u32x4 __attribute__((ext_vector_type(4)));
typedef __bf16 bf16x2_t __attribute__((ext_vector_type(2)));

constexpr int S = 16384, DM = 2048, FF = 5632, NIN = 10952, NP = 11008;
constexpr float EPS = 1e-6f;
constexpr int PC_Q = 0, PC_K = 512, PC_V = 1024, PC_O = 2048, PC_CQ = 3072, PC_CKV = 3456, PC_KR = 3712, PC_CX = 3776, PC_G = 4800, PC_I = 10944, PC_F = 10948;
constexpr float MQS = 0.08838834764831845f;
constexpr float AQS = 0.07216878364870322f * 1.4426950408889634f;

constexpr size_t MiB = 1u << 20;
constexpr size_t WS_TAB = 0;
constexpr size_t WS_SMALL = 4 * MiB;
constexpr size_t WS_WFFGU = 12 * MiB;
constexpr size_t WS_WFFD = 56 * MiB;
constexpr size_t WS_WIN = 78 * MiB;
constexpr size_t WS_WUQ = 121 * MiB;
constexpr size_t WS_WUKV = 123 * MiB;
constexpr size_t WS_WLRU = 124 * MiB;
constexpr size_t WS_WBR = 125 * MiB;
constexpr size_t WS_WOUT = 137 * MiB;
constexpr size_t WS_XN = 145 * MiB;
constexpr size_t WS_P = 209 * MiB;
constexpr size_t WS_Q = 553 * MiB;
constexpr size_t WS_KN = 601 * MiB;
constexpr size_t WS_VT = 633 * MiB;
constexpr size_t WS_Y = 665 * MiB;
constexpr size_t WS_XC = 761 * MiB;
constexpr size_t WS_CS = 793 * MiB;
constexpr size_t WS_END = 857 * MiB;
constexpr size_t WS_CTL = 11 * MiB, CTL_BYTES = 16384;
constexpr int SM_BT = 0, SM_MC = 1024, SM_MPREV = 2048, SM_DN = 4096  , SM_CA = 4096 + 131072  , SM_CH = SM_CA + 262144, SM_CARRY = SM_CH + 262144, SM_SP = SM_CARRY + 262144;

__device__ const float INVF[32] = {1.0f, 0.7498942613601685f, 0.5623413324356079f, 0.4216965138912201f, 0.3162277638912201f, 0.23713737726211548f, 0.17782793939113617f, 0.133352130651474f, 0.10000000149011612f, 0.07498941570520401f, 0.05623413249850273f, 0.04216965287923813f, 0.03162277489900589f, 0.023713737726211548f, 0.017782794311642647f, 0.01333521492779255f, 0.009999999776482582f, 0.007498941849917173f, 0.005623413249850273f, 0.0042169648222625256f, 0.003162277629598975f, 0.00237137358635664f, 0.0017782794311642647f, 0.0013335214462131262f, 0.0010000000474974513f, 0.0007498942431993783f, 0.000562341301701963f, 0.0004216965171508491f, 0.0003162277571391314f, 0.00023713737027719617f, 0.00017782794020604342f, 0.0001333521504420787f};

DI int opaque_tid() { int t = threadIdx.x; asm volatile("" : "+v"(t)); return t; }
DI float bf2f(bf16_t v) { return __uint_as_float((unsigned)v << 16); }
DI float bflo(unsigned w) { return __uint_as_float(w << 16); }
DI float bfhi(unsigned w) { return __uint_as_float(w & 0xffff0000u); }
DI unsigned pk2(float lo, float hi) { f32x2 v = {lo, hi}; bf16x2_t b = __builtin_convertvector(v, bf16x2_t); return __builtin_bit_cast(unsigned, b); }
DI bf16_t f2bf(float f) { return (bf16_t)(pk2(f, 0.f) & 0xffffu); }
DI float wave_sum(float v) {
#pragma unroll
    for (int o = 1; o < 64; o <<= 1) v += __shfl_xor(v, o);
    return v;
}
DI float wave_max(float v) {
#pragma unroll
    for (int o = 1; o < 64; o <<= 1) v = fmaxf(v, __shfl_xor(v, o));
    return v;
}
DI float wave_incl_scan(float v, int lane) {
#pragma unroll
    for (int o = 1; o < 64; o <<= 1) { const float n = __shfl_up(v, o); if (lane >= o) v += n; }
    return v;
}
DI float sigmoidf_(float x) { return 1.f / (1.f + __expf(-x)); }
DI float logsigmoid_(float x) { return fminf(x, 0.f) - log1pf(expf(-fabsf(x))); }
DI f32x16 mfma32(bf16x8 a, bf16x8 b, f32x16 c) { return __builtin_amdgcn_mfma_f32_32x32x16_bf16(a, b, c, 0, 0, 0); }
DI int crow(int r, int h) { return (r & 3) + 8 * (r >> 2) + 4 * h; }
DI int pi32(int m) { return (m & ~12) | ((m & 4) << 1) | ((m & 8) >> 1); }
typedef short v4i16_t __attribute__((ext_vector_type(4)));
DI s16x4 tr16(LAS const unsigned char* p) { return __builtin_bit_cast(s16x4, __builtin_amdgcn_ds_read_tr16_b64_v4i16((LAS v4i16_t*)p)); }
DI bf16x8 tr_frag(LAS const unsigned char* p, int rs) {
    const s16x4 lo = tr16(p), hi = tr16(p + 4 * rs);
    return __builtin_shufflevector(lo, hi, 0, 1, 2, 3, 4, 5, 6, 7);
}
DI bf16x8 pack8(float a0, float a1, float a2, float a3, float a4, float a5, float a6, float a7) {
    u32x4 w; w.x = pk2(a0, a1); w.y = pk2(a2, a3); w.z = pk2(a4, a5); w.w = pk2(a6, a7); return __builtin_bit_cast(bf16x8, w);
}

namespace pg8 {
constexpr int BM = 256, BK = 64, HALF = 128, HTB = HALF * BK * 2, STAGE_BYTES = 8 * HTB, NXCD = 8, WGM = 8;
DI int lds_byte(int r, int c) { const int st = (r >> 4) * 2 + (c >> 5), rr = r & 15, cc = c & 31, ob = rr * 64 + cc * 2; return st * 1024 + (ob ^ (((ob >> 9) & 1) << 5)); }
DI void stage_rc(int b, int& R, int& C) { const int st = b / 1024, sb = b % 1024, swz = sb ^ (((sb >> 9) & 1) << 5); R = (st >> 1) * 16 + swz / 64; C = (st & 1) * 32 + (swz % 64) / 2; }
DI int perm32(int rho) { const int n = rho >> 4, i = rho & 15; return 8 * (i >> 2) + 4 * n + (i & 3); }
struct Unit { int pm, pn; };
struct Gemm { const bf16_t* A; const bf16_t* Bt; int M, N, K, lda, ldb, apn; };
struct StaticOrder {
    int nM, nN, nwg, G, c;
    DI void init(int M, int N, int G_, int c_) { nM = M / BM; nN = N / BM; nwg = nM * nN; G = G_; c = c_; }
    DI bool next(int i, Unit& u) const {
        const long L = (long)i * G + c; if (L >= nwg) return false;
        int wgid = (int)L; { const int q = nwg / NXCD, r = nwg % NXCD, xcd = wgid % NXCD, off = wgid / NXCD; wgid = (xcd < r ? xcd * (q + 1) : r * (q + 1) + (xcd - r) * q) + off; }
        const int nig = WGM * nN, gid = wgid / nig, fm = gid * WGM, gsz = (nM - fm) < WGM ? (nM - fm) : WGM;
        u.pm = fm + ((wgid % nig) % gsz); u.pn = (wgid % nig) / gsz; return true;
    }
};
template <class Epi>
DI void gemm_phase(LAS unsigned char* lds, const Gemm g, const StaticOrder& S, const Epi& E) {
    const int tid = opaque_tid(), wid = __builtin_amdgcn_readfirstlane(tid >> 6), lane = tid & 63, wr = wid >> 2, wc = wid & 3, fr = lane & 15, fq = lane >> 4;
    int K = g.K; asm volatile("" : "+s"(K)); const int nt = K / BK;
    unsigned voffA[2], voffB[2];
#pragma unroll
    for (int i = 0; i < 2; ++i) { int R, C; stage_rc(tid * 16 + i * 8192, R, C); const int Rb = Epi::PERM ? ((R & ~31) + perm32(R & 31)) : R;
        voffA[i] = (unsigned)(R * g.lda + C) * 2u; voffB[i] = (unsigned)(Rb * g.ldb + C) * 2u; }
    const size_t kstep = (size_t)(BK * 2);
    const size_t hstepA = (size_t)HALF * g.lda * 2, hstepB = (size_t)HALF * g.ldb * 2;
    const unsigned ldsw = (unsigned)wid * 1024u;
    const int aoff = lds_byte(wr * 64 + fr, fq * 8), boff = lds_byte(wc * 32 + fr, fq * 8);
#define PG8_SA(b, h) (((b) * 2 + (h)) * HTB)
#define PG8_SB(b, h) ((4 + (b) * 2 + (h)) * HTB)
#define PG8_STAGE(bufoff, gbase, voff) do { _Pragma("unroll") for (int _i = 0; _i < 2; ++_i) \
        __builtin_amdgcn_global_load_lds((const unsigned*)((const char*)(gbase) + (voff)[_i]), (LAS unsigned*)(lds + (bufoff) + ldsw + _i * 8192), 16, 0, 0); } while (0)
#define PG8_LDA(dst, b, h) do { _Pragma("unroll") for (int m = 0; m < 4; ++m) _Pragma("unroll") for (int k = 0; k < 2; ++k) dst[m][k] = *(const LAS bf16x8*)(lds + PG8_SA(b, h) + aoff + m * 2048 + k * 1024); } while (0)
#define PG8_LDB(dst, b, h) do { _Pragma("unroll") for (int n = 0; n < 2; ++n) _Pragma("unroll") for (int k = 0; k < 2; ++k) dst[n][k] = *(const LAS bf16x8*)(lds + PG8_SB(b, h) + boff + n * 2048 + k * 1024); } while (0)
#define PG8_MMA(ai, bj, At, Bt) do { __builtin_amdgcn_s_setprio(1); _Pragma("unroll") for (int m = 0; m < 4; ++m) _Pragma("unroll") for (int n = 0; n < 2; ++n) _Pragma("unroll") for (int k = 0; k < 2; ++k) \
        acc[ai][bj][m][n] = __builtin_amdgcn_mfma_f32_16x16x32_bf16(Bt[n][k], At[m][k], acc[ai][bj][m][n], 0, 0, 0); __builtin_amdgcn_s_setprio(0); } while (0)
#define PG8_WAIT_V(n) asm volatile("s_waitcnt vmcnt(" #n ")" ::: "memory")
#define PG8_WAIT_L(n) asm volatile("s_waitcnt lgkmcnt(" #n ")" ::: "memory")
#define PG8_BAR __builtin_amdgcn_s_barrier()
#define PG8_SCHED __builtin_amdgcn_sched_barrier(0)
#define PG8_APTR(u) ((const char*)g.A + (size_t)(u).pm * 2 * hstepA + (size_t)(u).pn * (size_t)g.apn * 2)
#define PG8_BPTR(u) ((const char*)g.Bt + (size_t)(u).pn * 2 * hstepB)
    Unit cur, nxt; int ui = 0;
    if (!S.next(0, cur)) return;
    f32x4 acc[2][2][4][2];
#pragma unroll
    for (int a = 0; a < 2; ++a)
#pragma unroll
        for (int b = 0; b < 2; ++b)
#pragma unroll
            for (int m = 0; m < 4; ++m)
#pragma unroll
                for (int n = 0; n < 2; ++n) acc[a][b][m][n] = (f32x4){0.f, 0.f, 0.f, 0.f};
    bf16x8 At[4][2], B0[2][2], B1[2][2];
    const char* cA = PG8_APTR(cur); const char* cB = PG8_BPTR(cur);
    PG8_STAGE(PG8_SB(0, 0), cB, voffB); PG8_STAGE(PG8_SB(0, 1), cB + hstepB, voffB); PG8_STAGE(PG8_SA(0, 0), cA, voffA); PG8_STAGE(PG8_SA(0, 1), cA + hstepA, voffA);
    if (wr == 1) PG8_BAR;
    PG8_WAIT_V(2); PG8_BAR;
    PG8_STAGE(PG8_SB(1, 0), cB + kstep, voffB); PG8_STAGE(PG8_SA(1, 0), cA + kstep, voffA); PG8_STAGE(PG8_SB(1, 1), cB + hstepB + kstep, voffB);
    PG8_WAIT_V(6); PG8_BAR;
    for (;;) {
        const bool has_next = S.next(ui + 1, nxt);
        const char* nA = has_next ? PG8_APTR(nxt) : cA; const char* nB = has_next ? PG8_BPTR(nxt) : cB;
        for (int t = 0; t < nt; t += 2) {
            const bool last = (t == nt - 2);
            const char* a1 = cA + (size_t)(t + 1) * kstep;
            const char* a2 = last ? nA : cA + (size_t)(t + 2) * kstep; const char* b2 = last ? nB : cB + (size_t)(t + 2) * kstep;
            const char* a3 = a2 + kstep; const char* b3 = b2 + kstep;
            PG8_LDB(B0, 0, 0); PG8_LDB(B1, 0, 1); PG8_SCHED; PG8_LDA(At, 0, 0); PG8_STAGE(PG8_SA(1, 1), a1 + hstepA, voffA);
            PG8_WAIT_V(8); PG8_WAIT_L(0); PG8_BAR; PG8_MMA(0, 0, At, B0); PG8_MMA(0, 1, At, B1); PG8_BAR; PG8_SCHED;
            PG8_LDA(At, 0, 1); PG8_STAGE(PG8_SB(0, 0), b2, voffB); PG8_STAGE(PG8_SB(0, 1), b2 + hstepB, voffB); PG8_STAGE(PG8_SA(0, 0), a2, voffA);
            PG8_WAIT_V(8); PG8_WAIT_L(0); PG8_BAR; PG8_MMA(1, 0, At, B0); PG8_MMA(1, 1, At, B1); PG8_BAR; PG8_SCHED;
            PG8_LDB(B0, 1, 0); PG8_LDB(B1, 1, 1); PG8_SCHED; PG8_LDA(At, 1, 0); PG8_STAGE(PG8_SA(0, 1), a2 + hstepA, voffA);
            PG8_WAIT_V(8); PG8_WAIT_L(0); PG8_BAR; PG8_MMA(0, 0, At, B0); PG8_MMA(0, 1, At, B1); PG8_BAR; PG8_SCHED;
            PG8_LDA(At, 1, 1); PG8_STAGE(PG8_SB(1, 0), b3, voffB); PG8_STAGE(PG8_SB(1, 1), b3 + hstepB, voffB); PG8_STAGE(PG8_SA(1, 0), a3, voffA);
            PG8_WAIT_V(8); PG8_WAIT_L(0); PG8_BAR; PG8_MMA(1, 0, At, B0); PG8_MMA(1, 1, At, B1); PG8_BAR; PG8_SCHED;
        }
        if (wr == 0) PG8_BAR;
        E(acc, cur, wr, wc, fr, fq);
        if (!has_next) break;
#pragma unroll
        for (int a = 0; a < 2; ++a)
#pragma unroll
            for (int b = 0; b < 2; ++b)
#pragma unroll
                for (int m = 0; m < 4; ++m)
#pragma unroll
                    for (int n = 0; n < 2; ++n) acc[a][b][m][n] = (f32x4){0.f, 0.f, 0.f, 0.f};
        cur = nxt; cA = nA; cB = nB; ++ui;
        if (wr == 1) PG8_BAR;
    }
    PG8_WAIT_V(0);
    PG8_BAR;
#undef PG8_SA
#undef PG8_SB
#undef PG8_STAGE
#undef PG8_LDA
#undef PG8_LDB
#undef PG8_MMA
#undef PG8_WAIT_V
#undef PG8_WAIT_L
#undef PG8_BAR
#undef PG8_SCHED
#undef PG8_APTR
#undef PG8_BPTR
}

typedef f32x4 Acc[2][2][4][2];
struct EpiStore {
    static constexpr bool PERM = true;
    bf16_t* O; int ldc;
    DI void operator()(const Acc& acc, const Unit& u, int wr, int wc, int fr, int fq) const {
        const int row0 = u.pm * BM + wr * 64 + fr, col0 = u.pn * BM + wc * 32 + 8 * fq;
#pragma unroll
        for (int ai = 0; ai < 2; ++ai)
#pragma unroll
            for (int m = 0; m < 4; ++m) { bf16_t* rowp = O + (size_t)(row0 + ai * HALF + m * 16) * ldc + col0;
#pragma unroll
                for (int bj = 0; bj < 2; ++bj) { const f32x4 v0 = acc[ai][bj][m][0], v1 = acc[ai][bj][m][1];
                    u32x4 w; w.x = pk2(v0[0], v0[1]); w.y = pk2(v0[2], v0[3]); w.z = pk2(v1[0], v1[1]); w.w = pk2(v1[2], v1[3]);
                    *(u32x4*)(rowp + bj * HALF) = w; } }
    }
};
struct EpiSwiglu {
    static constexpr bool PERM = true;
    bf16_t* H;
    DI void operator()(const Acc& acc, const Unit& u, int wr, int wc, int fr, int fq) const {
        const int row0 = u.pm * BM + wr * 64 + fr, col0 = u.pn * HALF + wc * 32 + 8 * fq;
#pragma unroll
        for (int ai = 0; ai < 2; ++ai)
#pragma unroll
            for (int m = 0; m < 4; ++m) { bf16_t* rowp = H + (size_t)(row0 + ai * HALF + m * 16) * FF + col0;
                float o[8];
#pragma unroll
                for (int n = 0; n < 2; ++n)
#pragma unroll
                    for (int j = 0; j < 4; ++j) { const float gt = acc[ai][0][m][n][j], up = acc[ai][1][m][n][j]; o[n * 4 + j] = gt * sigmoidf_(gt) * up; }
                u32x4 w; w.x = pk2(o[0], o[1]); w.y = pk2(o[2], o[3]); w.z = pk2(o[4], o[5]); w.w = pk2(o[6], o[7]);
                *(u32x4*)rowp = w; }
    }
};
struct EpiRes {
    static constexpr bool PERM = false;
    const float* xin; float* xout; float alpha;
    DI void operator()(const Acc& acc, const Unit& u, int wr, int wc, int fr, int fq) const {
        const int col0 = u.pn * BM + wc * 32 + 4 * fq;
#pragma unroll
        for (int ai = 0; ai < 2; ++ai)
#pragma unroll
            for (int m = 0; m < 4; ++m) { const size_t off = (size_t)(u.pm * BM + ai * HALF + wr * 64 + m * 16 + fr) * DM + col0;
#pragma unroll
                for (int bj = 0; bj < 2; ++bj)
#pragma unroll
                    for (int n = 0; n < 2; ++n) { const f32x4 b = *(const f32x4*)(xin + off + bj * HALF + n * 16); *(f32x4*)(xout + off + bj * HALF + n * 16) = b + acc[ai][bj][m][n] * alpha; } }
    }
};
struct EpiQ {
    static constexpr bool PERM = true;
    bf16_t* Q; const f32x2* tab;
    DI void operator()(const Acc& acc, const Unit& u, int wr, int wc, int fr, int fq) const {
        const int row0 = u.pm * BM + wr * 64 + fr;
#pragma unroll
        for (int bj = 0; bj < 2; ++bj) {
            const int c0 = u.pn * BM + bj * HALF + wc * 32 + 8 * fq; const int hh = c0 / 192, dd = c0 - hh * 192; const bool rope = dd >= 128; const int j0 = (dd - 128) >> 1;
#pragma unroll
            for (int ai = 0; ai < 2; ++ai)
#pragma unroll
                for (int m = 0; m < 4; ++m) { const int row = row0 + ai * HALF + m * 16;
                    float v[8];
#pragma unroll
                    for (int n = 0; n < 2; ++n)
#pragma unroll
                        for (int j = 0; j < 4; ++j) v[n * 4 + j] = acc[ai][bj][m][n][j];
                    if (rope) {
#pragma unroll
                        for (int p = 0; p < 4; ++p) { const f32x2 cs = tab[(size_t)row * 32 + j0 + p]; const float x1 = v[2 * p], x2 = v[2 * p + 1]; v[2 * p] = x1 * cs.x - x2 * cs.y; v[2 * p + 1] = x1 * cs.y + x2 * cs.x; }
                    }
                    u32x4 w; w.x = pk2(v[0] * AQS, v[1] * AQS); w.y = pk2(v[2] * AQS, v[3] * AQS); w.z = pk2(v[4] * AQS, v[5] * AQS); w.w = pk2(v[6] * AQS, v[7] * AQS);
                    *(u32x4*)(Q + (size_t)row * 1536 + c0) = w; }
        }
    }
};
struct EpiLru {
    static constexpr bool PERM = true;
    bf16_t* XC; bf16_t* LA; const float* ba; const float* bx; const float* sp;
    DI void operator()(const Acc& acc, const Unit& u, int wr, int wc, int fr, int fq) const {
        const int row0 = u.pm * BM + wr * 64 + fr, ch0 = u.pn * HALF + wc * 32 + 8 * fq;
#pragma unroll
        for (int ai = 0; ai < 2; ++ai)
#pragma unroll
            for (int m = 0; m < 4; ++m) { const int row = row0 + ai * HALF + m * 16;
                const u32x4 xw = *(const u32x4*)(XC + (size_t)row * 1024 + ch0);
                const float xv[8] = {bflo(xw.x), bfhi(xw.x), bflo(xw.y), bfhi(xw.y), bflo(xw.z), bfhi(xw.z), bflo(xw.w), bfhi(xw.w)};
                u32x4 wl, wu;
#pragma unroll
                for (int n = 0; n < 2; ++n) { const f32x4 spv = *(const f32x4*)(sp + ch0 + 4 * n), bav = *(const f32x4*)(ba + ch0 + 4 * n), bxv = *(const f32x4*)(bx + ch0 + 4 * n);
                    float la[4], uu[4];
#pragma unroll
                    for (int j = 0; j < 4; ++j) { const float r = sigmoidf_(acc[ai][0][m][n][j] + bav[j]), gi = sigmoidf_(acc[ai][1][m][n][j] + bxv[j]);
                        const float l = r * spv[j]; la[j] = l; const float a2 = __expf(2.f * l); uu[j] = sqrtf(fmaxf(1.f - a2, 0.f)) * gi * xv[n * 4 + j]; }
                    if (n == 0) { wl.x = pk2(la[0], la[1]); wl.y = pk2(la[2], la[3]); wu.x = pk2(uu[0], uu[1]); wu.y = pk2(uu[2], uu[3]); }
                    else { wl.z = pk2(la[0], la[1]); wl.w = pk2(la[2], la[3]); wu.z = pk2(uu[0], uu[1]); wu.w = pk2(uu[2], uu[3]); } }
                *(u32x4*)(LA + (size_t)row * NP + ch0) = wl;
                *(u32x4*)(XC + (size_t)row * 1024 + ch0) = wu;
                asm volatile("" ::: "memory"); }
    }
};
struct EpiMerge {
    static constexpr bool PERM = true;
    bf16_t* Z; const bf16_t* G; int first;
    DI void operator()(const Acc& acc, const Unit& u, int wr, int wc, int fr, int fq) const {
        const int row0 = u.pm * BM + wr * 64 + fr, col0 = u.pn * BM + wc * 32 + 8 * fq;
#pragma unroll
        for (int ai = 0; ai < 2; ++ai)
#pragma unroll
            for (int m = 0; m < 4; ++m) { const int row = row0 + ai * HALF + m * 16;
#pragma unroll
                for (int bj = 0; bj < 2; ++bj) { const int c = col0 + bj * HALF;
                    const u32x4 gw = *(const u32x4*)(G + (size_t)row * NP + c);
                    const float gv[8] = {bflo(gw.x), bfhi(gw.x), bflo(gw.y), bfhi(gw.y), bflo(gw.z), bfhi(gw.z), bflo(gw.w), bfhi(gw.w)};
                    float o[8];
#pragma unroll
                    for (int n = 0; n < 2; ++n)
#pragma unroll
                        for (int j = 0; j < 4; ++j) o[n * 4 + j] = sigmoidf_(gv[n * 4 + j]) * acc[ai][bj][m][n][j];
                    bf16_t* zp = Z + (size_t)row * DM + c;
                    if (!first) { const u32x4 zw = *(const u32x4*)zp; o[0] += bflo(zw.x); o[1] += bfhi(zw.x); o[2] += bflo(zw.y); o[3] += bfhi(zw.y); o[4] += bflo(zw.z); o[5] += bfhi(zw.z); o[6] += bflo(zw.w); o[7] += bfhi(zw.w); }
                    u32x4 w; w.x = pk2(o[0], o[1]); w.y = pk2(o[2], o[3]); w.z = pk2(o[4], o[5]); w.w = pk2(o[6], o[7]);
                    *(u32x4*)zp = w; } }
    }
};
}

DI int map_row(int map, int n) {
    switch (map) {
        case 1: return ((n >> 7) << 8) + (n & 127);
        case 2: return ((n >> 7) << 8) + 128 + (n & 127);
        case 3: { if (n < 2048) return n; if (n < 2052) return PC_I + n - 2048; if (n < 2056) return PC_F + n - 2052; if (n < 3080) return PC_O + n - 2056; if (n < 3464) return PC_CQ + n - 3080;
                  if (n < 3720) return PC_CKV + n - 3464; if (n < 3784) return PC_KR + n - 3720; if (n < 4808) return PC_CX + n - 3784; return PC_G + n - 4808; }
        case 4: { const int hh = n / 192, dd = n - hh * 192; if (dd < 128) return n; const int jj = dd - 128; return hh * 192 + 128 + (jj < 32 ? 2 * jj : 2 * (jj - 32) + 1); }
        case 5: { const int hh = n >> 8, dd = n & 255; return dd < 128 ? hh * 128 + dd : 1024 + hh * 128 + dd - 128; }
        default: return n;
    }
}
DI void convert_mat(const float* W, int K, int N, bf16_t* WT, int map, int& rot) {
    const int tid_ = opaque_tid(), lane = tid_ & 63, gw = blockIdx.x * 8 + (tid_ >> 6), ngw = gridDim.x * 8, r = lane >> 3, c = lane & 7;
    const int nnb = (N + 31) >> 5, nkb = K >> 6, nitems = nnb * nkb;
    int it = gw - rot; if (it < 0) it += ngw;
#pragma unroll 2
    for (; it < nitems; it += ngw) {
        const int nb = it / nkb, kb = it - nb * nkb, n0 = nb * 32 + 4 * c, k0 = kb * 64 + 8 * r;
        if (n0 < N) {
            const float* src = W + (size_t)k0 * N + n0;
            f32x4 v[8];
#pragma unroll
            for (int i = 0; i < 8; ++i) v[i] = *(const f32x4*)(src + (size_t)i * N);
            u32x4 o;
            o.x = pk2(v[0].x, v[1].x); o.y = pk2(v[2].x, v[3].x); o.z = pk2(v[4].x, v[5].x); o.w = pk2(v[6].x, v[7].x); *(u32x4*)(WT + (size_t)map_row(map, n0) * K + k0) = o;
            o.x = pk2(v[0].y, v[1].y); o.y = pk2(v[2].y, v[3].y); o.z = pk2(v[4].y, v[5].y); o.w = pk2(v[6].y, v[7].y); *(u32x4*)(WT + (size_t)map_row(map, n0 + 1) * K + k0) = o;
            o.x = pk2(v[0].z, v[1].z); o.y = pk2(v[2].z, v[3].z); o.z = pk2(v[4].z, v[5].z); o.w = pk2(v[6].z, v[7].z); *(u32x4*)(WT + (size_t)map_row(map, n0 + 2) * K + k0) = o;
            o.x = pk2(v[0].w, v[1].w); o.y = pk2(v[2].w, v[3].w); o.z = pk2(v[4].w, v[5].w); o.w = pk2(v[6].w, v[7].w); *(u32x4*)(WT + (size_t)map_row(map, n0 + 3) * K + k0) = o;
        }
    }
    rot = (rot + nitems) % ngw;
}

DI void rmsnorm_rows(const float* X, const float* g, bf16_t* O) {
    const int tid_ = opaque_tid(), lane = tid_ & 63, gw = blockIdx.x * 8 + (tid_ >> 6), ngw = gridDim.x * 8;
    for (int r = gw; r < S; r += ngw) {
        const f32x4* xr = (const f32x4*)(X + (size_t)r * DM) + lane; f32x4 v[8]; float s = 0.f;
#pragma unroll
        for (int j = 0; j < 8; ++j) { v[j] = xr[64 * j]; s += (v[j].x * v[j].x + v[j].y * v[j].y) + (v[j].z * v[j].z + v[j].w * v[j].w); }
        const float rstd = 1.f / sqrtf(wave_sum(s) * (1.f / DM) + EPS);
        u32x2* o8 = (u32x2*)(O + (size_t)r * DM) + lane;
#pragma unroll
        for (int j = 0; j < 8; ++j) { const f32x4 gv = ((const f32x4*)g)[lane + 64 * j]; u32x2 w; w.x = pk2(v[j].x * rstd * gv.x, v[j].y * rstd * gv.y); w.y = pk2(v[j].z * rstd * gv.z, v[j].w * rstd * gv.w); o8[64 * j] = w; }
    }
}
DI void final_norm_rows(float* X, const float* g) {
    const int tid_ = opaque_tid(), lane = tid_ & 63, gw = blockIdx.x * 8 + (tid_ >> 6), ngw = gridDim.x * 8;
    for (int r = gw; r < S; r += ngw) {
        f32x4* xr = (f32x4*)(X + (size_t)r * DM) + lane; f32x4 v[8]; float s = 0.f;
#pragma unroll
        for (int j = 0; j < 8; ++j) { v[j] = xr[64 * j]; s += (v[j].x * v[j].x + v[j].y * v[j].y) + (v[j].z * v[j].z + v[j].w * v[j].w); }
        const float rstd = 1.f / sqrtf(wave_sum(s) * (1.f / DM) + EPS);
#pragma unroll
        for (int j = 0; j < 8; ++j) { const f32x4 gv = ((const f32x4*)g)[lane + 64 * j]; xr[64 * j] = v[j] * rstd * gv; }
    }
}
DI void prep_rows(bf16_t* P, const float* qn, const float* kvn, const float* cw, const float* cb, const f32x2* tab, bf16_t* XC) {
    const int tid_ = opaque_tid(), lane = tid_ & 63, gw = blockIdx.x * 8 + (tid_ >> 6), ngw = gridDim.x * 8;
    for (int t = gw; t < S; t += ngw) {
        bf16_t* row = P + (size_t)t * NP;
        unsigned wq[3], wk[2], wc[8][4];
#pragma unroll
        for (int k = 0; k < 3; ++k) wq[k] = *(const unsigned*)(row + PC_CQ + 128 * k + 2 * lane);
#pragma unroll
        for (int k = 0; k < 2; ++k) wk[k] = *(const unsigned*)(row + PC_CKV + 128 * k + 2 * lane);
        const int j = lane & 31; const float x1 = bf2f(row[PC_KR + j]), x2 = bf2f(row[PC_KR + 32 + j]); const f32x2 cs = tab[(size_t)t * 32 + j];
#pragma unroll
        for (int k = 0; k < 8; ++k)
#pragma unroll
            for (int jj = 0; jj < 4; ++jj) { const int tt = t - 3 + jj; wc[k][jj] = tt >= 0 ? *(const unsigned*)(P + (size_t)tt * NP + PC_CX + 128 * k + 2 * lane) : 0u; }
        asm volatile("" ::: "memory");
        { float s = 0.f;
#pragma unroll
          for (int k = 0; k < 3; ++k) { const float a = bflo(wq[k]), b = bfhi(wq[k]); s += a * a + b * b; }
          const float rstd = 1.f / sqrtf(wave_sum(s) * (1.f / 384.f) + EPS);
#pragma unroll
          for (int k = 0; k < 3; ++k) { const int c = 128 * k + 2 * lane; *(unsigned*)(row + PC_CQ + c) = pk2(bflo(wq[k]) * rstd * qn[c], bfhi(wq[k]) * rstd * qn[c + 1]); } }
        { float s = 0.f;
#pragma unroll
          for (int k = 0; k < 2; ++k) { const float a = bflo(wk[k]), b = bfhi(wk[k]); s += a * a + b * b; }
          const float rstd = 1.f / sqrtf(wave_sum(s) * (1.f / 256.f) + EPS);
#pragma unroll
          for (int k = 0; k < 2; ++k) { const int c = 128 * k + 2 * lane; *(unsigned*)(row + PC_CKV + c) = pk2(bflo(wk[k]) * rstd * kvn[c], bfhi(wk[k]) * rstd * kvn[c + 1]); } }
        { const unsigned o = pk2(x1 * cs.x - x2 * cs.y, x1 * cs.y + x2 * cs.x); if (lane < 32) *(unsigned*)(row + PC_KR + 2 * j) = o; }
#pragma unroll
        for (int k = 0; k < 8; ++k) { const int ch = 128 * k + 2 * lane; float a0 = cb[ch], a1 = cb[ch + 1];
#pragma unroll
            for (int jj = 0; jj < 4; ++jj) { a0 += cw[jj * 1024 + ch] * bflo(wc[k][jj]); a1 += cw[jj * 1024 + ch + 1] * bfhi(wc[k][jj]); }
            *(unsigned*)(XC + (size_t)t * 1024 + ch) = pk2(a0, a1); }
    }
}

DI void lru_p1(const bf16_t* LA, const bf16_t* U, float* CA, float* CH) {
    const int tid = opaque_tid();
    for (int c = blockIdx.x; c < 256; c += gridDim.x) {
        float h0 = 0.f, h1 = 0.f, s0 = 0.f, s1 = 0.f;
#pragma unroll 1
        for (int t0 = 0; t0 < 64; t0 += 16) {
            unsigned lw[16], uw[16];
#pragma unroll
            for (int i = 0; i < 16; ++i) { const size_t row = (size_t)c * 64 + t0 + i; lw[i] = *(const unsigned*)(LA + row * NP + 2 * tid); uw[i] = *(const unsigned*)(U + row * 1024 + 2 * tid); }
#pragma unroll
            for (int i = 0; i < 16; ++i) { const float l0 = bflo(lw[i]), l1 = bfhi(lw[i]); s0 += l0; s1 += l1; h0 = __expf(l0) * h0 + bflo(uw[i]); h1 = __expf(l1) * h1 + bfhi(uw[i]); }
        }
        CA[c * 1024 + 2 * tid] = __expf(s0); CA[c * 1024 + 2 * tid + 1] = __expf(s1); CH[c * 1024 + 2 * tid] = h0; CH[c * 1024 + 2 * tid + 1] = h1;
    }
}
DI void lru_p2(const float* CA, const float* CH, float* CARRY) {
    const int tid = opaque_tid(), lane = tid & 63, gw = blockIdx.x * 8 + (tid >> 6), ngw = gridDim.x * 8;
    for (int ch = gw; ch < 1024; ch += ngw) {
        float a[4], hh[4];
#pragma unroll
        for (int i = 0; i < 4; ++i) { a[i] = CA[(4 * lane + i) * 1024 + ch]; hh[i] = CH[(4 * lane + i) * 1024 + ch]; }
        float A = a[0], H = hh[0];
#pragma unroll
        for (int i = 1; i < 4; ++i) { H = a[i] * H + hh[i]; A = A * a[i]; }
#pragma unroll
        for (int o = 1; o < 64; o <<= 1) { const float Ap = __shfl_up(A, o), Hp = __shfl_up(H, o); if (lane >= o) { H = A * Hp + H; A = A * Ap; } }
        float st = __shfl_up(H, 1); if (lane == 0) st = 0.f;
#pragma unroll
        for (int i = 0; i < 4; ++i) { CARRY[(4 * lane + i) * 1024 + ch] = st; st = a[i] * st + hh[i]; }
    }
}
DI void lru_p3(const bf16_t* LA, const bf16_t* U, const float* CARRY, bf16_t* Y) {
    const int tid = opaque_tid();
    for (int c = blockIdx.x; c < 256; c += gridDim.x) {
        float h0 = CARRY[c * 1024 + 2 * tid], h1 = CARRY[c * 1024 + 2 * tid + 1];
#pragma unroll 1
        for (int t0 = 0; t0 < 64; t0 += 16) {
            unsigned lw[16], uw[16];
#pragma unroll
            for (int i = 0; i < 16; ++i) { const size_t row = (size_t)c * 64 + t0 + i; lw[i] = *(const unsigned*)(LA + row * NP + 2 * tid); uw[i] = *(const unsigned*)(U + row * 1024 + 2 * tid); }
            asm volatile("" ::: "memory");
#pragma unroll
            for (int i = 0; i < 16; ++i) { const size_t row = (size_t)c * 64 + t0 + i; h0 = __expf(bflo(lw[i])) * h0 + bflo(uw[i]); h1 = __expf(bfhi(lw[i])) * h1 + bfhi(uw[i]);
                *(unsigned*)(Y + row * 3072 + 2048 + 2 * tid) = pk2(h0, h1); }
            asm volatile("" ::: "memory");
        }
    }
}

DI void mlstm_a(LAS unsigned char* smem, const bf16_t* P, const float* gbias, bf16_t* CS, float* SMALL) {
    const int tid = opaque_tid(), lane = tid & 63, wid = tid >> 6, l31 = lane & 31, h = lane >> 5, q4 = (lane & 15) >> 2, p4 = lane & 3, blk = (lane >> 4) & 1;
    LAS float* sw = (LAS float*)smem;
    LAS unsigned char* Ks = smem + 1024;
    LAS unsigned char* Vs = smem + 1024 + 20480;
    for (int uid = blockIdx.x; uid < 1024; uid += gridDim.x) {
        const int c = uid >> 2, hh = uid & 3; const size_t row0 = (size_t)c * 64;
        if (wid == 0) {
            const bf16_t* r = P + (row0 + lane) * NP;
            const float li = bf2f(r[PC_I + hh]) + gbias[hh], lf = logsigmoid_(bf2f(r[PC_F + hh]) + gbias[4 + hh]);
            const float bc = wave_incl_scan(lf, lane), bt = __shfl(bc, 63), ds = bt - bc + li, M = wave_max(ds);
            sw[lane] = expf(ds - M);
            if (lane == 0) { SMALL[SM_BT + uid] = bt; SMALL[SM_MC + uid] = M; }
        }
        __syncthreads();
#pragma unroll
        for (int i = 0; i < 2; ++i) { const int id = tid + 512 * i, s = id >> 4, d8 = (id & 15) * 8; const u32x4 v = *(const u32x4*)(P + (row0 + s) * NP + PC_K + hh * 128 + d8); const float w = sw[s];
            u32x4 o; o.x = pk2(bflo(v.x) * w, bfhi(v.x) * w); o.y = pk2(bflo(v.y) * w, bfhi(v.y) * w); o.z = pk2(bflo(v.z) * w, bfhi(v.z) * w); o.w = pk2(bflo(v.w) * w, bfhi(v.w) * w);
            *(LAS u32x4*)(Ks + s * 320 + d8 * 2) = o; }
#pragma unroll
        for (int i = 0; i < 4; ++i) { const int id = tid + 512 * i, s = id >> 5, d8 = (id & 31) * 8; *(LAS u32x4*)(Vs + s * 576 + d8 * 2) = *(const u32x4*)(P + (row0 + s) * NP + PC_V + hh * 256 + d8); }
        __syncthreads();
        f32x16 acc[4];
#pragma unroll
        for (int d = 0; d < 4; ++d)
#pragma unroll
            for (int i = 0; i < 16; ++i) acc[d][i] = 0.f;
#pragma unroll
        for (int kk = 0; kk < 4; ++kk) {
            const bf16x8 vf = tr_frag(Vs + (16 * kk + 8 * h + q4) * 576 + (32 * wid + 16 * blk) * 2 + 8 * p4, 576);
#pragma unroll
            for (int d = 0; d < 4; ++d) { const bf16x8 kf = tr_frag(Ks + (16 * kk + 8 * h + q4) * 320 + (32 * d + 16 * blk) * 2 + 8 * p4, 320); acc[d] = mfma32(kf, vf, acc[d]); }
        }
        bf16_t* cs = CS + (size_t)uid * 32768 + (32 * wid + l31) * 128;
#pragma unroll
        for (int d = 0; d < 4; ++d)
#pragma unroll
            for (int g = 0; g < 4; ++g) { u32x2 w; w.x = pk2(acc[d][4 * g], acc[d][4 * g + 1]); w.y = pk2(acc[d][4 * g + 2], acc[d][4 * g + 3]); *(u32x2*)(cs + 32 * d + 8 * g + 4 * h) = w; }
        if (tid < 128) { float s = 0.f;
#pragma unroll 8
            for (int t = 0; t < 64; ++t) s += bf2f(*(LAS const bf16_t*)(Ks + t * 320 + tid * 2));
            SMALL[SM_DN + uid * 128 + tid] = s; }
        __syncthreads();
    }
}
DI void mlstm_b(LAS unsigned char* smem, bf16_t* CS, float* SMALL) {
    const int tid = opaque_tid();
    LAS float* dec = (LAS float*)smem; LAS float* inj = dec + 1024;
    LAS float* sbt = inj + 1024; LAS float* smc = sbt + 1024;
    sbt[tid] = SMALL[SM_BT + tid]; sbt[tid + 512] = SMALL[SM_BT + tid + 512]; smc[tid] = SMALL[SM_MC + tid]; smc[tid + 512] = SMALL[SM_MC + tid + 512];
    __syncthreads();
    if (tid < 4) { float m = -1e30f;
        for (int c = 0; c < 256; ++c) { const float bt = sbt[c * 4 + tid], M = smc[c * 4 + tid]; sbt[c * 4 + tid] = m;
            const float mn = fmaxf(bt + m, M); dec[tid * 256 + c] = __expf(bt + m - mn); inj[tid * 256 + c] = __expf(M - mn); m = mn; } }
    __syncthreads();
    if (blockIdx.x == 0) { SMALL[SM_MPREV + tid] = sbt[tid]; SMALL[SM_MPREV + tid + 512] = sbt[tid + 512]; }
    for (int e = blockIdx.x * 512 + tid; e < 131072; e += gridDim.x * 512) {
        const int hh = e >> 15, idx = e & 32767; bf16_t* pp = CS + (size_t)hh * 32768 + idx; float st = 0.f;
        bf16_t d[32];
#pragma unroll
        for (int i = 0; i < 32; ++i) d[i] = pp[(size_t)i * 131072];
#pragma unroll 1
        for (int c0 = 0; c0 < 256; c0 += 32) {
            bf16_t dn[32];
            const int cn = c0 + 32 < 256 ? c0 + 32 : c0;
#pragma unroll
            for (int i = 0; i < 32; ++i) dn[i] = pp[(size_t)(cn + i) * 131072];
            asm volatile("" ::: "memory");
#pragma unroll
            for (int i = 0; i < 32; ++i) { pp[(size_t)(c0 + i) * 131072] = f2bf(st); st = dec[hh * 256 + c0 + i] * st + inj[hh * 256 + c0 + i] * bf2f(d[i]); }
            asm volatile("" ::: "memory");
#pragma unroll
            for (int i = 0; i < 32; ++i) d[i] = dn[i];
        }
    }
    if (blockIdx.x == gridDim.x - 1) { const int hh = tid >> 7; float* pp = SMALL + SM_DN + tid; float st = 0.f;
#pragma unroll 1
        for (int c0 = 0; c0 < 256; c0 += 32) {
            float d[32];
#pragma unroll
            for (int i = 0; i < 32; ++i) d[i] = pp[(c0 + i) * 512];
            asm volatile("" ::: "memory");
#pragma unroll
            for (int i = 0; i < 32; ++i) { pp[(c0 + i) * 512] = st; st = dec[hh * 256 + c0 + i] * st + inj[hh * 256 + c0 + i] * d[i]; }
            asm volatile("" ::: "memory");
        } }
    __syncthreads();
}
DI void mlstm_c(LAS unsigned char* smem, const bf16_t* P, const float* gbias, const float* onorm, const bf16_t* CS, const float* SMALL, bf16_t* Y) {
    const int tid = opaque_tid(), lane = tid & 63, wid = tid >> 6, l31 = lane & 31, h = lane >> 5, q4 = (lane & 15) >> 2, p4 = lane & 3, blk = (lane >> 4) & 1;
    LAS float* sbc = (LAS float*)smem; LAS float* sav = sbc + 64; LAS float* snp = sbc + 128; LAS float* sx = sbc + 256;
    LAS unsigned char* Qs = smem + 2048;
    LAS unsigned char* Ks = Qs + 17408;
    LAS unsigned char* Vs = Ks + 17408;
    const int tb = wid & 1, dvq = wid >> 1, t = 32 * tb + l31, pr = pi32(l31);
    for (int uid = blockIdx.x; uid < 1024; uid += gridDim.x) {
        const int c = uid >> 2, hh = uid & 3; const size_t row0 = (size_t)c * 64;
        if (wid == 0) {
            const bf16_t* r = P + (row0 + lane) * NP;
            const float li = bf2f(r[PC_I + hh]) + gbias[hh], lf = logsigmoid_(bf2f(r[PC_F + hh]) + gbias[4 + hh]);
            const float bc = wave_incl_scan(lf, lane);
            sbc[lane] = bc; sav[lane] = li - bc;
        }
        if (tid >= 64 && tid < 192) snp[tid - 64] = SMALL[SM_DN + uid * 128 + tid - 64];
#pragma unroll
        for (int i = 0; i < 2; ++i) { const int id = tid + 512 * i, s = id >> 4, d8 = (id & 15) * 8;
            *(LAS u32x4*)(Qs + s * 272 + d8 * 2) = *(const u32x4*)(P + (row0 + s) * NP + PC_Q + hh * 128 + d8);
            *(LAS u32x4*)(Ks + s * 272 + d8 * 2) = *(const u32x4*)(P + (row0 + s) * NP + PC_K + hh * 128 + d8); }
#pragma unroll
        for (int i = 0; i < 4; ++i) { const int id = tid + 512 * i, s = id >> 5, d8 = (id & 31) * 8; *(LAS u32x4*)(Vs + s * 576 + d8 * 2) = *(const u32x4*)(P + (row0 + s) * NP + PC_V + hh * 256 + d8); }
        __syncthreads();
        const float mprev = SMALL[SM_MPREV + uid];
        bf16x8 qf[8];
#pragma unroll
        for (int ks = 0; ks < 8; ++ks) qf[ks] = *(const LAS bf16x8*)(Qs + t * 272 + (16 * ks + 8 * h) * 2);
        f32x16 st0, st1;
#pragma unroll
        for (int i = 0; i < 16; ++i) { st0[i] = 0.f; st1[i] = 0.f; }
#pragma unroll
        for (int ks = 0; ks < 8; ++ks) { const bf16x8 a0 = *(const LAS bf16x8*)(Ks + pr * 272 + (16 * ks + 8 * h) * 2); st0 = mfma32(a0, qf[ks], st0);
            if (tb) { const bf16x8 a1 = *(const LAS bf16x8*)(Ks + (32 + pr) * 272 + (16 * ks + 8 * h) * 2); st1 = mfma32(a1, qf[ks], st1); } }
        const float bt = sbc[t];
        float mx = -1e30f;
#pragma unroll
        for (int i = 0; i < 16; ++i) { const int s = 16 * (i >> 3) + 8 * h + (i & 7); if (s <= t) mx = fmaxf(mx, sav[s]); if (tb) mx = fmaxf(mx, (s + 32 <= t) ? sav[s + 32] : -1e30f); }
        mx = fmaxf(mx, __shfl_xor(mx, 32));
        const float mt = bt + fmaxf(mprev, mx);
        float den = 0.f;
#pragma unroll
        for (int i = 0; i < 16; ++i) { const int s = 16 * (i >> 3) + 8 * h + (i & 7);
            const float w0 = (s <= t) ? expf(bt + sav[s] - mt) * MQS : 0.f; st0[i] *= w0; den += st0[i];
            const float w1 = (tb && (s + 32 <= t)) ? expf(bt + sav[s + 32] - mt) * MQS : 0.f; st1[i] *= w1; den += st1[i]; }
        den += __shfl_xor(den, 32);
        float qn = 0.f;
#pragma unroll
        for (int ks = 0; ks < 8; ++ks)
#pragma unroll
            for (int j = 0; j < 8; ++j) qn += bf2f((bf16_t)qf[ks][j]) * snp[16 * ks + 8 * h + j];
        qn += __shfl_xor(qn, 32);
        const float wi = expf(bt + mprev - mt) * MQS;
        den += wi * qn;
        const float dinv = 1.f / fmaxf(fabsf(den), expf(-mt));
        bf16x8 pf[4];
        pf[0] = pack8(st0[0], st0[1], st0[2], st0[3], st0[4], st0[5], st0[6], st0[7]); pf[1] = pack8(st0[8], st0[9], st0[10], st0[11], st0[12], st0[13], st0[14], st0[15]);
        pf[2] = pack8(st1[0], st1[1], st1[2], st1[3], st1[4], st1[5], st1[6], st1[7]); pf[3] = pack8(st1[8], st1[9], st1[10], st1[11], st1[12], st1[13], st1[14], st1[15]);
        float hv[2][16]; float ss = 0.f;
#pragma unroll
        for (int db = 0; db < 2; ++db) { const int dvb = 2 * dvq + db;
            f32x16 a1, a2;
#pragma unroll
            for (int i = 0; i < 16; ++i) { a1[i] = 0.f; a2[i] = 0.f; }
#pragma unroll
            for (int sb = 0; sb < 2; ++sb)
#pragma unroll
                for (int kk = 0; kk < 2; ++kk) { if (sb <= tb) { const bf16x8 vf = tr_frag(Vs + (32 * sb + 16 * kk + 8 * h + q4) * 576 + (32 * dvb + 16 * blk) * 2 + 8 * p4, 576); a1 = mfma32(vf, pf[2 * sb + kk], a1); } }
            const bf16_t* cp = CS + (size_t)uid * 32768 + (32 * dvb + l31) * 128 + 8 * h;
#pragma unroll
            for (int ks = 0; ks < 8; ++ks) { const bf16x8 cf = *(const bf16x8*)(cp + 16 * ks); a2 = mfma32(cf, qf[ks], a2); }
#pragma unroll
            for (int i = 0; i < 16; ++i) { const float v = (a1[i] + wi * a2[i]) * dinv; hv[db][i] = v; ss += v * v; }
        }
        ss += __shfl_xor(ss, 32);
        if (h == 0) sx[(tb * 4 + dvq) * 32 + l31] = ss;
        __syncthreads();
        const float tot = (sx[(tb * 4 + 0) * 32 + l31] + sx[(tb * 4 + 1) * 32 + l31]) + (sx[(tb * 4 + 2) * 32 + l31] + sx[(tb * 4 + 3) * 32 + l31]);
        const float rstd = 1.f / sqrtf(tot * (1.f / 256.f) + EPS);
#pragma unroll
        for (int db = 0; db < 2; ++db)
#pragma unroll
            for (int g = 0; g < 4; ++g) { const int col = hh * 256 + 32 * (2 * dvq + db) + 8 * g + 4 * h;
                const f32x4 gn = *(const f32x4*)(onorm + col); const u32x2 og = *(const u32x2*)(P + (row0 + t) * NP + PC_O + col);
                const float o0 = hv[db][4 * g] * rstd * gn.x * sigmoidf_(bflo(og.x)), o1 = hv[db][4 * g + 1] * rstd * gn.y * sigmoidf_(bfhi(og.x));
                const float o2 = hv[db][4 * g + 2] * rstd * gn.z * sigmoidf_(bflo(og.y)), o3 = hv[db][4 * g + 3] * rstd * gn.w * sigmoidf_(bfhi(og.y));
                u32x2 w; w.x = pk2(o0, o1); w.y = pk2(o2, o3); *(u32x2*)(Y + (row0 + t) * 3072 + col) = w; }
        __syncthreads();
    }
}

DI void attn_unit(LAS unsigned char* smem, int hh, int qb, const bf16_t* Q, const bf16_t* KN, const bf16_t* P, const bf16_t* VT, bf16_t* Y) {
    const int tid = opaque_tid(), lane = tid & 63, wid = __builtin_amdgcn_readfirstlane(tid >> 6), l31 = lane & 31, h = lane >> 5;
    LAS unsigned char* Kb = smem; LAS unsigned char* Vb = smem + 51200;
    const int q0 = qb * 256, qw = q0 + 32 * wid, q = qw + l31, NT = 4 * qb + 4;
    bf16x8 qf[12];
#pragma unroll
    for (int ks = 0; ks < 12; ++ks) qf[ks] = *(const bf16x8*)(Q + (size_t)q * 1536 + hh * 192 + 16 * ks + 8 * h);
    f32x16 o[4];
#pragma unroll
    for (int d = 0; d < 4; ++d)
#pragma unroll
        for (int i = 0; i < 16; ++i) o[d][i] = 0.f;
    float mref = 0.f, lrun = 0.f; bool first = true;
    const bf16_t* ksrc0; const bf16_t* ksrc2; const bf16_t* vsrc0; int kdst0, kdst2, vdst0;
    { const int row = tid >> 4, ch = tid & 15; ksrc0 = KN + (size_t)row * 1024 + hh * 128 + 8 * ch; kdst0 = row * 400 + ch * 16; }
    { const int row = tid >> 3, ch = tid & 7; ksrc2 = P + (size_t)row * NP + PC_KR + 8 * ch; kdst2 = row * 400 + 256 + ch * 16; }
    { const int d = tid >> 3, ch = tid & 7; vsrc0 = VT + (size_t)(hh * 128 + d) * S + 8 * ch; vdst0 = d * 144 + ch * 16; }
    u32x4 kr[3], vr[2];
#define ATT_LOAD(tt) do { kr[0] = *(const u32x4*)(ksrc0 + (size_t)(tt) * 65536); kr[1] = *(const u32x4*)(ksrc0 + (size_t)(tt) * 65536 + 32 * 1024); kr[2] = *(const u32x4*)(ksrc2 + (size_t)(tt) * (64 * NP)); \
        vr[0] = *(const u32x4*)(vsrc0 + (size_t)(tt) * 64); vr[1] = *(const u32x4*)(vsrc0 + (size_t)(tt) * 64 + (size_t)64 * S); } while (0)
#define ATT_WRITE(kbuf, vslot) do { *(LAS u32x4*)(Kb + (kbuf) * 25600 + kdst0) = kr[0]; *(LAS u32x4*)(Kb + (kbuf) * 25600 + kdst0 + 32 * 400) = kr[1]; *(LAS u32x4*)(Kb + (kbuf) * 25600 + kdst2) = kr[2]; \
        *(LAS u32x4*)(Vb + (vslot) * 18432 + vdst0) = vr[0]; *(LAS u32x4*)(Vb + (vslot) * 18432 + vdst0 + 64 * 144) = vr[1]; } while (0)
#define ATT_BAR() do { asm volatile("s_waitcnt lgkmcnt(0)" ::: "memory"); __builtin_amdgcn_s_barrier(); asm volatile("" ::: "memory"); } while (0)
    ATT_LOAD(0);
    ATT_WRITE(0, 0);
    ATT_BAR();
    const int koff = pi32(l31) * 400 + 16 * h, voff = l31 * 144 + 16 * h;
#define SB() __builtin_amdgcn_sched_barrier(0)
#define KFR(kb, ks, b) (*(const LAS bf16x8*)((kb) + (b) * 32 * 400 + (ks) * 32))
#define VFR(vb, d, kk) (*(const LAS bf16x8*)((vb) + (d) * 32 * 144 + (kk) * 32))
    int vs = 0;
    for (int t = 0; t < NT; ++t) {
        const int kc = t & 1, vn = vs == 2 ? 0 : vs + 1;
        if (t + 1 < NT) ATT_LOAD(t + 1);
        if (64 * t <= qw + 31) {
            LAS const unsigned char* kb = Kb + kc * 25600 + koff; LAS const unsigned char* vb = Vb + vs * 18432 + voff;
            f32x16 s0, s1;
#pragma unroll
            for (int i = 0; i < 16; ++i) { s0[i] = 0.f; s1[i] = 0.f; }
            bf16x8 fa[4], fb[4];
            fa[0] = KFR(kb, 0, 0); fa[1] = KFR(kb, 0, 1); fa[2] = KFR(kb, 1, 0); fa[3] = KFR(kb, 1, 1); SB();
#pragma unroll
            for (int st = 0; st < 6; st += 2) {
                fb[0] = KFR(kb, 2 * st + 2, 0); fb[1] = KFR(kb, 2 * st + 2, 1); fb[2] = KFR(kb, 2 * st + 3, 0); fb[3] = KFR(kb, 2 * st + 3, 1); SB();
                s0 = mfma32(fa[0], qf[2 * st], s0); s1 = mfma32(fa[1], qf[2 * st], s1); s0 = mfma32(fa[2], qf[2 * st + 1], s0); s1 = mfma32(fa[3], qf[2 * st + 1], s1); SB();
                if (st + 2 < 6) { fa[0] = KFR(kb, 2 * st + 4, 0); fa[1] = KFR(kb, 2 * st + 4, 1); fa[2] = KFR(kb, 2 * st + 5, 0); fa[3] = KFR(kb, 2 * st + 5, 1); }
                else { fa[0] = VFR(vb, 0, 0); fa[1] = VFR(vb, 0, 1); fa[2] = VFR(vb, 0, 2); fa[3] = VFR(vb, 0, 3); }
                SB();
                s0 = mfma32(fb[0], qf[2 * st + 2], s0); s1 = mfma32(fb[1], qf[2 * st + 2], s1); s0 = mfma32(fb[2], qf[2 * st + 3], s0); s1 = mfma32(fb[3], qf[2 * st + 3], s1); SB();
            }
            if (64 * t + 63 > qw) {
#pragma unroll
                for (int i = 0; i < 16; ++i) { const int kv = 64 * t + 16 * (i >> 3) + 8 * h + (i & 7); if (kv > q) s0[i] = -1e30f; if (kv + 32 > q) s1[i] = -1e30f; }
            }
            float mx = fmaxf(s0[0], s1[0]);
#pragma unroll
            for (int i = 1; i < 16; ++i) mx = fmaxf(mx, fmaxf(s0[i], s1[i]));
            mx = fmaxf(mx, __shfl_xor(mx, 32));
            if (first || __any(mx - mref > 8.f)) {
                const float dl = first ? mx : fmaxf(mx - mref, 0.f);
                mref += dl;
                if (!first) { const float f = __builtin_amdgcn_exp2f(-dl); lrun *= f;
#pragma unroll
                    for (int d = 0; d < 4; ++d)
#pragma unroll
                        for (int i = 0; i < 16; ++i) o[d][i] *= f; }
                first = false; }
            float rs = 0.f;
#pragma unroll
            for (int i = 0; i < 16; ++i) { s0[i] = __builtin_amdgcn_exp2f(s0[i] - mref); s1[i] = __builtin_amdgcn_exp2f(s1[i] - mref); rs += s0[i] + s1[i]; }
            lrun += rs;
            bf16x8 pf[4];
            pf[0] = pack8(s0[0], s0[1], s0[2], s0[3], s0[4], s0[5], s0[6], s0[7]); pf[1] = pack8(s0[8], s0[9], s0[10], s0[11], s0[12], s0[13], s0[14], s0[15]);
            pf[2] = pack8(s1[0], s1[1], s1[2], s1[3], s1[4], s1[5], s1[6], s1[7]); pf[3] = pack8(s1[8], s1[9], s1[10], s1[11], s1[12], s1[13], s1[14], s1[15]);
            SB();
            fb[0] = VFR(vb, 1, 0); fb[1] = VFR(vb, 1, 1); fb[2] = VFR(vb, 1, 2); fb[3] = VFR(vb, 1, 3); SB();
            o[0] = mfma32(fa[0], pf[0], o[0]); o[0] = mfma32(fa[1], pf[1], o[0]); o[0] = mfma32(fa[2], pf[2], o[0]); o[0] = mfma32(fa[3], pf[3], o[0]); SB();
            fa[0] = VFR(vb, 2, 0); fa[1] = VFR(vb, 2, 1); fa[2] = VFR(vb, 2, 2); fa[3] = VFR(vb, 2, 3); SB();
            o[1] = mfma32(fb[0], pf[0], o[1]); o[1] = mfma32(fb[1], pf[1], o[1]); o[1] = mfma32(fb[2], pf[2], o[1]); o[1] = mfma32(fb[3], pf[3], o[1]); SB();
            fb[0] = VFR(vb, 3, 0); fb[1] = VFR(vb, 3, 1); fb[2] = VFR(vb, 3, 2); fb[3] = VFR(vb, 3, 3); SB();
            o[2] = mfma32(fa[0], pf[0], o[2]); o[2] = mfma32(fa[1], pf[1], o[2]); o[2] = mfma32(fa[2], pf[2], o[2]); o[2] = mfma32(fa[3], pf[3], o[2]); SB();
            o[3] = mfma32(fb[0], pf[0], o[3]); o[3] = mfma32(fb[1], pf[1], o[3]); o[3] = mfma32(fb[2], pf[2], o[3]); o[3] = mfma32(fb[3], pf[3], o[3]); SB();
        }
        if (t + 1 < NT) ATT_WRITE(kc ^ 1, vn);
        ATT_BAR();
        vs = vn;
    }
#undef SB
#undef KFR
#undef VFR
#undef ATT_LOAD
#undef ATT_WRITE
#undef ATT_BAR
    lrun += __shfl_xor(lrun, 32);
    const float inv = 1.f / lrun;
    bf16_t* yp = Y + (size_t)q * 3072 + 1024 + hh * 128 + 4 * h;
#pragma unroll
    for (int d = 0; d < 4; ++d)
#pragma unroll
        for (int g = 0; g < 4; ++g) { u32x2 w; w.x = pk2(o[d][4 * g] * inv, o[d][4 * g + 1] * inv); w.y = pk2(o[d][4 * g + 2] * inv, o[d][4 * g + 3] * inv); *(u32x2*)(yp + 32 * d + 8 * g) = w; }
}

#define XB_TMO      128
#define XB_XCNT(j)  (256  + 64 * (j))
#define XB_XSUB(j)  (1280 + 64 * (j))
#define XB_XGEN(j)  (2304 + 64 * (j))
#define XB_TOP      3328
#define XB_TOPGEN   3392
#define XCD_BAR_WORDS 3456
#define XB_SPIN_CAP (1u << 23)
DI unsigned xb_ld(unsigned* p)              { return __hip_atomic_load(p, __ATOMIC_RELAXED, __HIP_MEMORY_SCOPE_AGENT); }
DI unsigned xb_add(unsigned* p, unsigned v) { return __hip_atomic_fetch_add(p, v, __ATOMIC_RELAXED, __HIP_MEMORY_SCOPE_AGENT); }
DI unsigned xb_xcc_id() { return (unsigned)__builtin_amdgcn_s_getreg((3 << 11) | 20) & 0xFu; }
#define XB_SPIN(cond, bar) do { unsigned _sp = 0; while (cond) { __builtin_amdgcn_s_sleep(1); \
    if ((++_sp & 255u) == 0u) { if (xb_ld(&(bar)[XB_TMO])) break; if (_sp > XB_SPIN_CAP) { atomicAdd(&(bar)[XB_TMO], 1u); break; } } } } while (0)
struct XcdBarrier { unsigned* bar; unsigned x; volatile LAS unsigned* st; };
DI XcdBarrier xcd_barrier_post(unsigned* bar, volatile LAS unsigned* st) {
    XcdBarrier b; b.bar = bar; b.x = xb_xcc_id(); b.st = st;
    if (threadIdx.x == 0) (void)xb_add(&bar[XB_XCNT(b.x)], 1u);
    return b;
}
DI void xcd_barrier_complete(unsigned* bar, unsigned x, unsigned& nloc, unsigned& nx) {
    const unsigned G = gridDim.x * gridDim.y * gridDim.z;
    unsigned sum, cnt, mine, sp = 0u;
    for (;;) {
        sum = 0u; cnt = 0u; mine = 0u;
#pragma unroll
        for (unsigned j = 0; j < 16; ++j) { const unsigned c = xb_ld(&bar[XB_XCNT(j)]); sum += c; cnt += (c > 0u) ? 1u : 0u; mine = (j == x) ? c : mine; }
        if (sum == G) break;
        __builtin_amdgcn_s_sleep(1);
        if ((++sp & 255u) == 0u) { if (xb_ld(&bar[XB_TMO])) break; if (sp > XB_SPIN_CAP) { atomicAdd(&bar[XB_TMO], 1u); break; } }
    }
    nloc = mine > 0u ? mine : 1u; nx = cnt > 0u ? cnt : 1u;
}
DI void xcd_barrier(const XcdBarrier& b) {
    asm volatile("s_waitcnt vmcnt(0)" ::: "memory");
    __syncthreads();
    if (threadIdx.x == 0) {
        unsigned* bar = b.bar;
        __builtin_amdgcn_s_waitcnt(0);
        unsigned nloc = b.st[0], nx = b.st[1];
        if (nloc == 0u) { xcd_barrier_complete(bar, b.x, nloc, nx); b.st[0] = nloc; b.st[1] = nx; }
        const unsigned old = xb_add(&bar[XB_XSUB(b.x)], 1u);
        const unsigned gen = old / nloc;
        if (old + 1u == (gen + 1u) * nloc) {
            __builtin_amdgcn_fence(__ATOMIC_RELEASE, "agent");
            asm volatile("s_waitcnt vmcnt(0)" ::: "memory");
            const unsigned og = xb_add(&bar[XB_TOP], 1u);
            const unsigned tg = og / nx;
            if (og + 1u == (tg + 1u) * nx) xb_add(&bar[XB_TOPGEN], 1u);
            else XB_SPIN(xb_ld(&bar[XB_TOPGEN]) == tg, bar);
            __builtin_amdgcn_fence(__ATOMIC_ACQUIRE, "agent");
            xb_add(&bar[XB_XGEN(b.x)], 1u);
            asm volatile("s_waitcnt vmcnt(0)" ::: "memory");
        } else {
            XB_SPIN(xb_ld(&bar[XB_XGEN(b.x)]) == gen, bar);
            __builtin_amdgcn_fence(__ATOMIC_ACQUIRE, "agent");
            asm volatile("s_waitcnt vmcnt(0)" ::: "memory");
        }
    }
    __syncthreads();
}

struct Params { const float* in[27]; float* out; unsigned char* ws; };

__global__ void __launch_bounds__(512, 2) mega_fwd(Params p) {
    extern __shared__ __attribute__((aligned(16))) unsigned char smem_raw[];
    LAS unsigned char* smem = (LAS unsigned char*)smem_raw;
    cg::grid_group grid = cg::this_grid();
    const int G = gridDim.x, bx = blockIdx.x;
    { const int t0 = opaque_tid(); if (t0 < 128) ((LAS unsigned*)(smem + 131072))[t0] = 0u; }
    __syncthreads();
    XcdBarrier bar = xcd_barrier_post((unsigned*)(p.ws + WS_CTL), (volatile LAS unsigned*)(smem + 131072) + 8);
    unsigned char* ws = p.ws;
    f32x2* TAB = (f32x2*)(ws + WS_TAB); float* SMALL = (float*)(ws + WS_SMALL);
    bf16_t* WFFGU = (bf16_t*)(ws + WS_WFFGU); bf16_t* WFFD = (bf16_t*)(ws + WS_WFFD); bf16_t* WIN = (bf16_t*)(ws + WS_WIN); bf16_t* WUQ = (bf16_t*)(ws + WS_WUQ);
    bf16_t* WUKV = (bf16_t*)(ws + WS_WUKV); bf16_t* WLRU = (bf16_t*)(ws + WS_WLRU); bf16_t* WBR = (bf16_t*)(ws + WS_WBR); bf16_t* WOUT = (bf16_t*)(ws + WS_WOUT);
    bf16_t* XN = (bf16_t*)(ws + WS_XN); bf16_t* P = (bf16_t*)(ws + WS_P); bf16_t* Hb = P; bf16_t* Qb = (bf16_t*)(ws + WS_Q); bf16_t* KN = (bf16_t*)(ws + WS_KN);
    bf16_t* VT = (bf16_t*)(ws + WS_VT); bf16_t* Y = (bf16_t*)(ws + WS_Y); bf16_t* XC = (bf16_t*)(ws + WS_XC); bf16_t* CS = (bf16_t*)(ws + WS_CS);

    for (int i = bx * 512 + opaque_tid(); i < S * 32; i += G * 512) { const int t = i >> 5, j = i & 31; const float ang = (float)t * INVF[j];
        double r = (double)ang * 0.15915494309189535; r -= __builtin_floor(r); const float fr = (float)r;
        TAB[i] = (f32x2){__builtin_amdgcn_cosf(fr), __builtin_amdgcn_sinf(fr)}; }

#pragma unroll 1
    for (int hl = 0; hl < 4; ++hl) {
        const int l = hl >> 1, second = hl & 1;
        const float* xin = hl == 0 ? p.in[0] : p.out;
        {
            const int nmat = second ? 3 : 26; int rot = 0;
#pragma unroll 1
            for (int mi = 0; mi < nmat; ++mi) {
                const float* src; int K, N, map; bf16_t* dst;
                if (mi == 0) { src = p.in[second ? 23 : 2] + (size_t)l * DM * FF; K = DM; N = FF; map = 1; dst = WFFGU; }
                else if (mi == 1) { src = p.in[second ? 24 : 3] + (size_t)l * DM * FF; K = DM; N = FF; map = 2; dst = WFFGU; }
                else if (mi == 2) { src = p.in[second ? 25 : 4] + (size_t)l * DM * FF; K = FF; N = DM; map = 0; dst = WFFD; }
                else if (mi == 3) { src = p.in[6] + (size_t)l * DM * NIN; K = DM; N = NIN; map = 3; dst = WIN; }
                else if (mi == 4) { src = p.in[10] + (size_t)l * 384 * 1536; K = 384; N = 1536; map = 4; dst = WUQ; }
                else if (mi == 5) { src = p.in[12] + (size_t)l * 256 * 2048; K = 256; N = 2048; map = 5; dst = WUKV; }
                else if (mi < 22) { const int k = mi - 6, n = k >> 1, wx = k & 1; src = p.in[wx ? 17 : 15] + (size_t)l * 131072 + n * 16384; K = 128; N = 128; map = 0; dst = WLRU + (size_t)(n * 256 + wx * 128) * 128; }
                else if (mi < 25) { const int j = mi - 22; src = p.in[20] + (size_t)l * 3 * 1024 * 2048 + (size_t)j * 1024 * 2048; K = 1024; N = 2048; map = 0; dst = WBR + (size_t)j * 2048 * 1024; }
                else { src = p.in[21] + (size_t)l * DM * DM; K = DM; N = DM; map = 0; dst = WOUT; }
                convert_mat(src, K, N, dst, map, rot);
            }
            rmsnorm_rows(xin, p.in[second ? 22 : 1] + l * DM, XN);
        }
        if (hl == 0) grid.sync(); else xcd_barrier(bar);
        { pg8::Gemm g{XN, WFFGU, S, 2 * FF, DM, DM, DM, 0}; pg8::StaticOrder so; so.init(S, 2 * FF, G, bx); pg8::EpiSwiglu E{Hb}; pg8::gemm_phase(smem, g, so, E); }
        xcd_barrier(bar);
        { pg8::Gemm g{Hb, WFFD, S, DM, FF, FF, FF, 0}; pg8::StaticOrder so; so.init(S, DM, G, bx); pg8::EpiRes E{xin, p.out, 0.5f}; pg8::gemm_phase(smem, g, so, E); }
        xcd_barrier(bar);
        if (!second) {
            const float* gbias = p.in[7] + l * 8;
            rmsnorm_rows(p.out, p.in[5] + l * DM, XN);
            xcd_barrier(bar);
            { pg8::Gemm g{XN, WIN, S, NP, DM, DM, DM, 0}; pg8::StaticOrder so; so.init(S, NP, G, bx); pg8::EpiStore E{P, NP}; pg8::gemm_phase(smem, g, so, E); }
            xcd_barrier(bar);
            if (bx == G - 1) { const float* lam = p.in[19] + l * 1024; for (int ch = opaque_tid(); ch < 1024; ch += 512) SMALL[SM_SP + ch] = -8.f * log1pf(expf(-lam[ch])); }
            mlstm_a(smem, P, gbias, CS, SMALL);
            prep_rows(P, p.in[9] + l * 384, p.in[11] + l * 256, p.in[13] + l * 4096, p.in[14] + l * 1024, TAB, XC);
            xcd_barrier(bar);
            mlstm_b(smem, CS, SMALL);
            { pg8::Gemm g{P + PC_CQ, WUQ, S, 1536, 384, NP, 384, 0}; pg8::StaticOrder so; so.init(S, 1536, G, bx); pg8::EpiQ E{Qb, TAB}; pg8::gemm_phase(smem, g, so, E); }
#pragma unroll 1
            for (int gi = 0; gi < 2; ++gi) {
                pg8::Gemm g; pg8::StaticOrder so; pg8::EpiStore E;
                if (gi == 0) { g = pg8::Gemm{P + PC_CKV, WUKV, S, 1024, 256, NP, 256, 0}; so.init(S, 1024, G, bx); E = pg8::EpiStore{KN, 1024}; }
                else { g = pg8::Gemm{WUKV + 1024 * 256, P + PC_CKV, 1024, S, 256, 256, NP, 0}; so.init(1024, S, G, bx); E = pg8::EpiStore{VT, S}; }
                pg8::gemm_phase(smem, g, so, E);
            }
            { pg8::Gemm g{XC, WLRU, S, 2048, 128, 1024, 128, 128}; pg8::StaticOrder so; so.init(S, 2048, G, bx); pg8::EpiLru E{XC, P + PC_CX, p.in[16] + l * 1024, p.in[18] + l * 1024, SMALL + SM_SP}; pg8::gemm_phase(smem, g, so, E); }
            xcd_barrier(bar);
            mlstm_c(smem, P, gbias, p.in[8] + l * 1024, CS, SMALL, Y);
            lru_p1(P + PC_CX, XC, SMALL + SM_CA, SMALL + SM_CH);
            xcd_barrier(bar);
            lru_p2(SMALL + SM_CA, SMALL + SM_CH, SMALL + SM_CARRY);
            for (int item = bx; item < 256; item += G) { const int hh = item & 7, pp = item >> 3;
#pragma unroll 1
                for (int half = 0; half < 2; ++half) attn_unit(smem, hh, half ? 63 - pp : pp, Qb, KN, P, VT, Y); }
            xcd_barrier(bar);
            lru_p3(P + PC_CX, XC, SMALL + SM_CARRY, Y);
#pragma unroll 1
            for (int j = 0; j < 3; ++j) {
                if (j == 2) xcd_barrier(bar);
                pg8::Gemm g{Y + j * 1024, WBR + (size_t)j * 2048 * 1024, S, DM, 1024, 3072, 1024, 0}; pg8::StaticOrder so; so.init(S, DM, G, bx); pg8::EpiMerge E{XN, P + PC_G + j * 2048, j == 0}; pg8::gemm_phase(smem, g, so, E);
            }
            xcd_barrier(bar);
            { pg8::Gemm g{XN, WOUT, S, DM, DM, DM, DM, 0}; pg8::StaticOrder so; so.init(S, DM, G, bx); pg8::EpiRes E{p.out, p.out, 1.0f}; pg8::gemm_phase(smem, g, so, E); }
            xcd_barrier(bar);
        }
    }
    final_norm_rows(p.out, p.in[26]);
}

constexpr int LDS_BYTES = 143360;

extern "C" void kernel_launch(void* const* d_in, const int* in_sizes, int n_in, void* d_out, int out_size, void* d_ws, size_t ws_size, hipStream_t stream) {
    static int grid = 0;
    if (grid == 0) {
        if (n_in != 27 || out_size != S * DM || ws_size < WS_END) { fprintf(stderr, "kernel_launch: unexpected problem (n_in %d out %d ws %zu, need %zu)\n", n_in, out_size, ws_size, (size_t)WS_END); grid = -1; return; }
        int dev = 0, cus = 0, per_cu = 0;
        hipGetDevice(&dev); hipDeviceGetAttribute(&cus, hipDeviceAttributeMultiprocessorCount, dev);
        if (hipFuncSetAttribute((const void*)mega_fwd, hipFuncAttributeMaxDynamicSharedMemorySize, LDS_BYTES) != hipSuccess) { fprintf(stderr, "kernel_launch: hipFuncSetAttribute failed\n"); grid = -1; return; }
        if (hipOccupancyMaxActiveBlocksPerMultiprocessor(&per_cu, (const void*)mega_fwd, 512, LDS_BYTES) != hipSuccess || per_cu < 1) { fprintf(stderr, "kernel_launch: occupancy query says %d\n", per_cu); per_cu = 1; }
        (void)hipGetLastError();
        grid = cus * (per_cu > 1 ? 1 : per_cu);
    }
    if (grid < 0) return;
    if (hipMemsetAsync((char*)d_ws + WS_CTL, 0, CTL_BYTES, stream) != hipSuccess) { fprintf(stderr, "kernel_launch: memset failed\n"); return; }
    Params p{};
    for (int i = 0; i < 27; ++i) p.in[i] = (const float*)d_in[i];
    p.out = (float*)d_out; p.ws = (unsigned char*)d_ws;
    void* args[] = {&p};
    hipError_t e = hipLaunchCooperativeKernel((const void*)mega_fwd, dim3(grid), dim3(512), args, LDS_BYTES, stream);
    if (e != hipSuccess) fprintf(stderr, "cooperative launch failed: %s (grid %d)\n", hipGetErrorString(e), grid);
}
```

```cpp
#include <hip/hip_runtime.h>
#include <hip/hip_cooperative_groups.h>
#include <cstdio>
#include <cstdint>
namespace cg = cooperative_groups;

#define DI __device__ __forceinline__
#define LAS __attribute__((address_space(3)))
typedef unsigned short bf16_t;
typedef short bf16x8 __attribute__((ext_vector_type(8)));
typedef short s16x4 __attribute__((ext_vector_type(4)));
typedef float f32x2 __attribute__((ext_vector_type(2)));
typedef float f32x4 __attribute__((ext_vector_type(4)));
typedef float f32x16 __attribute__((ext_vector_type(16)));
typedef unsigned u32x2 __attribute__((ext_vector_type(2)));
typedef unsigned u32x4 __attribute__((ext_vector_type(4)));
typedef __bf16 bf16x2_t __attribute__((ext_vector_type(2)));

constexpr int S = 16384, DM = 2048, FF = 5632, NIN = 10952, NP = 11008;
constexpr float EPS = 1e-6f;
constexpr int PC_Q = 0, PC_K = 512, PC_V = 1024, PC_O = 2048, PC_CQ = 3072, PC_CKV = 3456, PC_KR = 3712, PC_CX = 3776, PC_G = 4800, PC_I = 10944, PC_F = 10948;
constexpr float MQS = 0.08838834764831845f;
constexpr float AQS = 0.07216878364870322f * 1.4426950408889634f;

constexpr size_t MiB = 1u << 20;
constexpr size_t WS_TAB = 0;
constexpr size_t WS_SMALL = 4 * MiB;
constexpr size_t WS_WFFGU = 12 * MiB;
constexpr size_t WS_WFFD = 56 * MiB;
constexpr size_t WS_WIN = 78 * MiB;
constexpr size_t WS_WUQ = 121 * MiB;
constexpr size_t WS_WUKV = 123 * MiB;
constexpr size_t WS_WLRU = 124 * MiB;
constexpr size_t WS_WBR = 125 * MiB;
constexpr size_t WS_WOUT = 137 * MiB;
constexpr size_t WS_XN = 145 * MiB;
constexpr size_t WS_P = 209 * MiB;
constexpr size_t WS_Q = 553 * MiB;
constexpr size_t WS_KN = 601 * MiB;
constexpr size_t WS_VT = 633 * MiB;
constexpr size_t WS_Y = 665 * MiB;
constexpr size_t WS_XC = 761 * MiB;
constexpr size_t WS_CS = 793 * MiB;
constexpr size_t WS_END = 857 * MiB;
constexpr size_t WS_CTL = 11 * MiB, CTL_BYTES = 16384;
constexpr int SM_BT = 0, SM_MC = 1024, SM_MPREV = 2048, SM_DN = 4096  , SM_CA = 4096 + 131072  , SM_CH = SM_CA + 262144, SM_CARRY = SM_CH + 262144, SM_SP = SM_CARRY + 262144;

__device__ const float INVF[32] = {1.0f, 0.7498942613601685f, 0.5623413324356079f, 0.4216965138912201f, 0.3162277638912201f, 0.23713737726211548f, 0.17782793939113617f, 0.133352130651474f, 0.10000000149011612f, 0.07498941570520401f, 0.05623413249850273f, 0.04216965287923813f, 0.03162277489900589f, 0.023713737726211548f, 0.017782794311642647f, 0.01333521492779255f, 0.009999999776482582f, 0.007498941849917173f, 0.005623413249850273f, 0.0042169648222625256f, 0.003162277629598975f, 0.00237137358635664f, 0.0017782794311642647f, 0.0013335214462131262f, 0.0010000000474974513f, 0.0007498942431993783f, 0.000562341301701963f, 0.0004216965171508491f, 0.0003162277571391314f, 0.00023713737027719617f, 0.00017782794020604342f, 0.0001333521504420787f};

DI int opaque_tid() { int t = threadIdx.x; asm volatile("" : "+v"(t)); return t; }
DI float bf2f(bf16_t v) { return __uint_as_float((unsigned)v << 16); }
DI float bflo(unsigned w) { return __uint_as_float(w << 16); }
DI float bfhi(unsigned w) { return __uint_as_float(w & 0xffff0000u); }
DI unsigned pk2(float lo, float hi) { f32x2 v = {lo, hi}; bf16x2_t b = __builtin_convertvector(v, bf16x2_t); return __builtin_bit_cast(unsigned, b); }
DI bf16_t f2bf(float f) { return (bf16_t)(pk2(f, 0.f) & 0xffffu); }
DI float wave_sum(float v) {
#pragma unroll
    for (int o = 1; o < 64; o <<= 1) v += __shfl_xor(v, o);
    return v;
}
DI float wave_max(float v) {
#pragma unroll
    for (int o = 1; o < 64; o <<= 1) v = fmaxf(v, __shfl_xor(v, o));
    return v;
}
DI float wave_incl_scan(float v, int lane) {
#pragma unroll
    for (int o = 1; o < 64; o <<= 1) { const float n = __shfl_up(v, o); if (lane >= o) v += n; }
    return v;
}
DI float sigmoidf_(float x) { return __builtin_amdgcn_rcpf(1.f + __expf(-x)); }
DI float logsigmoid_(float x) { return fminf(x, 0.f) - log1pf(expf(-fabsf(x))); }
DI f32x16 mfma32(bf16x8 a, bf16x8 b, f32x16 c) { return __builtin_amdgcn_mfma_f32_32x32x16_bf16(a, b, c, 0, 0, 0); }
DI int crow(int r, int h) { return (r & 3) + 8 * (r >> 2) + 4 * h; }
DI int pi32(int m) { return (m & ~12) | ((m & 4) << 1) | ((m & 8) >> 1); }
typedef short v4i16_t __attribute__((ext_vector_type(4)));
DI s16x4 tr16(LAS const unsigned char* p) { return __builtin_bit_cast(s16x4, __builtin_amdgcn_ds_read_tr16_b64_v4i16((LAS v4i16_t*)p)); }
DI bf16x8 tr_frag(LAS const unsigned char* p, int rs) {
    const s16x4 lo = tr16(p), hi = tr16(p + 4 * rs);
    return __builtin_shufflevector(lo, hi, 0, 1, 2, 3, 4, 5, 6, 7);
}
DI bf16x8 pack8(float a0, float a1, float a2, float a3, float a4, float a5, float a6, float a7) {
    u32x4 w; w.x = pk2(a0, a1); w.y = pk2(a2, a3); w.z = pk2(a4, a5); w.w = pk2(a6, a7); return __builtin_bit_cast(bf16x8, w);
}

namespace pg8 {
constexpr int BM = 256, BK = 64, HALF = 128, HTB = HALF * BK * 2, STAGE_BYTES = 8 * HTB, NXCD = 8, WGM = 8;
DI int lds_byte(int r, int c) { const int st = (r >> 4) * 2 + (c >> 5), rr = r & 15, cc = c & 31, ob = rr * 64 + cc * 2; return st * 1024 + (ob ^ (((ob >> 9) & 1) << 5)); }
DI void stage_rc(int b, int& R, int& C) { const int st = b / 1024, sb = b % 1024, swz = sb ^ (((sb >> 9) & 1) << 5); R = (st >> 1) * 16 + swz / 64; C = (st & 1) * 32 + (swz % 64) / 2; }
DI int perm32(int rho) { const int n = rho >> 4, i = rho & 15; return 8 * (i >> 2) + 4 * n + (i & 3); }
struct Unit { int pm, pn; };
struct Gemm { const bf16_t* A; const bf16_t* Bt; int M, N, K, lda, ldb, apn; };
struct StaticOrder {
    int nM, nN, nwg, G, c;
    DI void init(int M, int N, int G_, int c_) { nM = M / BM; nN = N / BM; nwg = nM * nN; G = G_; c = c_; }
    DI bool next(int i, Unit& u) const {
        const long L = (long)i * G + c; if (L >= nwg) return false;
        int wgid = (int)L; { const int q = nwg / NXCD, r = nwg % NXCD, xcd = wgid % NXCD, off = wgid / NXCD; wgid = (xcd < r ? xcd * (q + 1) : r * (q + 1) + (xcd - r) * q) + off; }
        const int nig = WGM * nN, gid = wgid / nig, fm = gid * WGM, gsz = (nM - fm) < WGM ? (nM - fm) : WGM;
        u.pm = fm + ((wgid % nig) % gsz); u.pn = (wgid % nig) / gsz; return true;
    }
};
template <class Epi>
DI void gemm_phase(LAS unsigned char* lds, const Gemm g, const StaticOrder& S, const Epi& E) {
    const int tid = opaque_tid(), wid = __builtin_amdgcn_readfirstlane(tid >> 6), lane = tid & 63, wr = wid >> 2, wc = wid & 3, fr = lane & 15, fq = lane >> 4;
    int K = g.K; asm volatile("" : "+s"(K)); const int nt = K / BK;
    unsigned voffA[2], voffB[2];
#pragma unroll
    for (int i = 0; i < 2; ++i) { int R, C; stage_rc(tid * 16 + i * 8192, R, C); const int Rb = Epi::PERM ? ((R & ~31) + perm32(R & 31)) : R;
        voffA[i] = (unsigned)(R * g.lda + C) * 2u; voffB[i] = (unsigned)(Rb * g.ldb + C) * 2u; }
    const size_t kstep = (size_t)(BK * 2);
    const size_t hstepA = (size_t)HALF * g.lda * 2, hstepB = (size_t)HALF * g.ldb * 2;
    const unsigned ldsw = (unsigned)wid * 1024u;
    const int aoff = lds_byte(wr * 64 + fr, fq * 8), boff = lds_byte(wc * 32 + fr, fq * 8);
#define PG8_SA(b, h) (((b) * 2 + (h)) * HTB)
#define PG8_SB(b, h) ((4 + (b) * 2 + (h)) * HTB)
#define PG8_STAGE(bufoff, gbase, voff) do { _Pragma("unroll") for (int _i = 0; _i < 2; ++_i) \
        __builtin_amdgcn_global_load_lds((const unsigned*)((const char*)(gbase) + (voff)[_i]), (LAS unsigned*)(lds + (bufoff) + ldsw + _i * 8192), 16, 0, 0); } while (0)
#define PG8_LDA(dst, b, h) do { _Pragma("unroll") for (int m = 0; m < 4; ++m) _Pragma("unroll") for (int k = 0; k < 2; ++k) dst[m][k] = *(const LAS bf16x8*)(lds + PG8_SA(b, h) + aoff + m * 2048 + k * 1024); } while (0)
#define PG8_LDB(dst, b, h) do { _Pragma("unroll") for (int n = 0; n < 2; ++n) _Pragma("unroll") for (int k = 0; k < 2; ++k) dst[n][k] = *(const LAS bf16x8*)(lds + PG8_SB(b, h) + boff + n * 2048 + k * 1024); } while (0)
#define PG8_MMA(ai, bj, At, Bt) do { __builtin_amdgcn_s_setprio(1); _Pragma("unroll") for (int m = 0; m < 4; ++m) _Pragma("unroll") for (int n = 0; n < 2; ++n) _Pragma("unroll") for (int k = 0; k < 2; ++k) \
        acc[ai][bj][m][n] = __builtin_amdgcn_mfma_f32_16x16x32_bf16(Bt[n][k], At[m][k], acc[ai][bj][m][n], 0, 0, 0); __builtin_amdgcn_s_setprio(0); } while (0)
#define PG8_WAIT_V(n) asm volatile("s_waitcnt vmcnt(" #n ")" ::: "memory")
#define PG8_WAIT_L(n) asm volatile("s_waitcnt lgkmcnt(" #n ")" ::: "memory")
#define PG8_BAR __builtin_amdgcn_s_barrier()
#define PG8_SCHED __builtin_amdgcn_sched_barrier(0)
#define PG8_APTR(u) ((const char*)g.A + (size_t)(u).pm * 2 * hstepA + (size_t)(u).pn * (size_t)g.apn * 2)
#define PG8_BPTR(u) ((const char*)g.Bt + (size_t)(u).pn * 2 * hstepB)
    Unit cur, nxt; int ui = 0;
    if (!S.next(0, cur)) return;
    f32x4 acc[2][2][4][2];
#pragma unroll
    for (int a = 0; a < 2; ++a)
#pragma unroll
        for (int b = 0; b < 2; ++b)
#pragma unroll
            for (int m = 0; m < 4; ++m)
#pragma unroll
                for (int n = 0; n < 2; ++n) acc[a][b][m][n] = (f32x4){0.f, 0.f, 0.f, 0.f};
    bf16x8 At[4][2], B0[2][2], B1[2][2];
    const char* cA = PG8_APTR(cur); const char* cB = PG8_BPTR(cur);
    PG8_STAGE(PG8_SB(0, 0), cB, voffB); PG8_STAGE(PG8_SB(0, 1), cB + hstepB, voffB); PG8_STAGE(PG8_SA(0, 0), cA, voffA); PG8_STAGE(PG8_SA(0, 1), cA + hstepA, voffA);
    if (wr == 1) PG8_BAR;
    PG8_WAIT_V(2); PG8_BAR;
    PG8_STAGE(PG8_SB(1, 0), cB + kstep, voffB); PG8_STAGE(PG8_SA(1, 0), cA + kstep, voffA); PG8_STAGE(PG8_SB(1, 1), cB + hstepB + kstep, voffB);
    PG8_WAIT_V(6); PG8_BAR;
    for (;;) {
        const bool has_next = S.next(ui + 1, nxt);
        const char* nA = has_next ? PG8_APTR(nxt) : cA; const char* nB = has_next ? PG8_BPTR(nxt) : cB;
        for (int t = 0; t < nt; t += 2) {
            const bool last = (t == nt - 2);
            const char* a1 = cA + (size_t)(t + 1) * kstep;
            const char* a2 = last ? nA : cA + (size_t)(t + 2) * kstep; const char* b2 = last ? nB : cB + (size_t)(t + 2) * kstep;
            const char* a3 = a2 + kstep; const char* b3 = b2 + kstep;
            PG8_LDB(B0, 0, 0); PG8_LDB(B1, 0, 1); PG8_SCHED; PG8_LDA(At, 0, 0); PG8_STAGE(PG8_SA(1, 1), a1 + hstepA, voffA);
            PG8_WAIT_V(8); PG8_WAIT_L(0); PG8_BAR; PG8_MMA(0, 0, At, B0); PG8_MMA(0, 1, At, B1); PG8_BAR; PG8_SCHED;
            PG8_LDA(At, 0, 1); PG8_STAGE(PG8_SB(0, 0), b2, voffB); PG8_STAGE(PG8_SB(0, 1), b2 + hstepB, voffB); PG8_STAGE(PG8_SA(0, 0), a2, voffA);
            PG8_WAIT_V(8); PG8_WAIT_L(0); PG8_BAR; PG8_MMA(1, 0, At, B0); PG8_MMA(1, 1, At, B1); PG8_BAR; PG8_SCHED;
            PG8_LDB(B0, 1, 0); PG8_LDB(B1, 1, 1); PG8_SCHED; PG8_LDA(At, 1, 0); PG8_STAGE(PG8_SA(0, 1), a2 + hstepA, voffA);
            PG8_WAIT_V(8); PG8_WAIT_L(0); PG8_BAR; PG8_MMA(0, 0, At, B0); PG8_MMA(0, 1, At, B1); PG8_BAR; PG8_SCHED;
            PG8_LDA(At, 1, 1); PG8_STAGE(PG8_SB(1, 0), b3, voffB); PG8_STAGE(PG8_SB(1, 1), b3 + hstepB, voffB); PG8_STAGE(PG8_SA(1, 0), a3, voffA);
            PG8_WAIT_V(8); PG8_WAIT_L(0); PG8_BAR; PG8_MMA(1, 0, At, B0); PG8_MMA(1, 1, At, B1); PG8_BAR; PG8_SCHED;
        }
        if (wr == 0) PG8_BAR;
        E(acc, cur, wr, wc, fr, fq);
        if (!has_next) break;
#pragma unroll
        for (int a = 0; a < 2; ++a)
#pragma unroll
            for (int b = 0; b < 2; ++b)
#pragma unroll
                for (int m = 0; m < 4; ++m)
#pragma unroll
                    for (int n = 0; n < 2; ++n) acc[a][b][m][n] = (f32x4){0.f, 0.f, 0.f, 0.f};
        cur = nxt; cA = nA; cB = nB; ++ui;
        if (wr == 1) PG8_BAR;
    }
    PG8_WAIT_V(0);
    PG8_BAR;
#undef PG8_SA
#undef PG8_SB
#undef PG8_STAGE
#undef PG8_LDA
#undef PG8_LDB
#undef PG8_MMA
#undef PG8_WAIT_V
#undef PG8_WAIT_L
#undef PG8_BAR
#undef PG8_SCHED
#undef PG8_APTR
#undef PG8_BPTR
}

typedef f32x4 Acc[2][2][4][2];
struct EpiStore {
    static constexpr bool PERM = true;
    bf16_t* O; int ldc;
    DI void operator()(const Acc& acc, const Unit& u, int wr, int wc, int fr, int fq) const {
        const int row0 = u.pm * BM + wr * 64 + fr, col0 = u.pn * BM + wc * 32 + 8 * fq;
#pragma unroll
        for (int ai = 0; ai < 2; ++ai)
#pragma unroll
            for (int m = 0; m < 4; ++m) { bf16_t* rowp = O + (size_t)(row0 + ai * HALF + m * 16) * ldc + col0;
#pragma unroll
                for (int bj = 0; bj < 2; ++bj) { const f32x4 v0 = acc[ai][bj][m][0], v1 = acc[ai][bj][m][1];
                    u32x4 w; w.x = pk2(v0[0], v0[1]); w.y = pk2(v0[2], v0[3]); w.z = pk2(v1[0], v1[1]); w.w = pk2(v1[2], v1[3]);
                    *(u32x4*)(rowp + bj * HALF) = w; } }
    }
};
struct EpiSwiglu {
    static constexpr bool PERM = true;
    bf16_t* H;
    DI void operator()(const Acc& acc, const Unit& u, int wr, int wc, int fr, int fq) const {
        const int row0 = u.pm * BM + wr * 64 + fr, col0 = u.pn * HALF + wc * 32 + 8 * fq;
#pragma unroll
        for (int ai = 0; ai < 2; ++ai)
#pragma unroll
            for (int m = 0; m < 4; ++m) { bf16_t* rowp = H + (size_t)(row0 + ai * HALF + m * 16) * FF + col0;
                float o[8];
#pragma unroll
                for (int n = 0; n < 2; ++n)
#pragma unroll
                    for (int j = 0; j < 4; ++j) { const float gt = acc[ai][0][m][n][j], up = acc[ai][1][m][n][j]; o[n * 4 + j] = gt * sigmoidf_(gt) * up; }
                u32x4 w; w.x = pk2(o[0], o[1]); w.y = pk2(o[2], o[3]); w.z = pk2(o[4], o[5]); w.w = pk2(o[6], o[7]);
                *(u32x4*)rowp = w; }
    }
};
struct EpiRes {
    static constexpr bool PERM = false;
    const float* xin; float* xout; float alpha;
    DI void operator()(const Acc& acc, const Unit& u, int wr, int wc, int fr, int fq) const {
        const int col0 = u.pn * BM + wc * 32 + 4 * fq;
#pragma unroll
        for (int ai = 0; ai < 2; ++ai)
#pragma unroll
            for (int m = 0; m < 4; ++m) { const size_t off = (size_t)(u.pm * BM + ai * HALF + wr * 64 + m * 16 + fr) * DM + col0;
#pragma unroll
                for (int bj = 0; bj < 2; ++bj)
#pragma unroll
                    for (int n = 0; n < 2; ++n) { const f32x4 b = *(const f32x4*)(xin + off + bj * HALF + n * 16); *(f32x4*)(xout + off + bj * HALF + n * 16) = b + acc[ai][bj][m][n] * alpha; } }
    }
};
struct EpiQ {
    static constexpr bool PERM = true;
    bf16_t* Q; const f32x2* tab;
    DI void operator()(const Acc& acc, const Unit& u, int wr, int wc, int fr, int fq) const {
        const int row0 = u.pm * BM + wr * 64 + fr;
#pragma unroll
        for (int bj = 0; bj < 2; ++bj) {
            const int c0 = u.pn * BM + bj * HALF + wc * 32 + 8 * fq; const int hh = c0 / 192, dd = c0 - hh * 192; const bool rope = dd >= 128; const int j0 = (dd - 128) >> 1;
#pragma unroll
            for (int ai = 0; ai < 2; ++ai)
#pragma unroll
                for (int m = 0; m < 4; ++m) { const int row = row0 + ai * HALF + m * 16;
                    float v[8];
#pragma unroll
                    for (int n = 0; n < 2; ++n)
#pragma unroll
                        for (int j = 0; j < 4; ++j) v[n * 4 + j] = acc[ai][bj][m][n][j];
                    if (rope) {
#pragma unroll
                        for (int p = 0; p < 4; ++p) { const f32x2 cs = tab[(size_t)row * 32 + j0 + p]; const float x1 = v[2 * p], x2 = v[2 * p + 1]; v[2 * p] = x1 * cs.x - x2 * cs.y; v[2 * p + 1] = x1 * cs.y + x2 * cs.x; }
                    }
                    u32x4 w; w.x = pk2(v[0] * AQS, v[1] * AQS); w.y = pk2(v[2] * AQS, v[3] * AQS); w.z = pk2(v[4] * AQS, v[5] * AQS); w.w = pk2(v[6] * AQS, v[7] * AQS);
                    *(u32x4*)(Q + (size_t)row * 1536 + c0) = w; }
        }
    }
};
struct EpiLru {
    static constexpr bool PERM = true;
    bf16_t* XC; bf16_t* LA; const float* ba; const float* bx; const float* sp;
    DI void operator()(const Acc& acc, const Unit& u, int wr, int wc, int fr, int fq) const {
        const int row0 = u.pm * BM + wr * 64 + fr, ch0 = u.pn * HALF + wc * 32 + 8 * fq;
#pragma unroll
        for (int ai = 0; ai < 2; ++ai)
#pragma unroll
            for (int m = 0; m < 4; ++m) { const int row = row0 + ai * HALF + m * 16;
                const u32x4 xw = *(const u32x4*)(XC + (size_t)row * 1024 + ch0);
                const float xv[8] = {bflo(xw.x), bfhi(xw.x), bflo(xw.y), bfhi(xw.y), bflo(xw.z), bfhi(xw.z), bflo(xw.w), bfhi(xw.w)};
                u32x4 wl, wu;
#pragma unroll
                for (int n = 0; n < 2; ++n) { const f32x4 spv = *(const f32x4*)(sp + ch0 + 4 * n), bav = *(const f32x4*)(ba + ch0 + 4 * n), bxv = *(const f32x4*)(bx + ch0 + 4 * n);
                    float la[4], uu[4];
#pragma unroll
                    for (int j = 0; j < 4; ++j) { const float r = sigmoidf_(acc[ai][0][m][n][j] + bav[j]), gi = sigmoidf_(acc[ai][1][m][n][j] + bxv[j]);
                        const float l = r * spv[j]; la[j] = l; const float a2 = __expf(2.f * l); uu[j] = sqrtf(fmaxf(1.f - a2, 0.f)) * gi * xv[n * 4 + j]; }
                    if (n == 0) { wl.x = pk2(la[0], la[1]); wl.y = pk2(la[2], la[3]); wu.x = pk2(uu[0], uu[1]); wu.y = pk2(uu[2], uu[3]); }
                    else { wl.z = pk2(la[0], la[1]); wl.w = pk2(la[2], la[3]); wu.z = pk2(uu[0], uu[1]); wu.w = pk2(uu[2], uu[3]); } }
                *(u32x4*)(LA + (size_t)row * NP + ch0) = wl;
                *(u32x4*)(XC + (size_t)row * 1024 + ch0) = wu;
                asm volatile("" ::: "memory"); }
    }
};
struct EpiMerge {
    static constexpr bool PERM = true;
    bf16_t* Z; const bf16_t* G; int first;
    DI void operator()(const Acc& acc, const Unit& u, int wr, int wc, int fr, int fq) const {
        const int row0 = u.pm * BM + wr * 64 + fr, col0 = u.pn * BM + wc * 32 + 8 * fq;
#pragma unroll
        for (int ai = 0; ai < 2; ++ai)
#pragma unroll
            for (int m = 0; m < 4; ++m) { const int row = row0 + ai * HALF + m * 16;
#pragma unroll
                for (int bj = 0; bj < 2; ++bj) { const int c = col0 + bj * HALF;
                    const u32x4 gw = *(const u32x4*)(G + (size_t)row * NP + c);
                    const float gv[8] = {bflo(gw.x), bfhi(gw.x), bflo(gw.y), bfhi(gw.y), bflo(gw.z), bfhi(gw.z), bflo(gw.w), bfhi(gw.w)};
                    float o[8];
#pragma unroll
                    for (int n = 0; n < 2; ++n)
#pragma unroll
                        for (int j = 0; j < 4; ++j) o[n * 4 + j] = sigmoidf_(gv[n * 4 + j]) * acc[ai][bj][m][n][j];
                    bf16_t* zp = Z + (size_t)row * DM + c;
                    if (!first) { const u32x4 zw = *(const u32x4*)zp; o[0] += bflo(zw.x); o[1] += bfhi(zw.x); o[2] += bflo(zw.y); o[3] += bfhi(zw.y); o[4] += bflo(zw.z); o[5] += bfhi(zw.z); o[6] += bflo(zw.w); o[7] += bfhi(zw.w); }
                    u32x4 w; w.x = pk2(o[0], o[1]); w.y = pk2(o[2], o[3]); w.z = pk2(o[4], o[5]); w.w = pk2(o[6], o[7]);
                    *(u32x4*)zp = w; } }
    }
};
}

DI int map_row(int map, int n) {
    switch (map) {
        case 1: return ((n >> 7) << 8) + (n & 127);
        case 2: return ((n >> 7) << 8) + 128 + (n & 127);
        case 3: { if (n < 2048) return n; if (n < 2052) return PC_I + n - 2048; if (n < 2056) return PC_F + n - 2052; if (n < 3080) return PC_O + n - 2056; if (n < 3464) return PC_CQ + n - 3080;
                  if (n < 3720) return PC_CKV + n - 3464; if (n < 3784) return PC_KR + n - 3720; if (n < 4808) return PC_CX + n - 3784; return PC_G + n - 4808; }
        case 4: { const int hh = n / 192, dd = n - hh * 192; if (dd < 128) return n; const int jj = dd - 128; return hh * 192 + 128 + (jj < 32 ? 2 * jj : 2 * (jj - 32) + 1); }
        case 5: { const int hh = n >> 8, dd = n & 255; return dd < 128 ? hh * 128 + dd : 1024 + hh * 128 + dd - 128; }
        default: return n;
    }
}
DI void convert_mat(const float* W, int K, int N, bf16_t* WT, int map, int& rot) {
    const int tid_ = opaque_tid(), lane = tid_ & 63, gw = blockIdx.x * 8 + (tid_ >> 6), ngw = gridDim.x * 8, r = lane >> 3, c = lane & 7;
    const int nnb = (N + 31) >> 5, nkb = K >> 6, nitems = nnb * nkb;
    int it = gw - rot; if (it < 0) it += ngw;
#pragma unroll 2
    for (; it < nitems; it += ngw) {
        const int nb = it / nkb, kb = it - nb * nkb, n0 = nb * 32 + 4 * c, k0 = kb * 64 + 8 * r;
        if (n0 < N) {
            const float* src = W + (size_t)k0 * N + n0;
            f32x4 v[8];
#pragma unroll
            for (int i = 0; i < 8; ++i) v[i] = *(const f32x4*)(src + (size_t)i * N);
            u32x4 o;
            o.x = pk2(v[0].x, v[1].x); o.y = pk2(v[2].x, v[3].x); o.z = pk2(v[4].x, v[5].x); o.w = pk2(v[6].x, v[7].x); *(u32x4*)(WT + (size_t)map_row(map, n0) * K + k0) = o;
            o.x = pk2(v[0].y, v[1].y); o.y = pk2(v[2].y, v[3].y); o.z = pk2(v[4].y, v[5].y); o.w = pk2(v[6].y, v[7].y); *(u32x4*)(WT + (size_t)map_row(map, n0 + 1) * K + k0) = o;
            o.x = pk2(v[0].z, v[1].z); o.y = pk2(v[2].z, v[3].z); o.z = pk2(v[4].z, v[5].z); o.w = pk2(v[6].z, v[7].z); *(u32x4*)(WT + (size_t)map_row(map, n0 + 2) * K + k0) = o;
            o.x = pk2(v[0].w, v[1].w); o.y = pk2(v[2].w, v[3].w); o.z = pk2(v[4].w, v[5].w); o.w = pk2(v[6].w, v[7].w); *(u32x4*)(WT + (size_t)map_row(map, n0 + 3) * K + k0) = o;
        }
    }
    rot = (rot + nitems) % ngw;
}

DI void rmsnorm_rows(const float* X, const float* g, bf16_t* O) {
    const int tid_ = opaque_tid(), lane = tid_ & 63, gw = blockIdx.x * 8 + (tid_ >> 6), ngw = gridDim.x * 8;
    for (int r = gw; r < S; r += ngw) {
        const f32x4* xr = (const f32x4*)(X + (size_t)r * DM) + lane; f32x4 v[8]; float s = 0.f;
#pragma unroll
        for (int j = 0; j < 8; ++j) { v[j] = xr[64 * j]; s += (v[j].x * v[j].x + v[j].y * v[j].y) + (v[j].z * v[j].z + v[j].w * v[j].w); }
        const float rstd = 1.f / sqrtf(wave_sum(s) * (1.f / DM) + EPS);
        u32x2* o8 = (u32x2*)(O + (size_t)r * DM) + lane;
#pragma unroll
        for (int j = 0; j < 8; ++j) { const f32x4 gv = ((const f32x4*)g)[lane + 64 * j]; u32x2 w; w.x = pk2(v[j].x * rstd * gv.x, v[j].y * rstd * gv.y); w.y = pk2(v[j].z * rstd * gv.z, v[j].w * rstd * gv.w); o8[64 * j] = w; }
    }
}
DI void final_norm_rows(float* X, const float* g) {
    const int tid_ = opaque_tid(), lane = tid_ & 63, gw = blockIdx.x * 8 + (tid_ >> 6), ngw = gridDim.x * 8;
    for (int r = gw; r < S; r += ngw) {
        f32x4* xr = (f32x4*)(X + (size_t)r * DM) + lane; f32x4 v[8]; float s = 0.f;
#pragma unroll
        for (int j = 0; j < 8; ++j) { v[j] = xr[64 * j]; s += (v[j].x * v[j].x + v[j].y * v[j].y) + (v[j].z * v[j].z + v[j].w * v[j].w); }
        const float rstd = 1.f / sqrtf(wave_sum(s) * (1.f / DM) + EPS);
#pragma unroll
        for (int j = 0; j < 8; ++j) { const f32x4 gv = ((const f32x4*)g)[lane + 64 * j]; xr[64 * j] = v[j] * rstd * gv; }
    }
}
DI void prep_rows(bf16_t* P, const float* qn, const float* kvn, const float* cw, const float* cb, const f32x2* tab, bf16_t* XC) {
    const int tid_ = opaque_tid(), lane = tid_ & 63, gw = blockIdx.x * 8 + (tid_ >> 6), ngw = gridDim.x * 8;
    for (int t = gw; t < S; t += ngw) {
        bf16_t* row = P + (size_t)t * NP;
        unsigned wq[3], wk[2], wc[8][4];
#pragma unroll
        for (int k = 0; k < 3; ++k) wq[k] = *(const unsigned*)(row + PC_CQ + 128 * k + 2 * lane);
#pragma unroll
        for (int k = 0; k < 2; ++k) wk[k] = *(const unsigned*)(row + PC_CKV + 128 * k + 2 * lane);
        const int j = lane & 31; const float x1 = bf2f(row[PC_KR + j]), x2 = bf2f(row[PC_KR + 32 + j]); const f32x2 cs = tab[(size_t)t * 32 + j];
#pragma unroll
        for (int k = 0; k < 8; ++k)
#pragma unroll
            for (int jj = 0; jj < 4; ++jj) { const int tt = t - 3 + jj; wc[k][jj] = tt >= 0 ? *(const unsigned*)(P + (size_t)tt * NP + PC_CX + 128 * k + 2 * lane) : 0u; }
        asm volatile("" ::: "memory");
        { float s = 0.f;
#pragma unroll
          for (int k = 0; k < 3; ++k) { const float a = bflo(wq[k]), b = bfhi(wq[k]); s += a * a + b * b; }
          const float rstd = 1.f / sqrtf(wave_sum(s) * (1.f / 384.f) + EPS);
#pragma unroll
          for (int k = 0; k < 3; ++k) { const int c = 128 * k + 2 * lane; *(unsigned*)(row + PC_CQ + c) = pk2(bflo(wq[k]) * rstd * qn[c], bfhi(wq[k]) * rstd * qn[c + 1]); } }
        { float s = 0.f;
#pragma unroll
          for (int k = 0; k < 2; ++k) { const float a = bflo(wk[k]), b = bfhi(wk[k]); s += a * a + b * b; }
          const float rstd = 1.f / sqrtf(wave_sum(s) * (1.f / 256.f) + EPS);
#pragma unroll
          for (int k = 0; k < 2; ++k) { const int c = 128 * k + 2 * lane; *(unsigned*)(row + PC_CKV + c) = pk2(bflo(wk[k]) * rstd * kvn[c], bfhi(wk[k]) * rstd * kvn[c + 1]); } }
        { const unsigned o = pk2(x1 * cs.x - x2 * cs.y, x1 * cs.y + x2 * cs.x); if (lane < 32) *(unsigned*)(row + PC_KR + 2 * j) = o; }
#pragma unroll
        for (int k = 0; k < 8; ++k) { const int ch = 128 * k + 2 * lane; float a0 = cb[ch], a1 = cb[ch + 1];
#pragma unroll
            for (int jj = 0; jj < 4; ++jj) { a0 += cw[jj * 1024 + ch] * bflo(wc[k][jj]); a1 += cw[jj * 1024 + ch + 1] * bfhi(wc[k][jj]); }
            *(unsigned*)(XC + (size_t)t * 1024 + ch) = pk2(a0, a1); }
    }
}

DI void lru_p1(const bf16_t* LA, const bf16_t* U, float* CA, float* CH) {
    const int tid = opaque_tid();
    for (int c = blockIdx.x; c < 256; c += gridDim.x) {
        float h0 = 0.f, h1 = 0.f, s0 = 0.f, s1 = 0.f;
#pragma unroll 1
        for (int t0 = 0; t0 < 64; t0 += 16) {
            unsigned lw[16], uw[16];
#pragma unroll
            for (int i = 0; i < 16; ++i) { const size_t row = (size_t)c * 64 + t0 + i; lw[i] = *(const unsigned*)(LA + row * NP + 2 * tid); uw[i] = *(const unsigned*)(U + row * 1024 + 2 * tid); }
#pragma unroll
            for (int i = 0; i < 16; ++i) { const float l0 = bflo(lw[i]), l1 = bfhi(lw[i]); s0 += l0; s1 += l1; h0 = __expf(l0) * h0 + bflo(uw[i]); h1 = __expf(l1) * h1 + bfhi(uw[i]); }
        }
        CA[c * 1024 + 2 * tid] = __expf(s0); CA[c * 1024 + 2 * tid + 1] = __expf(s1); CH[c * 1024 + 2 * tid] = h0; CH[c * 1024 + 2 * tid + 1] = h1;
    }
}
DI void lru_p2(const float* CA, const float* CH, float* CARRY) {
    const int tid = opaque_tid(), lane = tid & 63, gw = blockIdx.x * 8 + (tid >> 6), ngw = gridDim.x * 8;
    for (int ch = gw; ch < 1024; ch += ngw) {
        float a[4], hh[4];
#pragma unroll
        for (int i = 0; i < 4; ++i) { a[i] = CA[(4 * lane + i) * 1024 + ch]; hh[i] = CH[(4 * lane + i) * 1024 + ch]; }
        float A = a[0], H = hh[0];
#pragma unroll
        for (int i = 1; i < 4; ++i) { H = a[i] * H + hh[i]; A = A * a[i]; }
#pragma unroll
        for (int o = 1; o < 64; o <<= 1) { const float Ap = __shfl_up(A, o), Hp = __shfl_up(H, o); if (lane >= o) { H = A * Hp + H; A = A * Ap; } }
        float st = __shfl_up(H, 1); if (lane == 0) st = 0.f;
#pragma unroll
        for (int i = 0; i < 4; ++i) { CARRY[(4 * lane + i) * 1024 + ch] = st; st = a[i] * st + hh[i]; }
    }
}
DI void lru_p3(const bf16_t* LA, const bf16_t* U, const float* CARRY, bf16_t* Y) {
    const int tid = opaque_tid();
    for (int c = blockIdx.x; c < 256; c += gridDim.x) {
        float h0 = CARRY[c * 1024 + 2 * tid], h1 = CARRY[c * 1024 + 2 * tid + 1];
#pragma unroll 1
        for (int t0 = 0; t0 < 64; t0 += 16) {
            unsigned lw[16], uw[16];
#pragma unroll
            for (int i = 0; i < 16; ++i) { const size_t row = (size_t)c * 64 + t0 + i; lw[i] = *(const unsigned*)(LA + row * NP + 2 * tid); uw[i] = *(const unsigned*)(U + row * 1024 + 2 * tid); }
            asm volatile("" ::: "memory");
#pragma unroll
            for (int i = 0; i < 16; ++i) { const size_t row = (size_t)c * 64 + t0 + i; h0 = __expf(bflo(lw[i])) * h0 + bflo(uw[i]); h1 = __expf(bfhi(lw[i])) * h1 + bfhi(uw[i]);
                *(unsigned*)(Y + row * 3072 + 2048 + 2 * tid) = pk2(h0, h1); }
            asm volatile("" ::: "memory");
        }
    }
}

DI void mlstm_a(LAS unsigned char* smem, const bf16_t* P, const float* gbias, bf16_t* CS, float* SMALL) {
    const int tid = opaque_tid(), lane = tid & 63, wid = tid >> 6, l31 = lane & 31, h = lane >> 5, q4 = (lane & 15) >> 2, p4 = lane & 3, blk = (lane >> 4) & 1;
    LAS float* sw = (LAS float*)smem;
    LAS unsigned char* Ks = smem + 1024;
    LAS unsigned char* Vs = smem + 1024 + 20480;
    for (int uid = blockIdx.x; uid < 1024; uid += gridDim.x) {
        const int c = uid >> 2, hh = uid & 3; const size_t row0 = (size_t)c * 64;
        if (wid == 0) {
            const bf16_t* r = P + (row0 + lane) * NP;
            const float li = bf2f(r[PC_I + hh]) + gbias[hh], lf = logsigmoid_(bf2f(r[PC_F + hh]) + gbias[4 + hh]);
            const float bc = wave_incl_scan(lf, lane), bt = __shfl(bc, 63), ds = bt - bc + li, M = wave_max(ds);
            sw[lane] = expf(ds - M);
            if (lane == 0) { SMALL[SM_BT + uid] = bt; SMALL[SM_MC + uid] = M; }
        }
        __syncthreads();
#pragma unroll
        for (int i = 0; i < 2; ++i) { const int id = tid + 512 * i, s = id >> 4, d8 = (id & 15) * 8; const u32x4 v = *(const u32x4*)(P + (row0 + s) * NP + PC_K + hh * 128 + d8); const float w = sw[s];
            u32x4 o; o.x = pk2(bflo(v.x) * w, bfhi(v.x) * w); o.y = pk2(bflo(v.y) * w, bfhi(v.y) * w); o.z = pk2(bflo(v.z) * w, bfhi(v.z) * w); o.w = pk2(bflo(v.w) * w, bfhi(v.w) * w);
            *(LAS u32x4*)(Ks + s * 320 + d8 * 2) = o; }
#pragma unroll
        for (int i = 0; i < 4; ++i) { const int id = tid + 512 * i, s = id >> 5, d8 = (id & 31) * 8; *(LAS u32x4*)(Vs + s * 576 + d8 * 2) = *(const u32x4*)(P + (row0 + s) * NP + PC_V + hh * 256 + d8); }
        __syncthreads();
        f32x16 acc[4];
#pragma unroll
        for (int d = 0; d < 4; ++d)
#pragma unroll
            for (int i = 0; i < 16; ++i) acc[d][i] = 0.f;
#pragma unroll
        for (int kk = 0; kk < 4; ++kk) {
            const bf16x8 vf = tr_frag(Vs + (16 * kk + 8 * h + q4) * 576 + (32 * wid + 16 * blk) * 2 + 8 * p4, 576);
#pragma unroll
            for (int d = 0; d < 4; ++d) { const bf16x8 kf = tr_frag(Ks + (16 * kk + 8 * h + q4) * 320 + (32 * d + 16 * blk) * 2 + 8 * p4, 320); acc[d] = mfma32(kf, vf, acc[d]); }
        }
        bf16_t* cs = CS + (size_t)uid * 32768 + (32 * wid + l31) * 128;
#pragma unroll
        for (int d = 0; d < 4; ++d)
#pragma unroll
            for (int g = 0; g < 4; ++g) { u32x2 w; w.x = pk2(acc[d][4 * g], acc[d][4 * g + 1]); w.y = pk2(acc[d][4 * g + 2], acc[d][4 * g + 3]); *(u32x2*)(cs + 32 * d + 8 * g + 4 * h) = w; }
        if (tid < 128) { float s = 0.f;
#pragma unroll 8
            for (int t = 0; t < 64; ++t) s += bf2f(*(LAS const bf16_t*)(Ks + t * 320 + tid * 2));
            SMALL[SM_DN + uid * 128 + tid] = s; }
        __syncthreads();
    }
}
DI void mlstm_b(LAS unsigned char* smem, bf16_t* CS, float* SMALL) {
    const int tid = opaque_tid();
    LAS float* dec = (LAS float*)smem; LAS float* inj = dec + 1024;
    LAS float* sbt = inj + 1024; LAS float* smc = sbt + 1024;
    sbt[tid] = SMALL[SM_BT + tid]; sbt[tid + 512] = SMALL[SM_BT + tid + 512]; smc[tid] = SMALL[SM_MC + tid]; smc[tid + 512] = SMALL[SM_MC + tid + 512];
    __syncthreads();
    if (tid < 4) { float m = -1e30f;
        for (int c = 0; c < 256; ++c) { const float bt = sbt[c * 4 + tid], M = smc[c * 4 + tid]; sbt[c * 4 + tid] = m;
            const float mn = fmaxf(bt + m, M); dec[tid * 256 + c] = __expf(bt + m - mn); inj[tid * 256 + c] = __expf(M - mn); m = mn; } }
    __syncthreads();
    if (blockIdx.x == 0) { SMALL[SM_MPREV + tid] = sbt[tid]; SMALL[SM_MPREV + tid + 512] = sbt[tid + 512]; }
    for (int e = blockIdx.x * 512 + tid; e < 131072; e += gridDim.x * 512) {
        const int hh = e >> 15, idx = e & 32767; bf16_t* pp = CS + (size_t)hh * 32768 + idx; float st = 0.f;
        bf16_t d[32];
#pragma unroll
        for (int i = 0; i < 32; ++i) d[i] = pp[(size_t)i * 131072];
#pragma unroll 1
        for (int c0 = 0; c0 < 256; c0 += 32) {
            bf16_t dn[32];
            const int cn = c0 + 32 < 256 ? c0 + 32 : c0;
#pragma unroll
            for (int i = 0; i < 32; ++i) dn[i] = pp[(size_t)(cn + i) * 131072];
            asm volatile("" ::: "memory");
#pragma unroll
            for (int i = 0; i < 32; ++i) { pp[(size_t)(c0 + i) * 131072] = f2bf(st); st = dec[hh * 256 + c0 + i] * st + inj[hh * 256 + c0 + i] * bf2f(d[i]); }
            asm volatile("" ::: "memory");
#pragma unroll
            for (int i = 0; i < 32; ++i) d[i] = dn[i];
        }
    }
    if (blockIdx.x == gridDim.x - 1) { const int hh = tid >> 7; float* pp = SMALL + SM_DN + tid; float st = 0.f;
#pragma unroll 1
        for (int c0 = 0; c0 < 256; c0 += 32) {
            float d[32];
#pragma unroll
            for (int i = 0; i < 32; ++i) d[i] = pp[(c0 + i) * 512];
            asm volatile("" ::: "memory");
#pragma unroll
            for (int i = 0; i < 32; ++i) { pp[(c0 + i) * 512] = st; st = dec[hh * 256 + c0 + i] * st + inj[hh * 256 + c0 + i] * d[i]; }
            asm volatile("" ::: "memory");
        } }
    __syncthreads();
}
DI void mlstm_c(LAS unsigned char* smem, const bf16_t* P, const float* gbias, const float* onorm, const bf16_t* CS, const float* SMALL, bf16_t* Y) {
    const int tid = opaque_tid(), lane = tid & 63, wid = tid >> 6, l31 = lane & 31, h = lane >> 5, q4 = (lane & 15) >> 2, p4 = lane & 3, blk = (lane >> 4) & 1;
    LAS float* sbc = (LAS float*)smem; LAS float* sav = sbc + 64; LAS float* snp = sbc + 128; LAS float* sx = sbc + 256;
    LAS unsigned char* Qs = smem + 2048;
    LAS unsigned char* Ks = Qs + 17408;
    LAS unsigned char* Vs = Ks + 17408;
    const int tb = wid & 1, dvq = wid >> 1, t = 32 * tb + l31, pr = pi32(l31);
    for (int uid = blockIdx.x; uid < 1024; uid += gridDim.x) {
        const int c = uid >> 2, hh = uid & 3; const size_t row0 = (size_t)c * 64;
        if (wid == 0) {
            const bf16_t* r = P + (row0 + lane) * NP;
            const float li = bf2f(r[PC_I + hh]) + gbias[hh], lf = logsigmoid_(bf2f(r[PC_F + hh]) + gbias[4 + hh]);
            const float bc = wave_incl_scan(lf, lane);
            sbc[lane] = bc; sav[lane] = li - bc;
        }
        if (tid >= 64 && tid < 192) snp[tid - 64] = SMALL[SM_DN + uid * 128 + tid - 64];
#pragma unroll
        for (int i = 0; i < 2; ++i) { const int id = tid + 512 * i, s = id >> 4, d8 = (id & 15) * 8;
            *(LAS u32x4*)(Qs + s * 272 + d8 * 2) = *(const u32x4*)(P + (row0 + s) * NP + PC_Q + hh * 128 + d8);
            *(LAS u32x4*)(Ks + s * 272 + d8 * 2) = *(const u32x4*)(P + (row0 + s) * NP + PC_K + hh * 128 + d8); }
#pragma unroll
        for (int i = 0; i < 4; ++i) { const int id = tid + 512 * i, s = id >> 5, d8 = (id & 31) * 8; *(LAS u32x4*)(Vs + s * 576 + d8 * 2) = *(const u32x4*)(P + (row0 + s) * NP + PC_V + hh * 256 + d8); }
        __syncthreads();
        const float mprev = SMALL[SM_MPREV + uid];
        bf16x8 qf[8];
#pragma unroll
        for (int ks = 0; ks < 8; ++ks) qf[ks] = *(const LAS bf16x8*)(Qs + t * 272 + (16 * ks + 8 * h) * 2);
        f32x16 st0, st1;
#pragma unroll
        for (int i = 0; i < 16; ++i) { st0[i] = 0.f; st1[i] = 0.f; }
#pragma unroll
        for (int ks = 0; ks < 8; ++ks) { const bf16x8 a0 = *(const LAS bf16x8*)(Ks + pr * 272 + (16 * ks + 8 * h) * 2); st0 = mfma32(a0, qf[ks], st0);
            if (tb) { const bf16x8 a1 = *(const LAS bf16x8*)(Ks + (32 + pr) * 272 + (16 * ks + 8 * h) * 2); st1 = mfma32(a1, qf[ks], st1); } }
        const float bt = sbc[t];
        float mx = -1e30f;
#pragma unroll
        for (int i = 0; i < 16; ++i) { const int s = 16 * (i >> 3) + 8 * h + (i & 7); if (s <= t) mx = fmaxf(mx, sav[s]); if (tb) mx = fmaxf(mx, (s + 32 <= t) ? sav[s + 32] : -1e30f); }
        mx = fmaxf(mx, __shfl_xor(mx, 32));
        const float mt = bt + fmaxf(mprev, mx);
        float den = 0.f;
#pragma unroll
        for (int i = 0; i < 16; ++i) { const int s = 16 * (i >> 3) + 8 * h + (i & 7);
            const float w0 = (s <= t) ? __expf(bt + sav[s] - mt) * MQS : 0.f; st0[i] *= w0; den += st0[i];
            const float w1 = (tb && (s + 32 <= t)) ? __expf(bt + sav[s + 32] - mt) * MQS : 0.f; st1[i] *= w1; den += st1[i]; }
        den += __shfl_xor(den, 32);
        float qn = 0.f;
#pragma unroll
        for (int ks = 0; ks < 8; ++ks)
#pragma unroll
            for (int j = 0; j < 8; ++j) qn += bf2f((bf16_t)qf[ks][j]) * snp[16 * ks + 8 * h + j];
        qn += __shfl_xor(qn, 32);
        const float wi = expf(bt + mprev - mt) * MQS;
        den += wi * qn;
        const float dinv = 1.f / fmaxf(fabsf(den), expf(-mt));
        bf16x8 pf[4];
        pf[0] = pack8(st0[0], st0[1], st0[2], st0[3], st0[4], st0[5], st0[6], st0[7]); pf[1] = pack8(st0[8], st0[9], st0[10], st0[11], st0[12], st0[13], st0[14], st0[15]);
        pf[2] = pack8(st1[0], st1[1], st1[2], st1[3], st1[4], st1[5], st1[6], st1[7]); pf[3] = pack8(st1[8], st1[9], st1[10], st1[11], st1[12], st1[13], st1[14], st1[15]);
        float hv[2][16]; float ss = 0.f;
#pragma unroll
        for (int db = 0; db < 2; ++db) { const int dvb = 2 * dvq + db;
            f32x16 a1, a2;
#pragma unroll
            for (int i = 0; i < 16; ++i) { a1[i] = 0.f; a2[i] = 0.f; }
#pragma unroll
            for (int sb = 0; sb < 2; ++sb)
#pragma unroll
                for (int kk = 0; kk < 2; ++kk) { if (sb <= tb) { const bf16x8 vf = tr_frag(Vs + (32 * sb + 16 * kk + 8 * h + q4) * 576 + (32 * dvb + 16 * blk) * 2 + 8 * p4, 576); a1 = mfma32(vf, pf[2 * sb + kk], a1); } }
            const bf16_t* cp = CS + (size_t)uid * 32768 + (32 * dvb + l31) * 128 + 8 * h;
#pragma unroll
            for (int ks = 0; ks < 8; ++ks) { const bf16x8 cf = *(const bf16x8*)(cp + 16 * ks); a2 = mfma32(cf, qf[ks], a2); }
#pragma unroll
            for (int i = 0; i < 16; ++i) { const float v = (a1[i] + wi * a2[i]) * dinv; hv[db][i] = v; ss += v * v; }
        }
        ss += __shfl_xor(ss, 32);
        if (h == 0) sx[(tb * 4 + dvq) * 32 + l31] = ss;
        __syncthreads();
        const float tot = (sx[(tb * 4 + 0) * 32 + l31] + sx[(tb * 4 + 1) * 32 + l31]) + (sx[(tb * 4 + 2) * 32 + l31] + sx[(tb * 4 + 3) * 32 + l31]);
        const float rstd = 1.f / sqrtf(tot * (1.f / 256.f) + EPS);
#pragma unroll
        for (int db = 0; db < 2; ++db)
#pragma unroll
            for (int g = 0; g < 4; ++g) { const int col = hh * 256 + 32 * (2 * dvq + db) + 8 * g + 4 * h;
                const f32x4 gn = *(const f32x4*)(onorm + col); const u32x2 og = *(const u32x2*)(P + (row0 + t) * NP + PC_O + col);
                const float o0 = hv[db][4 * g] * rstd * gn.x * sigmoidf_(bflo(og.x)), o1 = hv[db][4 * g + 1] * rstd * gn.y * sigmoidf_(bfhi(og.x));
                const float o2 = hv[db][4 * g + 2] * rstd * gn.z * sigmoidf_(bflo(og.y)), o3 = hv[db][4 * g + 3] * rstd * gn.w * sigmoidf_(bfhi(og.y));
                u32x2 w; w.x = pk2(o0, o1); w.y = pk2(o2, o3); *(u32x2*)(Y + (row0 + t) * 3072 + col) = w; }
        __syncthreads();
    }
}

DI void attn_unit(LAS unsigned char* smem, int hh, int qb, const bf16_t* Q, const bf16_t* KN, const bf16_t* P, const bf16_t* VT, bf16_t* Y) {
    const int tid = opaque_tid(), lane = tid & 63, wid = __builtin_amdgcn_readfirstlane(tid >> 6), l31 = lane & 31, h = lane >> 5;
    LAS unsigned char* Kb = smem; LAS unsigned char* Vb = smem + 51200;
    const int q0 = qb * 256, qw = q0 + 32 * wid, q = qw + l31, NT = 4 * qb + 4;
    bf16x8 qf[12];
#pragma unroll
    for (int ks = 0; ks < 12; ++ks) qf[ks] = *(const bf16x8*)(Q + (size_t)q * 1536 + hh * 192 + 16 * ks + 8 * h);
    f32x16 o[4];
#pragma unroll
    for (int d = 0; d < 4; ++d)
#pragma unroll
        for (int i = 0; i < 16; ++i) o[d][i] = 0.f;
    float mref = 0.f, lrun = 0.f; bool first = true;
    const bf16_t* ksrc0; const bf16_t* ksrc2; const bf16_t* vsrc0; int kdst0, kdst2, vdst0;
    { const int row = tid >> 4, ch = tid & 15; ksrc0 = KN + (size_t)row * 1024 + hh * 128 + 8 * ch; kdst0 = row * 400 + ch * 16; }
    { const int row = tid >> 3, ch = tid & 7; ksrc2 = P + (size_t)row * NP + PC_KR + 8 * ch; kdst2 = row * 400 + 256 + ch * 16; }
    { const int d = tid >> 3, ch = tid & 7; vsrc0 = VT + (size_t)(hh * 128 + d) * S + 8 * ch; vdst0 = d * 144 + ch * 16; }
    u32x4 kr[3], vr[2];
#define ATT_LOAD(tt) do { kr[0] = *(const u32x4*)(ksrc0 + (size_t)(tt) * 65536); kr[1] = *(const u32x4*)(ksrc0 + (size_t)(tt) * 65536 + 32 * 1024); kr[2] = *(const u32x4*)(ksrc2 + (size_t)(tt) * (64 * NP)); \
        vr[0] = *(const u32x4*)(vsrc0 + (size_t)(tt) * 64); vr[1] = *(const u32x4*)(vsrc0 + (size_t)(tt) * 64 + (size_t)64 * S); } while (0)
#define ATT_WRITE(kbuf, vslot) do { *(LAS u32x4*)(Kb + (kbuf) * 25600 + kdst0) = kr[0]; *(LAS u32x4*)(Kb + (kbuf) * 25600 + kdst0 + 32 * 400) = kr[1]; *(LAS u32x4*)(Kb + (kbuf) * 25600 + kdst2) = kr[2]; \
        *(LAS u32x4*)(Vb + (vslot) * 18432 + vdst0) = vr[0]; *(LAS u32x4*)(Vb + (vslot) * 18432 + vdst0 + 64 * 144) = vr[1]; } while (0)
#define ATT_BAR() do { asm volatile("s_waitcnt lgkmcnt(0)" ::: "memory"); __builtin_amdgcn_s_barrier(); asm volatile("" ::: "memory"); } while (0)
    ATT_LOAD(0);
    ATT_WRITE(0, 0);
    ATT_BAR();
    const int koff = pi32(l31) * 400 + 16 * h, voff = l31 * 144 + 16 * h;
#define SB() __builtin_amdgcn_sched_barrier(0)
#define KFR(kb, ks, b) (*(const LAS bf16x8*)((kb) + (b) * 32 * 400 + (ks) * 32))
#define VFR(vb, d, kk) (*(const LAS bf16x8*)((vb) + (d) * 32 * 144 + (kk) * 32))
    int vs = 0;
    for (int t = 0; t < NT; ++t) {
        const int kc = t & 1, vn = vs == 2 ? 0 : vs + 1;
        if (t + 1 < NT) ATT_LOAD(t + 1);
        if (64 * t <= qw + 31) {
            LAS const unsigned char* kb = Kb + kc * 25600 + koff; LAS const unsigned char* vb = Vb + vs * 18432 + voff;
            f32x16 s0, s1;
#pragma unroll
            for (int i = 0; i < 16; ++i) { s0[i] = 0.f; s1[i] = 0.f; }
            bf16x8 fa[4], fb[4];
            fa[0] = KFR(kb, 0, 0); fa[1] = KFR(kb, 0, 1); fa[2] = KFR(kb, 1, 0); fa[3] = KFR(kb, 1, 1); SB();
#pragma unroll
            for (int st = 0; st < 6; st += 2) {
                fb[0] = KFR(kb, 2 * st + 2, 0); fb[1] = KFR(kb, 2 * st + 2, 1); fb[2] = KFR(kb, 2 * st + 3, 0); fb[3] = KFR(kb, 2 * st + 3, 1); SB();
                s0 = mfma32(fa[0], qf[2 * st], s0); s1 = mfma32(fa[1], qf[2 * st], s1); s0 = mfma32(fa[2], qf[2 * st + 1], s0); s1 = mfma32(fa[3], qf[2 * st + 1], s1); SB();
                if (st + 2 < 6) { fa[0] = KFR(kb, 2 * st + 4, 0); fa[1] = KFR(kb, 2 * st + 4, 1); fa[2] = KFR(kb, 2 * st + 5, 0); fa[3] = KFR(kb, 2 * st + 5, 1); }
                else { fa[0] = VFR(vb, 0, 0); fa[1] = VFR(vb, 0, 1); fa[2] = VFR(vb, 0, 2); fa[3] = VFR(vb, 0, 3); }
                SB();
                s0 = mfma32(fb[0], qf[2 * st + 2], s0); s1 = mfma32(fb[1], qf[2 * st + 2], s1); s0 = mfma32(fb[2], qf[2 * st + 3], s0); s1 = mfma32(fb[3], qf[2 * st + 3], s1); SB();
            }
            if (64 * t + 63 > qw) {
#pragma unroll
                for (int i = 0; i < 16; ++i) { const int kv = 64 * t + 16 * (i >> 3) + 8 * h + (i & 7); if (kv > q) s0[i] = -1e30f; if (kv + 32 > q) s1[i] = -1e30f; }
            }
            float mx = fmaxf(s0[0], s1[0]);
#pragma unroll
            for (int i = 1; i < 16; ++i) mx = fmaxf(mx, fmaxf(s0[i], s1[i]));
            mx = fmaxf(mx, __shfl_xor(mx, 32));
            if (first || __any(mx - mref > 8.f)) {
                const float dl = first ? mx : fmaxf(mx - mref, 0.f);
                mref += dl;
                if (!first) { const float f = __builtin_amdgcn_exp2f(-dl); lrun *= f;
#pragma unroll
                    for (int d = 0; d < 4; ++d)
#pragma unroll
                        for (int i = 0; i < 16; ++i) o[d][i] *= f; }
                first = false; }
            float rs = 0.f;
#pragma unroll
            for (int i = 0; i < 16; ++i) { s0[i] = __builtin_amdgcn_exp2f(s0[i] - mref); s1[i] = __builtin_amdgcn_exp2f(s1[i] - mref); rs += s0[i] + s1[i]; }
            lrun += rs;
            bf16x8 pf[4];
            pf[0] = pack8(s0[0], s0[1], s0[2], s0[3], s0[4], s0[5], s0[6], s0[7]); pf[1] = pack8(s0[8], s0[9], s0[10], s0[11], s0[12], s0[13], s0[14], s0[15]);
            pf[2] = pack8(s1[0], s1[1], s1[2], s1[3], s1[4], s1[5], s1[6], s1[7]); pf[3] = pack8(s1[8], s1[9], s1[10], s1[11], s1[12], s1[13], s1[14], s1[15]);
            SB();
            fb[0] = VFR(vb, 1, 0); fb[1] = VFR(vb, 1, 1); fb[2] = VFR(vb, 1, 2); fb[3] = VFR(vb, 1, 3); SB();
            o[0] = mfma32(fa[0], pf[0], o[0]); o[0] = mfma32(fa[1], pf[1], o[0]); o[0] = mfma32(fa[2], pf[2], o[0]); o[0] = mfma32(fa[3], pf[3], o[0]); SB();
            fa[0] = VFR(vb, 2, 0); fa[1] = VFR(vb, 2, 1); fa[2] = VFR(vb, 2, 2); fa[3] = VFR(vb, 2, 3); SB();
            o[1] = mfma32(fb[0], pf[0], o[1]); o[1] = mfma32(fb[1], pf[1], o[1]); o[1] = mfma32(fb[2], pf[2], o[1]); o[1] = mfma32(fb[3], pf[3], o[1]); SB();
            fb[0] = VFR(vb, 3, 0); fb[1] = VFR(vb, 3, 1); fb[2] = VFR(vb, 3, 2); fb[3] = VFR(vb, 3, 3); SB();
            o[2] = mfma32(fa[0], pf[0], o[2]); o[2] = mfma32(fa[1], pf[1], o[2]); o[2] = mfma32(fa[2], pf[2], o[2]); o[2] = mfma32(fa[3], pf[3], o[2]); SB();
            o[3] = mfma32(fb[0], pf[0], o[3]); o[3] = mfma32(fb[1], pf[1], o[3]); o[3] = mfma32(fb[2], pf[2], o[3]); o[3] = mfma32(fb[3], pf[3], o[3]); SB();
        }
        if (t + 1 < NT) ATT_WRITE(kc ^ 1, vn);
        ATT_BAR();
        vs = vn;
    }
#undef SB
#undef KFR
#undef VFR
#undef ATT_LOAD
#undef ATT_WRITE
#undef ATT_BAR
    lrun += __shfl_xor(lrun, 32);
    const float inv = 1.f / lrun;
    bf16_t* yp = Y + (size_t)q * 3072 + 1024 + hh * 128 + 4 * h;
#pragma unroll
    for (int d = 0; d < 4; ++d)
#pragma unroll
        for (int g = 0; g < 4; ++g) { u32x2 w; w.x = pk2(o[d][4 * g] * inv, o[d][4 * g + 1] * inv); w.y = pk2(o[d][4 * g + 2] * inv, o[d][4 * g + 3] * inv); *(u32x2*)(yp + 32 * d + 8 * g) = w; }
}

#define XB_TMO      128
#define XB_XCNT(j)  (256  + 64 * (j))
#define XB_XSUB(j)  (1280 + 64 * (j))
#define XB_XGEN(j)  (2304 + 64 * (j))
#define XB_TOP      3328
#define XB_TOPGEN   3392
#define XCD_BAR_WORDS 3456
#define XB_SPIN_CAP (1u << 23)
DI unsigned xb_ld(unsigned* p)              { return __hip_atomic_load(p, __ATOMIC_RELAXED, __HIP_MEMORY_SCOPE_AGENT); }
DI unsigned xb_add(unsigned* p, unsigned v) { return __hip_atomic_fetch_add(p, v, __ATOMIC_RELAXED, __HIP_MEMORY_SCOPE_AGENT); }
DI unsigned xb_xcc_id() { return (unsigned)__builtin_amdgcn_s_getreg((3 << 11) | 20) & 0xFu; }
#define XB_SPIN(cond, bar) do { unsigned _sp = 0; while (cond) { __builtin_amdgcn_s_sleep(1); \
    if ((++_sp & 255u) == 0u) { if (xb_ld(&(bar)[XB_TMO])) break; if (_sp > XB_SPIN_CAP) { atomicAdd(&(bar)[XB_TMO], 1u); break; } } } } while (0)
struct XcdBarrier { unsigned* bar; unsigned x; volatile LAS unsigned* st; };
DI XcdBarrier xcd_barrier_post(unsigned* bar, volatile LAS unsigned* st) {
    XcdBarrier b; b.bar = bar; b.x = xb_xcc_id(); b.st = st;
    if (threadIdx.x == 0) (void)xb_add(&bar[XB_XCNT(b.x)], 1u);
    return b;
}
DI void xcd_barrier_complete(unsigned* bar, unsigned x, unsigned& nloc, unsigned& nx) {
    const unsigned G = gridDim.x * gridDim.y * gridDim.z;
    unsigned sum, cnt, mine, sp = 0u;
    for (;;) {
        sum = 0u; cnt = 0u; mine = 0u;
#pragma unroll
        for (unsigned j = 0; j < 16; ++j) { const unsigned c = xb_ld(&bar[XB_XCNT(j)]); sum += c; cnt += (c > 0u) ? 1u : 0u; mine = (j == x) ? c : mine; }
        if (sum == G) break;
        __builtin_amdgcn_s_sleep(1);
        if ((++sp & 255u) == 0u) { if (xb_ld(&bar[XB_TMO])) break; if (sp > XB_SPIN_CAP) { atomicAdd(&bar[XB_TMO], 1u); break; } }
    }
    nloc = mine > 0u ? mine : 1u; nx = cnt > 0u ? cnt : 1u;
}
DI void xcd_barrier(const XcdBarrier& b) {
    asm volatile("s_waitcnt vmcnt(0)" ::: "memory");
    __syncthreads();
    if (threadIdx.x == 0) {
        unsigned* bar = b.bar;
        __builtin_amdgcn_s_waitcnt(0);
        unsigned nloc = b.st[0], nx = b.st[1];
        if (nloc == 0u) { xcd_barrier_complete(bar, b.x, nloc, nx); b.st[0] = nloc; b.st[1] = nx; }
        const unsigned old = xb_add(&bar[XB_XSUB(b.x)], 1u);
        const unsigned gen = old / nloc;
        if (old + 1u == (gen + 1u) * nloc) {
            __builtin_amdgcn_fence(__ATOMIC_RELEASE, "agent");
            asm volatile("s_waitcnt vmcnt(0)" ::: "memory");
            const unsigned og = xb_add(&bar[XB_TOP], 1u);
            const unsigned tg = og / nx;
            if (og + 1u == (tg + 1u) * nx) xb_add(&bar[XB_TOPGEN], 1u);
            else XB_SPIN(xb_ld(&bar[XB_TOPGEN]) == tg, bar);
            __builtin_amdgcn_fence(__ATOMIC_ACQUIRE, "agent");
            xb_add(&bar[XB_XGEN(b.x)], 1u);
            asm volatile("s_waitcnt vmcnt(0)" ::: "memory");
        } else {
            XB_SPIN(xb_ld(&bar[XB_XGEN(b.x)]) == gen, bar);
            __builtin_amdgcn_fence(__ATOMIC_ACQUIRE, "agent");
            asm volatile("s_waitcnt vmcnt(0)" ::: "memory");
        }
    }
    __syncthreads();
}

struct Params { const float* in[27]; float* out; unsigned char* ws; };

__global__ void __launch_bounds__(512, 2) mega_fwd(Params p) {
    extern __shared__ __attribute__((aligned(16))) unsigned char smem_raw[];
    LAS unsigned char* smem = (LAS unsigned char*)smem_raw;
    cg::grid_group grid = cg::this_grid();
    const int G = gridDim.x, bx = blockIdx.x;
    { const int t0 = opaque_tid(); if (t0 < 128) ((LAS unsigned*)(smem + 131072))[t0] = 0u; }
    __syncthreads();
    XcdBarrier bar = xcd_barrier_post((unsigned*)(p.ws + WS_CTL), (volatile LAS unsigned*)(smem + 131072) + 8);
    unsigned char* ws = p.ws;
    f32x2* TAB = (f32x2*)(ws + WS_TAB); float* SMALL = (float*)(ws + WS_SMALL);
    bf16_t* WFFGU = (bf16_t*)(ws + WS_WFFGU); bf16_t* WFFD = (bf16_t*)(ws + WS_WFFD); bf16_t* WIN = (bf16_t*)(ws + WS_WIN); bf16_t* WUQ = (bf16_t*)(ws + WS_WUQ);
    bf16_t* WUKV = (bf16_t*)(ws + WS_WUKV); bf16_t* WLRU = (bf16_t*)(ws + WS_WLRU); bf16_t* WBR = (bf16_t*)(ws + WS_WBR); bf16_t* WOUT = (bf16_t*)(ws + WS_WOUT);
    bf16_t* XN = (bf16_t*)(ws + WS_XN); bf16_t* P = (bf16_t*)(ws + WS_P); bf16_t* Hb = P; bf16_t* Qb = (bf16_t*)(ws + WS_Q); bf16_t* KN = (bf16_t*)(ws + WS_KN);
    bf16_t* VT = (bf16_t*)(ws + WS_VT); bf16_t* Y = (bf16_t*)(ws + WS_Y); bf16_t* XC = (bf16_t*)(ws + WS_XC); bf16_t* CS = (bf16_t*)(ws + WS_CS);

    for (int i = bx * 512 + opaque_tid(); i < S * 32; i += G * 512) { const int t = i >> 5, j = i & 31; const float ang = (float)t * INVF[j];
        double r = (double)ang * 0.15915494309189535; r -= __builtin_floor(r); const float fr = (float)r;
        TAB[i] = (f32x2){__builtin_amdgcn_cosf(fr), __builtin_amdgcn_sinf(fr)}; }

#pragma unroll 1
    for (int hl = 0; hl < 4; ++hl) {
        const int l = hl >> 1, second = hl & 1;
        const float* xin = hl == 0 ? p.in[0] : p.out;
        {
            const int nmat = second ? 3 : 26; int rot = 0;
#pragma unroll 1
            for (int mi = 0; mi < nmat; ++mi) {
                const float* src; int K, N, map; bf16_t* dst;
                if (mi == 0) { src = p.in[second ? 23 : 2] + (size_t)l * DM * FF; K = DM; N = FF; map = 1; dst = WFFGU; }
                else if (mi == 1) { src = p.in[second ? 24 : 3] + (size_t)l * DM * FF; K = DM; N = FF; map = 2; dst = WFFGU; }
                else if (mi == 2) { src = p.in[second ? 25 : 4] + (size_t)l * DM * FF; K = FF; N = DM; map = 0; dst = WFFD; }
                else if (mi == 3) { src = p.in[6] + (size_t)l * DM * NIN; K = DM; N = NIN; map = 3; dst = WIN; }
                else if (mi == 4) { src = p.in[10] + (size_t)l * 384 * 1536; K = 384; N = 1536; map = 4; dst = WUQ; }
                else if (mi == 5) { src = p.in[12] + (size_t)l * 256 * 2048; K = 256; N = 2048; map = 5; dst = WUKV; }
                else if (mi < 22) { const int k = mi - 6, n = k >> 1, wx = k & 1; src = p.in[wx ? 17 : 15] + (size_t)l * 131072 + n * 16384; K = 128; N = 128; map = 0; dst = WLRU + (size_t)(n * 256 + wx * 128) * 128; }
                else if (mi < 25) { const int j = mi - 22; src = p.in[20] + (size_t)l * 3 * 1024 * 2048 + (size_t)j * 1024 * 2048; K = 1024; N = 2048; map = 0; dst = WBR + (size_t)j * 2048 * 1024; }
                else { src = p.in[21] + (size_t)l * DM * DM; K = DM; N = DM; map = 0; dst = WOUT; }
                convert_mat(src, K, N, dst, map, rot);
            }
            rmsnorm_rows(xin, p.in[second ? 22 : 1] + l * DM, XN);
        }
        if (hl == 0) grid.sync(); else xcd_barrier(bar);
        { pg8::Gemm g{XN, WFFGU, S, 2 * FF, DM, DM, DM, 0}; pg8::StaticOrder so; so.init(S, 2 * FF, G, bx); pg8::EpiSwiglu E{Hb}; pg8::gemm_phase(smem, g, so, E); }
        xcd_barrier(bar);
        { pg8::Gemm g{Hb, WFFD, S, DM, FF, FF, FF, 0}; pg8::StaticOrder so; so.init(S, DM, G, bx); pg8::EpiRes E{xin, p.out, 0.5f}; pg8::gemm_phase(smem, g, so, E); }
        xcd_barrier(bar);
        if (!second) {
            const float* gbias = p.in[7] + l * 8;
            rmsnorm_rows(p.out, p.in[5] + l * DM, XN);
            xcd_barrier(bar);
            { pg8::Gemm g{XN, WIN, S, NP, DM, DM, DM, 0}; pg8::StaticOrder so; so.init(S, NP, G, bx); pg8::EpiStore E{P, NP}; pg8::gemm_phase(smem, g, so, E); }
            xcd_barrier(bar);
            if (bx == G - 1) { const float* lam = p.in[19] + l * 1024; for (int ch = opaque_tid(); ch < 1024; ch += 512) SMALL[SM_SP + ch] = -8.f * log1pf(expf(-lam[ch])); }
            mlstm_a(smem, P, gbias, CS, SMALL);
            prep_rows(P, p.in[9] + l * 384, p.in[11] + l * 256, p.in[13] + l * 4096, p.in[14] + l * 1024, TAB, XC);
            xcd_barrier(bar);
            mlstm_b(smem, CS, SMALL);
            { pg8::Gemm g{P + PC_CQ, WUQ, S, 1536, 384, NP, 384, 0}; pg8::StaticOrder so; so.init(S, 1536, G, bx); pg8::EpiQ E{Qb, TAB}; pg8::gemm_phase(smem, g, so, E); }
#pragma unroll 1
            for (int gi = 0; gi < 2; ++gi) {
                pg8::Gemm g; pg8::StaticOrder so; pg8::EpiStore E;
                if (gi == 0) { g = pg8::Gemm{P + PC_CKV, WUKV, S, 1024, 256, NP, 256, 0}; so.init(S, 1024, G, bx); E = pg8::EpiStore{KN, 1024}; }
                else { g = pg8::Gemm{WUKV + 1024 * 256, P + PC_CKV, 1024, S, 256, 256, NP, 0}; so.init(1024, S, G, bx); E = pg8::EpiStore{VT, S}; }
                pg8::gemm_phase(smem, g, so, E);
            }
            { pg8::Gemm g{XC, WLRU, S, 2048, 128, 1024, 128, 128}; pg8::StaticOrder so; so.init(S, 2048, G, bx); pg8::EpiLru E{XC, P + PC_CX, p.in[16] + l * 1024, p.in[18] + l * 1024, SMALL + SM_SP}; pg8::gemm_phase(smem, g, so, E); }
            xcd_barrier(bar);
            mlstm_c(smem, P, gbias, p.in[8] + l * 1024, CS, SMALL, Y);
            lru_p1(P + PC_CX, XC, SMALL + SM_CA, SMALL + SM_CH);
            xcd_barrier(bar);
            lru_p2(SMALL + SM_CA, SMALL + SM_CH, SMALL + SM_CARRY);
            for (int item = bx; item < 256; item += G) { const int hh = item & 7, pp = item >> 3;
#pragma unroll 1
                for (int half = 0; half < 2; ++half) attn_unit(smem, hh, half ? 63 - pp : pp, Qb, KN, P, VT, Y); }
            xcd_barrier(bar);
            lru_p3(P + PC_CX, XC, SMALL + SM_CARRY, Y);
#pragma unroll 1
            for (int j = 0; j < 3; ++j) {
                if (j == 2) xcd_barrier(bar);
                pg8::Gemm g{Y + j * 1024, WBR + (size_t)j * 2048 * 1024, S, DM, 1024, 3072, 1024, 0}; pg8::StaticOrder so; so.init(S, DM, G, bx); pg8::EpiMerge E{XN, P + PC_G + j * 2048, j == 0}; pg8::gemm_phase(smem, g, so, E);
            }
            xcd_barrier(bar);
            { pg8::Gemm g{XN, WOUT, S, DM, DM, DM, DM, 0}; pg8::StaticOrder so; so.init(S, DM, G, bx); pg8::EpiRes E{p.out, p.out, 1.0f}; pg8::gemm_phase(smem, g, so, E); }
            xcd_barrier(bar);
        }
    }
    final_norm_rows(p.out, p.in[26]);
}

constexpr int LDS_BYTES = 143360;

extern "C" void kernel_launch(void* const* d_in, const int* in_sizes, int n_in, void* d_out, int out_size, void* d_ws, size_t ws_size, hipStream_t stream) {
    static int grid = 0;
    if (grid == 0) {
        if (n_in != 27 || out_size != S * DM || ws_size < WS_END) { fprintf(stderr, "kernel_launch: unexpected problem (n_in %d out %d ws %zu, need %zu)\n", n_in, out_size, ws_size, (size_t)WS_END); grid = -1; return; }
        int dev = 0, cus = 0, per_cu = 0;
        hipGetDevice(&dev); hipDeviceGetAttribute(&cus, hipDeviceAttributeMultiprocessorCount, dev);
        if (hipFuncSetAttribute((const void*)mega_fwd, hipFuncAttributeMaxDynamicSharedMemorySize, LDS_BYTES) != hipSuccess) { fprintf(stderr, "kernel_launch: hipFuncSetAttribute failed\n"); grid = -1; return; }
        if (hipOccupancyMaxActiveBlocksPerMultiprocessor(&per_cu, (const void*)mega_fwd, 512, LDS_BYTES) != hipSuccess || per_cu < 1) { fprintf(stderr, "kernel_launch: occupancy query says %d\n", per_cu); per_cu = 1; }
        (void)hipGetLastError();
        grid = cus * (per_cu > 1 ? 1 : per_cu);
    }
    if (grid < 0) return;
    if (hipMemsetAsync((char*)d_ws + WS_CTL, 0, CTL_BYTES, stream) != hipSuccess) { fprintf(stderr, "kernel_launch: memset failed\n"); return; }
    Params p{};
    for (int i = 0; i < 27; ++i) p.in[i] = (const float*)d_in[i];
    p.out = (float*)d_out; p.ws = (unsigned char*)d_ws;
    void* args[] = {&p};
    hipError_t e = hipLaunchCooperativeKernel((const void*)mega_fwd, dim3(grid), dim3(512), args, LDS_BYTES, stream);
    if (e != hipSuccess) fprintf(stderr, "cooperative launch failed: %s (grid %d)\n", hipGetErrorString(e), grid);
}
```

```cpp
#include <hip/hip_runtime.h>
#include <hip/hip_cooperative_groups.h>
#include <cstdio>
#include <cstdint>
namespace cg = cooperative_groups;

#define DI __device__ __forceinline__
#define LAS __attribute__((address_space(3)))
typedef unsigned short bf16_t;
typedef short bf16x8 __attribute__((ext_vector_type(8)));
typedef short s16x4 __attribute__((ext_vector_type(4)));
typedef float f32x2 __attribute__((ext_vector_type(2)));
typedef float f32x4 __attribute__((ext_vector_type(4)));
typedef float f32x16 __attribute__((ext_vector_type(16)));
typedef unsigned u32x2 __attribute__((ext_vector_type(2)));
typedef unsigned u32x4 __attribute__((ext_vector_type(4)));
typedef __bf16 bf16x2_t __attribute__((ext_vector_type(2)));

constexpr int S = 16384, DM = 2048, FF = 5632, NIN = 10952, NP = 11008;
constexpr float EPS = 1e-6f;
constexpr int PC_Q = 0, PC_K = 512, PC_V = 1024, PC_O = 2048, PC_CQ = 3072, PC_CKV = 3456, PC_KR = 3712, PC_CX = 3776, PC_G = 4800, PC_I = 10944, PC_F = 10948;
constexpr float MQS = 0.08838834764831845f;
constexpr float AQS = 0.07216878364870322f * 1.4426950408889634f;

constexpr size_t MiB = 1u << 20;
constexpr size_t WS_TAB = 0;
constexpr size_t WS_SMALL = 4 * MiB;
constexpr size_t WS_WFFGU = 12 * MiB;
constexpr size_t WS_WFFD = 56 * MiB;
constexpr size_t WS_WIN = 78 * MiB;
constexpr size_t WS_WUQ = 121 * MiB;
constexpr size_t WS_WUKV = 123 * MiB;
constexpr size_t WS_WLRU = 124 * MiB;
constexpr size_t WS_WBR = 125 * MiB;
constexpr size_t WS_WOUT = 137 * MiB;
constexpr size_t WS_XN = 145 * MiB;
constexpr size_t WS_P = 209 * MiB;
constexpr size_t WS_Q = 553 * MiB;
constexpr size_t WS_KN = 601 * MiB;
constexpr size_t WS_VT = 633 * MiB;
constexpr size_t WS_Y = 665 * MiB;
constexpr size_t WS_XC = 761 * MiB;
constexpr size_t WS_CS = 793 * MiB;
constexpr size_t WS_END = 857 * MiB;
constexpr size_t WS_CTL = 11 * MiB, CTL_BYTES = 16384;
constexpr int SM_BT = 0, SM_MC = 1024, SM_MPREV = 2048, SM_DN = 4096  , SM_CA = 4096 + 131072  , SM_CH = SM_CA + 262144, SM_CARRY = SM_CH + 262144, SM_SP = SM_CARRY + 262144;

__device__ const float INVF[32] = {1.0f, 0.7498942613601685f, 0.5623413324356079f, 0.4216965138912201f, 0.3162277638912201f, 0.23713737726211548f, 0.17782793939113617f, 0.133352130651474f, 0.10000000149011612f, 0.07498941570520401f, 0.05623413249850273f, 0.04216965287923813f, 0.03162277489900589f, 0.023713737726211548f, 0.017782794311642647f, 0.01333521492779255f, 0.009999999776482582f, 0.007498941849917173f, 0.005623413249850273f, 0.0042169648222625256f, 0.003162277629598975f, 0.00237137358635664f, 0.0017782794311642647f, 0.0013335214462131262f, 0.0010000000474974513f, 0.0007498942431993783f, 0.000562341301701963f, 0.0004216965171508491f, 0.0003162277571391314f, 0.00023713737027719617f, 0.00017782794020604342f, 0.0001333521504420787f};

DI int opaque_tid() { int t = threadIdx.x; asm volatile("" : "+v"(t)); return t; }
DI float bf2f(bf16_t v) { return __uint_as_float((unsigned)v << 16); }
DI float bflo(unsigned w) { return __uint_as_float(w << 16); }
DI float bfhi(unsigned w) { return __uint_as_float(w & 0xffff0000u); }
DI unsigned pk2(float lo, float hi) { f32x2 v = {lo, hi}; bf16x2_t b = __builtin_convertvector(v, bf16x2_t); return __builtin_bit_cast(unsigned, b); }
DI bf16_t f2bf(float f) { return (bf16_t)(pk2(f, 0.f) & 0xffffu); }
DI float wave_sum(float v) {
#pragma unroll
    for (int o = 1; o < 64; o <<= 1) v += __shfl_xor(v, o);
    return v;
}
DI float wave_max(float v) {
#pragma unroll
    for (int o = 1; o < 64; o <<= 1) v = fmaxf(v, __shfl_xor(v, o));
    return v;
}
DI float wave_incl_scan(float v, int lane) {
#pragma unroll
    for (int o = 1; o < 64; o <<= 1) { const float n = __shfl_up(v, o); if (lane >= o) v += n; }
    return v;
}
DI float sigmoidf_(float x) { return __builtin_amdgcn_rcpf(1.f + __expf(-x)); }
DI float logsigmoid_(float x) { return fminf(x, 0.f) - log1pf(expf(-fabsf(x))); }
DI f32x16 mfma32(bf16x8 a, bf16x8 b, f32x16 c) { return __builtin_amdgcn_mfma_f32_32x32x16_bf16(a, b, c, 0, 0, 0); }
DI int crow(int r, int h) { return (r & 3) + 8 * (r >> 2) + 4 * h; }
DI int pi32(int m) { return (m & ~12) | ((m & 4) << 1) | ((m & 8) >> 1); }
typedef short v4i16_t __attribute__((ext_vector_type(4)));
DI s16x4 tr16(LAS const unsigned char* p) { return __builtin_bit_cast(s16x4, __builtin_amdgcn_ds_read_tr16_b64_v4i16((LAS v4i16_t*)p)); }
DI bf16x8 tr_frag(LAS const unsigned char* p, int rs) {
    const s16x4 lo = tr16(p), hi = tr16(p + 4 * rs);
    return __builtin_shufflevector(lo, hi, 0, 1, 2, 3, 4, 5, 6, 7);
}
DI bf16x8 pack8(float a0, float a1, float a2, float a3, float a4, float a5, float a6, float a7) {
    u32x4 w; w.x = pk2(a0, a1); w.y = pk2(a2, a3); w.z = pk2(a4, a5); w.w = pk2(a6, a7); return __builtin_bit_cast(bf16x8, w);
}

namespace pg8 {
constexpr int BM = 256, BK = 64, HALF = 128, HTB = HALF * BK * 2, STAGE_BYTES = 8 * HTB, NXCD = 8, WGM = 8;
DI int lds_byte(int r, int c) { const int st = (r >> 4) * 2 + (c >> 5), rr = r & 15, cc = c & 31, ob = rr * 64 + cc * 2; return st * 1024 + (ob ^ (((ob >> 9) & 1) << 5)); }
DI void stage_rc(int b, int& R, int& C) { const int st = b / 1024, sb = b % 1024, swz = sb ^ (((sb >> 9) & 1) << 5); R = (st >> 1) * 16 + swz / 64; C = (st & 1) * 32 + (swz % 64) / 2; }
DI int perm32(int rho) { const int n = rho >> 4, i = rho & 15; return 8 * (i >> 2) + 4 * n + (i & 3); }
struct Unit { int pm, pn; };
struct Gemm { const bf16_t* A; const bf16_t* Bt; int M, N, K, lda, ldb, apn; };
struct StaticOrder {
    int nM, nN, nwg, G, c;
    DI void init(int M, int N, int G_, int c_) { nM = M / BM; nN = N / BM; nwg = nM * nN; G = G_; c = c_; }
    DI bool next(int i, Unit& u) const {
        const long L = (long)i * G + c; if (L >= nwg) return false;
        int wgid = (int)L; { const int q = nwg / NXCD, r = nwg % NXCD, xcd = wgid % NXCD, off = wgid / NXCD; wgid = (xcd < r ? xcd * (q + 1) : r * (q + 1) + (xcd - r) * q) + off; }
        const int nig = WGM * nN, gid = wgid / nig, fm = gid * WGM, gsz = (nM - fm) < WGM ? (nM - fm) : WGM;
        u.pm = fm + ((wgid % nig) % gsz); u.pn = (wgid % nig) / gsz; return true;
    }
};
template <class Epi>
DI void gemm_phase(LAS unsigned char* lds, const Gemm g, const StaticOrder& S, const Epi& E) {
    const int tid = opaque_tid(), wid = __builtin_amdgcn_readfirstlane(tid >> 6), lane = tid & 63, wr = wid >> 2, wc = wid & 3, fr = lane & 15, fq = lane >> 4;
    int K = g.K; asm volatile("" : "+s"(K)); const int nt = K / BK;
    unsigned voffA[2], voffB[2];
#pragma unroll
    for (int i = 0; i < 2; ++i) { int R, C; stage_rc(tid * 16 + i * 8192, R, C); const int Rb = Epi::PERM ? ((R & ~31) + perm32(R & 31)) : R;
        voffA[i] = (unsigned)(R * g.lda + C) * 2u; voffB[i] = (unsigned)(Rb * g.ldb + C) * 2u; }
    const size_t kstep = (size_t)(BK * 2);
    const size_t hstepA = (size_t)HALF * g.lda * 2, hstepB = (size_t)HALF * g.ldb * 2;
    const unsigned ldsw = (unsigned)wid * 1024u;
    const int aoff = lds_byte(wr * 64 + fr, fq * 8), boff = lds_byte(wc * 32 + fr, fq * 8);
#define PG8_SA(b, h) (((b) * 2 + (h)) * HTB)
#define PG8_SB(b, h) ((4 + (b) * 2 + (h)) * HTB)
#define PG8_STAGE(bufoff, gbase, voff) do { _Pragma("unroll") for (int _i = 0; _i < 2; ++_i) \
        __builtin_amdgcn_global_load_lds((const unsigned*)((const char*)(gbase) + (voff)[_i]), (LAS unsigned*)(lds + (bufoff) + ldsw + _i * 8192), 16, 0, 0); } while (0)
#define PG8_LDA(dst, b, h) do { _Pragma("unroll") for (int m = 0; m < 4; ++m) _Pragma("unroll") for (int k = 0; k < 2; ++k) dst[m][k] = *(const LAS bf16x8*)(lds + PG8_SA(b, h) + aoff + m * 2048 + k * 1024); } while (0)
#define PG8_LDB(dst, b, h) do { _Pragma("unroll") for (int n = 0; n < 2; ++n) _Pragma("unroll") for (int k = 0; k < 2; ++k) dst[n][k] = *(const LAS bf16x8*)(lds + PG8_SB(b, h) + boff + n * 2048 + k * 1024); } while (0)
#define PG8_MMA(ai, bj, At, Bt) do { __builtin_amdgcn_s_setprio(1); _Pragma("unroll") for (int m = 0; m < 4; ++m) _Pragma("unroll") for (int n = 0; n < 2; ++n) _Pragma("unroll") for (int k = 0; k < 2; ++k) \
        acc[ai][bj][m][n] = __builtin_amdgcn_mfma_f32_16x16x32_bf16(Bt[n][k], At[m][k], acc[ai][bj][m][n], 0, 0, 0); __builtin_amdgcn_s_setprio(0); } while (0)
#define PG8_WAIT_V(n) asm volatile("s_waitcnt vmcnt(" #n ")" ::: "memory")
#define PG8_WAIT_L(n) asm volatile("s_waitcnt lgkmcnt(" #n ")" ::: "memory")
#define PG8_BAR __builtin_amdgcn_s_barrier()
#define PG8_SCHED __builtin_amdgcn_sched_barrier(0)
#define PG8_APTR(u) ((const char*)g.A + (size_t)(u).pm * 2 * hstepA + (size_t)(u).pn * (size_t)g.apn * 2)
#define PG8_BPTR(u) ((const char*)g.Bt + (size_t)(u).pn * 2 * hstepB)
    Unit cur, nxt; int ui = 0;
    if (!S.next(0, cur)) return;
    f32x4 acc[2][2][4][2];
#pragma unroll
    for (int a = 0; a < 2; ++a)
#pragma unroll
        for (int b = 0; b < 2; ++b)
#pragma unroll
            for (int m = 0; m < 4; ++m)
#pragma unroll
                for (int n = 0; n < 2; ++n) acc[a][b][m][n] = (f32x4){0.f, 0.f, 0.f, 0.f};
    bf16x8 At[4][2], B0[2][2], B1[2][2];
    const char* cA = PG8_APTR(cur); const char* cB = PG8_BPTR(cur);
    PG8_STAGE(PG8_SB(0, 0), cB, voffB); PG8_STAGE(PG8_SB(0, 1), cB + hstepB, voffB); PG8_STAGE(PG8_SA(0, 0), cA, voffA); PG8_STAGE(PG8_SA(0, 1), cA + hstepA, voffA);
    if (wr == 1) PG8_BAR;
    PG8_WAIT_V(2); PG8_BAR;
    PG8_STAGE(PG8_SB(1, 0), cB + kstep, voffB); PG8_STAGE(PG8_SA(1, 0), cA + kstep, voffA); PG8_STAGE(PG8_SB(1, 1), cB + hstepB + kstep, voffB);
    PG8_WAIT_V(6); PG8_BAR;
    for (;;) {
        const bool has_next = S.next(ui + 1, nxt);
        const char* nA = has_next ? PG8_APTR(nxt) : cA; const char* nB = has_next ? PG8_BPTR(nxt) : cB;
        for (int t = 0; t < nt; t += 2) {
            const bool last = (t == nt - 2);
            const char* a1 = cA + (size_t)(t + 1) * kstep;
            const char* a2 = last ? nA : cA + (size_t)(t + 2) * kstep; const char* b2 = last ? nB : cB + (size_t)(t + 2) * kstep;
            const char* a3 = a2 + kstep; const char* b3 = b2 + kstep;
            PG8_LDB(B0, 0, 0); PG8_LDB(B1, 0, 1); PG8_SCHED; PG8_LDA(At, 0, 0); PG8_STAGE(PG8_SA(1, 1), a1 + hstepA, voffA);
            PG8_WAIT_V(8); PG8_WAIT_L(0); PG8_BAR; PG8_MMA(0, 0, At, B0); PG8_MMA(0, 1, At, B1); PG8_BAR; PG8_SCHED;
            PG8_LDA(At, 0, 1); PG8_STAGE(PG8_SB(0, 0), b2, voffB); PG8_STAGE(PG8_SB(0, 1), b2 + hstepB, voffB); PG8_STAGE(PG8_SA(0, 0), a2, voffA);
            PG8_WAIT_V(8); PG8_WAIT_L(0); PG8_BAR; PG8_MMA(1, 0, At, B0); PG8_MMA(1, 1, At, B1); PG8_BAR; PG8_SCHED;
            PG8_LDB(B0, 1, 0); PG8_LDB(B1, 1, 1); PG8_SCHED; PG8_LDA(At, 1, 0); PG8_STAGE(PG8_SA(0, 1), a2 + hstepA, voffA);
            PG8_WAIT_V(8); PG8_WAIT_L(0); PG8_BAR; PG8_MMA(0, 0, At, B0); PG8_MMA(0, 1, At, B1); PG8_BAR; PG8_SCHED;
            PG8_LDA(At, 1, 1); PG8_STAGE(PG8_SB(1, 0), b3, voffB); PG8_STAGE(PG8_SB(1, 1), b3 + hstepB, voffB); PG8_STAGE(PG8_SA(1, 0), a3, voffA);
            PG8_WAIT_V(8); PG8_WAIT_L(0); PG8_BAR; PG8_MMA(1, 0, At, B0); PG8_MMA(1, 1, At, B1); PG8_BAR; PG8_SCHED;
        }
        if (wr == 0) PG8_BAR;
        E(acc, cur, wr, wc, fr, fq);
        if (!has_next) break;
#pragma unroll
        for (int a = 0; a < 2; ++a)
#pragma unroll
            for (int b = 0; b < 2; ++b)
#pragma unroll
                for (int m = 0; m < 4; ++m)
#pragma unroll
                    for (int n = 0; n < 2; ++n) acc[a][b][m][n] = (f32x4){0.f, 0.f, 0.f, 0.f};
        cur = nxt; cA = nA; cB = nB; ++ui;
        if (wr == 1) PG8_BAR;
    }
    PG8_WAIT_V(0);
    PG8_BAR;
#undef PG8_SA
#undef PG8_SB
#undef PG8_STAGE
#undef PG8_LDA
#undef PG8_LDB
#undef PG8_MMA
#undef PG8_WAIT_V
#undef PG8_WAIT_L
#undef PG8_BAR
#undef PG8_SCHED
#undef PG8_APTR
#undef PG8_BPTR
}

typedef f32x4 Acc[2][2][4][2];
struct EpiStore {
    static constexpr bool PERM = true;
    bf16_t* O; int ldc;
    DI void operator()(const Acc& acc, const Unit& u, int wr, int wc, int fr, int fq) const {
        const int row0 = u.pm * BM + wr * 64 + fr, col0 = u.pn * BM + wc * 32 + 8 * fq;
#pragma unroll
        for (int ai = 0; ai < 2; ++ai)
#pragma unroll
            for (int m = 0; m < 4; ++m) { bf16_t* rowp = O + (size_t)(row0 + ai * HALF + m * 16) * ldc + col0;
#pragma unroll
                for (int bj = 0; bj < 2; ++bj) { const f32x4 v0 = acc[ai][bj][m][0], v1 = acc[ai][bj][m][1];
                    u32x4 w; w.x = pk2(v0[0], v0[1]); w.y = pk2(v0[2], v0[3]); w.z = pk2(v1[0], v1[1]); w.w = pk2(v1[2], v1[3]);
                    *(u32x4*)(rowp + bj * HALF) = w; } }
    }
};
struct EpiSwiglu {
    static constexpr bool PERM = true;
    bf16_t* H;
    DI void operator()(const Acc& acc, const Unit& u, int wr, int wc, int fr, int fq) const {
        const int row0 = u.pm * BM + wr * 64 + fr, col0 = u.pn * HALF + wc * 32 + 8 * fq;
#pragma unroll
        for (int ai = 0; ai < 2; ++ai)
#pragma unroll
            for (int m = 0; m < 4; ++m) { bf16_t* rowp = H + (size_t)(row0 + ai * HALF + m * 16) * FF + col0;
                float o[8];
#pragma unroll
                for (int n = 0; n < 2; ++n)
#pragma unroll
                    for (int j = 0; j < 4; ++j) { const float gt = acc[ai][0][m][n][j], up = acc[ai][1][m][n][j]; o[n * 4 + j] = gt * sigmoidf_(gt) * up; }
                u32x4 w; w.x = pk2(o[0], o[1]); w.y = pk2(o[2], o[3]); w.z = pk2(o[4], o[5]); w.w = pk2(o[6], o[7]);
                *(u32x4*)rowp = w; }
    }
};
struct EpiRes {
    static constexpr bool PERM = false;
    const float* xin; float* xout; float alpha;
    DI void operator()(const Acc& acc, const Unit& u, int wr, int wc, int fr, int fq) const {
        const int col0 = u.pn * BM + wc * 32 + 4 * fq;
#pragma unroll
        for (int ai = 0; ai < 2; ++ai) {
            f32x4 b[4][2][2];
#pragma unroll
            for (int m = 0; m < 4; ++m) { const size_t off = (size_t)(u.pm * BM + ai * HALF + wr * 64 + m * 16 + fr) * DM + col0;
#pragma unroll
                for (int bj = 0; bj < 2; ++bj)
#pragma unroll
                    for (int n = 0; n < 2; ++n) b[m][bj][n] = *(const f32x4*)(xin + off + bj * HALF + n * 16); }
            __builtin_amdgcn_sched_barrier(0);
#pragma unroll
            for (int m = 0; m < 4; ++m) { const size_t off = (size_t)(u.pm * BM + ai * HALF + wr * 64 + m * 16 + fr) * DM + col0;
#pragma unroll
                for (int bj = 0; bj < 2; ++bj)
#pragma unroll
                    for (int n = 0; n < 2; ++n) *(f32x4*)(xout + off + bj * HALF + n * 16) = b[m][bj][n] + acc[ai][bj][m][n] * alpha; }
            __builtin_amdgcn_sched_barrier(0);
        }
    }
};
struct EpiQ {
    static constexpr bool PERM = true;
    bf16_t* Q; const f32x2* tab;
    DI void operator()(const Acc& acc, const Unit& u, int wr, int wc, int fr, int fq) const {
        const int row0 = u.pm * BM + wr * 64 + fr;
#pragma unroll
        for (int bj = 0; bj < 2; ++bj) {
            const int c0 = u.pn * BM + bj * HALF + wc * 32 + 8 * fq; const int hh = c0 / 192, dd = c0 - hh * 192; const bool rope = dd >= 128; const int j0 = (dd - 128) >> 1;
#pragma unroll
            for (int ai = 0; ai < 2; ++ai)
#pragma unroll
                for (int m = 0; m < 4; ++m) { const int row = row0 + ai * HALF + m * 16;
                    float v[8];
#pragma unroll
                    for (int n = 0; n < 2; ++n)
#pragma unroll
                        for (int j = 0; j < 4; ++j) v[n * 4 + j] = acc[ai][bj][m][n][j];
                    if (rope) {
#pragma unroll
                        for (int p = 0; p < 4; ++p) { const f32x2 cs = tab[(size_t)row * 32 + j0 + p]; const float x1 = v[2 * p], x2 = v[2 * p + 1]; v[2 * p] = x1 * cs.x - x2 * cs.y; v[2 * p + 1] = x1 * cs.y + x2 * cs.x; }
                    }
                    u32x4 w; w.x = pk2(v[0] * AQS, v[1] * AQS); w.y = pk2(v[2] * AQS, v[3] * AQS); w.z = pk2(v[4] * AQS, v[5] * AQS); w.w = pk2(v[6] * AQS, v[7] * AQS);
                    *(u32x4*)(Q + (size_t)row * 1536 + c0) = w; }
        }
    }
};
struct EpiLru {
    static constexpr bool PERM = true;
    bf16_t* XC; bf16_t* LA; const float* ba; const float* bx; const float* sp;
    DI void operator()(const Acc& acc, const Unit& u, int wr, int wc, int fr, int fq) const {
        const int row0 = u.pm * BM + wr * 64 + fr, ch0 = u.pn * HALF + wc * 32 + 8 * fq;
#pragma unroll
        for (int ai = 0; ai < 2; ++ai) {
            u32x4 xall[4];
#pragma unroll
            for (int m = 0; m < 4; ++m) xall[m] = *(const u32x4*)(XC + (size_t)(row0 + ai * HALF + m * 16) * 1024 + ch0);
            __builtin_amdgcn_sched_barrier(0);
#pragma unroll
            for (int m = 0; m < 4; ++m) { const int row = row0 + ai * HALF + m * 16;
                const u32x4 xw = xall[m];
                const float xv[8] = {bflo(xw.x), bfhi(xw.x), bflo(xw.y), bfhi(xw.y), bflo(xw.z), bfhi(xw.z), bflo(xw.w), bfhi(xw.w)};
                u32x4 wl, wu;
#pragma unroll
                for (int n = 0; n < 2; ++n) { const f32x4 spv = *(const f32x4*)(sp + ch0 + 4 * n), bav = *(const f32x4*)(ba + ch0 + 4 * n), bxv = *(const f32x4*)(bx + ch0 + 4 * n);
                    float la[4], uu[4];
#pragma unroll
                    for (int j = 0; j < 4; ++j) { const float r = sigmoidf_(acc[ai][0][m][n][j] + bav[j]), gi = sigmoidf_(acc[ai][1][m][n][j] + bxv[j]);
                        const float l = r * spv[j]; la[j] = l; const float a2 = __expf(2.f * l); uu[j] = sqrtf(fmaxf(1.f - a2, 0.f)) * gi * xv[n * 4 + j]; }
                    if (n == 0) { wl.x = pk2(la[0], la[1]); wl.y = pk2(la[2], la[3]); wu.x = pk2(uu[0], uu[1]); wu.y = pk2(uu[2], uu[3]); }
                    else { wl.z = pk2(la[0], la[1]); wl.w = pk2(la[2], la[3]); wu.z = pk2(uu[0], uu[1]); wu.w = pk2(uu[2], uu[3]); } }
                *(u32x4*)(LA + (size_t)row * NP + ch0) = wl;
                *(u32x4*)(XC + (size_t)row * 1024 + ch0) = wu;
                asm volatile("" ::: "memory"); }
        }
    }
};
struct EpiMerge {
    static constexpr bool PERM = true;
    bf16_t* Z; const bf16_t* G; int first;
    DI void operator()(const Acc& acc, const Unit& u, int wr, int wc, int fr, int fq) const {
        const int row0 = u.pm * BM + wr * 64 + fr, col0 = u.pn * BM + wc * 32 + 8 * fq;
#pragma unroll
        for (int ai = 0; ai < 2; ++ai) {
            u32x4 gw[4][2], zw[4][2];
#pragma unroll
            for (int m = 0; m < 4; ++m) { const int row = row0 + ai * HALF + m * 16;
#pragma unroll
                for (int bj = 0; bj < 2; ++bj) { const int c = col0 + bj * HALF; gw[m][bj] = *(const u32x4*)(G + (size_t)row * NP + c);
                    zw[m][bj] = first ? (u32x4){0u, 0u, 0u, 0u} : *(const u32x4*)(Z + (size_t)row * DM + c); } }
            __builtin_amdgcn_sched_barrier(0);
#pragma unroll
            for (int m = 0; m < 4; ++m) { const int row = row0 + ai * HALF + m * 16;
#pragma unroll
                for (int bj = 0; bj < 2; ++bj) { const int c = col0 + bj * HALF;
                    const u32x4 g4 = gw[m][bj], z4 = zw[m][bj];
                    const float gv[8] = {bflo(g4.x), bfhi(g4.x), bflo(g4.y), bfhi(g4.y), bflo(g4.z), bfhi(g4.z), bflo(g4.w), bfhi(g4.w)};
                    const float zv[8] = {bflo(z4.x), bfhi(z4.x), bflo(z4.y), bfhi(z4.y), bflo(z4.z), bfhi(z4.z), bflo(z4.w), bfhi(z4.w)};
                    float o[8];
#pragma unroll
                    for (int n = 0; n < 2; ++n)
#pragma unroll
                        for (int j = 0; j < 4; ++j) o[n * 4 + j] = zv[n * 4 + j] + sigmoidf_(gv[n * 4 + j]) * acc[ai][bj][m][n][j];
                    u32x4 w; w.x = pk2(o[0], o[1]); w.y = pk2(o[2], o[3]); w.z = pk2(o[4], o[5]); w.w = pk2(o[6], o[7]);
                    *(u32x4*)(Z + (size_t)row * DM + c) = w; } }
            __builtin_amdgcn_sched_barrier(0);
        }
    }
};
}

DI int map_row(int map, int n) {
    switch (map) {
        case 1: return ((n >> 7) << 8) + (n & 127);
        case 2: return ((n >> 7) << 8) + 128 + (n & 127);
        case 3: { if (n < 2048) return n; if (n < 2052) return PC_I + n - 2048; if (n < 2056) return PC_F + n - 2052; if (n < 3080) return PC_O + n - 2056; if (n < 3464) return PC_CQ + n - 3080;
                  if (n < 3720) return PC_CKV + n - 3464; if (n < 3784) return PC_KR + n - 3720; if (n < 4808) return PC_CX + n - 3784; return PC_G + n - 4808; }
        case 4: { const int hh = n / 192, dd = n - hh * 192; if (dd < 128) return n; const int jj = dd - 128; return hh * 192 + 128 + (jj < 32 ? 2 * jj : 2 * (jj - 32) + 1); }
        case 5: { const int hh = n >> 8, dd = n & 255; return dd < 128 ? hh * 128 + dd : 1024 + hh * 128 + dd - 128; }
        default: return n;
    }
}
DI void convert_mat(const float* W, int K, int N, bf16_t* WT, int map, int& rot) {
    const int tid_ = opaque_tid(), lane = tid_ & 63, gw = blockIdx.x * 8 + (tid_ >> 6), ngw = gridDim.x * 8, r = lane >> 3, c = lane & 7;
    const int nnb = (N + 31) >> 5, nkb = K >> 6, nitems = nnb * nkb;
    int it = gw - rot; if (it < 0) it += ngw;
#pragma unroll 2
    for (; it < nitems; it += ngw) {
        const int nb = it / nkb, kb = it - nb * nkb, n0 = nb * 32 + 4 * c, k0 = kb * 64 + 8 * r;
        if (n0 < N) {
            const float* src = W + (size_t)k0 * N + n0;
            f32x4 v[8];
#pragma unroll
            for (int i = 0; i < 8; ++i) v[i] = *(const f32x4*)(src + (size_t)i * N);
            u32x4 o;
            o.x = pk2(v[0].x, v[1].x); o.y = pk2(v[2].x, v[3].x); o.z = pk2(v[4].x, v[5].x); o.w = pk2(v[6].x, v[7].x); *(u32x4*)(WT + (size_t)map_row(map, n0) * K + k0) = o;
            o.x = pk2(v[0].y, v[1].y); o.y = pk2(v[2].y, v[3].y); o.z = pk2(v[4].y, v[5].y); o.w = pk2(v[6].y, v[7].y); *(u32x4*)(WT + (size_t)map_row(map, n0 + 1) * K + k0) = o;
            o.x = pk2(v[0].z, v[1].z); o.y = pk2(v[2].z, v[3].z); o.z = pk2(v[4].z, v[5].z); o.w = pk2(v[6].z, v[7].z); *(u32x4*)(WT + (size_t)map_row(map, n0 + 2) * K + k0) = o;
            o.x = pk2(v[0].w, v[1].w); o.y = pk2(v[2].w, v[3].w); o.z = pk2(v[4].w, v[5].w); o.w = pk2(v[6].w, v[7].w); *(u32x4*)(WT + (size_t)map_row(map, n0 + 3) * K + k0) = o;
        }
    }
    rot = (rot + nitems) % ngw;
}

DI void rmsnorm_rows(const float* X, const float* g, bf16_t* O) {
    const int tid_ = opaque_tid(), lane = tid_ & 63, gw = blockIdx.x * 8 + (tid_ >> 6), ngw = gridDim.x * 8;
    for (int r = gw; r < S; r += ngw) {
        const f32x4* xr = (const f32x4*)(X + (size_t)r * DM) + lane; f32x4 v[8]; float s = 0.f;
#pragma unroll
        for (int j = 0; j < 8; ++j) { v[j] = xr[64 * j]; s += (v[j].x * v[j].x + v[j].y * v[j].y) + (v[j].z * v[j].z + v[j].w * v[j].w); }
        const float rstd = 1.f / sqrtf(wave_sum(s) * (1.f / DM) + EPS);
        u32x2* o8 = (u32x2*)(O + (size_t)r * DM) + lane;
#pragma unroll
        for (int j = 0; j < 8; ++j) { const f32x4 gv = ((const f32x4*)g)[lane + 64 * j]; u32x2 w; w.x = pk2(v[j].x * rstd * gv.x, v[j].y * rstd * gv.y); w.y = pk2(v[j].z * rstd * gv.z, v[j].w * rstd * gv.w); o8[64 * j] = w; }
    }
}
DI void final_norm_rows(float* X, const float* g) {
    const int tid_ = opaque_tid(), lane = tid_ & 63, gw = blockIdx.x * 8 + (tid_ >> 6), ngw = gridDim.x * 8;
    for (int r = gw; r < S; r += ngw) {
        f32x4* xr = (f32x4*)(X + (size_t)r * DM) + lane; f32x4 v[8]; float s = 0.f;
#pragma unroll
        for (int j = 0; j < 8; ++j) { v[j] = xr[64 * j]; s += (v[j].x * v[j].x + v[j].y * v[j].y) + (v[j].z * v[j].z + v[j].w * v[j].w); }
        const float rstd = 1.f / sqrtf(wave_sum(s) * (1.f / DM) + EPS);
#pragma unroll
        for (int j = 0; j < 8; ++j) { const f32x4 gv = ((const f32x4*)g)[lane + 64 * j]; xr[64 * j] = v[j] * rstd * gv; }
    }
}
DI void prep_rows(bf16_t* P, const float* qn, const float* kvn, const float* cw, const float* cb, const f32x2* tab, bf16_t* XC) {
    const int tid_ = opaque_tid(), lane = tid_ & 63, gw = blockIdx.x * 8 + (tid_ >> 6), ngw = gridDim.x * 8;
    for (int t = gw; t < S; t += ngw) {
        bf16_t* row = P + (size_t)t * NP;
        unsigned wq[3], wk[2], wc[8][4];
#pragma unroll
        for (int k = 0; k < 3; ++k) wq[k] = *(const unsigned*)(row + PC_CQ + 128 * k + 2 * lane);
#pragma unroll
        for (int k = 0; k < 2; ++k) wk[k] = *(const unsigned*)(row + PC_CKV + 128 * k + 2 * lane);
        const int j = lane & 31; const float x1 = bf2f(row[PC_KR + j]), x2 = bf2f(row[PC_KR + 32 + j]); const f32x2 cs = tab[(size_t)t * 32 + j];
#pragma unroll
        for (int k = 0; k < 8; ++k)
#pragma unroll
            for (int jj = 0; jj < 4; ++jj) { const int tt = t - 3 + jj; wc[k][jj] = tt >= 0 ? *(const unsigned*)(P + (size_t)tt * NP + PC_CX + 128 * k + 2 * lane) : 0u; }
        asm volatile("" ::: "memory");
        { float s = 0.f;
#pragma unroll
          for (int k = 0; k < 3; ++k) { const float a = bflo(wq[k]), b = bfhi(wq[k]); s += a * a + b * b; }
          const float rstd = 1.f / sqrtf(wave_sum(s) * (1.f / 384.f) + EPS);
#pragma unroll
          for (int k = 0; k < 3; ++k) { const int c = 128 * k + 2 * lane; *(unsigned*)(row + PC_CQ + c) = pk2(bflo(wq[k]) * rstd * qn[c], bfhi(wq[k]) * rstd * qn[c + 1]); } }
        { float s = 0.f;
#pragma unroll
          for (int k = 0; k < 2; ++k) { const float a = bflo(wk[k]), b = bfhi(wk[k]); s += a * a + b * b; }
          const float rstd = 1.f / sqrtf(wave_sum(s) * (1.f / 256.f) + EPS);
#pragma unroll
          for (int k = 0; k < 2; ++k) { const int c = 128 * k + 2 * lane; *(unsigned*)(row + PC_CKV + c) = pk2(bflo(wk[k]) * rstd * kvn[c], bfhi(wk[k]) * rstd * kvn[c + 1]); } }
        { const unsigned o = pk2(x1 * cs.x - x2 * cs.y, x1 * cs.y + x2 * cs.x); if (lane < 32) *(unsigned*)(row + PC_KR + 2 * j) = o; }
#pragma unroll
        for (int k = 0; k < 8; ++k) { const int ch = 128 * k + 2 * lane; float a0 = cb[ch], a1 = cb[ch + 1];
#pragma unroll
            for (int jj = 0; jj < 4; ++jj) { a0 += cw[jj * 1024 + ch] * bflo(wc[k][jj]); a1 += cw[jj * 1024 + ch + 1] * bfhi(wc[k][jj]); }
            *(unsigned*)(XC + (size_t)t * 1024 + ch) = pk2(a0, a1); }
    }
}

DI void lru_p1(const bf16_t* LA, const bf16_t* U, float* CA, float* CH) {
    const int tid = opaque_tid();
    for (int c = blockIdx.x; c < 256; c += gridDim.x) {
        float h0 = 0.f, h1 = 0.f, s0 = 0.f, s1 = 0.f;
#pragma unroll 1
        for (int t0 = 0; t0 < 64; t0 += 16) {
            unsigned lw[16], uw[16];
#pragma unroll
            for (int i = 0; i < 16; ++i) { const size_t row = (size_t)c * 64 + t0 + i; lw[i] = *(const unsigned*)(LA + row * NP + 2 * tid); uw[i] = *(const unsigned*)(U + row * 1024 + 2 * tid); }
#pragma unroll
            for (int i = 0; i < 16; ++i) { const float l0 = bflo(lw[i]), l1 = bfhi(lw[i]); s0 += l0; s1 += l1; h0 = __expf(l0) * h0 + bflo(uw[i]); h1 = __expf(l1) * h1 + bfhi(uw[i]); }
        }
        CA[c * 1024 + 2 * tid] = __expf(s0); CA[c * 1024 + 2 * tid + 1] = __expf(s1); CH[c * 1024 + 2 * tid] = h0; CH[c * 1024 + 2 * tid + 1] = h1;
    }
}
DI void lru_p2(const float* CA, const float* CH, float* CARRY) {
    const int tid = opaque_tid(), lane = tid & 63, gw = blockIdx.x * 8 + (tid >> 6), ngw = gridDim.x * 8;
    for (int ch = gw; ch < 1024; ch += ngw) {
        float a[4], hh[4];
#pragma unroll
        for (int i = 0; i < 4; ++i) { a[i] = CA[(4 * lane + i) * 1024 + ch]; hh[i] = CH[(4 * lane + i) * 1024 + ch]; }
        float A = a[0], H = hh[0];
#pragma unroll
        for (int i = 1; i < 4; ++i) { H = a[i] * H + hh[i]; A = A * a[i]; }
#pragma unroll
        for (int o = 1; o < 64; o <<= 1) { const float Ap = __shfl_up(A, o), Hp = __shfl_up(H, o); if (lane >= o) { H = A * Hp + H; A = A * Ap; } }
        float st = __shfl_up(H, 1); if (lane == 0) st = 0.f;
#pragma unroll
        for (int i = 0; i < 4; ++i) { CARRY[(4 * lane + i) * 1024 + ch] = st; st = a[i] * st + hh[i]; }
    }
}
DI void lru_p3(const bf16_t* LA, const bf16_t* U, const float* CARRY, bf16_t* Y) {
    const int tid = opaque_tid();
    for (int c = blockIdx.x; c < 256; c += gridDim.x) {
        float h0 = CARRY[c * 1024 + 2 * tid], h1 = CARRY[c * 1024 + 2 * tid + 1];
#pragma unroll 1
        for (int t0 = 0; t0 < 64; t0 += 16) {
            unsigned lw[16], uw[16];
#pragma unroll
            for (int i = 0; i < 16; ++i) { const size_t row = (size_t)c * 64 + t0 + i; lw[i] = *(const unsigned*)(LA + row * NP + 2 * tid); uw[i] = *(const unsigned*)(U + row * 1024 + 2 * tid); }
            asm volatile("" ::: "memory");
#pragma unroll
            for (int i = 0; i < 16; ++i) { const size_t row = (size_t)c * 64 + t0 + i; h0 = __expf(bflo(lw[i])) * h0 + bflo(uw[i]); h1 = __expf(bfhi(lw[i])) * h1 + bfhi(uw[i]);
                *(unsigned*)(Y + row * 3072 + 2048 + 2 * tid) = pk2(h0, h1); }
            asm volatile("" ::: "memory");
        }
    }
}

DI void mlstm_a(LAS unsigned char* smem, const bf16_t* P, const float* gbias, bf16_t* CS, float* SMALL) {
    const int tid = opaque_tid(), lane = tid & 63, wid = tid >> 6, l31 = lane & 31, h = lane >> 5, q4 = (lane & 15) >> 2, p4 = lane & 3, blk = (lane >> 4) & 1;
    LAS float* sw = (LAS float*)smem;
    LAS unsigned char* Ks = smem + 1024;
    LAS unsigned char* Vs = smem + 1024 + 20480;
    for (int uid = blockIdx.x; uid < 1024; uid += gridDim.x) {
        const int c = uid >> 2, hh = uid & 3; const size_t row0 = (size_t)c * 64;
        if (wid == 0) {
            const bf16_t* r = P + (row0 + lane) * NP;
            const float li = bf2f(r[PC_I + hh]) + gbias[hh], lf = logsigmoid_(bf2f(r[PC_F + hh]) + gbias[4 + hh]);
            const float bc = wave_incl_scan(lf, lane), bt = __shfl(bc, 63), ds = bt - bc + li, M = wave_max(ds);
            sw[lane] = expf(ds - M);
            if (lane == 0) { SMALL[SM_BT + uid] = bt; SMALL[SM_MC + uid] = M; }
        }
        __syncthreads();
#pragma unroll
        for (int i = 0; i < 2; ++i) { const int id = tid + 512 * i, s = id >> 4, d8 = (id & 15) * 8; const u32x4 v = *(const u32x4*)(P + (row0 + s) * NP + PC_K + hh * 128 + d8); const float w = sw[s];
            u32x4 o; o.x = pk2(bflo(v.x) * w, bfhi(v.x) * w); o.y = pk2(bflo(v.y) * w, bfhi(v.y) * w); o.z = pk2(bflo(v.z) * w, bfhi(v.z) * w); o.w = pk2(bflo(v.w) * w, bfhi(v.w) * w);
            *(LAS u32x4*)(Ks + s * 320 + d8 * 2) = o; }
#pragma unroll
        for (int i = 0; i < 4; ++i) { const int id = tid + 512 * i, s = id >> 5, d8 = (id & 31) * 8; *(LAS u32x4*)(Vs + s * 576 + d8 * 2) = *(const u32x4*)(P + (row0 + s) * NP + PC_V + hh * 256 + d8); }
        __syncthreads();
        f32x16 acc[4];
#pragma unroll
        for (int d = 0; d < 4; ++d)
#pragma unroll
            for (int i = 0; i < 16; ++i) acc[d][i] = 0.f;
#pragma unroll
        for (int kk = 0; kk < 4; ++kk) {
            const bf16x8 vf = tr_frag(Vs + (16 * kk + 8 * h + q4) * 576 + (32 * wid + 16 * blk) * 2 + 8 * p4, 576);
#pragma unroll
            for (int d = 0; d < 4; ++d) { const bf16x8 kf = tr_frag(Ks + (16 * kk + 8 * h + q4) * 320 + (32 * d + 16 * blk) * 2 + 8 * p4, 320); acc[d] = mfma32(kf, vf, acc[d]); }
        }
        bf16_t* cs = CS + (size_t)uid * 32768 + (32 * wid + l31) * 128;
#pragma unroll
        for (int d = 0; d < 4; ++d)
#pragma unroll
            for (int g = 0; g < 4; ++g) { u32x2 w; w.x = pk2(acc[d][4 * g], acc[d][4 * g + 1]); w.y = pk2(acc[d][4 * g + 2], acc[d][4 * g + 3]); *(u32x2*)(cs + 32 * d + 8 * g + 4 * h) = w; }
        if (tid < 128) { float s = 0.f;
#pragma unroll 8
            for (int t = 0; t < 64; ++t) s += bf2f(*(LAS const bf16_t*)(Ks + t * 320 + tid * 2));
            SMALL[SM_DN + uid * 128 + tid] = s; }
        __syncthreads();
    }
}
DI void mlstm_b(LAS unsigned char* smem, bf16_t* CS, float* SMALL) {
    const int tid = opaque_tid();
    LAS float* dec = (LAS float*)smem; LAS float* inj = dec + 1024;
    LAS float* sbt = inj + 1024; LAS float* smc = sbt + 1024;
    sbt[tid] = SMALL[SM_BT + tid]; sbt[tid + 512] = SMALL[SM_BT + tid + 512]; smc[tid] = SMALL[SM_MC + tid]; smc[tid + 512] = SMALL[SM_MC + tid + 512];
    __syncthreads();
    if (tid < 4) { float m = -1e30f;
        for (int c = 0; c < 256; ++c) { const float bt = sbt[c * 4 + tid], M = smc[c * 4 + tid]; sbt[c * 4 + tid] = m;
            const float mn = fmaxf(bt + m, M); dec[tid * 256 + c] = __expf(bt + m - mn); inj[tid * 256 + c] = __expf(M - mn); m = mn; } }
    __syncthreads();
    if (blockIdx.x == 0) { SMALL[SM_MPREV + tid] = sbt[tid]; SMALL[SM_MPREV + tid + 512] = sbt[tid + 512]; }
    for (int e = blockIdx.x * 512 + tid; e < 131072; e += gridDim.x * 512) {
        const int hh = e >> 15, idx = e & 32767; bf16_t* pp = CS + (size_t)hh * 32768 + idx; float st = 0.f;
        bf16_t d[32];
#pragma unroll
        for (int i = 0; i < 32; ++i) d[i] = pp[(size_t)i * 131072];
#pragma unroll 1
        for (int c0 = 0; c0 < 256; c0 += 32) {
            bf16_t dn[32];
            const int cn = c0 + 32 < 256 ? c0 + 32 : c0;
#pragma unroll
            for (int i = 0; i < 32; ++i) dn[i] = pp[(size_t)(cn + i) * 131072];
            asm volatile("" ::: "memory");
#pragma unroll
            for (int i = 0; i < 32; ++i) { pp[(size_t)(c0 + i) * 131072] = f2bf(st); st = dec[hh * 256 + c0 + i] * st + inj[hh * 256 + c0 + i] * bf2f(d[i]); }
            asm volatile("" ::: "memory");
#pragma unroll
            for (int i = 0; i < 32; ++i) d[i] = dn[i];
        }
    }
    if (blockIdx.x == gridDim.x - 1) { const int hh = tid >> 7; float* pp = SMALL + SM_DN + tid; float st = 0.f;
#pragma unroll 1
        for (int c0 = 0; c0 < 256; c0 += 32) {
            float d[32];
#pragma unroll
            for (int i = 0; i < 32; ++i) d[i] = pp[(c0 + i) * 512];
            asm volatile("" ::: "memory");
#pragma unroll
            for (int i = 0; i < 32; ++i) { pp[(c0 + i) * 512] = st; st = dec[hh * 256 + c0 + i] * st + inj[hh * 256 + c0 + i] * d[i]; }
            asm volatile("" ::: "memory");
        } }
    __syncthreads();
}
DI void mlstm_c(LAS unsigned char* smem, const bf16_t* P, const float* gbias, const float* onorm, const bf16_t* CS, const float* SMALL, bf16_t* Y) {
    const int tid = opaque_tid(), lane = tid & 63, wid = tid >> 6, l31 = lane & 31, h = lane >> 5, q4 = (lane & 15) >> 2, p4 = lane & 3, blk = (lane >> 4) & 1;
    LAS float* sbc = (LAS float*)smem; LAS float* sav = sbc + 64; LAS float* snp = sbc + 128; LAS float* sx = sbc + 256;
    LAS unsigned char* Qs = smem + 2048;
    LAS unsigned char* Ks = Qs + 17408;
    LAS unsigned char* Vs = Ks + 17408;
    const int tb = wid & 1, dvq = wid >> 1, t = 32 * tb + l31, pr = pi32(l31);
    for (int uid = blockIdx.x; uid < 1024; uid += gridDim.x) {
        const int c = uid >> 2, hh = uid & 3; const size_t row0 = (size_t)c * 64;
        if (wid == 0) {
            const bf16_t* r = P + (row0 + lane) * NP;
            const float li = bf2f(r[PC_I + hh]) + gbias[hh], lf = logsigmoid_(bf2f(r[PC_F + hh]) + gbias[4 + hh]);
            const float bc = wave_incl_scan(lf, lane);
            sbc[lane] = bc; sav[lane] = li - bc;
        }
        if (tid >= 64 && tid < 192) snp[tid - 64] = SMALL[SM_DN + uid * 128 + tid - 64];
#pragma unroll
        for (int i = 0; i < 2; ++i) { const int id = tid + 512 * i, s = id >> 4, d8 = (id & 15) * 8;
            *(LAS u32x4*)(Qs + s * 272 + d8 * 2) = *(const u32x4*)(P + (row0 + s) * NP + PC_Q + hh * 128 + d8);
            *(LAS u32x4*)(Ks + s * 272 + d8 * 2) = *(const u32x4*)(P + (row0 + s) * NP + PC_K + hh * 128 + d8); }
#pragma unroll
        for (int i = 0; i < 4; ++i) { const int id = tid + 512 * i, s = id >> 5, d8 = (id & 31) * 8; *(LAS u32x4*)(Vs + s * 576 + d8 * 2) = *(const u32x4*)(P + (row0 + s) * NP + PC_V + hh * 256 + d8); }
        __syncthreads();
        const float mprev = SMALL[SM_MPREV + uid];
        bf16x8 qf[8];
#pragma unroll
        for (int ks = 0; ks < 8; ++ks) qf[ks] = *(const LAS bf16x8*)(Qs + t * 272 + (16 * ks + 8 * h) * 2);
        f32x16 st0, st1;
#pragma unroll
        for (int i = 0; i < 16; ++i) { st0[i] = 0.f; st1[i] = 0.f; }
#pragma unroll
        for (int ks = 0; ks < 8; ++ks) { const bf16x8 a0 = *(const LAS bf16x8*)(Ks + pr * 272 + (16 * ks + 8 * h) * 2); st0 = mfma32(a0, qf[ks], st0);
            if (tb) { const bf16x8 a1 = *(const LAS bf16x8*)(Ks + (32 + pr) * 272 + (16 * ks + 8 * h) * 2); st1 = mfma32(a1, qf[ks], st1); } }
        const float bt = sbc[t];
        float mx = -1e30f;
#pragma unroll
        for (int i = 0; i < 16; ++i) { const int s = 16 * (i >> 3) + 8 * h + (i & 7); if (s <= t) mx = fmaxf(mx, sav[s]); if (tb) mx = fmaxf(mx, (s + 32 <= t) ? sav[s + 32] : -1e30f); }
        mx = fmaxf(mx, __shfl_xor(mx, 32));
        const float mt = bt + fmaxf(mprev, mx);
        float den = 0.f;
#pragma unroll
        for (int i = 0; i < 16; ++i) { const int s = 16 * (i >> 3) + 8 * h + (i & 7);
            const float w0 = (s <= t) ? __expf(bt + sav[s] - mt) * MQS : 0.f; st0[i] *= w0; den += st0[i];
            const float w1 = (tb && (s + 32 <= t)) ? __expf(bt + sav[s + 32] - mt) * MQS : 0.f; st1[i] *= w1; den += st1[i]; }
        den += __shfl_xor(den, 32);
        float qn = 0.f;
#pragma unroll
        for (int ks = 0; ks < 8; ++ks)
#pragma unroll
            for (int j = 0; j < 8; ++j) qn += bf2f((bf16_t)qf[ks][j]) * snp[16 * ks + 8 * h + j];
        qn += __shfl_xor(qn, 32);
        const float wi = expf(bt + mprev - mt) * MQS;
        den += wi * qn;
        const float dinv = 1.f / fmaxf(fabsf(den), expf(-mt));
        bf16x8 pf[4];
        pf[0] = pack8(st0[0], st0[1], st0[2], st0[3], st0[4], st0[5], st0[6], st0[7]); pf[1] = pack8(st0[8], st0[9], st0[10], st0[11], st0[12], st0[13], st0[14], st0[15]);
        pf[2] = pack8(st1[0], st1[1], st1[2], st1[3], st1[4], st1[5], st1[6], st1[7]); pf[3] = pack8(st1[8], st1[9], st1[10], st1[11], st1[12], st1[13], st1[14], st1[15]);
        float hv[2][16]; float ss = 0.f;
#pragma unroll
        for (int db = 0; db < 2; ++db) { const int dvb = 2 * dvq + db;
            f32x16 a1, a2;
#pragma unroll
            for (int i = 0; i < 16; ++i) { a1[i] = 0.f; a2[i] = 0.f; }
#pragma unroll
            for (int sb = 0; sb < 2; ++sb)
#pragma unroll
                for (int kk = 0; kk < 2; ++kk) { if (sb <= tb) { const bf16x8 vf = tr_frag(Vs + (32 * sb + 16 * kk + 8 * h + q4) * 576 + (32 * dvb + 16 * blk) * 2 + 8 * p4, 576); a1 = mfma32(vf, pf[2 * sb + kk], a1); } }
            const bf16_t* cp = CS + (size_t)uid * 32768 + (32 * dvb + l31) * 128 + 8 * h;
#pragma unroll
            for (int ks = 0; ks < 8; ++ks) { const bf16x8 cf = *(const bf16x8*)(cp + 16 * ks); a2 = mfma32(cf, qf[ks], a2); }
#pragma unroll
            for (int i = 0; i < 16; ++i) { const float v = (a1[i] + wi * a2[i]) * dinv; hv[db][i] = v; ss += v * v; }
        }
        ss += __shfl_xor(ss, 32);
        if (h == 0) sx[(tb * 4 + dvq) * 32 + l31] = ss;
        __syncthreads();
        const float tot = (sx[(tb * 4 + 0) * 32 + l31] + sx[(tb * 4 + 1) * 32 + l31]) + (sx[(tb * 4 + 2) * 32 + l31] + sx[(tb * 4 + 3) * 32 + l31]);
        const float rstd = 1.f / sqrtf(tot * (1.f / 256.f) + EPS);
#pragma unroll
        for (int db = 0; db < 2; ++db)
#pragma unroll
            for (int g = 0; g < 4; ++g) { const int col = hh * 256 + 32 * (2 * dvq + db) + 8 * g + 4 * h;
                const f32x4 gn = *(const f32x4*)(onorm + col); const u32x2 og = *(const u32x2*)(P + (row0 + t) * NP + PC_O + col);
                const float o0 = hv[db][4 * g] * rstd * gn.x * sigmoidf_(bflo(og.x)), o1 = hv[db][4 * g + 1] * rstd * gn.y * sigmoidf_(bfhi(og.x));
                const float o2 = hv[db][4 * g + 2] * rstd * gn.z * sigmoidf_(bflo(og.y)), o3 = hv[db][4 * g + 3] * rstd * gn.w * sigmoidf_(bfhi(og.y));
                u32x2 w; w.x = pk2(o0, o1); w.y = pk2(o2, o3); *(u32x2*)(Y + (row0 + t) * 3072 + col) = w; }
        __syncthreads();
    }
}

DI void attn_unit(LAS unsigned char* smem, int hh, int qb, const bf16_t* Q, const bf16_t* KN, const bf16_t* P, const bf16_t* VT, bf16_t* Y) {
    const int tid = opaque_tid(), lane = tid & 63, wid = __builtin_amdgcn_readfirstlane(tid >> 6), l31 = lane & 31, h = lane >> 5;
    LAS unsigned char* Kb = smem; LAS unsigned char* Vb = smem + 51200;
    const int q0 = qb * 256, qw = q0 + 32 * wid, q = qw + l31, NT = 4 * qb + 4;
    bf16x8 qf[12];
#pragma unroll
    for (int ks = 0; ks < 12; ++ks) qf[ks] = *(const bf16x8*)(Q + (size_t)q * 1536 + hh * 192 + 16 * ks + 8 * h);
    f32x16 o[4];
#pragma unroll
    for (int d = 0; d < 4; ++d)
#pragma unroll
        for (int i = 0; i < 16; ++i) o[d][i] = 0.f;
    float mref = 0.f, lrun = 0.f; bool first = true;
    const bf16_t* ksrc0; const bf16_t* ksrc2; const bf16_t* vsrc0; int kdst0, kdst2, vdst0;
    { const int row = tid >> 4, ch = tid & 15; ksrc0 = KN + (size_t)row * 1024 + hh * 128 + 8 * ch; kdst0 = row * 400 + ch * 16; }
    { const int row = tid >> 3, ch = tid & 7; ksrc2 = P + (size_t)row * NP + PC_KR + 8 * ch; kdst2 = row * 400 + 256 + ch * 16; }
    { const int d = tid >> 3, ch = tid & 7; vsrc0 = VT + (size_t)(hh * 128 + d) * S + 8 * ch; vdst0 = d * 144 + ch * 16; }
    u32x4 kr[3], vr[2];
#define ATT_LOAD(tt) do { kr[0] = *(const u32x4*)(ksrc0 + (size_t)(tt) * 65536); kr[1] = *(const u32x4*)(ksrc0 + (size_t)(tt) * 65536 + 32 * 1024); kr[2] = *(const u32x4*)(ksrc2 + (size_t)(tt) * (64 * NP)); \
        vr[0] = *(const u32x4*)(vsrc0 + (size_t)(tt) * 64); vr[1] = *(const u32x4*)(vsrc0 + (size_t)(tt) * 64 + (size_t)64 * S); } while (0)
#define ATT_WRITE(kbuf, vslot) do { *(LAS u32x4*)(Kb + (kbuf) * 25600 + kdst0) = kr[0]; *(LAS u32x4*)(Kb + (kbuf) * 25600 + kdst0 + 32 * 400) = kr[1]; *(LAS u32x4*)(Kb + (kbuf) * 25600 + kdst2) = kr[2]; \
        *(LAS u32x4*)(Vb + (vslot) * 18432 + vdst0) = vr[0]; *(LAS u32x4*)(Vb + (vslot) * 18432 + vdst0 + 64 * 144) = vr[1]; } while (0)
#define ATT_BAR() do { asm volatile("s_waitcnt lgkmcnt(0)" ::: "memory"); __builtin_amdgcn_s_barrier(); asm volatile("" ::: "memory"); } while (0)
    ATT_LOAD(0);
    ATT_WRITE(0, 0);
    ATT_BAR();
    const int koff = pi32(l31) * 400 + 16 * h, voff = l31 * 144 + 16 * h;
#define SB() __builtin_amdgcn_sched_barrier(0)
#define KFR(kb, ks, b) (*(const LAS bf16x8*)((kb) + (b) * 32 * 400 + (ks) * 32))
#define VFR(vb, d, kk) (*(const LAS bf16x8*)((vb) + (d) * 32 * 144 + (kk) * 32))
    int vs = 0;
    for (int t = 0; t < NT; ++t) {
        const int kc = t & 1, vn = vs == 2 ? 0 : vs + 1;
        if (t + 1 < NT) ATT_LOAD(t + 1);
        if (64 * t <= qw + 31) {
            LAS const unsigned char* kb = Kb + kc * 25600 + koff; LAS const unsigned char* vb = Vb + vs * 18432 + voff;
            f32x16 s0, s1;
#pragma unroll
            for (int i = 0; i < 16; ++i) { s0[i] = 0.f; s1[i] = 0.f; }
            bf16x8 fa[4], fb[4];
            fa[0] = KFR(kb, 0, 0); fa[1] = KFR(kb, 0, 1); fa[2] = KFR(kb, 1, 0); fa[3] = KFR(kb, 1, 1); SB();
#pragma unroll
            for (int st = 0; st < 6; st += 2) {
                fb[0] = KFR(kb, 2 * st + 2, 0); fb[1] = KFR(kb, 2 * st + 2, 1); fb[2] = KFR(kb, 2 * st + 3, 0); fb[3] = KFR(kb, 2 * st + 3, 1); SB();
                s0 = mfma32(fa[0], qf[2 * st], s0); s1 = mfma32(fa[1], qf[2 * st], s1); s0 = mfma32(fa[2], qf[2 * st + 1], s0); s1 = mfma32(fa[3], qf[2 * st + 1], s1); SB();
                if (st + 2 < 6) { fa[0] = KFR(kb, 2 * st + 4, 0); fa[1] = KFR(kb, 2 * st + 4, 1); fa[2] = KFR(kb, 2 * st + 5, 0); fa[3] = KFR(kb, 2 * st + 5, 1); }
                else { fa[0] = VFR(vb, 0, 0); fa[1] = VFR(vb, 0, 1); fa[2] = VFR(vb, 0, 2); fa[3] = VFR(vb, 0, 3); }
                SB();
                s0 = mfma32(fb[0], qf[2 * st + 2], s0); s1 = mfma32(fb[1], qf[2 * st + 2], s1); s0 = mfma32(fb[2], qf[2 * st + 3], s0); s1 = mfma32(fb[3], qf[2 * st + 3], s1); SB();
            }
            if (64 * t + 63 > qw) {
#pragma unroll
                for (int i = 0; i < 16; ++i) { const int kv = 64 * t + 16 * (i >> 3) + 8 * h + (i & 7); if (kv > q) s0[i] = -1e30f; if (kv + 32 > q) s1[i] = -1e30f; }
            }
            float mx = fmaxf(s0[0], s1[0]);
#pragma unroll
            for (int i = 1; i < 16; ++i) mx = fmaxf(mx, fmaxf(s0[i], s1[i]));
            mx = fmaxf(mx, __shfl_xor(mx, 32));
            if (first || __any(mx - mref > 8.f)) {
                const float dl = first ? mx : fmaxf(mx - mref, 0.f);
                mref += dl;
                if (!first) { const float f = __builtin_amdgcn_exp2f(-dl); lrun *= f;
#pragma unroll
                    for (int d = 0; d < 4; ++d)
#pragma unroll
                        for (int i = 0; i < 16; ++i) o[d][i] *= f; }
                first = false; }
            float rs = 0.f;
#pragma unroll
            for (int i = 0; i < 16; ++i) { s0[i] = __builtin_amdgcn_exp2f(s0[i] - mref); s1[i] = __builtin_amdgcn_exp2f(s1[i] - mref); rs += s0[i] + s1[i]; }
            lrun += rs;
            bf16x8 pf[4];
            pf[0] = pack8(s0[0], s0[1], s0[2], s0[3], s0[4], s0[5], s0[6], s0[7]); pf[1] = pack8(s0[8], s0[9], s0[10], s0[11], s0[12], s0[13], s0[14], s0[15]);
            pf[2] = pack8(s1[0], s1[1], s1[2], s1[3], s1[4], s1[5], s1[6], s1[7]); pf[3] = pack8(s1[8], s1[9], s1[10], s1[11], s1[12], s1[13], s1[14], s1[15]);
            SB();
            fb[0] = VFR(vb, 1, 0); fb[1] = VFR(vb, 1, 1); fb[2] = VFR(vb, 1, 2); fb[3] = VFR(vb, 1, 3); SB();
            o[0] = mfma32(fa[0], pf[0], o[0]); o[0] = mfma32(fa[1], pf[1], o[0]); o[0] = mfma32(fa[2], pf[2], o[0]); o[0] = mfma32(fa[3], pf[3], o[0]); SB();
            fa[0] = VFR(vb, 2, 0); fa[1] = VFR(vb, 2, 1); fa[2] = VFR(vb, 2, 2); fa[3] = VFR(vb, 2, 3); SB();
            o[1] = mfma32(fb[0], pf[0], o[1]); o[1] = mfma32(fb[1], pf[1], o[1]); o[1] = mfma32(fb[2], pf[2], o[1]); o[1] = mfma32(fb[3], pf[3], o[1]); SB();
            fb[0] = VFR(vb, 3, 0); fb[1] = VFR(vb, 3, 1); fb[2] = VFR(vb, 3, 2); fb[3] = VFR(vb, 3, 3); SB();
            o[2] = mfma32(fa[0], pf[0], o[2]); o[2] = mfma32(fa[1], pf[1], o[2]); o[2] = mfma32(fa[2], pf[2], o[2]); o[2] = mfma32(fa[3], pf[3], o[2]); SB();
            o[3] = mfma32(fb[0], pf[0], o[3]); o[3] = mfma32(fb[1], pf[1], o[3]); o[3] = mfma32(fb[2], pf[2], o[3]); o[3] = mfma32(fb[3], pf[3], o[3]); SB();
        }
        if (t + 1 < NT) ATT_WRITE(kc ^ 1, vn);
        ATT_BAR();
        vs = vn;
    }
#undef SB
#undef KFR
#undef VFR
#undef ATT_LOAD
#undef ATT_WRITE
#undef ATT_BAR
    lrun += __shfl_xor(lrun, 32);
    const float inv = 1.f / lrun;
    bf16_t* yp = Y + (size_t)q * 3072 + 1024 + hh * 128 + 4 * h;
#pragma unroll
    for (int d = 0; d < 4; ++d)
#pragma unroll
        for (int g = 0; g < 4; ++g) { u32x2 w; w.x = pk2(o[d][4 * g] * inv, o[d][4 * g + 1] * inv); w.y = pk2(o[d][4 * g + 2] * inv, o[d][4 * g + 3] * inv); *(u32x2*)(yp + 32 * d + 8 * g) = w; }
}

#define XB_TMO      128
#define XB_XCNT(j)  (256  + 64 * (j))
#define XB_XSUB(j)  (1280 + 64 * (j))
#define XB_XGEN(j)  (2304 + 64 * (j))
#define XB_TOP      3328
#define XB_TOPGEN   3392
#define XCD_BAR_WORDS 3456
#define XB_SPIN_CAP (1u << 23)
DI unsigned xb_ld(unsigned* p)              { return __hip_atomic_load(p, __ATOMIC_RELAXED, __HIP_MEMORY_SCOPE_AGENT); }
DI unsigned xb_add(unsigned* p, unsigned v) { return __hip_atomic_fetch_add(p, v, __ATOMIC_RELAXED, __HIP_MEMORY_SCOPE_AGENT); }
DI unsigned xb_xcc_id() { return (unsigned)__builtin_amdgcn_s_getreg((3 << 11) | 20) & 0xFu; }
#define XB_SPIN(cond, bar) do { unsigned _sp = 0; while (cond) { __builtin_amdgcn_s_sleep(1); \
    if ((++_sp & 255u) == 0u) { if (xb_ld(&(bar)[XB_TMO])) break; if (_sp > XB_SPIN_CAP) { atomicAdd(&(bar)[XB_TMO], 1u); break; } } } } while (0)
struct XcdBarrier { unsigned* bar; unsigned x; volatile LAS unsigned* st; };
DI XcdBarrier xcd_barrier_post(unsigned* bar, volatile LAS unsigned* st) {
    XcdBarrier b; b.bar = bar; b.x = xb_xcc_id(); b.st = st;
    if (threadIdx.x == 0) (void)xb_add(&bar[XB_XCNT(b.x)], 1u);
    return b;
}
DI void xcd_barrier_complete(unsigned* bar, unsigned x, unsigned& nloc, unsigned& nx) {
    const unsigned G = gridDim.x * gridDim.y * gridDim.z;
    unsigned sum, cnt, mine, sp = 0u;
    for (;;) {
        sum = 0u; cnt = 0u; mine = 0u;
#pragma unroll
        for (unsigned j = 0; j < 16; ++j) { const unsigned c = xb_ld(&bar[XB_XCNT(j)]); sum += c; cnt += (c > 0u) ? 1u : 0u; mine = (j == x) ? c : mine; }
        if (sum == G) break;
        __builtin_amdgcn_s_sleep(1);
        if ((++sp & 255u) == 0u) { if (xb_ld(&bar[XB_TMO])) break; if (sp > XB_SPIN_CAP) { atomicAdd(&bar[XB_TMO], 1u); break; } }
    }
    nloc = mine > 0u ? mine : 1u; nx = cnt > 0u ? cnt : 1u;
}
DI void xcd_barrier(const XcdBarrier& b) {
    asm volatile("s_waitcnt vmcnt(0)" ::: "memory");
    __syncthreads();
    if (threadIdx.x == 0) {
        unsigned* bar = b.bar;
        __builtin_amdgcn_s_waitcnt(0);
        unsigned nloc = b.st[0], nx = b.st[1];
        if (nloc == 0u) { xcd_barrier_complete(bar, b.x, nloc, nx); b.st[0] = nloc; b.st[1] = nx; }
        const unsigned old = xb_add(&bar[XB_XSUB(b.x)], 1u);
        const unsigned gen = old / nloc;
        if (old + 1u == (gen + 1u) * nloc) {
            __builtin_amdgcn_fence(__ATOMIC_RELEASE, "agent");
            asm volatile("s_waitcnt vmcnt(0)" ::: "memory");
            const unsigned og = xb_add(&bar[XB_TOP], 1u);
            const unsigned tg = og / nx;
            if (og + 1u == (tg + 1u) * nx) xb_add(&bar[XB_TOPGEN], 1u);
            else XB_SPIN(xb_ld(&bar[XB_TOPGEN]) == tg, bar);
            __builtin_amdgcn_fence(__ATOMIC_ACQUIRE, "agent");
            xb_add(&bar[XB_XGEN(b.x)], 1u);
            asm volatile("s_waitcnt vmcnt(0)" ::: "memory");
        } else {
            XB_SPIN(xb_ld(&bar[XB_XGEN(b.x)]) == gen, bar);
            __builtin_amdgcn_fence(__ATOMIC_ACQUIRE, "agent");
            asm volatile("s_waitcnt vmcnt(0)" ::: "memory");
        }
    }
    __syncthreads();
}

struct Params { const float* in[27]; float* out; unsigned char* ws; };

__global__ void __launch_bounds__(512, 2) mega_fwd(Params p) {
    extern __shared__ __attribute__((aligned(16))) unsigned char smem_raw[];
    LAS unsigned char* smem = (LAS unsigned char*)smem_raw;
    cg::grid_group grid = cg::this_grid();
    const int G = gridDim.x, bx = blockIdx.x;
    { const int t0 = opaque_tid(); if (t0 < 128) ((LAS unsigned*)(smem + 131072))[t0] = 0u; }
    __syncthreads();
    XcdBarrier bar = xcd_barrier_post((unsigned*)(p.ws + WS_CTL), (volatile LAS unsigned*)(smem + 131072) + 8);
    unsigned char* ws = p.ws;
    f32x2* TAB = (f32x2*)(ws + WS_TAB); float* SMALL = (float*)(ws + WS_SMALL);
    bf16_t* WFFGU = (bf16_t*)(ws + WS_WFFGU); bf16_t* WFFD = (bf16_t*)(ws + WS_WFFD); bf16_t* WIN = (bf16_t*)(ws + WS_WIN); bf16_t* WUQ = (bf16_t*)(ws + WS_WUQ);
    bf16_t* WUKV = (bf16_t*)(ws + WS_WUKV); bf16_t* WLRU = (bf16_t*)(ws + WS_WLRU); bf16_t* WBR = (bf16_t*)(ws + WS_WBR); bf16_t* WOUT = (bf16_t*)(ws + WS_WOUT);
    bf16_t* XN = (bf16_t*)(ws + WS_XN); bf16_t* P = (bf16_t*)(ws + WS_P); bf16_t* Hb = P; bf16_t* Qb = (bf16_t*)(ws + WS_Q); bf16_t* KN = (bf16_t*)(ws + WS_KN);
    bf16_t* VT = (bf16_t*)(ws + WS_VT); bf16_t* Y = (bf16_t*)(ws + WS_Y); bf16_t* XC = (bf16_t*)(ws + WS_XC); bf16_t* CS = (bf16_t*)(ws + WS_CS);

    for (int i = bx * 512 + opaque_tid(); i < S * 32; i += G * 512) { const int t = i >> 5, j = i & 31; const float ang = (float)t * INVF[j];
        double r = (double)ang * 0.15915494309189535; r -= __builtin_floor(r); const float fr = (float)r;
        TAB[i] = (f32x2){__builtin_amdgcn_cosf(fr), __builtin_amdgcn_sinf(fr)}; }

#pragma unroll 1
    for (int hl = 0; hl < 4; ++hl) {
        const int l = hl >> 1, second = hl & 1;
        const float* xin = hl == 0 ? p.in[0] : p.out;
        {
            const int nmat = second ? 3 : 26; int rot = 0;
#pragma unroll 1
            for (int mi = 0; mi < nmat; ++mi) {
                const float* src; int K, N, map; bf16_t* dst;
                if (mi == 0) { src = p.in[second ? 23 : 2] + (size_t)l * DM * FF; K = DM; N = FF; map = 1; dst = WFFGU; }
                else if (mi == 1) { src = p.in[second ? 24 : 3] + (size_t)l * DM * FF; K = DM; N = FF; map = 2; dst = WFFGU; }
                else if (mi == 2) { src = p.in[second ? 25 : 4] + (size_t)l * DM * FF; K = FF; N = DM; map = 0; dst = WFFD; }
                else if (mi == 3) { src = p.in[6] + (size_t)l * DM * NIN; K = DM; N = NIN; map = 3; dst = WIN; }
                else if (mi == 4) { src = p.in[10] + (size_t)l * 384 * 1536; K = 384; N = 1536; map = 4; dst = WUQ; }
                else if (mi == 5) { src = p.in[12] + (size_t)l * 256 * 2048; K = 256; N = 2048; map = 5; dst = WUKV; }
                else if (mi < 22) { const int k = mi - 6, n = k >> 1, wx = k & 1; src = p.in[wx ? 17 : 15] + (size_t)l * 131072 + n * 16384; K = 128; N = 128; map = 0; dst = WLRU + (size_t)(n * 256 + wx * 128) * 128; }
                else if (mi < 25) { const int j = mi - 22; src = p.in[20] + (size_t)l * 3 * 1024 * 2048 + (size_t)j * 1024 * 2048; K = 1024; N = 2048; map = 0; dst = WBR + (size_t)j * 2048 * 1024; }
                else { src = p.in[21] + (size_t)l * DM * DM; K = DM; N = DM; map = 0; dst = WOUT; }
                convert_mat(src, K, N, dst, map, rot);
            }
            rmsnorm_rows(xin, p.in[second ? 22 : 1] + l * DM, XN);
        }
        if (hl == 0) grid.sync(); else xcd_barrier(bar);
        { pg8::Gemm g{XN, WFFGU, S, 2 * FF, DM, DM, DM, 0}; pg8::StaticOrder so; so.init(S, 2 * FF, G, bx); pg8::EpiSwiglu E{Hb}; pg8::gemm_phase(smem, g, so, E); }
        xcd_barrier(bar);
        { pg8::Gemm g{Hb, WFFD, S, DM, FF, FF, FF, 0}; pg8::StaticOrder so; so.init(S, DM, G, bx); pg8::EpiRes E{xin, p.out, 0.5f}; pg8::gemm_phase(smem, g, so, E); }
        xcd_barrier(bar);
        if (!second) {
            const float* gbias = p.in[7] + l * 8;
            rmsnorm_rows(p.out, p.in[5] + l * DM, XN);
            xcd_barrier(bar);
            { pg8::Gemm g{XN, WIN, S, NP, DM, DM, DM, 0}; pg8::StaticOrder so; so.init(S, NP, G, bx); pg8::EpiStore E{P, NP}; pg8::gemm_phase(smem, g, so, E); }
            xcd_barrier(bar);
            if (bx == G - 1) { const float* lam = p.in[19] + l * 1024; for (int ch = opaque_tid(); ch < 1024; ch += 512) SMALL[SM_SP + ch] = -8.f * log1pf(expf(-lam[ch])); }
            mlstm_a(smem, P, gbias, CS, SMALL);
            prep_rows(P, p.in[9] + l * 384, p.in[11] + l * 256, p.in[13] + l * 4096, p.in[14] + l * 1024, TAB, XC);
            xcd_barrier(bar);
            mlstm_b(smem, CS, SMALL);
            { pg8::Gemm g{P + PC_CQ, WUQ, S, 1536, 384, NP, 384, 0}; pg8::StaticOrder so; so.init(S, 1536, G, bx); pg8::EpiQ E{Qb, TAB}; pg8::gemm_phase(smem, g, so, E); }
#pragma unroll 1
            for (int gi = 0; gi < 2; ++gi) {
                pg8::Gemm g; pg8::StaticOrder so; pg8::EpiStore E;
                if (gi == 0) { g = pg8::Gemm{P + PC_CKV, WUKV, S, 1024, 256, NP, 256, 0}; so.init(S, 1024, G, bx); E = pg8::EpiStore{KN, 1024}; }
                else { g = pg8::Gemm{WUKV + 1024 * 256, P + PC_CKV, 1024, S, 256, 256, NP, 0}; so.init(1024, S, G, bx); E = pg8::EpiStore{VT, S}; }
                pg8::gemm_phase(smem, g, so, E);
            }
            { pg8::Gemm g{XC, WLRU, S, 2048, 128, 1024, 128, 128}; pg8::StaticOrder so; so.init(S, 2048, G, bx); pg8::EpiLru E{XC, P + PC_CX, p.in[16] + l * 1024, p.in[18] + l * 1024, SMALL + SM_SP}; pg8::gemm_phase(smem, g, so, E); }
            xcd_barrier(bar);
            mlstm_c(smem, P, gbias, p.in[8] + l * 1024, CS, SMALL, Y);
            lru_p1(P + PC_CX, XC, SMALL + SM_CA, SMALL + SM_CH);
            xcd_barrier(bar);
            lru_p2(SMALL + SM_CA, SMALL + SM_CH, SMALL + SM_CARRY);
            for (int item = bx; item < 256; item += G) { const int hh = item & 7, pp = item >> 3;
#pragma unroll 1
                for (int half = 0; half < 2; ++half) attn_unit(smem, hh, half ? 63 - pp : pp, Qb, KN, P, VT, Y); }
            xcd_barrier(bar);
            lru_p3(P + PC_CX, XC, SMALL + SM_CARRY, Y);
#pragma unroll 1
            for (int j = 0; j < 3; ++j) {
                if (j == 2) xcd_barrier(bar);
                pg8::Gemm g{Y + j * 1024, WBR + (size_t)j * 2048 * 1024, S, DM, 1024, 3072, 1024, 0}; pg8::StaticOrder so; so.init(S, DM, G, bx); pg8::EpiMerge E{XN, P + PC_G + j * 2048, j == 0}; pg8::gemm_phase(smem, g, so, E);
            }
            xcd_barrier(bar);
            { pg8::Gemm g{XN, WOUT, S, DM, DM, DM, DM, 0}; pg8::StaticOrder so; so.init(S, DM, G, bx); pg8::EpiRes E{p.out, p.out, 1.0f}; pg8::gemm_phase(smem, g, so, E); }
            xcd_barrier(bar);
        }
    }
    final_norm_rows(p.out, p.in[26]);
}

constexpr int LDS_BYTES = 143360;

extern "C" void kernel_launch(void* const* d_in, const int* in_sizes, int n_in, void* d_out, int out_size, void* d_ws, size_t ws_size, hipStream_t stream) {
    static int grid = 0;
    if (grid == 0) {
        if (n_in != 27 || out_size != S * DM || ws_size < WS_END) { fprintf(stderr, "kernel_launch: unexpected problem (n_in %d out %d ws %zu, need %zu)\n", n_in, out_size, ws_size, (size_t)WS_END); grid = -1; return; }
        int dev = 0, cus = 0, per_cu = 0;
        hipGetDevice(&dev); hipDeviceGetAttribute(&cus, hipDeviceAttributeMultiprocessorCount, dev);
        if (hipFuncSetAttribute((const void*)mega_fwd, hipFuncAttributeMaxDynamicSharedMemorySize, LDS_BYTES) != hipSuccess) { fprintf(stderr, "kernel_launch: hipFuncSetAttribute failed\n"); grid = -1; return; }
        if (hipOccupancyMaxActiveBlocksPerMultiprocessor(&per_cu, (const void*)mega_fwd, 512, LDS_BYTES) != hipSuccess || per_cu < 1) { fprintf(stderr, "kernel_launch: occupancy query says %d\n", per_cu); per_cu = 1; }
        (void)hipGetLastError();
        grid = cus * (per_cu > 1 ? 1 : per_cu);
    }
    if (grid < 0) return;
    if (hipMemsetAsync((char*)d_ws + WS_CTL, 0, CTL_BYTES, stream) != hipSuccess) { fprintf(stderr, "kernel_launch: memset failed\n"); return; }
    Params p{};
    for (int i = 0; i < 27; ++i) p.in[i] = (const float*)d_in[i];
    p.out = (float*)d_out; p.ws = (unsigned char*)d_ws;
    void* args[] = {&p};
    hipError_t e = hipLaunchCooperativeKernel((const void*)mega_fwd, dim3(grid), dim3(512), args, LDS_BYTES, stream);
    if (e != hipSuccess) fprintf(stderr, "cooperative launch failed: %s (grid %d)\n", hipGetErrorString(e), grid);
}
```

```cpp
#include <hip/hip_runtime.h>
#include <hip/hip_cooperative_groups.h>
#include <cstdio>
#include <cstdint>
namespace cg = cooperative_groups;

#define DI __device__ __forceinline__
#define LAS __attribute__((address_space(3)))
typedef unsigned short bf16_t;
typedef short bf16x8 __attribute__((ext_vector_type(8)));
typedef short s16x4 __attribute__((ext_vector_type(4)));
typedef float f32x2 __attribute__((ext_vector_type(2)));
typedef float f32x4 __attribute__((ext_vector_type(4)));
typedef float f32x16 __attribute__((ext_vector_type(16)));
typedef unsigned u32x2 __attribute__((ext_vector_type(2)));
typedef unsigned u32x4 __attribute__((ext_vector_type(4)));
typedef __bf16 bf16x2_t __attribute__((ext_vector_type(2)));

constexpr int S = 16384, DM = 2048, FF = 5632, NIN = 10952, NP = 11008;
constexpr float EPS = 1e-6f;
constexpr int PC_Q = 0, PC_K = 512, PC_V = 1024, PC_O = 2048, PC_CQ = 3072, PC_CKV = 3456, PC_KR = 3712, PC_CX = 3776, PC_G = 4800, PC_I = 10944, PC_F = 10948;
constexpr float MQS = 0.08838834764831845f;
constexpr float AQS = 0.07216878364870322f * 1.4426950408889634f;

constexpr size_t MiB = 1u << 20;
constexpr size_t WS_TAB = 0;
constexpr size_t WS_SMALL = 4 * MiB;
constexpr size_t WS_WFFGU = 12 * MiB;
constexpr size_t WS_WFFD = 56 * MiB;
constexpr size_t WS_WIN = 78 * MiB;
constexpr size_t WS_WUQ = 121 * MiB;
constexpr size_t WS_WUKV = 123 * MiB;
constexpr size_t WS_WLRU = 124 * MiB;
constexpr size_t WS_WBR = 125 * MiB;
constexpr size_t WS_WOUT = 137 * MiB;
constexpr size_t WS_XN = 145 * MiB;
constexpr size_t WS_P = 209 * MiB;
constexpr size_t WS_Q = 553 * MiB;
constexpr size_t WS_KN = 601 * MiB;
constexpr size_t WS_VT = 633 * MiB;
constexpr size_t WS_Y = 665 * MiB;
constexpr size_t WS_XC = 761 * MiB;
constexpr size_t WS_CS = 793 * MiB;
constexpr size_t WS_END = 857 * MiB;
constexpr size_t WS_CTL = 11 * MiB, CTL_BYTES = 16384;
constexpr int SM_BT = 0, SM_MC = 1024, SM_MPREV = 2048, SM_DN = 4096  , SM_CA = 4096 + 131072  , SM_CH = SM_CA + 262144, SM_CARRY = SM_CH + 262144, SM_SP = SM_CARRY + 262144;

__device__ const float INVF[32] = {1.0f, 0.7498942613601685f, 0.5623413324356079f, 0.4216965138912201f, 0.3162277638912201f, 0.23713737726211548f, 0.17782793939113617f, 0.133352130651474f, 0.10000000149011612f, 0.07498941570520401f, 0.05623413249850273f, 0.04216965287923813f, 0.03162277489900589f, 0.023713737726211548f, 0.017782794311642647f, 0.01333521492779255f, 0.009999999776482582f, 0.007498941849917173f, 0.005623413249850273f, 0.0042169648222625256f, 0.003162277629598975f, 0.00237137358635664f, 0.0017782794311642647f, 0.0013335214462131262f, 0.0010000000474974513f, 0.0007498942431993783f, 0.000562341301701963f, 0.0004216965171508491f, 0.0003162277571391314f, 0.00023713737027719617f, 0.00017782794020604342f, 0.0001333521504420787f};

DI int opaque_tid() { int t = threadIdx.x; asm volatile("" : "+v"(t)); return t; }
DI float bf2f(bf16_t v) { return __uint_as_float((unsigned)v << 16); }
DI float bflo(unsigned w) { return __uint_as_float(w << 16); }
DI float bfhi(unsigned w) { return __uint_as_float(w & 0xffff0000u); }
DI unsigned pk2(float lo, float hi) { f32x2 v = {lo, hi}; bf16x2_t b = __builtin_convertvector(v, bf16x2_t); return __builtin_bit_cast(unsigned, b); }
DI bf16_t f2bf(float f) { return (bf16_t)(pk2(f, 0.f) & 0xffffu); }
DI float wave_sum(float v) {
#pragma unroll
    for (int o = 1; o < 64; o <<= 1) v += __shfl_xor(v, o);
    return v;
}
DI float wave_max(float v) {
#pragma unroll
    for (int o = 1; o < 64; o <<= 1) v = fmaxf(v, __shfl_xor(v, o));
    return v;
}
DI float wave_incl_scan(float v, int lane) {
#pragma unroll
    for (int o = 1; o < 64; o <<= 1) { const float n = __shfl_up(v, o); if (lane >= o) v += n; }
    return v;
}
DI float sigmoidf_(float x) { return __builtin_amdgcn_rcpf(1.f + __expf(-x)); }
DI float logsigmoid_(float x) { return fminf(x, 0.f) - log1pf(expf(-fabsf(x))); }
DI f32x16 mfma32(bf16x8 a, bf16x8 b, f32x16 c) { return __builtin_amdgcn_mfma_f32_32x32x16_bf16(a, b, c, 0, 0, 0); }
DI int crow(int r, int h) { return (r & 3) + 8 * (r >> 2) + 4 * h; }
DI int pi32(int m) { return (m & ~12) | ((m & 4) << 1) | ((m & 8) >> 1); }
typedef short v4i16_t __attribute__((ext_vector_type(4)));
DI s16x4 tr16(LAS const unsigned char* p) { return __builtin_bit_cast(s16x4, __builtin_amdgcn_ds_read_tr16_b64_v4i16((LAS v4i16_t*)p)); }
DI bf16x8 tr_frag(LAS const unsigned char* p, int rs) {
    const s16x4 lo = tr16(p), hi = tr16(p + 4 * rs);
    return __builtin_shufflevector(lo, hi, 0, 1, 2, 3, 4, 5, 6, 7);
}
DI bf16x8 pack8(float a0, float a1, float a2, float a3, float a4, float a5, float a6, float a7) {
    u32x4 w; w.x = pk2(a0, a1); w.y = pk2(a2, a3); w.z = pk2(a4, a5); w.w = pk2(a6, a7); return __builtin_bit_cast(bf16x8, w);
}

namespace pg8 {
constexpr int BM = 256, BK = 64, HALF = 128, HTB = HALF * BK * 2, STAGE_BYTES = 8 * HTB, NXCD = 8, WGM = 8;
DI int lds_byte(int r, int c) { const int st = (r >> 4) * 2 + (c >> 5), rr = r & 15, cc = c & 31, ob = rr * 64 + cc * 2; return st * 1024 + (ob ^ (((ob >> 9) & 1) << 5)); }
DI void stage_rc(int b, int& R, int& C) { const int st = b / 1024, sb = b % 1024, swz = sb ^ (((sb >> 9) & 1) << 5); R = (st >> 1) * 16 + swz / 64; C = (st & 1) * 32 + (swz % 64) / 2; }
DI int perm32(int rho) { const int n = rho >> 4, i = rho & 15; return 8 * (i >> 2) + 4 * n + (i & 3); }
struct Unit { int pm, pn; };
struct Gemm { const bf16_t* A; const bf16_t* Bt; int M, N, K, lda, ldb, apn; };
struct StaticOrder {
    int nM, nN, nwg, G, c;
    DI void init(int M, int N, int G_, int c_) { nM = M / BM; nN = N / BM; nwg = nM * nN; G = G_; c = c_; }
    DI bool next(int i, Unit& u) const {
        const long L = (long)i * G + c; if (L >= nwg) return false;
        int wgid = (int)L; { const int q = nwg / NXCD, r = nwg % NXCD, xcd = wgid % NXCD, off = wgid / NXCD; wgid = (xcd < r ? xcd * (q + 1) : r * (q + 1) + (xcd - r) * q) + off; }
        const int nig = WGM * nN, gid = wgid / nig, fm = gid * WGM, gsz = (nM - fm) < WGM ? (nM - fm) : WGM;
        u.pm = fm + ((wgid % nig) % gsz); u.pn = (wgid % nig) / gsz; return true;
    }
};
template <class Epi>
DI void gemm_phase(LAS unsigned char* lds, const Gemm g, const StaticOrder& S, const Epi& E) {
    const int tid = opaque_tid(), wid = __builtin_amdgcn_readfirstlane(tid >> 6), lane = tid & 63, wr = wid >> 2, wc = wid & 3, fr = lane & 15, fq = lane >> 4;
    int K = g.K; asm volatile("" : "+s"(K)); const int nt = K / BK;
    unsigned voffA[2], voffB[2];
#pragma unroll
    for (int i = 0; i < 2; ++i) { int R, C; stage_rc(tid * 16 + i * 8192, R, C); const int Rb = Epi::PERM ? ((R & ~31) + perm32(R & 31)) : R;
        voffA[i] = (unsigned)(R * g.lda + C) * 2u; voffB[i] = (unsigned)(Rb * g.ldb + C) * 2u; }
    const size_t kstep = (size_t)(BK * 2);
    const size_t hstepA = (size_t)HALF * g.lda * 2, hstepB = (size_t)HALF * g.ldb * 2;
    const unsigned ldsw = (unsigned)wid * 1024u;
    const int aoff = lds_byte(wr * 64 + fr, fq * 8), boff = lds_byte(wc * 32 + fr, fq * 8);
#define PG8_SA(b, h) (((b) * 2 + (h)) * HTB)
#define PG8_SB(b, h) ((4 + (b) * 2 + (h)) * HTB)
#define PG8_STAGE(bufoff, gbase, voff) do { _Pragma("unroll") for (int _i = 0; _i < 2; ++_i) \
        __builtin_amdgcn_global_load_lds((const unsigned*)((const char*)(gbase) + (voff)[_i]), (LAS unsigned*)(lds + (bufoff) + ldsw + _i * 8192), 16, 0, 0); } while (0)
#define PG8_LDA(dst, b, h) do { _Pragma("unroll") for (int m = 0; m < 4; ++m) _Pragma("unroll") for (int k = 0; k < 2; ++k) dst[m][k] = *(const LAS bf16x8*)(lds + PG8_SA(b, h) + aoff + m * 2048 + k * 1024); } while (0)
#define PG8_LDB(dst, b, h) do { _Pragma("unroll") for (int n = 0; n < 2; ++n) _Pragma("unroll") for (int k = 0; k < 2; ++k) dst[n][k] = *(const LAS bf16x8*)(lds + PG8_SB(b, h) + boff + n * 2048 + k * 1024); } while (0)
#define PG8_MMA(ai, bj, At, Bt) do { __builtin_amdgcn_s_setprio(1); _Pragma("unroll") for (int m = 0; m < 4; ++m) _Pragma("unroll") for (int n = 0; n < 2; ++n) _Pragma("unroll") for (int k = 0; k < 2; ++k) \
        acc[ai][bj][m][n] = __builtin_amdgcn_mfma_f32_16x16x32_bf16(Bt[n][k], At[m][k], acc[ai][bj][m][n], 0, 0, 0); __builtin_amdgcn_s_setprio(0); } while (0)
#define PG8_WAIT_V(n) asm volatile("s_waitcnt vmcnt(" #n ")" ::: "memory")
#define PG8_WAIT_L(n) asm volatile("s_waitcnt lgkmcnt(" #n ")" ::: "memory")
#define PG8_BAR __builtin_amdgcn_s_barrier()
#define PG8_SCHED __builtin_amdgcn_sched_barrier(0)
#define PG8_APTR(u) ((const char*)g.A + (size_t)(u).pm * 2 * hstepA + (size_t)(u).pn * (size_t)g.apn * 2)
#define PG8_BPTR(u) ((const char*)g.Bt + (size_t)(u).pn * 2 * hstepB)
    Unit cur, nxt; int ui = 0;
    if (!S.next(0, cur)) return;
    f32x4 acc[2][2][4][2];
#pragma unroll
    for (int a = 0; a < 2; ++a)
#pragma unroll
        for (int b = 0; b < 2; ++b)
#pragma unroll
            for (int m = 0; m < 4; ++m)
#pragma unroll
                for (int n = 0; n < 2; ++n) acc[a][b][m][n] = (f32x4){0.f, 0.f, 0.f, 0.f};
    bf16x8 At[4][2], B0[2][2], B1[2][2];
    const char* cA = PG8_APTR(cur); const char* cB = PG8_BPTR(cur);
    PG8_STAGE(PG8_SB(0, 0), cB, voffB); PG8_STAGE(PG8_SB(0, 1), cB + hstepB, voffB); PG8_STAGE(PG8_SA(0, 0), cA, voffA); PG8_STAGE(PG8_SA(0, 1), cA + hstepA, voffA);
    if (wr == 1) PG8_BAR;
    PG8_WAIT_V(2); PG8_BAR;
    PG8_STAGE(PG8_SB(1, 0), cB + kstep, voffB); PG8_STAGE(PG8_SA(1, 0), cA + kstep, voffA); PG8_STAGE(PG8_SB(1, 1), cB + hstepB + kstep, voffB);
    PG8_WAIT_V(6); PG8_BAR;
    for (;;) {
        const bool has_next = S.next(ui + 1, nxt);
        const char* nA = has_next ? PG8_APTR(nxt) : cA; const char* nB = has_next ? PG8_BPTR(nxt) : cB;
        for (int t = 0; t < nt; t += 2) {
            const bool last = (t == nt - 2);
            const char* a1 = cA + (size_t)(t + 1) * kstep;
            const char* a2 = last ? nA : cA + (size_t)(t + 2) * kstep; const char* b2 = last ? nB : cB + (size_t)(t + 2) * kstep;
            const char* a3 = a2 + kstep; const char* b3 = b2 + kstep;
            PG8_LDB(B0, 0, 0); PG8_LDB(B1, 0, 1); PG8_SCHED; PG8_LDA(At, 0, 0); PG8_STAGE(PG8_SA(1, 1), a1 + hstepA, voffA);
            PG8_WAIT_V(8); PG8_WAIT_L(0); PG8_BAR; PG8_MMA(0, 0, At, B0); PG8_MMA(0, 1, At, B1); PG8_BAR; PG8_SCHED;
            PG8_LDA(At, 0, 1); PG8_STAGE(PG8_SB(0, 0), b2, voffB); PG8_STAGE(PG8_SB(0, 1), b2 + hstepB, voffB); PG8_STAGE(PG8_SA(0, 0), a2, voffA);
            PG8_WAIT_V(8); PG8_WAIT_L(0); PG8_BAR; PG8_MMA(1, 0, At, B0); PG8_MMA(1, 1, At, B1); PG8_BAR; PG8_SCHED;
            PG8_LDB(B0, 1, 0); PG8_LDB(B1, 1, 1); PG8_SCHED; PG8_LDA(At, 1, 0); PG8_STAGE(PG8_SA(0, 1), a2 + hstepA, voffA);
            PG8_WAIT_V(8); PG8_WAIT_L(0); PG8_BAR; PG8_MMA(0, 0, At, B0); PG8_MMA(0, 1, At, B1); PG8_BAR; PG8_SCHED;
            PG8_LDA(At, 1, 1); PG8_STAGE(PG8_SB(1, 0), b3, voffB); PG8_STAGE(PG8_SB(1, 1), b3 + hstepB, voffB); PG8_STAGE(PG8_SA(1, 0), a3, voffA);
            PG8_WAIT_V(8); PG8_WAIT_L(0); PG8_BAR; PG8_MMA(1, 0, At, B0); PG8_MMA(1, 1, At, B1); PG8_BAR; PG8_SCHED;
        }
        if (wr == 0) PG8_BAR;
        E(acc, cur, wr, wc, fr, fq);
        if (!has_next) break;
#pragma unroll
        for (int a = 0; a < 2; ++a)
#pragma unroll
            for (int b = 0; b < 2; ++b)
#pragma unroll
                for (int m = 0; m < 4; ++m)
#pragma unroll
                    for (int n = 0; n < 2; ++n) acc[a][b][m][n] = (f32x4){0.f, 0.f, 0.f, 0.f};
        cur = nxt; cA = nA; cB = nB; ++ui;
        if (wr == 1) PG8_BAR;
    }
    PG8_WAIT_V(0);
    PG8_BAR;
#undef PG8_SA
#undef PG8_SB
#undef PG8_STAGE
#undef PG8_LDA
#undef PG8_LDB
#undef PG8_MMA
#undef PG8_WAIT_V
#undef PG8_WAIT_L
#undef PG8_BAR
#undef PG8_SCHED
#undef PG8_APTR
#undef PG8_BPTR
}

typedef f32x4 Acc[2][2][4][2];
struct EpiStore {
    static constexpr bool PERM = true;
    bf16_t* O; int ldc;
    DI void operator()(const Acc& acc, const Unit& u, int wr, int wc, int fr, int fq) const {
        const int row0 = u.pm * BM + wr * 64 + fr, col0 = u.pn * BM + wc * 32 + 8 * fq;
#pragma unroll
        for (int ai = 0; ai < 2; ++ai)
#pragma unroll
            for (int m = 0; m < 4; ++m) { bf16_t* rowp = O + (size_t)(row0 + ai * HALF + m * 16) * ldc + col0;
#pragma unroll
                for (int bj = 0; bj < 2; ++bj) { const f32x4 v0 = acc[ai][bj][m][0], v1 = acc[ai][bj][m][1];
                    u32x4 w; w.x = pk2(v0[0], v0[1]); w.y = pk2(v0[2], v0[3]); w.z = pk2(v1[0], v1[1]); w.w = pk2(v1[2], v1[3]);
                    *(u32x4*)(rowp + bj * HALF) = w; } }
    }
};
struct EpiSwiglu {
    static constexpr bool PERM = true;
    bf16_t* H;
    DI void operator()(const Acc& acc, const Unit& u, int wr, int wc, int fr, int fq) const {
        const int row0 = u.pm * BM + wr * 64 + fr, col0 = u.pn * HALF + wc * 32 + 8 * fq;
#pragma unroll
        for (int ai = 0; ai < 2; ++ai)
#pragma unroll
            for (int m = 0; m < 4; ++m) { bf16_t* rowp = H + (size_t)(row0 + ai * HALF + m * 16) * FF + col0;
                float o[8];
#pragma unroll
                for (int n = 0; n < 2; ++n)
#pragma unroll
                    for (int j = 0; j < 4; ++j) { const float gt = acc[ai][0][m][n][j], up = acc[ai][1][m][n][j]; o[n * 4 + j] = gt * sigmoidf_(gt) * up; }
                u32x4 w; w.x = pk2(o[0], o[1]); w.y = pk2(o[2], o[3]); w.z = pk2(o[4], o[5]); w.w = pk2(o[6], o[7]);
                *(u32x4*)rowp = w; }
    }
};
struct EpiRes {
    static constexpr bool PERM = false;
    const float* xin; float* xout; float alpha;
    DI void operator()(const Acc& acc, const Unit& u, int wr, int wc, int fr, int fq) const {
        const int col0 = u.pn * BM + wc * 32 + 4 * fq;
#pragma unroll
        for (int ai = 0; ai < 2; ++ai) {
            f32x4 b[4][2][2];
#pragma unroll
            for (int m = 0; m < 4; ++m) { const size_t off = (size_t)(u.pm * BM + ai * HALF + wr * 64 + m * 16 + fr) * DM + col0;
#pragma unroll
                for (int bj = 0; bj < 2; ++bj)
#pragma unroll
                    for (int n = 0; n < 2; ++n) b[m][bj][n] = *(const f32x4*)(xin + off + bj * HALF + n * 16); }
            __builtin_amdgcn_sched_barrier(0);
#pragma unroll
            for (int m = 0; m < 4; ++m) { const size_t off = (size_t)(u.pm * BM + ai * HALF + wr * 64 + m * 16 + fr) * DM + col0;
#pragma unroll
                for (int bj = 0; bj < 2; ++bj)
#pragma unroll
                    for (int n = 0; n < 2; ++n) *(f32x4*)(xout + off + bj * HALF + n * 16) = b[m][bj][n] + acc[ai][bj][m][n] * alpha; }
            __builtin_amdgcn_sched_barrier(0);
        }
    }
};
struct EpiQ {
    static constexpr bool PERM = true;
    bf16_t* Q; const f32x2* tab;
    DI void operator()(const Acc& acc, const Unit& u, int wr, int wc, int fr, int fq) const {
        const int row0 = u.pm * BM + wr * 64 + fr;
#pragma unroll
        for (int bj = 0; bj < 2; ++bj) {
            const int c0 = u.pn * BM + bj * HALF + wc * 32 + 8 * fq; const int hh = c0 / 192, dd = c0 - hh * 192; const bool rope = dd >= 128; const int j0 = rope ? (dd - 128) >> 1 : 0;
#pragma unroll
            for (int ai = 0; ai < 2; ++ai) {
                f32x4 cs[4][2];
#pragma unroll
                for (int m = 0; m < 4; ++m) { const f32x4* tp = (const f32x4*)(tab + (size_t)(row0 + ai * HALF + m * 16) * 32 + j0); cs[m][0] = tp[0]; cs[m][1] = tp[1]; }
                __builtin_amdgcn_sched_barrier(0);
#pragma unroll
                for (int m = 0; m < 4; ++m) { const int row = row0 + ai * HALF + m * 16;
                    float v[8];
#pragma unroll
                    for (int n = 0; n < 2; ++n)
#pragma unroll
                        for (int j = 0; j < 4; ++j) v[n * 4 + j] = acc[ai][bj][m][n][j];
                    if (rope) {
                        const float cc[4] = {cs[m][0].x, cs[m][0].z, cs[m][1].x, cs[m][1].z}, sn[4] = {cs[m][0].y, cs[m][0].w, cs[m][1].y, cs[m][1].w};
#pragma unroll
                        for (int p = 0; p < 4; ++p) { const float x1 = v[2 * p], x2 = v[2 * p + 1]; v[2 * p] = x1 * cc[p] - x2 * sn[p]; v[2 * p + 1] = x1 * sn[p] + x2 * cc[p]; }
                    }
                    u32x4 w; w.x = pk2(v[0] * AQS, v[1] * AQS); w.y = pk2(v[2] * AQS, v[3] * AQS); w.z = pk2(v[4] * AQS, v[5] * AQS); w.w = pk2(v[6] * AQS, v[7] * AQS);
                    *(u32x4*)(Q + (size_t)row * 1536 + c0) = w; }
                __builtin_amdgcn_sched_barrier(0);
            }
        }
    }
};
struct EpiLru {
    static constexpr bool PERM = true;
    bf16_t* XC; bf16_t* LA; const float* ba; const float* bx; const float* sp;
    DI void operator()(const Acc& acc, const Unit& u, int wr, int wc, int fr, int fq) const {
        const int row0 = u.pm * BM + wr * 64 + fr, ch0 = u.pn * HALF + wc * 32 + 8 * fq;
#pragma unroll
        for (int ai = 0; ai < 2; ++ai) {
            u32x4 xall[4];
#pragma unroll
            for (int m = 0; m < 4; ++m) xall[m] = *(const u32x4*)(XC + (size_t)(row0 + ai * HALF + m * 16) * 1024 + ch0);
            __builtin_amdgcn_sched_barrier(0);
#pragma unroll
            for (int m = 0; m < 4; ++m) { const int row = row0 + ai * HALF + m * 16;
                const u32x4 xw = xall[m];
                const float xv[8] = {bflo(xw.x), bfhi(xw.x), bflo(xw.y), bfhi(xw.y), bflo(xw.z), bfhi(xw.z), bflo(xw.w), bfhi(xw.w)};
                u32x4 wl, wu;
#pragma unroll
                for (int n = 0; n < 2; ++n) { const f32x4 spv = *(const f32x4*)(sp + ch0 + 4 * n), bav = *(const f32x4*)(ba + ch0 + 4 * n), bxv = *(const f32x4*)(bx + ch0 + 4 * n);
                    float la[4], uu[4];
#pragma unroll
                    for (int j = 0; j < 4; ++j) { const float r = sigmoidf_(acc[ai][0][m][n][j] + bav[j]), gi = sigmoidf_(acc[ai][1][m][n][j] + bxv[j]);
                        const float l = r * spv[j]; la[j] = l; const float a2 = __expf(2.f * l); uu[j] = sqrtf(fmaxf(1.f - a2, 0.f)) * gi * xv[n * 4 + j]; }
                    if (n == 0) { wl.x = pk2(la[0], la[1]); wl.y = pk2(la[2], la[3]); wu.x = pk2(uu[0], uu[1]); wu.y = pk2(uu[2], uu[3]); }
                    else { wl.z = pk2(la[0], la[1]); wl.w = pk2(la[2], la[3]); wu.z = pk2(uu[0], uu[1]); wu.w = pk2(uu[2], uu[3]); } }
                *(u32x4*)(LA + (size_t)row * NP + ch0) = wl;
                *(u32x4*)(XC + (size_t)row * 1024 + ch0) = wu;
                asm volatile("" ::: "memory"); }
        }
    }
};
struct EpiMerge {
    static constexpr bool PERM = true;
    bf16_t* Z; const bf16_t* G; int first;
    DI void operator()(const Acc& acc, const Unit& u, int wr, int wc, int fr, int fq) const {
        const int row0 = u.pm * BM + wr * 64 + fr, col0 = u.pn * BM + wc * 32 + 8 * fq;
#pragma unroll
        for (int ai = 0; ai < 2; ++ai) {
            u32x4 gw[4][2], zw[4][2];
#pragma unroll
            for (int m = 0; m < 4; ++m) { const int row = row0 + ai * HALF + m * 16;
#pragma unroll
                for (int bj = 0; bj < 2; ++bj) { const int c = col0 + bj * HALF; gw[m][bj] = *(const u32x4*)(G + (size_t)row * NP + c);
                    zw[m][bj] = first ? (u32x4){0u, 0u, 0u, 0u} : *(const u32x4*)(Z + (size_t)row * DM + c); } }
            __builtin_amdgcn_sched_barrier(0);
#pragma unroll
            for (int m = 0; m < 4; ++m) { const int row = row0 + ai * HALF + m * 16;
#pragma unroll
                for (int bj = 0; bj < 2; ++bj) { const int c = col0 + bj * HALF;
                    const u32x4 g4 = gw[m][bj], z4 = zw[m][bj];
                    const float gv[8] = {bflo(g4.x), bfhi(g4.x), bflo(g4.y), bfhi(g4.y), bflo(g4.z), bfhi(g4.z), bflo(g4.w), bfhi(g4.w)};
                    const float zv[8] = {bflo(z4.x), bfhi(z4.x), bflo(z4.y), bfhi(z4.y), bflo(z4.z), bfhi(z4.z), bflo(z4.w), bfhi(z4.w)};
                    float o[8];
#pragma unroll
                    for (int n = 0; n < 2; ++n)
#pragma unroll
                        for (int j = 0; j < 4; ++j) o[n * 4 + j] = zv[n * 4 + j] + sigmoidf_(gv[n * 4 + j]) * acc[ai][bj][m][n][j];
                    u32x4 w; w.x = pk2(o[0], o[1]); w.y = pk2(o[2], o[3]); w.z = pk2(o[4], o[5]); w.w = pk2(o[6], o[7]);
                    *(u32x4*)(Z + (size_t)row * DM + c) = w; } }
            __builtin_amdgcn_sched_barrier(0);
        }
    }
};
}

DI int map_row(int map, int n) {
    switch (map) {
        case 1: return ((n >> 7) << 8) + (n & 127);
        case 2: return ((n >> 7) << 8) + 128 + (n & 127);
        case 3: { if (n < 2048) return n; if (n < 2052) return PC_I + n - 2048; if (n < 2056) return PC_F + n - 2052; if (n < 3080) return PC_O + n - 2056; if (n < 3464) return PC_CQ + n - 3080;
                  if (n < 3720) return PC_CKV + n - 3464; if (n < 3784) return PC_KR + n - 3720; if (n < 4808) return PC_CX + n - 3784; return PC_G + n - 4808; }
        case 4: { const int hh = n / 192, dd = n - hh * 192; if (dd < 128) return n; const int jj = dd - 128; return hh * 192 + 128 + (jj < 32 ? 2 * jj : 2 * (jj - 32) + 1); }
        case 5: { const int hh = n >> 8, dd = n & 255; return dd < 128 ? hh * 128 + dd : 1024 + hh * 128 + dd - 128; }
        default: return n;
    }
}
DI void convert_mat(const float* W, int K, int N, bf16_t* WT, int map, int& rot) {
    const int tid_ = opaque_tid(), lane = tid_ & 63, gw = blockIdx.x * 8 + (tid_ >> 6), ngw = gridDim.x * 8, r = lane >> 3, c = lane & 7;
    const int nnb = (N + 31) >> 5, nkb = K >> 6, nitems = nnb * nkb;
    int it = gw - rot; if (it < 0) it += ngw;
    for (; it < nitems; it += 2 * ngw) {
        const int it2 = it + ngw; const bool two = it2 < nitems;
        const int nbA = it / nkb, kbA = it - nbA * nkb, nA = nbA * 32 + 4 * c, kA = kbA * 64 + 8 * r;
        const int nbB = two ? it2 / nkb : nbA, kbB = two ? it2 - nbB * nkb : kbA, nB = nbB * 32 + 4 * c, kB = kbB * 64 + 8 * r;
        const bool okA = nA < N, okB = two && nB < N;
        f32x4 va[8], vb[8];
        if (okA) { const float* src = W + (size_t)kA * N + nA;
#pragma unroll
            for (int i = 0; i < 8; ++i) va[i] = *(const f32x4*)(src + (size_t)i * N); }
        if (okB) { const float* src = W + (size_t)kB * N + nB;
#pragma unroll
            for (int i = 0; i < 8; ++i) vb[i] = *(const f32x4*)(src + (size_t)i * N); }
        __builtin_amdgcn_sched_barrier(0);
#define CV_STORE(v, n0, k0) do { u32x4 o; \
            o.x = pk2(v[0].x, v[1].x); o.y = pk2(v[2].x, v[3].x); o.z = pk2(v[4].x, v[5].x); o.w = pk2(v[6].x, v[7].x); *(u32x4*)(WT + (size_t)map_row(map, (n0)) * K + (k0)) = o; \
            o.x = pk2(v[0].y, v[1].y); o.y = pk2(v[2].y, v[3].y); o.z = pk2(v[4].y, v[5].y); o.w = pk2(v[6].y, v[7].y); *(u32x4*)(WT + (size_t)map_row(map, (n0) + 1) * K + (k0)) = o; \
            o.x = pk2(v[0].z, v[1].z); o.y = pk2(v[2].z, v[3].z); o.z = pk2(v[4].z, v[5].z); o.w = pk2(v[6].z, v[7].z); *(u32x4*)(WT + (size_t)map_row(map, (n0) + 2) * K + (k0)) = o; \
            o.x = pk2(v[0].w, v[1].w); o.y = pk2(v[2].w, v[3].w); o.z = pk2(v[4].w, v[5].w); o.w = pk2(v[6].w, v[7].w); *(u32x4*)(WT + (size_t)map_row(map, (n0) + 3) * K + (k0)) = o; } while (0)
        if (okA) CV_STORE(va, nA, kA);
        if (okB) CV_STORE(vb, nB, kB);
#undef CV_STORE
    }
    rot = (rot + nitems) % ngw;
}

DI void rmsnorm_rows(const float* X, const float* g, bf16_t* O) {
    const int tid_ = opaque_tid(), lane = tid_ & 63, gw = blockIdx.x * 8 + (tid_ >> 6), ngw = gridDim.x * 8;
    f32x4 gv[8];
#pragma unroll
    for (int j = 0; j < 8; ++j) gv[j] = ((const f32x4*)g)[lane + 64 * j];
    for (int r = gw; r < S; r += ngw) {
        const f32x4* xr = (const f32x4*)(X + (size_t)r * DM) + lane; f32x4 v[8]; float s = 0.f;
#pragma unroll
        for (int j = 0; j < 8; ++j) { v[j] = xr[64 * j]; s += (v[j].x * v[j].x + v[j].y * v[j].y) + (v[j].z * v[j].z + v[j].w * v[j].w); }
        const float rstd = 1.f / sqrtf(wave_sum(s) * (1.f / DM) + EPS);
        u32x2* o8 = (u32x2*)(O + (size_t)r * DM) + lane;
#pragma unroll
        for (int j = 0; j < 8; ++j) { u32x2 w; w.x = pk2(v[j].x * rstd * gv[j].x, v[j].y * rstd * gv[j].y); w.y = pk2(v[j].z * rstd * gv[j].z, v[j].w * rstd * gv[j].w); o8[64 * j] = w; }
    }
}
DI void final_norm_rows(float* X, const float* g) {
    const int tid_ = opaque_tid(), lane = tid_ & 63, gw = blockIdx.x * 8 + (tid_ >> 6), ngw = gridDim.x * 8;
    f32x4 gv[8];
#pragma unroll
    for (int j = 0; j < 8; ++j) gv[j] = ((const f32x4*)g)[lane + 64 * j];
    for (int r = gw; r < S; r += ngw) {
        f32x4* xr = (f32x4*)(X + (size_t)r * DM) + lane; f32x4 v[8]; float s = 0.f;
#pragma unroll
        for (int j = 0; j < 8; ++j) { v[j] = xr[64 * j]; s += (v[j].x * v[j].x + v[j].y * v[j].y) + (v[j].z * v[j].z + v[j].w * v[j].w); }
        const float rstd = 1.f / sqrtf(wave_sum(s) * (1.f / DM) + EPS);
#pragma unroll
        for (int j = 0; j < 8; ++j) xr[64 * j] = v[j] * rstd * gv[j];
    }
}
DI void prep_rows(bf16_t* P, const float* qn, const float* kvn, const float* cw, const float* cb, const f32x2* tab, bf16_t* XC) {
    const int tid_ = opaque_tid(), lane = tid_ & 63, gw = blockIdx.x * 8 + (tid_ >> 6), ngw = gridDim.x * 8;
    f32x2 qg[3], kg[2], cbv[8], cwv[8][4];
#pragma unroll
    for (int k = 0; k < 3; ++k) qg[k] = *(const f32x2*)(qn + 128 * k + 2 * lane);
#pragma unroll
    for (int k = 0; k < 2; ++k) kg[k] = *(const f32x2*)(kvn + 128 * k + 2 * lane);
#pragma unroll
    for (int k = 0; k < 8; ++k) { cbv[k] = *(const f32x2*)(cb + 128 * k + 2 * lane);
#pragma unroll
        for (int jj = 0; jj < 4; ++jj) cwv[k][jj] = *(const f32x2*)(cw + jj * 1024 + 128 * k + 2 * lane); }
    for (int t = gw; t < S; t += ngw) {
        bf16_t* row = P + (size_t)t * NP;
        unsigned wq[3], wk[2], wc[8][4];
#pragma unroll
        for (int k = 0; k < 3; ++k) wq[k] = *(const unsigned*)(row + PC_CQ + 128 * k + 2 * lane);
#pragma unroll
        for (int k = 0; k < 2; ++k) wk[k] = *(const unsigned*)(row + PC_CKV + 128 * k + 2 * lane);
        const int j = lane & 31; const float x1 = bf2f(row[PC_KR + j]), x2 = bf2f(row[PC_KR + 32 + j]); const f32x2 cs = tab[(size_t)t * 32 + j];
#pragma unroll
        for (int k = 0; k < 8; ++k)
#pragma unroll
            for (int jj = 0; jj < 4; ++jj) { const int tt = t - 3 + jj; wc[k][jj] = tt >= 0 ? *(const unsigned*)(P + (size_t)tt * NP + PC_CX + 128 * k + 2 * lane) : 0u; }
        __builtin_amdgcn_sched_barrier(0);
        { float s = 0.f;
#pragma unroll
          for (int k = 0; k < 3; ++k) { const float a = bflo(wq[k]), b = bfhi(wq[k]); s += a * a + b * b; }
          const float rstd = 1.f / sqrtf(wave_sum(s) * (1.f / 384.f) + EPS);
#pragma unroll
          for (int k = 0; k < 3; ++k) *(unsigned*)(row + PC_CQ + 128 * k + 2 * lane) = pk2(bflo(wq[k]) * rstd * qg[k].x, bfhi(wq[k]) * rstd * qg[k].y); }
        { float s = 0.f;
#pragma unroll
          for (int k = 0; k < 2; ++k) { const float a = bflo(wk[k]), b = bfhi(wk[k]); s += a * a + b * b; }
          const float rstd = 1.f / sqrtf(wave_sum(s) * (1.f / 256.f) + EPS);
#pragma unroll
          for (int k = 0; k < 2; ++k) *(unsigned*)(row + PC_CKV + 128 * k + 2 * lane) = pk2(bflo(wk[k]) * rstd * kg[k].x, bfhi(wk[k]) * rstd * kg[k].y); }
        { const unsigned o = pk2(x1 * cs.x - x2 * cs.y, x1 * cs.y + x2 * cs.x); if (lane < 32) *(unsigned*)(row + PC_KR + 2 * j) = o; }
#pragma unroll
        for (int k = 0; k < 8; ++k) { float a0 = cbv[k].x, a1 = cbv[k].y;
#pragma unroll
            for (int jj = 0; jj < 4; ++jj) { a0 += cwv[k][jj].x * bflo(wc[k][jj]); a1 += cwv[k][jj].y * bfhi(wc[k][jj]); }
            *(unsigned*)(XC + (size_t)t * 1024 + 128 * k + 2 * lane) = pk2(a0, a1); }
    }
}

DI void lru_p1(const bf16_t* LA, const bf16_t* U, float* CA, float* CH) {
    const int tid = opaque_tid();
    for (int c = blockIdx.x; c < 256; c += gridDim.x) {
        float h0 = 0.f, h1 = 0.f, s0 = 0.f, s1 = 0.f;
#pragma unroll 1
        for (int t0 = 0; t0 < 64; t0 += 16) {
            unsigned lw[16], uw[16];
#pragma unroll
            for (int i = 0; i < 16; ++i) { const size_t row = (size_t)c * 64 + t0 + i; lw[i] = *(const unsigned*)(LA + row * NP + 2 * tid); uw[i] = *(const unsigned*)(U + row * 1024 + 2 * tid); }
#pragma unroll
            for (int i = 0; i < 16; ++i) { const float l0 = bflo(lw[i]), l1 = bfhi(lw[i]); s0 += l0; s1 += l1; h0 = __expf(l0) * h0 + bflo(uw[i]); h1 = __expf(l1) * h1 + bfhi(uw[i]); }
        }
        CA[c * 1024 + 2 * tid] = __expf(s0); CA[c * 1024 + 2 * tid + 1] = __expf(s1); CH[c * 1024 + 2 * tid] = h0; CH[c * 1024 + 2 * tid + 1] = h1;
    }
}
DI void lru_p2(const float* CA, const float* CH, float* CARRY) {
    const int tid = opaque_tid(), lane = tid & 63, gw = blockIdx.x * 8 + (tid >> 6), ngw = gridDim.x * 8;
    for (int ch = gw; ch < 1024; ch += ngw) {
        float a[4], hh[4];
#pragma unroll
        for (int i = 0; i < 4; ++i) { a[i] = CA[(4 * lane + i) * 1024 + ch]; hh[i] = CH[(4 * lane + i) * 1024 + ch]; }
        float A = a[0], H = hh[0];
#pragma unroll
        for (int i = 1; i < 4; ++i) { H = a[i] * H + hh[i]; A = A * a[i]; }
#pragma unroll
        for (int o = 1; o < 64; o <<= 1) { const float Ap = __shfl_up(A, o), Hp = __shfl_up(H, o); if (lane >= o) { H = A * Hp + H; A = A * Ap; } }
        float st = __shfl_up(H, 1); if (lane == 0) st = 0.f;
#pragma unroll
        for (int i = 0; i < 4; ++i) { CARRY[(4 * lane + i) * 1024 + ch] = st; st = a[i] * st + hh[i]; }
    }
}
DI void lru_p3(const bf16_t* LA, const bf16_t* U, const float* CARRY, bf16_t* Y) {
    const int tid = opaque_tid();
    for (int c = blockIdx.x; c < 256; c += gridDim.x) {
        float h0 = CARRY[c * 1024 + 2 * tid], h1 = CARRY[c * 1024 + 2 * tid + 1];
#pragma unroll 1
        for (int t0 = 0; t0 < 64; t0 += 16) {
            unsigned lw[16], uw[16];
#pragma unroll
            for (int i = 0; i < 16; ++i) { const size_t row = (size_t)c * 64 + t0 + i; lw[i] = *(const unsigned*)(LA + row * NP + 2 * tid); uw[i] = *(const unsigned*)(U + row * 1024 + 2 * tid); }
            asm volatile("" ::: "memory");
#pragma unroll
            for (int i = 0; i < 16; ++i) { const size_t row = (size_t)c * 64 + t0 + i; h0 = __expf(bflo(lw[i])) * h0 + bflo(uw[i]); h1 = __expf(bfhi(lw[i])) * h1 + bfhi(uw[i]);
                *(unsigned*)(Y + row * 3072 + 2048 + 2 * tid) = pk2(h0, h1); }
            asm volatile("" ::: "memory");
        }
    }
}

DI void mlstm_a(LAS unsigned char* smem, const bf16_t* P, const float* gbias, bf16_t* CS, float* SMALL) {
    const int tid = opaque_tid(), lane = tid & 63, wid = tid >> 6, l31 = lane & 31, h = lane >> 5, q4 = (lane & 15) >> 2, p4 = lane & 3, blk = (lane >> 4) & 1;
    LAS float* sw = (LAS float*)smem;
    LAS unsigned char* Ks = smem + 1024;
    LAS unsigned char* Vs = smem + 1024 + 20480;
    for (int uid = blockIdx.x; uid < 1024; uid += gridDim.x) {
        const int c = uid >> 2, hh = uid & 3; const size_t row0 = (size_t)c * 64;
        if (wid == 0) {
            const bf16_t* r = P + (row0 + lane) * NP;
            const float li = bf2f(r[PC_I + hh]) + gbias[hh], lf = logsigmoid_(bf2f(r[PC_F + hh]) + gbias[4 + hh]);
            const float bc = wave_incl_scan(lf, lane), bt = __shfl(bc, 63), ds = bt - bc + li, M = wave_max(ds);
            sw[lane] = expf(ds - M);
            if (lane == 0) { SMALL[SM_BT + uid] = bt; SMALL[SM_MC + uid] = M; }
        }
        __syncthreads();
#pragma unroll
        for (int i = 0; i < 2; ++i) { const int id = tid + 512 * i, s = id >> 4, d8 = (id & 15) * 8; const u32x4 v = *(const u32x4*)(P + (row0 + s) * NP + PC_K + hh * 128 + d8); const float w = sw[s];
            u32x4 o; o.x = pk2(bflo(v.x) * w, bfhi(v.x) * w); o.y = pk2(bflo(v.y) * w, bfhi(v.y) * w); o.z = pk2(bflo(v.z) * w, bfhi(v.z) * w); o.w = pk2(bflo(v.w) * w, bfhi(v.w) * w);
            *(LAS u32x4*)(Ks + s * 320 + d8 * 2) = o; }
#pragma unroll
        for (int i = 0; i < 4; ++i) { const int id = tid + 512 * i, s = id >> 5, d8 = (id & 31) * 8; *(LAS u32x4*)(Vs + s * 576 + d8 * 2) = *(const u32x4*)(P + (row0 + s) * NP + PC_V + hh * 256 + d8); }
        __syncthreads();
        f32x16 acc[4];
#pragma unroll
        for (int d = 0; d < 4; ++d)
#pragma unroll
            for (int i = 0; i < 16; ++i) acc[d][i] = 0.f;
#pragma unroll
        for (int kk = 0; kk < 4; ++kk) {
            const bf16x8 vf = tr_frag(Vs + (16 * kk + 8 * h + q4) * 576 + (32 * wid + 16 * blk) * 2 + 8 * p4, 576);
#pragma unroll
            for (int d = 0; d < 4; ++d) { const bf16x8 kf = tr_frag(Ks + (16 * kk + 8 * h + q4) * 320 + (32 * d + 16 * blk) * 2 + 8 * p4, 320); acc[d] = mfma32(kf, vf, acc[d]); }
        }
        bf16_t* cs = CS + (size_t)uid * 32768 + (32 * wid + l31) * 128;
#pragma unroll
        for (int d = 0; d < 4; ++d)
#pragma unroll
            for (int g = 0; g < 4; ++g) { u32x2 w; w.x = pk2(acc[d][4 * g], acc[d][4 * g + 1]); w.y = pk2(acc[d][4 * g + 2], acc[d][4 * g + 3]); *(u32x2*)(cs + 32 * d + 8 * g + 4 * h) = w; }
        if (tid < 128) { float s = 0.f;
#pragma unroll 8
            for (int t = 0; t < 64; ++t) s += bf2f(*(LAS const bf16_t*)(Ks + t * 320 + tid * 2));
            SMALL[SM_DN + uid * 128 + tid] = s; }
        __syncthreads();
    }
}
DI void mlstm_b(LAS unsigned char* smem, bf16_t* CS, float* SMALL) {
    const int tid = opaque_tid();
    LAS float* dec = (LAS float*)smem; LAS float* inj = dec + 1024;
    LAS float* sbt = inj + 1024; LAS float* smc = sbt + 1024;
    sbt[tid] = SMALL[SM_BT + tid]; sbt[tid + 512] = SMALL[SM_BT + tid + 512]; smc[tid] = SMALL[SM_MC + tid]; smc[tid + 512] = SMALL[SM_MC + tid + 512];
    __syncthreads();
    if (tid < 4) { float m = -1e30f;
        for (int c = 0; c < 256; ++c) { const float bt = sbt[c * 4 + tid], M = smc[c * 4 + tid]; sbt[c * 4 + tid] = m;
            const float mn = fmaxf(bt + m, M); dec[tid * 256 + c] = __expf(bt + m - mn); inj[tid * 256 + c] = __expf(M - mn); m = mn; } }
    __syncthreads();
    if (blockIdx.x == 0) { SMALL[SM_MPREV + tid] = sbt[tid]; SMALL[SM_MPREV + tid + 512] = sbt[tid + 512]; }
    for (int e = blockIdx.x * 512 + tid; e < 131072; e += gridDim.x * 512) {
        const int hh = e >> 15, idx = e & 32767; bf16_t* pp = CS + (size_t)hh * 32768 + idx; float st = 0.f;
        bf16_t d[32];
#pragma unroll
        for (int i = 0; i < 32; ++i) d[i] = pp[(size_t)i * 131072];
#pragma unroll 1
        for (int c0 = 0; c0 < 256; c0 += 32) {
            bf16_t dn[32];
            const int cn = c0 + 32 < 256 ? c0 + 32 : c0;
#pragma unroll
            for (int i = 0; i < 32; ++i) dn[i] = pp[(size_t)(cn + i) * 131072];
            asm volatile("" ::: "memory");
#pragma unroll
            for (int i = 0; i < 32; ++i) { pp[(size_t)(c0 + i) * 131072] = f2bf(st); st = dec[hh * 256 + c0 + i] * st + inj[hh * 256 + c0 + i] * bf2f(d[i]); }
            asm volatile("" ::: "memory");
#pragma unroll
            for (int i = 0; i < 32; ++i) d[i] = dn[i];
        }
    }
    if (blockIdx.x == gridDim.x - 1) { const int hh = tid >> 7; float* pp = SMALL + SM_DN + tid; float st = 0.f;
#pragma unroll 1
        for (int c0 = 0; c0 < 256; c0 += 32) {
            float d[32];
#pragma unroll
            for (int i = 0; i < 32; ++i) d[i] = pp[(c0 + i) * 512];
            asm volatile("" ::: "memory");
#pragma unroll
            for (int i = 0; i < 32; ++i) { pp[(c0 + i) * 512] = st; st = dec[hh * 256 + c0 + i] * st + inj[hh * 256 + c0 + i] * d[i]; }
            asm volatile("" ::: "memory");
        } }
    __syncthreads();
}
DI void mlstm_c(LAS unsigned char* smem, const bf16_t* P, const float* gbias, const float* onorm, const bf16_t* CS, const float* SMALL, bf16_t* Y) {
    const int tid = opaque_tid(), lane = tid & 63, wid = tid >> 6, l31 = lane & 31, h = lane >> 5, q4 = (lane & 15) >> 2, p4 = lane & 3, blk = (lane >> 4) & 1;
    LAS float* sbc = (LAS float*)smem; LAS float* sav = sbc + 64; LAS float* snp = sbc + 128; LAS float* sx = sbc + 256;
    LAS unsigned char* Qs = smem + 2048;
    LAS unsigned char* Ks = Qs + 17408;
    LAS unsigned char* Vs = Ks + 17408;
    const int tb = wid & 1, dvq = wid >> 1, t = 32 * tb + l31, pr = pi32(l31);
    for (int uid = blockIdx.x; uid < 1024; uid += gridDim.x) {
        const int c = uid >> 2, hh = uid & 3; const size_t row0 = (size_t)c * 64;
        if (wid == 0) {
            const bf16_t* r = P + (row0 + lane) * NP;
            const float li = bf2f(r[PC_I + hh]) + gbias[hh], lf = logsigmoid_(bf2f(r[PC_F + hh]) + gbias[4 + hh]);
            const float bc = wave_incl_scan(lf, lane);
            sbc[lane] = bc; sav[lane] = li - bc;
        }
        if (tid >= 64 && tid < 192) snp[tid - 64] = SMALL[SM_DN + uid * 128 + tid - 64];
#pragma unroll
        for (int i = 0; i < 2; ++i) { const int id = tid + 512 * i, s = id >> 4, d8 = (id & 15) * 8;
            *(LAS u32x4*)(Qs + s * 272 + d8 * 2) = *(const u32x4*)(P + (row0 + s) * NP + PC_Q + hh * 128 + d8);
            *(LAS u32x4*)(Ks + s * 272 + d8 * 2) = *(const u32x4*)(P + (row0 + s) * NP + PC_K + hh * 128 + d8); }
#pragma unroll
        for (int i = 0; i < 4; ++i) { const int id = tid + 512 * i, s = id >> 5, d8 = (id & 31) * 8; *(LAS u32x4*)(Vs + s * 576 + d8 * 2) = *(const u32x4*)(P + (row0 + s) * NP + PC_V + hh * 256 + d8); }
        __syncthreads();
        const float mprev = SMALL[SM_MPREV + uid];
        bf16x8 qf[8];
#pragma unroll
        for (int ks = 0; ks < 8; ++ks) qf[ks] = *(const LAS bf16x8*)(Qs + t * 272 + (16 * ks + 8 * h) * 2);
        f32x16 st0, st1;
#pragma unroll
        for (int i = 0; i < 16; ++i) { st0[i] = 0.f; st1[i] = 0.f; }
#pragma unroll
        for (int ks = 0; ks < 8; ++ks) { const bf16x8 a0 = *(const LAS bf16x8*)(Ks + pr * 272 + (16 * ks + 8 * h) * 2); st0 = mfma32(a0, qf[ks], st0);
            if (tb) { const bf16x8 a1 = *(const LAS bf16x8*)(Ks + (32 + pr) * 272 + (16 * ks + 8 * h) * 2); st1 = mfma32(a1, qf[ks], st1); } }
        const float bt = sbc[t];
        float mx = -1e30f;
#pragma unroll
        for (int i = 0; i < 16; ++i) { const int s = 16 * (i >> 3) + 8 * h + (i & 7); if (s <= t) mx = fmaxf(mx, sav[s]); if (tb) mx = fmaxf(mx, (s + 32 <= t) ? sav[s + 32] : -1e30f); }
        mx = fmaxf(mx, __shfl_xor(mx, 32));
        const float mt = bt + fmaxf(mprev, mx);
        float den = 0.f;
#pragma unroll
        for (int i = 0; i < 16; ++i) { const int s = 16 * (i >> 3) + 8 * h + (i & 7);
            const float w0 = (s <= t) ? __expf(bt + sav[s] - mt) * MQS : 0.f; st0[i] *= w0; den += st0[i];
            const float w1 = (tb && (s + 32 <= t)) ? __expf(bt + sav[s + 32] - mt) * MQS : 0.f; st1[i] *= w1; den += st1[i]; }
        den += __shfl_xor(den, 32);
        float qn = 0.f;
#pragma unroll
        for (int ks = 0; ks < 8; ++ks)
#pragma unroll
            for (int j = 0; j < 8; ++j) qn += bf2f((bf16_t)qf[ks][j]) * snp[16 * ks + 8 * h + j];
        qn += __shfl_xor(qn, 32);
        const float wi = expf(bt + mprev - mt) * MQS;
        den += wi * qn;
        const float dinv = 1.f / fmaxf(fabsf(den), expf(-mt));
        bf16x8 pf[4];
        pf[0] = pack8(st0[0], st0[1], st0[2], st0[3], st0[4], st0[5], st0[6], st0[7]); pf[1] = pack8(st0[8], st0[9], st0[10], st0[11], st0[12], st0[13], st0[14], st0[15]);
        pf[2] = pack8(st1[0], st1[1], st1[2], st1[3], st1[4], st1[5], st1[6], st1[7]); pf[3] = pack8(st1[8], st1[9], st1[10], st1[11], st1[12], st1[13], st1[14], st1[15]);
        float hv[2][16]; float ss = 0.f;
#pragma unroll
        for (int db = 0; db < 2; ++db) { const int dvb = 2 * dvq + db;
            f32x16 a1, a2;
#pragma unroll
            for (int i = 0; i < 16; ++i) { a1[i] = 0.f; a2[i] = 0.f; }
#pragma unroll
            for (int sb = 0; sb < 2; ++sb)
#pragma unroll
                for (int kk = 0; kk < 2; ++kk) { if (sb <= tb) { const bf16x8 vf = tr_frag(Vs + (32 * sb + 16 * kk + 8 * h + q4) * 576 + (32 * dvb + 16 * blk) * 2 + 8 * p4, 576); a1 = mfma32(vf, pf[2 * sb + kk], a1); } }
            const bf16_t* cp = CS + (size_t)uid * 32768 + (32 * dvb + l31) * 128 + 8 * h;
#pragma unroll
            for (int ks = 0; ks < 8; ++ks) { const bf16x8 cf = *(const bf16x8*)(cp + 16 * ks); a2 = mfma32(cf, qf[ks], a2); }
#pragma unroll
            for (int i = 0; i < 16; ++i) { const float v = (a1[i] + wi * a2[i]) * dinv; hv[db][i] = v; ss += v * v; }
        }
        ss += __shfl_xor(ss, 32);
        if (h == 0) sx[(tb * 4 + dvq) * 32 + l31] = ss;
        __syncthreads();
        const float tot = (sx[(tb * 4 + 0) * 32 + l31] + sx[(tb * 4 + 1) * 32 + l31]) + (sx[(tb * 4 + 2) * 32 + l31] + sx[(tb * 4 + 3) * 32 + l31]);
        const float rstd = 1.f / sqrtf(tot * (1.f / 256.f) + EPS);
        f32x4 gnv[2][4]; u32x2 ogv[2][4];
#pragma unroll
        for (int db = 0; db < 2; ++db)
#pragma unroll
            for (int g = 0; g < 4; ++g) { const int col = hh * 256 + 32 * (2 * dvq + db) + 8 * g + 4 * h; gnv[db][g] = *(const f32x4*)(onorm + col); ogv[db][g] = *(const u32x2*)(P + (row0 + t) * NP + PC_O + col); }
        __builtin_amdgcn_sched_barrier(0);
#pragma unroll
        for (int db = 0; db < 2; ++db)
#pragma unroll
            for (int g = 0; g < 4; ++g) { const int col = hh * 256 + 32 * (2 * dvq + db) + 8 * g + 4 * h;
                const f32x4 gn = gnv[db][g]; const u32x2 og = ogv[db][g];
                const float o0 = hv[db][4 * g] * rstd * gn.x * sigmoidf_(bflo(og.x)), o1 = hv[db][4 * g + 1] * rstd * gn.y * sigmoidf_(bfhi(og.x));
                const float o2 = hv[db][4 * g + 2] * rstd * gn.z * sigmoidf_(bflo(og.y)), o3 = hv[db][4 * g + 3] * rstd * gn.w * sigmoidf_(bfhi(og.y));
                u32x2 w; w.x = pk2(o0, o1); w.y = pk2(o2, o3); *(u32x2*)(Y + (row0 + t) * 3072 + col) = w; }
        __syncthreads();
    }
}

DI void attn_unit(LAS unsigned char* smem, int hh, int qb, const bf16_t* Q, const bf16_t* KN, const bf16_t* P, const bf16_t* VT, bf16_t* Y) {
    const int tid = opaque_tid(), lane = tid & 63, wid = __builtin_amdgcn_readfirstlane(tid >> 6), l31 = lane & 31, h = lane >> 5;
    LAS unsigned char* Kb = smem; LAS unsigned char* Vb = smem + 51200;
    const int q0 = qb * 256, qw = q0 + 32 * wid, q = qw + l31, NT = 4 * qb + 4;
    bf16x8 qf[12];
#pragma unroll
    for (int ks = 0; ks < 12; ++ks) qf[ks] = *(const bf16x8*)(Q + (size_t)q * 1536 + hh * 192 + 16 * ks + 8 * h);
    f32x16 o[4];
#pragma unroll
    for (int d = 0; d < 4; ++d)
#pragma unroll
        for (int i = 0; i < 16; ++i) o[d][i] = 0.f;
    float mref = 0.f, lrun = 0.f; bool first = true;
    const bf16_t* ksrc0; const bf16_t* ksrc2; const bf16_t* vsrc0; int kdst0, kdst2, vdst0;
    { const int row = tid >> 4, ch = tid & 15; ksrc0 = KN + (size_t)row * 1024 + hh * 128 + 8 * ch; kdst0 = row * 400 + ch * 16; }
    { const int row = tid >> 3, ch = tid & 7; ksrc2 = P + (size_t)row * NP + PC_KR + 8 * ch; kdst2 = row * 400 + 256 + ch * 16; }
    { const int d = tid >> 3, ch = tid & 7; vsrc0 = VT + (size_t)(hh * 128 + d) * S + 8 * ch; vdst0 = d * 144 + ch * 16; }
    u32x4 kr[3], vr[2];
#define ATT_LOAD(tt) do { kr[0] = *(const u32x4*)(ksrc0 + (size_t)(tt) * 65536); kr[1] = *(const u32x4*)(ksrc0 + (size_t)(tt) * 65536 + 32 * 1024); kr[2] = *(const u32x4*)(ksrc2 + (size_t)(tt) * (64 * NP)); \
        vr[0] = *(const u32x4*)(vsrc0 + (size_t)(tt) * 64); vr[1] = *(const u32x4*)(vsrc0 + (size_t)(tt) * 64 + (size_t)64 * S); } while (0)
#define ATT_WRITE(kbuf, vslot) do { *(LAS u32x4*)(Kb + (kbuf) * 25600 + kdst0) = kr[0]; *(LAS u32x4*)(Kb + (kbuf) * 25600 + kdst0 + 32 * 400) = kr[1]; *(LAS u32x4*)(Kb + (kbuf) * 25600 + kdst2) = kr[2]; \
        *(LAS u32x4*)(Vb + (vslot) * 18432 + vdst0) = vr[0]; *(LAS u32x4*)(Vb + (vslot) * 18432 + vdst0 + 64 * 144) = vr[1]; } while (0)
#define ATT_BAR() do { asm volatile("s_waitcnt lgkmcnt(0)" ::: "memory"); __builtin_amdgcn_s_barrier(); asm volatile("" ::: "memory"); } while (0)
    ATT_LOAD(0);
    ATT_WRITE(0, 0);
    ATT_BAR();
    const int koff = pi32(l31) * 400 + 16 * h, voff = l31 * 144 + 16 * h;
#define SB() __builtin_amdgcn_sched_barrier(0)
#define KFR(kb, ks, b) (*(const LAS bf16x8*)((kb) + (b) * 32 * 400 + (ks) * 32))
#define VFR(vb, d, kk) (*(const LAS bf16x8*)((vb) + (d) * 32 * 144 + (kk) * 32))
    int vs = 0;
    for (int t = 0; t < NT; ++t) {
        const int kc = t & 1, vn = vs == 2 ? 0 : vs + 1;
        if (t + 1 < NT) ATT_LOAD(t + 1);
        if (64 * t <= qw + 31) {
            LAS const unsigned char* kb = Kb + kc * 25600 + koff; LAS const unsigned char* vb = Vb + vs * 18432 + voff;
            f32x16 s0, s1;
#pragma unroll
            for (int i = 0; i < 16; ++i) { s0[i] = 0.f; s1[i] = 0.f; }
            bf16x8 fa[4], fb[4];
            fa[0] = KFR(kb, 0, 0); fa[1] = KFR(kb, 0, 1); fa[2] = KFR(kb, 1, 0); fa[3] = KFR(kb, 1, 1); SB();
#pragma unroll
            for (int st = 0; st < 6; st += 2) {
                fb[0] = KFR(kb, 2 * st + 2, 0); fb[1] = KFR(kb, 2 * st + 2, 1); fb[2] = KFR(kb, 2 * st + 3, 0); fb[3] = KFR(kb, 2 * st + 3, 1); SB();
                s0 = mfma32(fa[0], qf[2 * st], s0); s1 = mfma32(fa[1], qf[2 * st], s1); s0 = mfma32(fa[2], qf[2 * st + 1], s0); s1 = mfma32(fa[3], qf[2 * st + 1], s1); SB();
                if (st + 2 < 6) { fa[0] = KFR(kb, 2 * st + 4, 0); fa[1] = KFR(kb, 2 * st + 4, 1); fa[2] = KFR(kb, 2 * st + 5, 0); fa[3] = KFR(kb, 2 * st + 5, 1); }
                else { fa[0] = VFR(vb, 0, 0); fa[1] = VFR(vb, 0, 1); fa[2] = VFR(vb, 0, 2); fa[3] = VFR(vb, 0, 3); }
                SB();
                s0 = mfma32(fb[0], qf[2 * st + 2], s0); s1 = mfma32(fb[1], qf[2 * st + 2], s1); s0 = mfma32(fb[2], qf[2 * st + 3], s0); s1 = mfma32(fb[3], qf[2 * st + 3], s1); SB();
            }
            if (64 * t + 63 > qw) {
#pragma unroll
                for (int i = 0; i < 16; ++i) { const int kv = 64 * t + 16 * (i >> 3) + 8 * h + (i & 7); if (kv > q) s0[i] = -1e30f; if (kv + 32 > q) s1[i] = -1e30f; }
            }
            float mx = fmaxf(s0[0], s1[0]);
#pragma unroll
            for (int i = 1; i < 16; ++i) mx = fmaxf(mx, fmaxf(s0[i], s1[i]));
            mx = fmaxf(mx, __shfl_xor(mx, 32));
            if (first || __any(mx - mref > 8.f)) {
                const float dl = first ? mx : fmaxf(mx - mref, 0.f);
                mref += dl;
                if (!first) { const float f = __builtin_amdgcn_exp2f(-dl); lrun *= f;
#pragma unroll
                    for (int d = 0; d < 4; ++d)
#pragma unroll
                        for (int i = 0; i < 16; ++i) o[d][i] *= f; }
                first = false; }
            float rs = 0.f;
#pragma unroll
            for (int i = 0; i < 16; ++i) { s0[i] = __builtin_amdgcn_exp2f(s0[i] - mref); s1[i] = __builtin_amdgcn_exp2f(s1[i] - mref); rs += s0[i] + s1[i]; }
            lrun += rs;
            bf16x8 pf[4];
            pf[0] = pack8(s0[0], s0[1], s0[2], s0[3], s0[4], s0[5], s0[6], s0[7]); pf[1] = pack8(s0[8], s0[9], s0[10], s0[11], s0[12], s0[13], s0[14], s0[15]);
            pf[2] = pack8(s1[0], s1[1], s1[2], s1[3], s1[4], s1[5], s1[6], s1[7]); pf[3] = pack8(s1[8], s1[9], s1[10], s1[11], s1[12], s1[13], s1[14], s1[15]);
            SB();
            fb[0] = VFR(vb, 1, 0); fb[1] = VFR(vb, 1, 1); fb[2] = VFR(vb, 1, 2); fb[3] = VFR(vb, 1, 3); SB();
            o[0] = mfma32(fa[0], pf[0], o[0]); o[0] = mfma32(fa[1], pf[1], o[0]); o[0] = mfma32(fa[2], pf[2], o[0]); o[0] = mfma32(fa[3], pf[3], o[0]); SB();
            fa[0] = VFR(vb, 2, 0); fa[1] = VFR(vb, 2, 1); fa[2] = VFR(vb, 2, 2); fa[3] = VFR(vb, 2, 3); SB();
            o[1] = mfma32(fb[0], pf[0], o[1]); o[1] = mfma32(fb[1], pf[1], o[1]); o[1] = mfma32(fb[2], pf[2], o[1]); o[1] = mfma32(fb[3], pf[3], o[1]); SB();
            fb[0] = VFR(vb, 3, 0); fb[1] = VFR(vb, 3, 1); fb[2] = VFR(vb, 3, 2); fb[3] = VFR(vb, 3, 3); SB();
            o[2] = mfma32(fa[0], pf[0], o[2]); o[2] = mfma32(fa[1], pf[1], o[2]); o[2] = mfma32(fa[2], pf[2], o[2]); o[2] = mfma32(fa[3], pf[3], o[2]); SB();
            o[3] = mfma32(fb[0], pf[0], o[3]); o[3] = mfma32(fb[1], pf[1], o[3]); o[3] = mfma32(fb[2], pf[2], o[3]); o[3] = mfma32(fb[3], pf[3], o[3]); SB();
        }
        if (t + 1 < NT) ATT_WRITE(kc ^ 1, vn);
        ATT_BAR();
        vs = vn;
    }
#undef SB
#undef KFR
#undef VFR
#undef ATT_LOAD
#undef ATT_WRITE
#undef ATT_BAR
    lrun += __shfl_xor(lrun, 32);
    const float inv = 1.f / lrun;
    bf16_t* yp = Y + (size_t)q * 3072 + 1024 + hh * 128 + 4 * h;
#pragma unroll
    for (int d = 0; d < 4; ++d)
#pragma unroll
        for (int g = 0; g < 4; ++g) { u32x2 w; w.x = pk2(o[d][4 * g] * inv, o[d][4 * g + 1] * inv); w.y = pk2(o[d][4 * g + 2] * inv, o[d][4 * g + 3] * inv); *(u32x2*)(yp + 32 * d + 8 * g) = w; }
}

#define XB_TMO      128
#define XB_XCNT(j)  (256  + 64 * (j))
#define XB_XSUB(j)  (1280 + 64 * (j))
#define XB_XGEN(j)  (2304 + 64 * (j))
#define XB_TOP      3328
#define XB_TOPGEN   3392
#define XCD_BAR_WORDS 3456
#define XB_SPIN_CAP (1u << 23)
DI unsigned xb_ld(unsigned* p)              { return __hip_atomic_load(p, __ATOMIC_RELAXED, __HIP_MEMORY_SCOPE_AGENT); }
DI unsigned xb_add(unsigned* p, unsigned v) { return __hip_atomic_fetch_add(p, v, __ATOMIC_RELAXED, __HIP_MEMORY_SCOPE_AGENT); }
DI unsigned xb_xcc_id() { return (unsigned)__builtin_amdgcn_s_getreg((3 << 11) | 20) & 0xFu; }
#define XB_SPIN(cond, bar) do { unsigned _sp = 0; while (cond) { __builtin_amdgcn_s_sleep(1); \
    if ((++_sp & 255u) == 0u) { if (xb_ld(&(bar)[XB_TMO])) break; if (_sp > XB_SPIN_CAP) { atomicAdd(&(bar)[XB_TMO], 1u); break; } } } } while (0)
struct XcdBarrier { unsigned* bar; unsigned x; volatile LAS unsigned* st; };
DI XcdBarrier xcd_barrier_post(unsigned* bar, volatile LAS unsigned* st) {
    XcdBarrier b; b.bar = bar; b.x = xb_xcc_id(); b.st = st;
    if (threadIdx.x == 0) (void)xb_add(&bar[XB_XCNT(b.x)], 1u);
    return b;
}
DI void xcd_barrier_complete(unsigned* bar, unsigned x, unsigned& nloc, unsigned& nx) {
    const unsigned G = gridDim.x * gridDim.y * gridDim.z;
    unsigned sum, cnt, mine, sp = 0u;
    for (;;) {
        sum = 0u; cnt = 0u; mine = 0u;
#pragma unroll
        for (unsigned j = 0; j < 16; ++j) { const unsigned c = xb_ld(&bar[XB_XCNT(j)]); sum += c; cnt += (c > 0u) ? 1u : 0u; mine = (j == x) ? c : mine; }
        if (sum == G) break;
        __builtin_amdgcn_s_sleep(1);
        if ((++sp & 255u) == 0u) { if (xb_ld(&bar[XB_TMO])) break; if (sp > XB_SPIN_CAP) { atomicAdd(&bar[XB_TMO], 1u); break; } }
    }
    nloc = mine > 0u ? mine : 1u; nx = cnt > 0u ? cnt : 1u;
}
DI void xcd_barrier(const XcdBarrier& b) {
    asm volatile("s_waitcnt vmcnt(0)" ::: "memory");
    __syncthreads();
    if (threadIdx.x == 0) {
        unsigned* bar = b.bar;
        __builtin_amdgcn_s_waitcnt(0);
        unsigned nloc = b.st[0], nx = b.st[1];
        if (nloc == 0u) { xcd_barrier_complete(bar, b.x, nloc, nx); b.st[0] = nloc; b.st[1] = nx; }
        const unsigned old = xb_add(&bar[XB_XSUB(b.x)], 1u);
        const unsigned gen = old / nloc;
        if (old + 1u == (gen + 1u) * nloc) {
            __builtin_amdgcn_fence(__ATOMIC_RELEASE, "agent");
            asm volatile("s_waitcnt vmcnt(0)" ::: "memory");
            const unsigned og = xb_add(&bar[XB_TOP], 1u);
            const unsigned tg = og / nx;
            if (og + 1u == (tg + 1u) * nx) xb_add(&bar[XB_TOPGEN], 1u);
            else XB_SPIN(xb_ld(&bar[XB_TOPGEN]) == tg, bar);
            __builtin_amdgcn_fence(__ATOMIC_ACQUIRE, "agent");
            xb_add(&bar[XB_XGEN(b.x)], 1u);
            asm volatile("s_waitcnt vmcnt(0)" ::: "memory");
        } else {
            XB_SPIN(xb_ld(&bar[XB_XGEN(b.x)]) == gen, bar);
            __builtin_amdgcn_fence(__ATOMIC_ACQUIRE, "agent");
            asm volatile("s_waitcnt vmcnt(0)" ::: "memory");
        }
    }
    __syncthreads();
}

struct Params { const float* in[27]; float* out; unsigned char* ws; };

__global__ void __launch_bounds__(512, 2) mega_fwd(Params p) {
    extern __shared__ __attribute__((aligned(16))) unsigned char smem_raw[];
    LAS unsigned char* smem = (LAS unsigned char*)smem_raw;
    cg::grid_group grid = cg::this_grid();
    const int G = gridDim.x, bx = blockIdx.x;
    { const int t0 = opaque_tid(); if (t0 < 128) ((LAS unsigned*)(smem + 131072))[t0] = 0u; }
    __syncthreads();
    XcdBarrier bar = xcd_barrier_post((unsigned*)(p.ws + WS_CTL), (volatile LAS unsigned*)(smem + 131072) + 8);
    unsigned char* ws = p.ws;
    f32x2* TAB = (f32x2*)(ws + WS_TAB); float* SMALL = (float*)(ws + WS_SMALL);
    bf16_t* WFFGU = (bf16_t*)(ws + WS_WFFGU); bf16_t* WFFD = (bf16_t*)(ws + WS_WFFD); bf16_t* WIN = (bf16_t*)(ws + WS_WIN); bf16_t* WUQ = (bf16_t*)(ws + WS_WUQ);
    bf16_t* WUKV = (bf16_t*)(ws + WS_WUKV); bf16_t* WLRU = (bf16_t*)(ws + WS_WLRU); bf16_t* WBR = (bf16_t*)(ws + WS_WBR); bf16_t* WOUT = (bf16_t*)(ws + WS_WOUT);
    bf16_t* XN = (bf16_t*)(ws + WS_XN); bf16_t* P = (bf16_t*)(ws + WS_P); bf16_t* Hb = P; bf16_t* Qb = (bf16_t*)(ws + WS_Q); bf16_t* KN = (bf16_t*)(ws + WS_KN);
    bf16_t* VT = (bf16_t*)(ws + WS_VT); bf16_t* Y = (bf16_t*)(ws + WS_Y); bf16_t* XC = (bf16_t*)(ws + WS_XC); bf16_t* CS = (bf16_t*)(ws + WS_CS);

    for (int i = bx * 512 + opaque_tid(); i < S * 32; i += G * 512) { const int t = i >> 5, j = i & 31; const float ang = (float)t * INVF[j];
        double r = (double)ang * 0.15915494309189535; r -= __builtin_floor(r); const float fr = (float)r;
        TAB[i] = (f32x2){__builtin_amdgcn_cosf(fr), __builtin_amdgcn_sinf(fr)}; }

#pragma unroll 1
    for (int hl = 0; hl < 4; ++hl) {
        const int l = hl >> 1, second = hl & 1;
        const float* xin = hl == 0 ? p.in[0] : p.out;
        {
            const int nmat = second ? 3 : 26; int rot = 0;
#pragma unroll 1
            for (int mi = 0; mi < nmat; ++mi) {
                const float* src; int K, N, map; bf16_t* dst;
                if (mi == 0) { src = p.in[second ? 23 : 2] + (size_t)l * DM * FF; K = DM; N = FF; map = 1; dst = WFFGU; }
                else if (mi == 1) { src = p.in[second ? 24 : 3] + (size_t)l * DM * FF; K = DM; N = FF; map = 2; dst = WFFGU; }
                else if (mi == 2) { src = p.in[second ? 25 : 4] + (size_t)l * DM * FF; K = FF; N = DM; map = 0; dst = WFFD; }
                else if (mi == 3) { src = p.in[6] + (size_t)l * DM * NIN; K = DM; N = NIN; map = 3; dst = WIN; }
                else if (mi == 4) { src = p.in[10] + (size_t)l * 384 * 1536; K = 384; N = 1536; map = 4; dst = WUQ; }
                else if (mi == 5) { src = p.in[12] + (size_t)l * 256 * 2048; K = 256; N = 2048; map = 5; dst = WUKV; }
                else if (mi < 22) { const int k = mi - 6, n = k >> 1, wx = k & 1; src = p.in[wx ? 17 : 15] + (size_t)l * 131072 + n * 16384; K = 128; N = 128; map = 0; dst = WLRU + (size_t)(n * 256 + wx * 128) * 128; }
                else if (mi < 25) { const int j = mi - 22; src = p.in[20] + (size_t)l * 3 * 1024 * 2048 + (size_t)j * 1024 * 2048; K = 1024; N = 2048; map = 0; dst = WBR + (size_t)j * 2048 * 1024; }
                else { src = p.in[21] + (size_t)l * DM * DM; K = DM; N = DM; map = 0; dst = WOUT; }
                convert_mat(src, K, N, dst, map, rot);
            }
            rmsnorm_rows(xin, p.in[second ? 22 : 1] + l * DM, XN);
        }
        if (hl == 0) grid.sync(); else xcd_barrier(bar);
        { pg8::Gemm g{XN, WFFGU, S, 2 * FF, DM, DM, DM, 0}; pg8::StaticOrder so; so.init(S, 2 * FF, G, bx); pg8::EpiSwiglu E{Hb}; pg8::gemm_phase(smem, g, so, E); }
        xcd_barrier(bar);
        { pg8::Gemm g{Hb, WFFD, S, DM, FF, FF, FF, 0}; pg8::StaticOrder so; so.init(S, DM, G, bx); pg8::EpiRes E{xin, p.out, 0.5f}; pg8::gemm_phase(smem, g, so, E); }
        xcd_barrier(bar);
        if (!second) {
            const float* gbias = p.in[7] + l * 8;
            rmsnorm_rows(p.out, p.in[5] + l * DM, XN);
            xcd_barrier(bar);
            { pg8::Gemm g{XN, WIN, S, NP, DM, DM, DM, 0}; pg8::StaticOrder so; so.init(S, NP, G, bx); pg8::EpiStore E{P, NP}; pg8::gemm_phase(smem, g, so, E); }
            xcd_barrier(bar);
            if (bx == G - 1) { const float* lam = p.in[19] + l * 1024; for (int ch = opaque_tid(); ch < 1024; ch += 512) SMALL[SM_SP + ch] = -8.f * log1pf(expf(-lam[ch])); }
            mlstm_a(smem, P, gbias, CS, SMALL);
            prep_rows(P, p.in[9] + l * 384, p.in[11] + l * 256, p.in[13] + l * 4096, p.in[14] + l * 1024, TAB, XC);
            xcd_barrier(bar);
            mlstm_b(smem, CS, SMALL);
            { pg8::Gemm g{P + PC_CQ, WUQ, S, 1536, 384, NP, 384, 0}; pg8::StaticOrder so; so.init(S, 1536, G, bx); pg8::EpiQ E{Qb, TAB}; pg8::gemm_phase(smem, g, so, E); }
#pragma unroll 1
            for (int gi = 0; gi < 2; ++gi) {
                pg8::Gemm g; pg8::StaticOrder so; pg8::EpiStore E;
                if (gi == 0) { g = pg8::Gemm{P + PC_CKV, WUKV, S, 1024, 256, NP, 256, 0}; so.init(S, 1024, G, bx); E = pg8::EpiStore{KN, 1024}; }
                else { g = pg8::Gemm{WUKV + 1024 * 256, P + PC_CKV, 1024, S, 256, 256, NP, 0}; so.init(1024, S, G, bx); E = pg8::EpiStore{VT, S}; }
                pg8::gemm_phase(smem, g, so, E);
            }
            { pg8::Gemm g{XC, WLRU, S, 2048, 128, 1024, 128, 128}; pg8::StaticOrder so; so.init(S, 2048, G, bx); pg8::EpiLru E{XC, P + PC_CX, p.in[16] + l * 1024, p.in[18] + l * 1024, SMALL + SM_SP}; pg8::gemm_phase(smem, g, so, E); }
            xcd_barrier(bar);
            mlstm_c(smem, P, gbias, p.in[8] + l * 1024, CS, SMALL, Y);
            lru_p1(P + PC_CX, XC, SMALL + SM_CA, SMALL + SM_CH);
            xcd_barrier(bar);
            lru_p2(SMALL + SM_CA, SMALL + SM_CH, SMALL + SM_CARRY);
            for (int item = bx; item < 256; item += G) { const int hh = item & 7, pp = item >> 3;
#pragma unroll 1
                for (int half = 0; half < 2; ++half) attn_unit(smem, hh, half ? 63 - pp : pp, Qb, KN, P, VT, Y); }
            xcd_barrier(bar);
            lru_p3(P + PC_CX, XC, SMALL + SM_CARRY, Y);
#pragma unroll 1
            for (int j = 0; j < 3; ++j) {
                if (j == 2) xcd_barrier(bar);
                pg8::Gemm g{Y + j * 1024, WBR + (size_t)j * 2048 * 1024, S, DM, 1024, 3072, 1024, 0}; pg8::StaticOrder so; so.init(S, DM, G, bx); pg8::EpiMerge E{XN, P + PC_G + j * 2048, j == 0}; pg8::gemm_phase(smem, g, so, E);
            }
            xcd_barrier(bar);
            { pg8::Gemm g{XN, WOUT, S, DM, DM, DM, DM, 0}; pg8::StaticOrder so; so.init(S, DM, G, bx); pg8::EpiRes E{p.out, p.out, 1.0f}; pg8::gemm_phase(smem, g, so, E); }
            xcd_barrier(bar);
        }
    }
    final_norm_rows(p.out, p.in[26]);
}

constexpr int LDS_BYTES = 143360;

extern "C" void kernel_launch(void* const* d_in, const int* in_sizes, int n_in, void* d_out, int out_size, void* d_ws, size_t ws_size, hipStream_t stream) {
    static int grid = 0;
    if (grid == 0) {
        if (n_in != 27 || out_size != S * DM || ws_size < WS_END) { fprintf(stderr, "kernel_launch: unexpected problem (n_in %d out %d ws %zu, need %zu)\n", n_in, out_size, ws_size, (size_t)WS_END); grid = -1; return; }
        int dev = 0, cus = 0, per_cu = 0;
        hipGetDevice(&dev); hipDeviceGetAttribute(&cus, hipDeviceAttributeMultiprocessorCount, dev);
        if (hipFuncSetAttribute((const void*)mega_fwd, hipFuncAttributeMaxDynamicSharedMemorySize, LDS_BYTES) != hipSuccess) { fprintf(stderr, "kernel_launch: hipFuncSetAttribute failed\n"); grid = -1; return; }
        if (hipOccupancyMaxActiveBlocksPerMultiprocessor(&per_cu, (const void*)mega_fwd, 512, LDS_BYTES) != hipSuccess || per_cu < 1) { fprintf(stderr, "kernel_launch: occupancy query says %d\n", per_cu); per_cu = 1; }
        (void)hipGetLastError();
        grid = cus * (per_cu > 1 ? 1 : per_cu);
    }
    if (grid < 0) return;
    if (hipMemsetAsync((char*)d_ws + WS_CTL, 0, CTL_BYTES, stream) != hipSuccess) { fprintf(stderr, "kernel_launch: memset failed\n"); return; }
    Params p{};
    for (int i = 0; i < 27; ++i) p.in[i] = (const float*)d_in[i];
    p.out = (float*)d_out; p.ws = (unsigned char*)d_ws;
    void* args[] = {&p};
    hipError_t e = hipLaunchCooperativeKernel((const void*)mega_fwd, dim3(grid), dim3(512), args, LDS_BYTES, stream);
    if (e != hipSuccess) fprintf(stderr, "cooperative launch failed: %s (grid %d)\n", hipGetErrorString(e), grid);
}
```

```cpp
#include <hip/hip_runtime.h>
#include <hip/hip_cooperative_groups.h>
#include <cstdio>
#include <cstdint>
namespace cg = cooperative_groups;

#define DI __device__ __forceinline__
#define LAS __attribute__((address_space(3)))
typedef unsigned short bf16_t;
typedef short bf16x8 __attribute__((ext_vector_type(8)));
typedef short s16x4 __attribute__((ext_vector_type(4)));
typedef float f32x2 __attribute__((ext_vector_type(2)));
typedef float f32x4 __attribute__((ext_vector_type(4)));
typedef float f32x16 __attribute__((ext_vector_type(16)));
typedef unsigned u32x2 __attribute__((ext_vector_type(2)));
typedef unsigned u32x4 __attribute__((ext_vector_type(4)));
typedef __bf16 bf16x2_t __attribute__((ext_vector_type(2)));

constexpr int S = 16384, DM = 2048, FF = 5632, NIN = 10952, NP = 11008;
constexpr float EPS = 1e-6f;
constexpr int PC_Q = 0, PC_K = 512, PC_V = 1024, PC_O = 2048, PC_CQ = 3072, PC_CKV = 3456, PC_KR = 3712, PC_CX = 3776, PC_G = 4800, PC_I = 10944, PC_F = 10948;
constexpr float MQS = 0.08838834764831845f;
constexpr float AQS = 0.07216878364870322f * 1.4426950408889634f;

constexpr size_t MiB = 1u << 20;
constexpr size_t WS_TAB = 0;
constexpr size_t WS_SMALL = 4 * MiB;
constexpr size_t WS_WFFGU = 12 * MiB;
constexpr size_t WS_WFFD = 56 * MiB;
constexpr size_t WS_WIN = 78 * MiB;
constexpr size_t WS_WUQ = 121 * MiB;
constexpr size_t WS_WUKV = 123 * MiB;
constexpr size_t WS_WLRU = 124 * MiB;
constexpr size_t WS_WBR = 125 * MiB;
constexpr size_t WS_WOUT = 137 * MiB;
constexpr size_t WS_XN = 145 * MiB;
constexpr size_t WS_P = 209 * MiB;
constexpr size_t WS_Q = 553 * MiB;
constexpr size_t WS_KN = 601 * MiB;
constexpr size_t WS_VT = 633 * MiB;
constexpr size_t WS_Y = 665 * MiB;
constexpr size_t WS_XC = 761 * MiB;
constexpr size_t WS_CS = 793 * MiB;
constexpr size_t WS_END = 857 * MiB;
constexpr size_t WS_CTL = 11 * MiB, CTL_BYTES = 16384;
constexpr int SM_BT = 0, SM_MC = 1024, SM_MPREV = 2048, SM_DN = 4096  , SM_CA = 4096 + 131072  , SM_CH = SM_CA + 262144, SM_CARRY = SM_CH + 262144, SM_SP = SM_CARRY + 262144;

__device__ const float INVF[32] = {1.0f, 0.7498942613601685f, 0.5623413324356079f, 0.4216965138912201f, 0.3162277638912201f, 0.23713737726211548f, 0.17782793939113617f, 0.133352130651474f, 0.10000000149011612f, 0.07498941570520401f, 0.05623413249850273f, 0.04216965287923813f, 0.03162277489900589f, 0.023713737726211548f, 0.017782794311642647f, 0.01333521492779255f, 0.009999999776482582f, 0.007498941849917173f, 0.005623413249850273f, 0.0042169648222625256f, 0.003162277629598975f, 0.00237137358635664f, 0.0017782794311642647f, 0.0013335214462131262f, 0.0010000000474974513f, 0.0007498942431993783f, 0.000562341301701963f, 0.0004216965171508491f, 0.0003162277571391314f, 0.00023713737027719617f, 0.00017782794020604342f, 0.0001333521504420787f};

DI int opaque_tid() { int t = threadIdx.x; asm volatile("" : "+v"(t)); return t; }
DI float bf2f(bf16_t v) { return __uint_as_float((unsigned)v << 16); }
DI float bflo(unsigned w) { return __uint_as_float(w << 16); }
DI float bfhi(unsigned w) { return __uint_as_float(w & 0xffff0000u); }
DI unsigned pk2(float lo, float hi) { f32x2 v = {lo, hi}; bf16x2_t b = __builtin_convertvector(v, bf16x2_t); return __builtin_bit_cast(unsigned, b); }
DI bf16_t f2bf(float f) { return (bf16_t)(pk2(f, 0.f) & 0xffffu); }
DI float wave_sum(float v) {
#pragma unroll
    for (int o = 1; o < 64; o <<= 1) v += __shfl_xor(v, o);
    return v;
}
DI float wave_max(float v) {
#pragma unroll
    for (int o = 1; o < 64; o <<= 1) v = fmaxf(v, __shfl_xor(v, o));
    return v;
}
DI float wave_incl_scan(float v, int lane) {
#pragma unroll
    for (int o = 1; o < 64; o <<= 1) { const float n = __shfl_up(v, o); if (lane >= o) v += n; }
    return v;
}
DI float sigmoidf_(float x) { return __builtin_amdgcn_rcpf(1.f + __expf(-x)); }
DI float logsigmoid_(float x) { return fminf(x, 0.f) - log1pf(expf(-fabsf(x))); }
DI f32x16 mfma32(bf16x8 a, bf16x8 b, f32x16 c) { return __builtin_amdgcn_mfma_f32_32x32x16_bf16(a, b, c, 0, 0, 0); }
DI int crow(int r, int h) { return (r & 3) + 8 * (r >> 2) + 4 * h; }
DI int pi32(int m) { return (m & ~12) | ((m & 4) << 1) | ((m & 8) >> 1); }
typedef short v4i16_t __attribute__((ext_vector_type(4)));
DI s16x4 tr16(LAS const unsigned char* p) { return __builtin_bit_cast(s16x4, __builtin_amdgcn_ds_read_tr16_b64_v4i16((LAS v4i16_t*)p)); }
DI bf16x8 tr_frag(LAS const unsigned char* p, int rs) {
    const s16x4 lo = tr16(p), hi = tr16(p + 4 * rs);
    return __builtin_shufflevector(lo, hi, 0, 1, 2, 3, 4, 5, 6, 7);
}
DI bf16x8 pack8(float a0, float a1, float a2, float a3, float a4, float a5, float a6, float a7) {
    u32x4 w; w.x = pk2(a0, a1); w.y = pk2(a2, a3); w.z = pk2(a4, a5); w.w = pk2(a6, a7); return __builtin_bit_cast(bf16x8, w);
}

namespace pg8 {
constexpr int BM = 256, BK = 64, HALF = 128, HTB = HALF * BK * 2, STAGE_BYTES = 8 * HTB, NXCD = 8, WGM = 8;
DI int lds_byte(int r, int c) { const int st = (r >> 4) * 2 + (c >> 5), rr = r & 15, cc = c & 31, ob = rr * 64 + cc * 2; return st * 1024 + (ob ^ (((ob >> 9) & 1) << 5)); }
DI void stage_rc(int b, int& R, int& C) { const int st = b / 1024, sb = b % 1024, swz = sb ^ (((sb >> 9) & 1) << 5); R = (st >> 1) * 16 + swz / 64; C = (st & 1) * 32 + (swz % 64) / 2; }
DI int perm32(int rho) { const int n = rho >> 4, i = rho & 15; return 8 * (i >> 2) + 4 * n + (i & 3); }
struct Unit { int pm, pn; };
struct Gemm { const bf16_t* A; const bf16_t* Bt; int M, N, K, lda, ldb, apn; };
struct StaticOrder {
    int nM, nN, nwg, G, c;
    DI void init(int M, int N, int G_, int c_) { nM = M / BM; nN = N / BM; nwg = nM * nN; G = G_; c = c_; }
    DI bool next(int i, Unit& u) const {
        const long L = (long)i * G + c; if (L >= nwg) return false;
        int wgid = (int)L; { const int q = nwg / NXCD, r = nwg % NXCD, xcd = wgid % NXCD, off = wgid / NXCD; wgid = (xcd < r ? xcd * (q + 1) : r * (q + 1) + (xcd - r) * q) + off; }
        const int nig = WGM * nN, gid = wgid / nig, fm = gid * WGM, gsz = (nM - fm) < WGM ? (nM - fm) : WGM;
        u.pm = fm + ((wgid % nig) % gsz); u.pn = (wgid % nig) / gsz; return true;
    }
};
template <class Epi>
DI void gemm_phase(LAS unsigned char* lds, const Gemm g, const StaticOrder& S, const Epi& E) {
    const int tid = opaque_tid(), wid = __builtin_amdgcn_readfirstlane(tid >> 6), lane = tid & 63, wr = wid >> 2, wc = wid & 3, fr = lane & 15, fq = lane >> 4;
    int K = g.K; asm volatile("" : "+s"(K)); const int nt = K / BK;
    unsigned voffA[2], voffB[2];
#pragma unroll
    for (int i = 0; i < 2; ++i) { int R, C; stage_rc(tid * 16 + i * 8192, R, C); const int Rb = Epi::PERM ? ((R & ~31) + perm32(R & 31)) : R;
        voffA[i] = (unsigned)(R * g.lda + C) * 2u; voffB[i] = (unsigned)(Rb * g.ldb + C) * 2u; }
    const size_t kstep = (size_t)(BK * 2);
    const size_t hstepA = (size_t)HALF * g.lda * 2, hstepB = (size_t)HALF * g.ldb * 2;
    const unsigned ldsw = (unsigned)wid * 1024u;
    const int aoff = lds_byte(wr * 64 + fr, fq * 8), boff = lds_byte(wc * 32 + fr, fq * 8);
#define PG8_SA(b, h) (((b) * 2 + (h)) * HTB)
#define PG8_SB(b, h) ((4 + (b) * 2 + (h)) * HTB)
#define PG8_STAGE(bufoff, gbase, voff) do { _Pragma("unroll") for (int _i = 0; _i < 2; ++_i) \
        __builtin_amdgcn_global_load_lds((const unsigned*)((const char*)(gbase) + (voff)[_i]), (LAS unsigned*)(lds + (bufoff) + ldsw + _i * 8192), 16, 0, 0); } while (0)
#define PG8_LDA(dst, b, h) do { _Pragma("unroll") for (int m = 0; m < 4; ++m) _Pragma("unroll") for (int k = 0; k < 2; ++k) dst[m][k] = *(const LAS bf16x8*)(lds + PG8_SA(b, h) + aoff + m * 2048 + k * 1024); } while (0)
#define PG8_LDB(dst, b, h) do { _Pragma("unroll") for (int n = 0; n < 2; ++n) _Pragma("unroll") for (int k = 0; k < 2; ++k) dst[n][k] = *(const LAS bf16x8*)(lds + PG8_SB(b, h) + boff + n * 2048 + k * 1024); } while (0)
#define PG8_MMA(ai, bj, At, Bt) do { __builtin_amdgcn_s_setprio(1); _Pragma("unroll") for (int m = 0; m < 4; ++m) _Pragma("unroll") for (int n = 0; n < 2; ++n) _Pragma("unroll") for (int k = 0; k < 2; ++k) \
        acc[ai][bj][m][n] = __builtin_amdgcn_mfma_f32_16x16x32_bf16(Bt[n][k], At[m][k], acc[ai][bj][m][n], 0, 0, 0); __builtin_amdgcn_s_setprio(0); } while (0)
#define PG8_WAIT_V(n) asm volatile("s_waitcnt vmcnt(" #n ")" ::: "memory")
#define PG8_WAIT_L(n) asm volatile("s_waitcnt lgkmcnt(" #n ")" ::: "memory")
#define PG8_BAR __builtin_amdgcn_s_barrier()
#define PG8_SCHED __builtin_amdgcn_sched_barrier(0)
#define PG8_APTR(u) ((const char*)g.A + (size_t)(u).pm * 2 * hstepA + (size_t)(u).pn * (size_t)g.apn * 2)
#define PG8_BPTR(u) ((const char*)g.Bt + (size_t)(u).pn * 2 * hstepB)
    Unit cur, nxt; int ui = 0;
    if (!S.next(0, cur)) return;
    f32x4 acc[2][2][4][2];
#pragma unroll
    for (int a = 0; a < 2; ++a)
#pragma unroll
        for (int b = 0; b < 2; ++b)
#pragma unroll
            for (int m = 0; m < 4; ++m)
#pragma unroll
                for (int n = 0; n < 2; ++n) acc[a][b][m][n] = (f32x4){0.f, 0.f, 0.f, 0.f};
    bf16x8 At[4][2], B0[2][2], B1[2][2];
    const char* cA = PG8_APTR(cur); const char* cB = PG8_BPTR(cur);
    PG8_STAGE(PG8_SB(0, 0), cB, voffB); PG8_STAGE(PG8_SB(0, 1), cB + hstepB, voffB); PG8_STAGE(PG8_SA(0, 0), cA, voffA); PG8_STAGE(PG8_SA(0, 1), cA + hstepA, voffA);
    if (wr == 1) PG8_BAR;
    PG8_WAIT_V(2); PG8_BAR;
    PG8_STAGE(PG8_SB(1, 0), cB + kstep, voffB); PG8_STAGE(PG8_SA(1, 0), cA + kstep, voffA); PG8_STAGE(PG8_SB(1, 1), cB + hstepB + kstep, voffB);
    PG8_WAIT_V(6); PG8_BAR;
    for (;;) {
        const bool has_next = S.next(ui + 1, nxt);
        const char* nA = has_next ? PG8_APTR(nxt) : cA; const char* nB = has_next ? PG8_BPTR(nxt) : cB;
        for (int t = 0; t < nt; t += 2) {
            const bool last = (t == nt - 2);
            const char* a1 = cA + (size_t)(t + 1) * kstep;
            const char* a2 = last ? nA : cA + (size_t)(t + 2) * kstep; const char* b2 = last ? nB : cB + (size_t)(t + 2) * kstep;
            const char* a3 = a2 + kstep; const char* b3 = b2 + kstep;
            PG8_LDB(B0, 0, 0); PG8_LDB(B1, 0, 1); PG8_SCHED; PG8_LDA(At, 0, 0); PG8_STAGE(PG8_SA(1, 1), a1 + hstepA, voffA);
            PG8_WAIT_V(8); PG8_WAIT_L(0); PG8_BAR; PG8_MMA(0, 0, At, B0); PG8_MMA(0, 1, At, B1); PG8_BAR; PG8_SCHED;
            PG8_LDA(At, 0, 1); PG8_STAGE(PG8_SB(0, 0), b2, voffB); PG8_STAGE(PG8_SB(0, 1), b2 + hstepB, voffB); PG8_STAGE(PG8_SA(0, 0), a2, voffA);
            PG8_WAIT_V(8); PG8_WAIT_L(0); PG8_BAR; PG8_MMA(1, 0, At, B0); PG8_MMA(1, 1, At, B1); PG8_BAR; PG8_SCHED;
            PG8_LDB(B0, 1, 0); PG8_LDB(B1, 1, 1); PG8_SCHED; PG8_LDA(At, 1, 0); PG8_STAGE(PG8_SA(0, 1), a2 + hstepA, voffA);
            PG8_WAIT_V(8); PG8_WAIT_L(0); PG8_BAR; PG8_MMA(0, 0, At, B0); PG8_MMA(0, 1, At, B1); PG8_BAR; PG8_SCHED;
            PG8_LDA(At, 1, 1); PG8_STAGE(PG8_SB(1, 0), b3, voffB); PG8_STAGE(PG8_SB(1, 1), b3 + hstepB, voffB); PG8_STAGE(PG8_SA(1, 0), a3, voffA);
            PG8_WAIT_V(8); PG8_WAIT_L(0); PG8_BAR; PG8_MMA(1, 0, At, B0); PG8_MMA(1, 1, At, B1); PG8_BAR; PG8_SCHED;
        }
        if (wr == 0) PG8_BAR;
        E(acc, cur, wr, wc, fr, fq);
        if (!has_next) break;
#pragma unroll
        for (int a = 0; a < 2; ++a)
#pragma unroll
            for (int b = 0; b < 2; ++b)
#pragma unroll
                for (int m = 0; m < 4; ++m)
#pragma unroll
                    for (int n = 0; n < 2; ++n) acc[a][b][m][n] = (f32x4){0.f, 0.f, 0.f, 0.f};
        cur = nxt; cA = nA; cB = nB; ++ui;
        if (wr == 1) PG8_BAR;
    }
    PG8_WAIT_V(0);
    PG8_BAR;
#undef PG8_SA
#undef PG8_SB
#undef PG8_STAGE
#undef PG8_LDA
#undef PG8_LDB
#undef PG8_MMA
#undef PG8_WAIT_V
#undef PG8_WAIT_L
#undef PG8_BAR
#undef PG8_SCHED
#undef PG8_APTR
#undef PG8_BPTR
}

typedef f32x4 Acc[2][2][4][2];
struct EpiStore {
    static constexpr bool PERM = true;
    bf16_t* O; int ldc;
    DI void operator()(const Acc& acc, const Unit& u, int wr, int wc, int fr, int fq) const {
        const int row0 = u.pm * BM + wr * 64 + fr, col0 = u.pn * BM + wc * 32 + 8 * fq;
#pragma unroll
        for (int ai = 0; ai < 2; ++ai)
#pragma unroll
            for (int m = 0; m < 4; ++m) { bf16_t* rowp = O + (size_t)(row0 + ai * HALF + m * 16) * ldc + col0;
#pragma unroll
                for (int bj = 0; bj < 2; ++bj) { const f32x4 v0 = acc[ai][bj][m][0], v1 = acc[ai][bj][m][1];
                    u32x4 w; w.x = pk2(v0[0], v0[1]); w.y = pk2(v0[2], v0[3]); w.z = pk2(v1[0], v1[1]); w.w = pk2(v1[2], v1[3]);
                    *(u32x4*)(rowp + bj * HALF) = w; } }
    }
};
struct EpiSwiglu {
    static constexpr bool PERM = true;
    bf16_t* H;
    DI void operator()(const Acc& acc, const Unit& u, int wr, int wc, int fr, int fq) const {
        const int row0 = u.pm * BM + wr * 64 + fr, col0 = u.pn * HALF + wc * 32 + 8 * fq;
#pragma unroll
        for (int ai = 0; ai < 2; ++ai)
#pragma unroll
            for (int m = 0; m < 4; ++m) { bf16_t* rowp = H + (size_t)(row0 + ai * HALF + m * 16) * FF + col0;
                float o[8];
#pragma unroll
                for (int n = 0; n < 2; ++n)
#pragma unroll
                    for (int j = 0; j < 4; ++j) { const float gt = acc[ai][0][m][n][j], up = acc[ai][1][m][n][j]; o[n * 4 + j] = gt * sigmoidf_(gt) * up; }
                u32x4 w; w.x = pk2(o[0], o[1]); w.y = pk2(o[2], o[3]); w.z = pk2(o[4], o[5]); w.w = pk2(o[6], o[7]);
                *(u32x4*)rowp = w; }
    }
};
struct EpiRes {
    static constexpr bool PERM = false;
    const float* xin; float* xout; float alpha;
    DI void operator()(const Acc& acc, const Unit& u, int wr, int wc, int fr, int fq) const {
        const int col0 = u.pn * BM + wc * 32 + 4 * fq;
#pragma unroll
        for (int ai = 0; ai < 2; ++ai) {
            f32x4 b[4][2][2];
#pragma unroll
            for (int m = 0; m < 4; ++m) { const size_t off = (size_t)(u.pm * BM + ai * HALF + wr * 64 + m * 16 + fr) * DM + col0;
#pragma unroll
                for (int bj = 0; bj < 2; ++bj)
#pragma unroll
                    for (int n = 0; n < 2; ++n) b[m][bj][n] = *(const f32x4*)(xin + off + bj * HALF + n * 16); }
            __builtin_amdgcn_sched_barrier(0);
#pragma unroll
            for (int m = 0; m < 4; ++m) { const size_t off = (size_t)(u.pm * BM + ai * HALF + wr * 64 + m * 16 + fr) * DM + col0;
#pragma unroll
                for (int bj = 0; bj < 2; ++bj)
#pragma unroll
                    for (int n = 0; n < 2; ++n) *(f32x4*)(xout + off + bj * HALF + n * 16) = b[m][bj][n] + acc[ai][bj][m][n] * alpha; }
            __builtin_amdgcn_sched_barrier(0);
        }
    }
};
struct EpiQ {
    static constexpr bool PERM = true;
    bf16_t* Q; const f32x2* tab;
    DI void operator()(const Acc& acc, const Unit& u, int wr, int wc, int fr, int fq) const {
        const int row0 = u.pm * BM + wr * 64 + fr;
#pragma unroll
        for (int bj = 0; bj < 2; ++bj) {
            const int c0 = u.pn * BM + bj * HALF + wc * 32 + 8 * fq; const int hh = c0 / 192, dd = c0 - hh * 192; const bool rope = dd >= 128; const int j0 = rope ? (dd - 128) >> 1 : 0;
#pragma unroll
            for (int ai = 0; ai < 2; ++ai) {
                f32x4 cs[4][2];
#pragma unroll
                for (int m = 0; m < 4; ++m) { const f32x4* tp = (const f32x4*)(tab + (size_t)(row0 + ai * HALF + m * 16) * 32 + j0); cs[m][0] = tp[0]; cs[m][1] = tp[1]; }
                __builtin_amdgcn_sched_barrier(0);
#pragma unroll
                for (int m = 0; m < 4; ++m) { const int row = row0 + ai * HALF + m * 16;
                    float v[8];
#pragma unroll
                    for (int n = 0; n < 2; ++n)
#pragma unroll
                        for (int j = 0; j < 4; ++j) v[n * 4 + j] = acc[ai][bj][m][n][j];
                    if (rope) {
                        const float cc[4] = {cs[m][0].x, cs[m][0].z, cs[m][1].x, cs[m][1].z}, sn[4] = {cs[m][0].y, cs[m][0].w, cs[m][1].y, cs[m][1].w};
#pragma unroll
                        for (int p = 0; p < 4; ++p) { const float x1 = v[2 * p], x2 = v[2 * p + 1]; v[2 * p] = x1 * cc[p] - x2 * sn[p]; v[2 * p + 1] = x1 * sn[p] + x2 * cc[p]; }
                    }
                    u32x4 w; w.x = pk2(v[0] * AQS, v[1] * AQS); w.y = pk2(v[2] * AQS, v[3] * AQS); w.z = pk2(v[4] * AQS, v[5] * AQS); w.w = pk2(v[6] * AQS, v[7] * AQS);
                    *(u32x4*)(Q + (size_t)row * 1536 + c0) = w; }
                __builtin_amdgcn_sched_barrier(0);
            }
        }
    }
};
struct EpiLru {
    static constexpr bool PERM = true;
    bf16_t* XC; bf16_t* LA; const float* ba; const float* bx; const float* sp;
    DI void operator()(const Acc& acc, const Unit& u, int wr, int wc, int fr, int fq) const {
        const int row0 = u.pm * BM + wr * 64 + fr, ch0 = u.pn * HALF + wc * 32 + 8 * fq;
#pragma unroll
        for (int ai = 0; ai < 2; ++ai) {
            u32x4 xall[4];
#pragma unroll
            for (int m = 0; m < 4; ++m) xall[m] = *(const u32x4*)(XC + (size_t)(row0 + ai * HALF + m * 16) * 1024 + ch0);
            __builtin_amdgcn_sched_barrier(0);
#pragma unroll
            for (int m = 0; m < 4; ++m) { const int row = row0 + ai * HALF + m * 16;
                const u32x4 xw = xall[m];
                const float xv[8] = {bflo(xw.x), bfhi(xw.x), bflo(xw.y), bfhi(xw.y), bflo(xw.z), bfhi(xw.z), bflo(xw.w), bfhi(xw.w)};
                u32x4 wl, wu;
#pragma unroll
                for (int n = 0; n < 2; ++n) { const f32x4 spv = *(const f32x4*)(sp + ch0 + 4 * n), bav = *(const f32x4*)(ba + ch0 + 4 * n), bxv = *(const f32x4*)(bx + ch0 + 4 * n);
                    float la[4], uu[4];
#pragma unroll
                    for (int j = 0; j < 4; ++j) { const float r = sigmoidf_(acc[ai][0][m][n][j] + bav[j]), gi = sigmoidf_(acc[ai][1][m][n][j] + bxv[j]);
                        const float l = r * spv[j]; la[j] = l; const float a2 = __expf(2.f * l); uu[j] = sqrtf(fmaxf(1.f - a2, 0.f)) * gi * xv[n * 4 + j]; }
                    if (n == 0) { wl.x = pk2(la[0], la[1]); wl.y = pk2(la[2], la[3]); wu.x = pk2(uu[0], uu[1]); wu.y = pk2(uu[2], uu[3]); }
                    else { wl.z = pk2(la[0], la[1]); wl.w = pk2(la[2], la[3]); wu.z = pk2(uu[0], uu[1]); wu.w = pk2(uu[2], uu[3]); } }
                *(u32x4*)(LA + (size_t)row * NP + ch0) = wl;
                *(u32x4*)(XC + (size_t)row * 1024 + ch0) = wu;
                asm volatile("" ::: "memory"); }
        }
    }
};
struct EpiMerge {
    static constexpr bool PERM = true;
    bf16_t* Z; const bf16_t* G; int first;
    DI void operator()(const Acc& acc, const Unit& u, int wr, int wc, int fr, int fq) const {
        const int row0 = u.pm * BM + wr * 64 + fr, col0 = u.pn * BM + wc * 32 + 8 * fq;
#pragma unroll
        for (int ai = 0; ai < 2; ++ai) {
            u32x4 gw[4][2], zw[4][2];
#pragma unroll
            for (int m = 0; m < 4; ++m) { const int row = row0 + ai * HALF + m * 16;
#pragma unroll
                for (int bj = 0; bj < 2; ++bj) { const int c = col0 + bj * HALF; gw[m][bj] = *(const u32x4*)(G + (size_t)row * NP + c);
                    zw[m][bj] = first ? (u32x4){0u, 0u, 0u, 0u} : *(const u32x4*)(Z + (size_t)row * DM + c); } }
            __builtin_amdgcn_sched_barrier(0);
#pragma unroll
            for (int m = 0; m < 4; ++m) { const int row = row0 + ai * HALF + m * 16;
#pragma unroll
                for (int bj = 0; bj < 2; ++bj) { const int c = col0 + bj * HALF;
                    const u32x4 g4 = gw[m][bj], z4 = zw[m][bj];
                    const float gv[8] = {bflo(g4.x), bfhi(g4.x), bflo(g4.y), bfhi(g4.y), bflo(g4.z), bfhi(g4.z), bflo(g4.w), bfhi(g4.w)};
                    const float zv[8] = {bflo(z4.x), bfhi(z4.x), bflo(z4.y), bfhi(z4.y), bflo(z4.z), bfhi(z4.z), bflo(z4.w), bfhi(z4.w)};
                    float o[8];
#pragma unroll
                    for (int n = 0; n < 2; ++n)
#pragma unroll
                        for (int j = 0; j < 4; ++j) o[n * 4 + j] = zv[n * 4 + j] + sigmoidf_(gv[n * 4 + j]) * acc[ai][bj][m][n][j];
                    u32x4 w; w.x = pk2(o[0], o[1]); w.y = pk2(o[2], o[3]); w.z = pk2(o[4], o[5]); w.w = pk2(o[6], o[7]);
                    *(u32x4*)(Z + (size_t)row * DM + c) = w; } }
            __builtin_amdgcn_sched_barrier(0);
        }
    }
};
}

DI int map_row(int map, int n) {
    switch (map) {
        case 1: return ((n >> 7) << 8) + (n & 127);
        case 2: return ((n >> 7) << 8) + 128 + (n & 127);
        case 3: { if (n < 2048) return n; if (n < 2052) return PC_I + n - 2048; if (n < 2056) return PC_F + n - 2052; if (n < 3080) return PC_O + n - 2056; if (n < 3464) return PC_CQ + n - 3080;
                  if (n < 3720) return PC_CKV + n - 3464; if (n < 3784) return PC_KR + n - 3720; if (n < 4808) return PC_CX + n - 3784; return PC_G + n - 4808; }
        case 4: { const int hh = n / 192, dd = n - hh * 192; if (dd < 128) return n; const int jj = dd - 128; return hh * 192 + 128 + (jj < 32 ? 2 * jj : 2 * (jj - 32) + 1); }
        case 5: { const int hh = n >> 8, dd = n & 255; return dd < 128 ? hh * 128 + dd : 1024 + hh * 128 + dd - 128; }
        default: return n;
    }
}
DI void convert_mat(const float* W, int K, int N, bf16_t* WT, int map, int& rot) {
    const int tid_ = opaque_tid(), lane = tid_ & 63, gw = blockIdx.x * 8 + (tid_ >> 6), ngw = gridDim.x * 8, r = lane >> 3, c = lane & 7;
    const int nnb = (N + 31) >> 5, nkb = K >> 6, nitems = nnb * nkb;
    int it = gw - rot; if (it < 0) it += ngw;
    for (; it < nitems; it += 2 * ngw) {
        const int it2 = it + ngw; const bool two = it2 < nitems;
        const int nbA = it / nkb, kbA = it - nbA * nkb, nA = nbA * 32 + 4 * c, kA = kbA * 64 + 8 * r;
        const int nbB = two ? it2 / nkb : nbA, kbB = two ? it2 - nbB * nkb : kbA, nB = nbB * 32 + 4 * c, kB = kbB * 64 + 8 * r;
        const bool okA = nA < N, okB = two && nB < N;
        f32x4 va[8], vb[8];
        if (okA) { const float* src = W + (size_t)kA * N + nA;
#pragma unroll
            for (int i = 0; i < 8; ++i) va[i] = *(const f32x4*)(src + (size_t)i * N); }
        if (okB) { const float* src = W + (size_t)kB * N + nB;
#pragma unroll
            for (int i = 0; i < 8; ++i) vb[i] = *(const f32x4*)(src + (size_t)i * N); }
        __builtin_amdgcn_sched_barrier(0);
#define CV_STORE(v, n0, k0) do { u32x4 o; \
            o.x = pk2(v[0].x, v[1].x); o.y = pk2(v[2].x, v[3].x); o.z = pk2(v[4].x, v[5].x); o.w = pk2(v[6].x, v[7].x); *(u32x4*)(WT + (size_t)map_row(map, (n0)) * K + (k0)) = o; \
            o.x = pk2(v[0].y, v[1].y); o.y = pk2(v[2].y, v[3].y); o.z = pk2(v[4].y, v[5].y); o.w = pk2(v[6].y, v[7].y); *(u32x4*)(WT + (size_t)map_row(map, (n0) + 1) * K + (k0)) = o; \
            o.x = pk2(v[0].z, v[1].z); o.y = pk2(v[2].z, v[3].z); o.z = pk2(v[4].z, v[5].z); o.w = pk2(v[6].z, v[7].z); *(u32x4*)(WT + (size_t)map_row(map, (n0) + 2) * K + (k0)) = o; \
            o.x = pk2(v[0].w, v[1].w); o.y = pk2(v[2].w, v[3].w); o.z = pk2(v[4].w, v[5].w); o.w = pk2(v[6].w, v[7].w); *(u32x4*)(WT + (size_t)map_row(map, (n0) + 3) * K + (k0)) = o; } while (0)
        if (okA) CV_STORE(va, nA, kA);
        if (okB) CV_STORE(vb, nB, kB);
#undef CV_STORE
    }
    rot = (rot + nitems) % ngw;
}

DI void rmsnorm_rows(const float* X, const float* g, bf16_t* O) {
    const int tid_ = opaque_tid(), lane = tid_ & 63, gw = blockIdx.x * 8 + (tid_ >> 6), ngw = gridDim.x * 8;
    f32x4 gv[8], v[8], vn[8];
#pragma unroll
    for (int j = 0; j < 8; ++j) gv[j] = ((const f32x4*)g)[lane + 64 * j];
    if (gw < S) {
#pragma unroll
        for (int j = 0; j < 8; ++j) v[j] = ((const f32x4*)(X + (size_t)gw * DM) + lane)[64 * j]; }
    for (int r = gw; r < S; r += ngw) {
        const int rn = r + ngw < S ? r + ngw : r;
#pragma unroll
        for (int j = 0; j < 8; ++j) vn[j] = ((const f32x4*)(X + (size_t)rn * DM) + lane)[64 * j];
        __builtin_amdgcn_sched_barrier(0);
        float s = 0.f;
#pragma unroll
        for (int j = 0; j < 8; ++j) s += (v[j].x * v[j].x + v[j].y * v[j].y) + (v[j].z * v[j].z + v[j].w * v[j].w);
        const float rstd = 1.f / sqrtf(wave_sum(s) * (1.f / DM) + EPS);
        u32x2* o8 = (u32x2*)(O + (size_t)r * DM) + lane;
#pragma unroll
        for (int j = 0; j < 8; ++j) { u32x2 w; w.x = pk2(v[j].x * rstd * gv[j].x, v[j].y * rstd * gv[j].y); w.y = pk2(v[j].z * rstd * gv[j].z, v[j].w * rstd * gv[j].w); o8[64 * j] = w; }
        __builtin_amdgcn_sched_barrier(0);
#pragma unroll
        for (int j = 0; j < 8; ++j) v[j] = vn[j];
    }
}
DI void final_norm_rows(float* X, const float* g) {
    const int tid_ = opaque_tid(), lane = tid_ & 63, gw = blockIdx.x * 8 + (tid_ >> 6), ngw = gridDim.x * 8;
    f32x4 gv[8], v[8], vn[8];
#pragma unroll
    for (int j = 0; j < 8; ++j) gv[j] = ((const f32x4*)g)[lane + 64 * j];
    if (gw < S) {
#pragma unroll
        for (int j = 0; j < 8; ++j) v[j] = ((const f32x4*)(X + (size_t)gw * DM) + lane)[64 * j]; }
    for (int r = gw; r < S; r += ngw) {
        const int rn = r + ngw < S ? r + ngw : r;
#pragma unroll
        for (int j = 0; j < 8; ++j) vn[j] = ((const f32x4*)(X + (size_t)rn * DM) + lane)[64 * j];
        __builtin_amdgcn_sched_barrier(0);
        float s = 0.f;
#pragma unroll
        for (int j = 0; j < 8; ++j) s += (v[j].x * v[j].x + v[j].y * v[j].y) + (v[j].z * v[j].z + v[j].w * v[j].w);
        const float rstd = 1.f / sqrtf(wave_sum(s) * (1.f / DM) + EPS);
        f32x4* xr = (f32x4*)(X + (size_t)r * DM) + lane;
#pragma unroll
        for (int j = 0; j < 8; ++j) xr[64 * j] = v[j] * rstd * gv[j];
        __builtin_amdgcn_sched_barrier(0);
#pragma unroll
        for (int j = 0; j < 8; ++j) v[j] = vn[j];
    }
}
DI void prep_rows(bf16_t* P, const float* qn, const float* kvn, const float* cw, const float* cb, const f32x2* tab, bf16_t* XC) {
    const int tid_ = opaque_tid(), lane = tid_ & 63, gw = blockIdx.x * 8 + (tid_ >> 6), ngw = gridDim.x * 8;
    f32x2 qg[3], kg[2], cbv[8], cwv[8][4];
#pragma unroll
    for (int k = 0; k < 3; ++k) qg[k] = *(const f32x2*)(qn + 128 * k + 2 * lane);
#pragma unroll
    for (int k = 0; k < 2; ++k) kg[k] = *(const f32x2*)(kvn + 128 * k + 2 * lane);
#pragma unroll
    for (int k = 0; k < 8; ++k) { cbv[k] = *(const f32x2*)(cb + 128 * k + 2 * lane);
#pragma unroll
        for (int jj = 0; jj < 4; ++jj) cwv[k][jj] = *(const f32x2*)(cw + jj * 1024 + 128 * k + 2 * lane); }
    for (int t = gw; t < S; t += ngw) {
        bf16_t* row = P + (size_t)t * NP;
        unsigned wq[3], wk[2], wc[8][4];
#pragma unroll
        for (int k = 0; k < 3; ++k) wq[k] = *(const unsigned*)(row + PC_CQ + 128 * k + 2 * lane);
#pragma unroll
        for (int k = 0; k < 2; ++k) wk[k] = *(const unsigned*)(row + PC_CKV + 128 * k + 2 * lane);
        const int j = lane & 31; const float x1 = bf2f(row[PC_KR + j]), x2 = bf2f(row[PC_KR + 32 + j]); const f32x2 cs = tab[(size_t)t * 32 + j];
#pragma unroll
        for (int k = 0; k < 8; ++k)
#pragma unroll
            for (int jj = 0; jj < 4; ++jj) { const int tt = t - 3 + jj; wc[k][jj] = tt >= 0 ? *(const unsigned*)(P + (size_t)tt * NP + PC_CX + 128 * k + 2 * lane) : 0u; }
        __builtin_amdgcn_sched_barrier(0);
        { float s = 0.f;
#pragma unroll
          for (int k = 0; k < 3; ++k) { const float a = bflo(wq[k]), b = bfhi(wq[k]); s += a * a + b * b; }
          const float rstd = 1.f / sqrtf(wave_sum(s) * (1.f / 384.f) + EPS);
#pragma unroll
          for (int k = 0; k < 3; ++k) *(unsigned*)(row + PC_CQ + 128 * k + 2 * lane) = pk2(bflo(wq[k]) * rstd * qg[k].x, bfhi(wq[k]) * rstd * qg[k].y); }
        { float s = 0.f;
#pragma unroll
          for (int k = 0; k < 2; ++k) { const float a = bflo(wk[k]), b = bfhi(wk[k]); s += a * a + b * b; }
          const float rstd = 1.f / sqrtf(wave_sum(s) * (1.f / 256.f) + EPS);
#pragma unroll
          for (int k = 0; k < 2; ++k) *(unsigned*)(row + PC_CKV + 128 * k + 2 * lane) = pk2(bflo(wk[k]) * rstd * kg[k].x, bfhi(wk[k]) * rstd * kg[k].y); }
        { const unsigned o = pk2(x1 * cs.x - x2 * cs.y, x1 * cs.y + x2 * cs.x); if (lane < 32) *(unsigned*)(row + PC_KR + 2 * j) = o; }
#pragma unroll
        for (int k = 0; k < 8; ++k) { float a0 = cbv[k].x, a1 = cbv[k].y;
#pragma unroll
            for (int jj = 0; jj < 4; ++jj) { a0 += cwv[k][jj].x * bflo(wc[k][jj]); a1 += cwv[k][jj].y * bfhi(wc[k][jj]); }
            *(unsigned*)(XC + (size_t)t * 1024 + 128 * k + 2 * lane) = pk2(a0, a1); }
    }
}

DI void lru_p1(const bf16_t* LA, const bf16_t* U, float* CA, float* CH) {
    const int tid = opaque_tid();
    for (int c = blockIdx.x; c < 256; c += gridDim.x) {
        float h0 = 0.f, h1 = 0.f, s0 = 0.f, s1 = 0.f;
        unsigned lw[64], uw[64];
#pragma unroll
        for (int i = 0; i < 64; ++i) { const size_t row = (size_t)c * 64 + i; lw[i] = *(const unsigned*)(LA + row * NP + 2 * tid); uw[i] = *(const unsigned*)(U + row * 1024 + 2 * tid); }
#pragma unroll
        for (int i = 0; i < 64; ++i) { const float l0 = bflo(lw[i]), l1 = bfhi(lw[i]); s0 += l0; s1 += l1; h0 = __expf(l0) * h0 + bflo(uw[i]); h1 = __expf(l1) * h1 + bfhi(uw[i]); }
        CA[c * 1024 + 2 * tid] = __expf(s0); CA[c * 1024 + 2 * tid + 1] = __expf(s1); CH[c * 1024 + 2 * tid] = h0; CH[c * 1024 + 2 * tid + 1] = h1;
    }
}
DI void lru_p2(const float* CA, const float* CH, float* CARRY) {
    const int tid = opaque_tid(), lane = tid & 63, gw = blockIdx.x * 8 + (tid >> 6), ngw = gridDim.x * 8;
    for (int ch = gw; ch < 1024; ch += ngw) {
        float a[4], hh[4];
#pragma unroll
        for (int i = 0; i < 4; ++i) { a[i] = CA[(4 * lane + i) * 1024 + ch]; hh[i] = CH[(4 * lane + i) * 1024 + ch]; }
        float A = a[0], H = hh[0];
#pragma unroll
        for (int i = 1; i < 4; ++i) { H = a[i] * H + hh[i]; A = A * a[i]; }
#pragma unroll
        for (int o = 1; o < 64; o <<= 1) { const float Ap = __shfl_up(A, o), Hp = __shfl_up(H, o); if (lane >= o) { H = A * Hp + H; A = A * Ap; } }
        float st = __shfl_up(H, 1); if (lane == 0) st = 0.f;
#pragma unroll
        for (int i = 0; i < 4; ++i) { CARRY[(4 * lane + i) * 1024 + ch] = st; st = a[i] * st + hh[i]; }
    }
}
DI void lru_p3(const bf16_t* LA, const bf16_t* U, const float* CARRY, bf16_t* Y) {
    const int tid = opaque_tid();
    for (int c = blockIdx.x; c < 256; c += gridDim.x) {
        float h0 = CARRY[c * 1024 + 2 * tid], h1 = CARRY[c * 1024 + 2 * tid + 1];
        unsigned lw[64], uw[64];
#pragma unroll
        for (int i = 0; i < 64; ++i) { const size_t row = (size_t)c * 64 + i; lw[i] = *(const unsigned*)(LA + row * NP + 2 * tid); uw[i] = *(const unsigned*)(U + row * 1024 + 2 * tid); }
        __builtin_amdgcn_sched_barrier(0);
#pragma unroll
        for (int i = 0; i < 64; ++i) { const size_t row = (size_t)c * 64 + i; h0 = __expf(bflo(lw[i])) * h0 + bflo(uw[i]); h1 = __expf(bfhi(lw[i])) * h1 + bfhi(uw[i]);
            *(unsigned*)(Y + row * 3072 + 2048 + 2 * tid) = pk2(h0, h1); }
    }
}

DI void mlstm_a(LAS unsigned char* smem, const bf16_t* P, const float* gbias, bf16_t* CS, float* SMALL) {
    const int tid = opaque_tid(), lane = tid & 63, wid = tid >> 6, l31 = lane & 31, h = lane >> 5, q4 = (lane & 15) >> 2, p4 = lane & 3, blk = (lane >> 4) & 1;
    LAS float* sw = (LAS float*)smem;
    LAS unsigned char* Ks = smem + 1024;
    LAS unsigned char* Vs = smem + 1024 + 20480;
    u32x4 kpre[2], vpre[4]; bf16_t gipre = 0, gfpre = 0;
#define MA_LOAD(u_) do { const int c_ = (u_) >> 2, hh_ = (u_) & 3; const size_t r0_ = (size_t)c_ * 64; \
        _Pragma("unroll") for (int i = 0; i < 2; ++i) { const int id = tid + 512 * i, s_ = id >> 4, d8 = (id & 15) * 8; kpre[i] = *(const u32x4*)(P + (r0_ + s_) * NP + PC_K + hh_ * 128 + d8); } \
        _Pragma("unroll") for (int i = 0; i < 4; ++i) { const int id = tid + 512 * i, s_ = id >> 5, d8 = (id & 31) * 8; vpre[i] = *(const u32x4*)(P + (r0_ + s_) * NP + PC_V + hh_ * 256 + d8); } \
        if (wid == 0) { const bf16_t* r_ = P + (r0_ + lane) * NP; gipre = r_[PC_I + hh_]; gfpre = r_[PC_F + hh_]; } } while (0)
    if ((int)blockIdx.x < 1024) MA_LOAD((int)blockIdx.x);
    for (int uid = blockIdx.x; uid < 1024; uid += gridDim.x) {
        const int hh = uid & 3;
        if (wid == 0) {
            const float li = bf2f(gipre) + gbias[hh], lf = logsigmoid_(bf2f(gfpre) + gbias[4 + hh]);
            const float bc = wave_incl_scan(lf, lane), bt = __shfl(bc, 63), ds = bt - bc + li, M = wave_max(ds);
            sw[lane] = expf(ds - M);
            if (lane == 0) { SMALL[SM_BT + uid] = bt; SMALL[SM_MC + uid] = M; }
        }
        __syncthreads();
#pragma unroll
        for (int i = 0; i < 2; ++i) { const int id = tid + 512 * i, s = id >> 4, d8 = (id & 15) * 8; const u32x4 v = kpre[i]; const float w = sw[s];
            u32x4 o; o.x = pk2(bflo(v.x) * w, bfhi(v.x) * w); o.y = pk2(bflo(v.y) * w, bfhi(v.y) * w); o.z = pk2(bflo(v.z) * w, bfhi(v.z) * w); o.w = pk2(bflo(v.w) * w, bfhi(v.w) * w);
            *(LAS u32x4*)(Ks + s * 320 + d8 * 2) = o; }
#pragma unroll
        for (int i = 0; i < 4; ++i) { const int id = tid + 512 * i, s = id >> 5, d8 = (id & 31) * 8; *(LAS u32x4*)(Vs + s * 576 + d8 * 2) = vpre[i]; }
        __syncthreads();
        if (uid + (int)gridDim.x < 1024) MA_LOAD(uid + (int)gridDim.x);
        f32x16 acc[4];
#pragma unroll
        for (int d = 0; d < 4; ++d)
#pragma unroll
            for (int i = 0; i < 16; ++i) acc[d][i] = 0.f;
#pragma unroll
        for (int kk = 0; kk < 4; ++kk) {
            const bf16x8 vf = tr_frag(Vs + (16 * kk + 8 * h + q4) * 576 + (32 * wid + 16 * blk) * 2 + 8 * p4, 576);
#pragma unroll
            for (int d = 0; d < 4; ++d) { const bf16x8 kf = tr_frag(Ks + (16 * kk + 8 * h + q4) * 320 + (32 * d + 16 * blk) * 2 + 8 * p4, 320); acc[d] = mfma32(kf, vf, acc[d]); }
        }
        bf16_t* cs = CS + (size_t)uid * 32768 + (32 * wid + l31) * 128;
#pragma unroll
        for (int d = 0; d < 4; ++d)
#pragma unroll
            for (int g = 0; g < 4; ++g) { u32x2 w; w.x = pk2(acc[d][4 * g], acc[d][4 * g + 1]); w.y = pk2(acc[d][4 * g + 2], acc[d][4 * g + 3]); *(u32x2*)(cs + 32 * d + 8 * g + 4 * h) = w; }
        if (tid < 128) { float s = 0.f;
#pragma unroll 8
            for (int t = 0; t < 64; ++t) s += bf2f(*(LAS const bf16_t*)(Ks + t * 320 + tid * 2));
            SMALL[SM_DN + uid * 128 + tid] = s; }
        __syncthreads();
    }
#undef MA_LOAD
}
DI void mlstm_b(LAS unsigned char* smem, bf16_t* CS, float* SMALL) {
    const int tid = opaque_tid();
    LAS float* dec = (LAS float*)smem; LAS float* inj = dec + 1024;
    LAS float* sbt = inj + 1024; LAS float* smc = sbt + 1024;
    sbt[tid] = SMALL[SM_BT + tid]; sbt[tid + 512] = SMALL[SM_BT + tid + 512]; smc[tid] = SMALL[SM_MC + tid]; smc[tid + 512] = SMALL[SM_MC + tid + 512];
    __syncthreads();
    if (tid < 4) { float m = -1e30f;
        for (int c = 0; c < 256; ++c) { const float bt = sbt[c * 4 + tid], M = smc[c * 4 + tid]; sbt[c * 4 + tid] = m;
            const float mn = fmaxf(bt + m, M); dec[tid * 256 + c] = __expf(bt + m - mn); inj[tid * 256 + c] = __expf(M - mn); m = mn; } }
    __syncthreads();
    if (blockIdx.x == 0) { SMALL[SM_MPREV + tid] = sbt[tid]; SMALL[SM_MPREV + tid + 512] = sbt[tid + 512]; }
    for (int e = blockIdx.x * 512 + tid; e < 131072; e += gridDim.x * 512) {
        const int hh = e >> 15, idx = e & 32767; bf16_t* pp = CS + (size_t)hh * 32768 + idx; float st = 0.f;
        bf16_t d[32];
#pragma unroll
        for (int i = 0; i < 32; ++i) d[i] = pp[(size_t)i * 131072];
#pragma unroll 1
        for (int c0 = 0; c0 < 256; c0 += 32) {
            bf16_t dn[32];
            const int cn = c0 + 32 < 256 ? c0 + 32 : c0;
#pragma unroll
            for (int i = 0; i < 32; ++i) dn[i] = pp[(size_t)(cn + i) * 131072];
            asm volatile("" ::: "memory");
#pragma unroll
            for (int i = 0; i < 32; ++i) { pp[(size_t)(c0 + i) * 131072] = f2bf(st); st = dec[hh * 256 + c0 + i] * st + inj[hh * 256 + c0 + i] * bf2f(d[i]); }
            asm volatile("" ::: "memory");
#pragma unroll
            for (int i = 0; i < 32; ++i) d[i] = dn[i];
        }
    }
    if (blockIdx.x == gridDim.x - 1) { const int hh = tid >> 7; float* pp = SMALL + SM_DN + tid; float st = 0.f;
#pragma unroll 1
        for (int c0 = 0; c0 < 256; c0 += 32) {
            float d[32];
#pragma unroll
            for (int i = 0; i < 32; ++i) d[i] = pp[(c0 + i) * 512];
            asm volatile("" ::: "memory");
#pragma unroll
            for (int i = 0; i < 32; ++i) { pp[(c0 + i) * 512] = st; st = dec[hh * 256 + c0 + i] * st + inj[hh * 256 + c0 + i] * d[i]; }
            asm volatile("" ::: "memory");
        } }
    __syncthreads();
}
DI void mlstm_c(LAS unsigned char* smem, const bf16_t* P, const float* gbias, const float* onorm, const bf16_t* CS, const float* SMALL, bf16_t* Y) {
    const int tid = opaque_tid(), lane = tid & 63, wid = tid >> 6, l31 = lane & 31, h = lane >> 5, q4 = (lane & 15) >> 2, p4 = lane & 3, blk = (lane >> 4) & 1;
    LAS float* sbc = (LAS float*)smem; LAS float* sav = sbc + 64; LAS float* snp = sbc + 128; LAS float* sx = sbc + 256;
    LAS unsigned char* Qs = smem + 2048;
    LAS unsigned char* Ks = Qs + 17408;
    LAS unsigned char* Vs = Ks + 17408;
    const int tb = wid & 1, dvq = wid >> 1, t = 32 * tb + l31, pr = pi32(l31);
    u32x4 qpre[2], kpre[2], vpre[4]; bf16_t gipre = 0, gfpre = 0; float nppre = 0.f, mppre = 0.f;
#define MC_LOAD(u_) do { const int c_ = (u_) >> 2, hh_ = (u_) & 3; const size_t r0_ = (size_t)c_ * 64; \
        _Pragma("unroll") for (int i = 0; i < 2; ++i) { const int id = tid + 512 * i, s_ = id >> 4, d8 = (id & 15) * 8; \
            qpre[i] = *(const u32x4*)(P + (r0_ + s_) * NP + PC_Q + hh_ * 128 + d8); kpre[i] = *(const u32x4*)(P + (r0_ + s_) * NP + PC_K + hh_ * 128 + d8); } \
        _Pragma("unroll") for (int i = 0; i < 4; ++i) { const int id = tid + 512 * i, s_ = id >> 5, d8 = (id & 31) * 8; vpre[i] = *(const u32x4*)(P + (r0_ + s_) * NP + PC_V + hh_ * 256 + d8); } \
        if (wid == 0) { const bf16_t* r_ = P + (r0_ + lane) * NP; gipre = r_[PC_I + hh_]; gfpre = r_[PC_F + hh_]; } \
        if (tid >= 64 && tid < 192) nppre = SMALL[SM_DN + (u_) * 128 + tid - 64]; \
        mppre = SMALL[SM_MPREV + (u_)]; } while (0)
    if ((int)blockIdx.x < 1024) MC_LOAD((int)blockIdx.x);
    for (int uid = blockIdx.x; uid < 1024; uid += gridDim.x) {
        const int c = uid >> 2, hh = uid & 3; const size_t row0 = (size_t)c * 64;
        if (wid == 0) {
            const float li = bf2f(gipre) + gbias[hh], lf = logsigmoid_(bf2f(gfpre) + gbias[4 + hh]);
            const float bc = wave_incl_scan(lf, lane);
            sbc[lane] = bc; sav[lane] = li - bc;
        }
        if (tid >= 64 && tid < 192) snp[tid - 64] = nppre;
#pragma unroll
        for (int i = 0; i < 2; ++i) { const int id = tid + 512 * i, s = id >> 4, d8 = (id & 15) * 8;
            *(LAS u32x4*)(Qs + s * 272 + d8 * 2) = qpre[i]; *(LAS u32x4*)(Ks + s * 272 + d8 * 2) = kpre[i]; }
#pragma unroll
        for (int i = 0; i < 4; ++i) { const int id = tid + 512 * i, s = id >> 5, d8 = (id & 31) * 8; *(LAS u32x4*)(Vs + s * 576 + d8 * 2) = vpre[i]; }
        const float mprev = mppre;
        __syncthreads();
        if (uid + (int)gridDim.x < 1024) MC_LOAD(uid + (int)gridDim.x);
        bf16x8 qf[8];
#pragma unroll
        for (int ks = 0; ks < 8; ++ks) qf[ks] = *(const LAS bf16x8*)(Qs + t * 272 + (16 * ks + 8 * h) * 2);
        f32x16 st0, st1;
#pragma unroll
        for (int i = 0; i < 16; ++i) { st0[i] = 0.f; st1[i] = 0.f; }
#pragma unroll
        for (int ks = 0; ks < 8; ++ks) { const bf16x8 a0 = *(const LAS bf16x8*)(Ks + pr * 272 + (16 * ks + 8 * h) * 2); st0 = mfma32(a0, qf[ks], st0);
            if (tb) { const bf16x8 a1 = *(const LAS bf16x8*)(Ks + (32 + pr) * 272 + (16 * ks + 8 * h) * 2); st1 = mfma32(a1, qf[ks], st1); } }
        const float bt = sbc[t];
        float mx = -1e30f;
#pragma unroll
        for (int i = 0; i < 16; ++i) { const int s = 16 * (i >> 3) + 8 * h + (i & 7); if (s <= t) mx = fmaxf(mx, sav[s]); if (tb) mx = fmaxf(mx, (s + 32 <= t) ? sav[s + 32] : -1e30f); }
        mx = fmaxf(mx, __shfl_xor(mx, 32));
        const float mt = bt + fmaxf(mprev, mx);
        float den = 0.f;
#pragma unroll
        for (int i = 0; i < 16; ++i) { const int s = 16 * (i >> 3) + 8 * h + (i & 7);
            const float w0 = (s <= t) ? __expf(bt + sav[s] - mt) * MQS : 0.f; st0[i] *= w0; den += st0[i];
            const float w1 = (tb && (s + 32 <= t)) ? __expf(bt + sav[s + 32] - mt) * MQS : 0.f; st1[i] *= w1; den += st1[i]; }
        den += __shfl_xor(den, 32);
        float qn = 0.f;
#pragma unroll
        for (int ks = 0; ks < 8; ++ks)
#pragma unroll
            for (int j = 0; j < 8; ++j) qn += bf2f((bf16_t)qf[ks][j]) * snp[16 * ks + 8 * h + j];
        qn += __shfl_xor(qn, 32);
        const float wi = expf(bt + mprev - mt) * MQS;
        den += wi * qn;
        const float dinv = 1.f / fmaxf(fabsf(den), expf(-mt));
        bf16x8 pf[4];
        pf[0] = pack8(st0[0], st0[1], st0[2], st0[3], st0[4], st0[5], st0[6], st0[7]); pf[1] = pack8(st0[8], st0[9], st0[10], st0[11], st0[12], st0[13], st0[14], st0[15]);
        pf[2] = pack8(st1[0], st1[1], st1[2], st1[3], st1[4], st1[5], st1[6], st1[7]); pf[3] = pack8(st1[8], st1[9], st1[10], st1[11], st1[12], st1[13], st1[14], st1[15]);
        float hv[2][16]; float ss = 0.f;
#pragma unroll
        for (int db = 0; db < 2; ++db) { const int dvb = 2 * dvq + db;
            f32x16 a1, a2;
#pragma unroll
            for (int i = 0; i < 16; ++i) { a1[i] = 0.f; a2[i] = 0.f; }
#pragma unroll
            for (int sb = 0; sb < 2; ++sb)
#pragma unroll
                for (int kk = 0; kk < 2; ++kk) { if (sb <= tb) { const bf16x8 vf = tr_frag(Vs + (32 * sb + 16 * kk + 8 * h + q4) * 576 + (32 * dvb + 16 * blk) * 2 + 8 * p4, 576); a1 = mfma32(vf, pf[2 * sb + kk], a1); } }
            const bf16_t* cp = CS + (size_t)uid * 32768 + (32 * dvb + l31) * 128 + 8 * h;
#pragma unroll
            for (int ks = 0; ks < 8; ++ks) { const bf16x8 cf = *(const bf16x8*)(cp + 16 * ks); a2 = mfma32(cf, qf[ks], a2); }
#pragma unroll
            for (int i = 0; i < 16; ++i) { const float v = (a1[i] + wi * a2[i]) * dinv; hv[db][i] = v; ss += v * v; }
        }
        ss += __shfl_xor(ss, 32);
        if (h == 0) sx[(tb * 4 + dvq) * 32 + l31] = ss;
        __syncthreads();
        const float tot = (sx[(tb * 4 + 0) * 32 + l31] + sx[(tb * 4 + 1) * 32 + l31]) + (sx[(tb * 4 + 2) * 32 + l31] + sx[(tb * 4 + 3) * 32 + l31]);
        const float rstd = 1.f / sqrtf(tot * (1.f / 256.f) + EPS);
        f32x4 gnv[2][4]; u32x2 ogv[2][4];
#pragma unroll
        for (int db = 0; db < 2; ++db)
#pragma unroll
            for (int g = 0; g < 4; ++g) { const int col = hh * 256 + 32 * (2 * dvq + db) + 8 * g + 4 * h; gnv[db][g] = *(const f32x4*)(onorm + col); ogv[db][g] = *(const u32x2*)(P + (row0 + t) * NP + PC_O + col); }
        __builtin_amdgcn_sched_barrier(0);
#pragma unroll
        for (int db = 0; db < 2; ++db)
#pragma unroll
            for (int g = 0; g < 4; ++g) { const int col = hh * 256 + 32 * (2 * dvq + db) + 8 * g + 4 * h;
                const f32x4 gn = gnv[db][g]; const u32x2 og = ogv[db][g];
                const float o0 = hv[db][4 * g] * rstd * gn.x * sigmoidf_(bflo(og.x)), o1 = hv[db][4 * g + 1] * rstd * gn.y * sigmoidf_(bfhi(og.x));
                const float o2 = hv[db][4 * g + 2] * rstd * gn.z * sigmoidf_(bflo(og.y)), o3 = hv[db][4 * g + 3] * rstd * gn.w * sigmoidf_(bfhi(og.y));
                u32x2 w; w.x = pk2(o0, o1); w.y = pk2(o2, o3); *(u32x2*)(Y + (row0 + t) * 3072 + col) = w; }
        __syncthreads();
    }
#undef MC_LOAD
}

DI void attn_unit(LAS unsigned char* smem, int hh, int qb, const bf16_t* Q, const bf16_t* KN, const bf16_t* P, const bf16_t* VT, bf16_t* Y) {
    const int tid = opaque_tid(), lane = tid & 63, wid = __builtin_amdgcn_readfirstlane(tid >> 6), l31 = lane & 31, h = lane >> 5;
    LAS unsigned char* Kb = smem; LAS unsigned char* Vb = smem + 51200;
    const int q0 = qb * 256, qw = q0 + 32 * wid, q = qw + l31, NT = 4 * qb + 4;
    bf16x8 qf[12];
#pragma unroll
    for (int ks = 0; ks < 12; ++ks) qf[ks] = *(const bf16x8*)(Q + (size_t)q * 1536 + hh * 192 + 16 * ks + 8 * h);
    f32x16 o[4];
#pragma unroll
    for (int d = 0; d < 4; ++d)
#pragma unroll
        for (int i = 0; i < 16; ++i) o[d][i] = 0.f;
    float mref = 0.f, lrun = 0.f; bool first = true;
    const bf16_t* ksrc0; const bf16_t* ksrc2; const bf16_t* vsrc0; int kdst0, kdst2, vdst0;
    { const int row = tid >> 4, ch = tid & 15; ksrc0 = KN + (size_t)row * 1024 + hh * 128 + 8 * ch; kdst0 = row * 400 + ch * 16; }
    { const int row = tid >> 3, ch = tid & 7; ksrc2 = P + (size_t)row * NP + PC_KR + 8 * ch; kdst2 = row * 400 + 256 + ch * 16; }
    { const int d = tid >> 3, ch = tid & 7; vsrc0 = VT + (size_t)(hh * 128 + d) * S + 8 * ch; vdst0 = d * 144 + ch * 16; }
    u32x4 kr[3], vr[2];
#define ATT_LOAD(tt) do { kr[0] = *(const u32x4*)(ksrc0 + (size_t)(tt) * 65536); kr[1] = *(const u32x4*)(ksrc0 + (size_t)(tt) * 65536 + 32 * 1024); kr[2] = *(const u32x4*)(ksrc2 + (size_t)(tt) * (64 * NP)); \
        vr[0] = *(const u32x4*)(vsrc0 + (size_t)(tt) * 64); vr[1] = *(const u32x4*)(vsrc0 + (size_t)(tt) * 64 + (size_t)64 * S); } while (0)
#define ATT_WRITE(kbuf, vslot) do { *(LAS u32x4*)(Kb + (kbuf) * 25600 + kdst0) = kr[0]; *(LAS u32x4*)(Kb + (kbuf) * 25600 + kdst0 + 32 * 400) = kr[1]; *(LAS u32x4*)(Kb + (kbuf) * 25600 + kdst2) = kr[2]; \
        *(LAS u32x4*)(Vb + (vslot) * 18432 + vdst0) = vr[0]; *(LAS u32x4*)(Vb + (vslot) * 18432 + vdst0 + 64 * 144) = vr[1]; } while (0)
#define ATT_BAR() do { asm volatile("s_waitcnt lgkmcnt(0)" ::: "memory"); __builtin_amdgcn_s_barrier(); asm volatile("" ::: "memory"); } while (0)
    ATT_LOAD(0);
    ATT_WRITE(0, 0);
    ATT_BAR();
    const int koff = pi32(l31) * 400 + 16 * h, voff = l31 * 144 + 16 * h;
#define SB() __builtin_amdgcn_sched_barrier(0)
#define KFR(kb, ks, b) (*(const LAS bf16x8*)((kb) + (b) * 32 * 400 + (ks) * 32))
#define VFR(vb, d, kk) (*(const LAS bf16x8*)((vb) + (d) * 32 * 144 + (kk) * 32))
    int vs = 0;
    for (int t = 0; t < NT; ++t) {
        const int kc = t & 1, vn = vs == 2 ? 0 : vs + 1;
        if (t + 1 < NT) ATT_LOAD(t + 1);
        if (64 * t <= qw + 31) {
            LAS const unsigned char* kb = Kb + kc * 25600 + koff; LAS const unsigned char* vb = Vb + vs * 18432 + voff;
            f32x16 s0, s1;
#pragma unroll
            for (int i = 0; i < 16; ++i) { s0[i] = 0.f; s1[i] = 0.f; }
            bf16x8 fa[4], fb[4];
            fa[0] = KFR(kb, 0, 0); fa[1] = KFR(kb, 0, 1); fa[2] = KFR(kb, 1, 0); fa[3] = KFR(kb, 1, 1); SB();
#pragma unroll
            for (int st = 0; st < 6; st += 2) {
                fb[0] = KFR(kb, 2 * st + 2, 0); fb[1] = KFR(kb, 2 * st + 2, 1); fb[2] = KFR(kb, 2 * st + 3, 0); fb[3] = KFR(kb, 2 * st + 3, 1); SB();
                s0 = mfma32(fa[0], qf[2 * st], s0); s1 = mfma32(fa[1], qf[2 * st], s1); s0 = mfma32(fa[2], qf[2 * st + 1], s0); s1 = mfma32(fa[3], qf[2 * st + 1], s1); SB();
                if (st + 2 < 6) { fa[0] = KFR(kb, 2 * st + 4, 0); fa[1] = KFR(kb, 2 * st + 4, 1); fa[2] = KFR(kb, 2 * st + 5, 0); fa[3] = KFR(kb, 2 * st + 5, 1); }
                else { fa[0] = VFR(vb, 0, 0); fa[1] = VFR(vb, 0, 1); fa[2] = VFR(vb, 0, 2); fa[3] = VFR(vb, 0, 3); }
                SB();
                s0 = mfma32(fb[0], qf[2 * st + 2], s0); s1 = mfma32(fb[1], qf[2 * st + 2], s1); s0 = mfma32(fb[2], qf[2 * st + 3], s0); s1 = mfma32(fb[3], qf[2 * st + 3], s1); SB();
            }
            if (64 * t + 63 > qw) {
#pragma unroll
                for (int i = 0; i < 16; ++i) { const int kv = 64 * t + 16 * (i >> 3) + 8 * h + (i & 7); if (kv > q) s0[i] = -1e30f; if (kv + 32 > q) s1[i] = -1e30f; }
            }
            float mx = fmaxf(s0[0], s1[0]);
#pragma unroll
            for (int i = 1; i < 16; ++i) mx = fmaxf(mx, fmaxf(s0[i], s1[i]));
            mx = fmaxf(mx, __shfl_xor(mx, 32));
            if (first || __any(mx - mref > 8.f)) {
                const float dl = first ? mx : fmaxf(mx - mref, 0.f);
                mref += dl;
                if (!first) { const float f = __builtin_amdgcn_exp2f(-dl); lrun *= f;
#pragma unroll
                    for (int d = 0; d < 4; ++d)
#pragma unroll
                        for (int i = 0; i < 16; ++i) o[d][i] *= f; }
                first = false; }
            float rs = 0.f;
#pragma unroll
            for (int i = 0; i < 16; ++i) { s0[i] = __builtin_amdgcn_exp2f(s0[i] - mref); s1[i] = __builtin_amdgcn_exp2f(s1[i] - mref); rs += s0[i] + s1[i]; }
            lrun += rs;
            bf16x8 pf[4];
            pf[0] = pack8(s0[0], s0[1], s0[2], s0[3], s0[4], s0[5], s0[6], s0[7]); pf[1] = pack8(s0[8], s0[9], s0[10], s0[11], s0[12], s0[13], s0[14], s0[15]);
            pf[2] = pack8(s1[0], s1[1], s1[2], s1[3], s1[4], s1[5], s1[6], s1[7]); pf[3] = pack8(s1[8], s1[9], s1[10], s1[11], s1[12], s1[13], s1[14], s1[15]);
            SB();
            fb[0] = VFR(vb, 1, 0); fb[1] = VFR(vb, 1, 1); fb[2] = VFR(vb, 1, 2); fb[3] = VFR(vb, 1, 3); SB();
            o[0] = mfma32(fa[0], pf[0], o[0]); o[0] = mfma32(fa[1], pf[1], o[0]); o[0] = mfma32(fa[2], pf[2], o[0]); o[0] = mfma32(fa[3], pf[3], o[0]); SB();
            fa[0] = VFR(vb, 2, 0); fa[1] = VFR(vb, 2, 1); fa[2] = VFR(vb, 2, 2); fa[3] = VFR(vb, 2, 3); SB();
            o[1] = mfma32(fb[0], pf[0], o[1]); o[1] = mfma32(fb[1], pf[1], o[1]); o[1] = mfma32(fb[2], pf[2], o[1]); o[1] = mfma32(fb[3], pf[3], o[1]); SB();
            fb[0] = VFR(vb, 3, 0); fb[1] = VFR(vb, 3, 1); fb[2] = VFR(vb, 3, 2); fb[3] = VFR(vb, 3, 3); SB();
            o[2] = mfma32(fa[0], pf[0], o[2]); o[2] = mfma32(fa[1], pf[1], o[2]); o[2] = mfma32(fa[2], pf[2], o[2]); o[2] = mfma32(fa[3], pf[3], o[2]); SB();
            o[3] = mfma32(fb[0], pf[0], o[3]); o[3] = mfma32(fb[1], pf[1], o[3]); o[3] = mfma32(fb[2], pf[2], o[3]); o[3] = mfma32(fb[3], pf[3], o[3]); SB();
        }
        if (t + 1 < NT) ATT_WRITE(kc ^ 1, vn);
        ATT_BAR();
        vs = vn;
    }
#undef SB
#undef KFR
#undef VFR
#undef ATT_LOAD
#undef ATT_WRITE
#undef ATT_BAR
    lrun += __shfl_xor(lrun, 32);
    const float inv = 1.f / lrun;
    bf16_t* yp = Y + (size_t)q * 3072 + 1024 + hh * 128 + 4 * h;
#pragma unroll
    for (int d = 0; d < 4; ++d)
#pragma unroll
        for (int g = 0; g < 4; ++g) { u32x2 w; w.x = pk2(o[d][4 * g] * inv, o[d][4 * g + 1] * inv); w.y = pk2(o[d][4 * g + 2] * inv, o[d][4 * g + 3] * inv); *(u32x2*)(yp + 32 * d + 8 * g) = w; }
}

#define XB_TMO      128
#define XB_XCNT(j)  (256  + 64 * (j))
#define XB_XSUB(j)  (1280 + 64 * (j))
#define XB_XGEN(j)  (2304 + 64 * (j))
#define XB_TOP      3328
#define XB_TOPGEN   3392
#define XCD_BAR_WORDS 3456
#define XB_SPIN_CAP (1u << 23)
DI unsigned xb_ld(unsigned* p)              { return __hip_atomic_load(p, __ATOMIC_RELAXED, __HIP_MEMORY_SCOPE_AGENT); }
DI unsigned xb_add(unsigned* p, unsigned v) { return __hip_atomic_fetch_add(p, v, __ATOMIC_RELAXED, __HIP_MEMORY_SCOPE_AGENT); }
DI unsigned xb_xcc_id() { return (unsigned)__builtin_amdgcn_s_getreg((3 << 11) | 20) & 0xFu; }
#define XB_SPIN(cond, bar) do { unsigned _sp = 0; while (cond) { __builtin_amdgcn_s_sleep(1); \
    if ((++_sp & 255u) == 0u) { if (xb_ld(&(bar)[XB_TMO])) break; if (_sp > XB_SPIN_CAP) { atomicAdd(&(bar)[XB_TMO], 1u); break; } } } } while (0)
struct XcdBarrier { unsigned* bar; unsigned x; volatile LAS unsigned* st; };
DI XcdBarrier xcd_barrier_post(unsigned* bar, volatile LAS unsigned* st) {
    XcdBarrier b; b.bar = bar; b.x = xb_xcc_id(); b.st = st;
    if (threadIdx.x == 0) (void)xb_add(&bar[XB_XCNT(b.x)], 1u);
    return b;
}
DI void xcd_barrier_complete(unsigned* bar, unsigned x, unsigned& nloc, unsigned& nx) {
    const unsigned G = gridDim.x * gridDim.y * gridDim.z;
    unsigned sum, cnt, mine, sp = 0u;
    for (;;) {
        sum = 0u; cnt = 0u; mine = 0u;
#pragma unroll
        for (unsigned j = 0; j < 16; ++j) { const unsigned c = xb_ld(&bar[XB_XCNT(j)]); sum += c; cnt += (c > 0u) ? 1u : 0u; mine = (j == x) ? c : mine; }
        if (sum == G) break;
        __builtin_amdgcn_s_sleep(1);
        if ((++sp & 255u) == 0u) { if (xb_ld(&bar[XB_TMO])) break; if (sp > XB_SPIN_CAP) { atomicAdd(&bar[XB_TMO], 1u); break; } }
    }
    nloc = mine > 0u ? mine : 1u; nx = cnt > 0u ? cnt : 1u;
}
DI void xcd_barrier(const XcdBarrier& b) {
    asm volatile("s_waitcnt vmcnt(0)" ::: "memory");
    __syncthreads();
    if (threadIdx.x == 0) {
        unsigned* bar = b.bar;
        __builtin_amdgcn_s_waitcnt(0);
        unsigned nloc = b.st[0], nx = b.st[1];
        if (nloc == 0u) { xcd_barrier_complete(bar, b.x, nloc, nx); b.st[0] = nloc; b.st[1] = nx; }
        const unsigned old = xb_add(&bar[XB_XSUB(b.x)], 1u);
        const unsigned gen = old / nloc;
        if (old + 1u == (gen + 1u) * nloc) {
            __builtin_amdgcn_fence(__ATOMIC_RELEASE, "agent");
            asm volatile("s_waitcnt vmcnt(0)" ::: "memory");
            const unsigned og = xb_add(&bar[XB_TOP], 1u);
            const unsigned tg = og / nx;
            if (og + 1u == (tg + 1u) * nx) xb_add(&bar[XB_TOPGEN], 1u);
            else XB_SPIN(xb_ld(&bar[XB_TOPGEN]) == tg, bar);
            __builtin_amdgcn_fence(__ATOMIC_ACQUIRE, "agent");
            xb_add(&bar[XB_XGEN(b.x)], 1u);
            asm volatile("s_waitcnt vmcnt(0)" ::: "memory");
        } else {
            XB_SPIN(xb_ld(&bar[XB_XGEN(b.x)]) == gen, bar);
            __builtin_amdgcn_fence(__ATOMIC_ACQUIRE, "agent");
            asm volatile("s_waitcnt vmcnt(0)" ::: "memory");
        }
    }
    __syncthreads();
}

struct Params { const float* in[27]; float* out; unsigned char* ws; };

__global__ void __launch_bounds__(512, 2) mega_fwd(Params p) {
    extern __shared__ __attribute__((aligned(16))) unsigned char smem_raw[];
    LAS unsigned char* smem = (LAS unsigned char*)smem_raw;
    cg::grid_group grid = cg::this_grid();
    const int G = gridDim.x, bx = blockIdx.x;
    { const int t0 = opaque_tid(); if (t0 < 128) ((LAS unsigned*)(smem + 131072))[t0] = 0u; }
    __syncthreads();
    XcdBarrier bar = xcd_barrier_post((unsigned*)(p.ws + WS_CTL), (volatile LAS unsigned*)(smem + 131072) + 8);
    unsigned char* ws = p.ws;
    f32x2* TAB = (f32x2*)(ws + WS_TAB); float* SMALL = (float*)(ws + WS_SMALL);
    bf16_t* WFFGU = (bf16_t*)(ws + WS_WFFGU); bf16_t* WFFD = (bf16_t*)(ws + WS_WFFD); bf16_t* WIN = (bf16_t*)(ws + WS_WIN); bf16_t* WUQ = (bf16_t*)(ws + WS_WUQ);
    bf16_t* WUKV = (bf16_t*)(ws + WS_WUKV); bf16_t* WLRU = (bf16_t*)(ws + WS_WLRU); bf16_t* WBR = (bf16_t*)(ws + WS_WBR); bf16_t* WOUT = (bf16_t*)(ws + WS_WOUT);
    bf16_t* XN = (bf16_t*)(ws + WS_XN); bf16_t* P = (bf16_t*)(ws + WS_P); bf16_t* Hb = P; bf16_t* Qb = (bf16_t*)(ws + WS_Q); bf16_t* KN = (bf16_t*)(ws + WS_KN);
    bf16_t* VT = (bf16_t*)(ws + WS_VT); bf16_t* Y = (bf16_t*)(ws + WS_Y); bf16_t* XC = (bf16_t*)(ws + WS_XC); bf16_t* CS = (bf16_t*)(ws + WS_CS);

    for (int i = bx * 512 + opaque_tid(); i < S * 32; i += G * 512) { const int t = i >> 5, j = i & 31; const float ang = (float)t * INVF[j];
        double r = (double)ang * 0.15915494309189535; r -= __builtin_floor(r); const float fr = (float)r;
        TAB[i] = (f32x2){__builtin_amdgcn_cosf(fr), __builtin_amdgcn_sinf(fr)}; }

#pragma unroll 1
    for (int hl = 0; hl < 4; ++hl) {
        const int l = hl >> 1, second = hl & 1;
        const float* xin = hl == 0 ? p.in[0] : p.out;
        {
            const int nmat = second ? 3 : 26; int rot = 0;
#pragma unroll 1
            for (int mi = 0; mi < nmat; ++mi) {
                const float* src; int K, N, map; bf16_t* dst;
                if (mi == 0) { src = p.in[second ? 23 : 2] + (size_t)l * DM * FF; K = DM; N = FF; map = 1; dst = WFFGU; }
                else if (mi == 1) { src = p.in[second ? 24 : 3] + (size_t)l * DM * FF; K = DM; N = FF; map = 2; dst = WFFGU; }
                else if (mi == 2) { src = p.in[second ? 25 : 4] + (size_t)l * DM * FF; K = FF; N = DM; map = 0; dst = WFFD; }
                else if (mi == 3) { src = p.in[6] + (size_t)l * DM * NIN; K = DM; N = NIN; map = 3; dst = WIN; }
                else if (mi == 4) { src = p.in[10] + (size_t)l * 384 * 1536; K = 384; N = 1536; map = 4; dst = WUQ; }
                else if (mi == 5) { src = p.in[12] + (size_t)l * 256 * 2048; K = 256; N = 2048; map = 5; dst = WUKV; }
                else if (mi < 22) { const int k = mi - 6, n = k >> 1, wx = k & 1; src = p.in[wx ? 17 : 15] + (size_t)l * 131072 + n * 16384; K = 128; N = 128; map = 0; dst = WLRU + (size_t)(n * 256 + wx * 128) * 128; }
                else if (mi < 25) { const int j = mi - 22; src = p.in[20] + (size_t)l * 3 * 1024 * 2048 + (size_t)j * 1024 * 2048; K = 1024; N = 2048; map = 0; dst = WBR + (size_t)j * 2048 * 1024; }
                else { src = p.in[21] + (size_t)l * DM * DM; K = DM; N = DM; map = 0; dst = WOUT; }
                convert_mat(src, K, N, dst, map, rot);
            }
            rmsnorm_rows(xin, p.in[second ? 22 : 1] + l * DM, XN);
        }
        if (hl == 0) grid.sync(); else xcd_barrier(bar);
        { pg8::Gemm g{XN, WFFGU, S, 2 * FF, DM, DM, DM, 0}; pg8::StaticOrder so; so.init(S, 2 * FF, G, bx); pg8::EpiSwiglu E{Hb}; pg8::gemm_phase(smem, g, so, E); }
        xcd_barrier(bar);
        { pg8::Gemm g{Hb, WFFD, S, DM, FF, FF, FF, 0}; pg8::StaticOrder so; so.init(S, DM, G, bx); pg8::EpiRes E{xin, p.out, 0.5f}; pg8::gemm_phase(smem, g, so, E); }
        xcd_barrier(bar);
        if (!second) {
            const float* gbias = p.in[7] + l * 8;
            rmsnorm_rows(p.out, p.in[5] + l * DM, XN);
            xcd_barrier(bar);
            { pg8::Gemm g{XN, WIN, S, NP, DM, DM, DM, 0}; pg8::StaticOrder so; so.init(S, NP, G, bx); pg8::EpiStore E{P, NP}; pg8::gemm_phase(smem, g, so, E); }
            xcd_barrier(bar);
            if (bx == G - 1) { const float* lam = p.in[19] + l * 1024; for (int ch = opaque_tid(); ch < 1024; ch += 512) SMALL[SM_SP + ch] = -8.f * log1pf(expf(-lam[ch])); }
            mlstm_a(smem, P, gbias, CS, SMALL);
            prep_rows(P, p.in[9] + l * 384, p.in[11] + l * 256, p.in[13] + l * 4096, p.in[14] + l * 1024, TAB, XC);
            xcd_barrier(bar);
            mlstm_b(smem, CS, SMALL);
            { pg8::Gemm g{P + PC_CQ, WUQ, S, 1536, 384, NP, 384, 0}; pg8::StaticOrder so; so.init(S, 1536, G, bx); pg8::EpiQ E{Qb, TAB}; pg8::gemm_phase(smem, g, so, E); }
#pragma unroll 1
            for (int gi = 0; gi < 2; ++gi) {
                pg8::Gemm g; pg8::StaticOrder so; pg8::EpiStore E;
                if (gi == 0) { g = pg8::Gemm{P + PC_CKV, WUKV, S, 1024, 256, NP, 256, 0}; so.init(S, 1024, G, bx); E = pg8::EpiStore{KN, 1024}; }
                else { g = pg8::Gemm{WUKV + 1024 * 256, P + PC_CKV, 1024, S, 256, 256, NP, 0}; so.init(1024, S, G, bx); E = pg8::EpiStore{VT, S}; }
                pg8::gemm_phase(smem, g, so, E);
            }
            { pg8::Gemm g{XC, WLRU, S, 2048, 128, 1024, 128, 128}; pg8::StaticOrder so; so.init(S, 2048, G, bx); pg8::EpiLru E{XC, P + PC_CX, p.in[16] + l * 1024, p.in[18] + l * 1024, SMALL + SM_SP}; pg8::gemm_phase(smem, g, so, E); }
            xcd_barrier(bar);
            mlstm_c(smem, P, gbias, p.in[8] + l * 1024, CS, SMALL, Y);
            lru_p1(P + PC_CX, XC, SMALL + SM_CA, SMALL + SM_CH);
            xcd_barrier(bar);
            lru_p2(SMALL + SM_CA, SMALL + SM_CH, SMALL + SM_CARRY);
            for (int item = bx; item < 256; item += G) { const int hh = item & 7, pp = item >> 3;
#pragma unroll 1
                for (int half = 0; half < 2; ++half) attn_unit(smem, hh, half ? 63 - pp : pp, Qb, KN, P, VT, Y); }
            xcd_barrier(bar);
            lru_p3(P + PC_CX, XC, SMALL + SM_CARRY, Y);
#pragma unroll 1
            for (int j = 0; j < 3; ++j) {
                if (j == 2) xcd_barrier(bar);
                pg8::Gemm g{Y + j * 1024, WBR + (size_t)j * 2048 * 1024, S, DM, 1024, 3072, 1024, 0}; pg8::StaticOrder so; so.init(S, DM, G, bx); pg8::EpiMerge E{XN, P + PC_G + j * 2048, j == 0}; pg8::gemm_phase(smem, g, so, E);
            }
            xcd_barrier(bar);
            { pg8::Gemm g{XN, WOUT, S, DM, DM, DM, DM, 0}; pg8::StaticOrder so; so.init(S, DM, G, bx); pg8::EpiRes E{p.out, p.out, 1.0f}; pg8::gemm_phase(smem, g, so, E); }
            xcd_barrier(bar);
        }
    }
    final_norm_rows(p.out, p.in[26]);
}

constexpr int LDS_BYTES = 143360;

extern "C" void kernel_launch(void* const* d_in, const int* in_sizes, int n_in, void* d_out, int out_size, void* d_ws, size_t ws_size, hipStream_t stream) {
    static int grid = 0;
    if (grid == 0) {
        if (n_in != 27 || out_size != S * DM || ws_size < WS_END) { fprintf(stderr, "kernel_launch: unexpected problem (n_in %d out %d ws %zu, need %zu)\n", n_in, out_size, ws_size, (size_t)WS_END); grid = -1; return; }
        int dev = 0, cus = 0, per_cu = 0;
        hipGetDevice(&dev); hipDeviceGetAttribute(&cus, hipDeviceAttributeMultiprocessorCount, dev);
        if (hipFuncSetAttribute((const void*)mega_fwd, hipFuncAttributeMaxDynamicSharedMemorySize, LDS_BYTES) != hipSuccess) { fprintf(stderr, "kernel_launch: hipFuncSetAttribute failed\n"); grid = -1; return; }
        if (hipOccupancyMaxActiveBlocksPerMultiprocessor(&per_cu, (const void*)mega_fwd, 512, LDS_BYTES) != hipSuccess || per_cu < 1) { fprintf(stderr, "kernel_launch: occupancy query says %d\n", per_cu); per_cu = 1; }
        (void)hipGetLastError();
        grid = cus * (per_cu > 1 ? 1 : per_cu);
    }
    if (grid < 0) return;
    if (hipMemsetAsync((char*)d_ws + WS_CTL, 0, CTL_BYTES, stream) != hipSuccess) { fprintf(stderr, "kernel_launch: memset failed\n"); return; }
    Params p{};
    for (int i = 0; i < 27; ++i) p.in[i] = (const float*)d_in[i];
    p.out = (float*)d_out; p.ws = (unsigned char*)d_ws;
    void* args[] = {&p};
    hipError_t e = hipLaunchCooperativeKernel((const void*)mega_fwd, dim3(grid), dim3(512), args, LDS_BYTES, stream);
    if (e != hipSuccess) fprintf(stderr, "cooperative launch failed: %s (grid %d)\n", hipGetErrorString(e), grid);
}
```

```cpp
#include <hip/hip_runtime.h>
#include <hip/hip_cooperative_groups.h>
#include <cstdio>
#include <cstdint>
namespace cg = cooperative_groups;

#define DI __device__ __forceinline__
#define LAS __attribute__((address_space(3)))
typedef unsigned short bf16_t;
typedef short bf16x8 __attribute__((ext_vector_type(8)));
typedef short s16x4 __attribute__((ext_vector_type(4)));
typedef float f32x2 __attribute__((ext_vector_type(2)));
typedef float f32x4 __attribute__((ext_vector_type(4)));
typedef float f32x16 __attribute__((ext_vector_type(16)));
typedef unsigned u32x2 __attribute__((ext_vector_type(2)));
typedef unsigned u32x4 __attribute__((ext_vector_type(4)));
typedef __bf16 bf16x2_t __attribute__((ext_vector_type(2)));

constexpr int S = 16384, DM = 2048, FF = 5632, NIN = 10952, NP = 11008;
constexpr float EPS = 1e-6f;
constexpr int PC_Q = 0, PC_K = 512, PC_V = 1024, PC_O = 2048, PC_CQ = 3072, PC_CKV = 3456, PC_KR = 3712, PC_CX = 3776, PC_G = 4800, PC_I = 10944, PC_F = 10948;
constexpr float MQS = 0.08838834764831845f;
constexpr float AQS = 0.07216878364870322f * 1.4426950408889634f;

constexpr size_t MiB = 1u << 20;
constexpr size_t WS_TAB = 0;
constexpr size_t WS_SMALL = 4 * MiB;
constexpr size_t WS_WFFGU = 12 * MiB;
constexpr size_t WS_WFFD = 56 * MiB;
constexpr size_t WS_WIN = 78 * MiB;
constexpr size_t WS_WUQ = 121 * MiB;
constexpr size_t WS_WUKV = 123 * MiB;
constexpr size_t WS_WLRU = 124 * MiB;
constexpr size_t WS_WBR = 125 * MiB;
constexpr size_t WS_WOUT = 137 * MiB;
constexpr size_t WS_XN = 145 * MiB;
constexpr size_t WS_P = 209 * MiB;
constexpr size_t WS_Q = 553 * MiB;
constexpr size_t WS_KN = 601 * MiB;
constexpr size_t WS_VT = 633 * MiB;
constexpr size_t WS_Y = 665 * MiB;
constexpr size_t WS_XC = 761 * MiB;
constexpr size_t WS_CS = 793 * MiB;
constexpr size_t WS_END = 857 * MiB;
constexpr size_t WS_CTL = 11 * MiB, CTL_BYTES = 16384;
constexpr int SM_BT = 0, SM_MC = 1024, SM_MPREV = 2048, SM_DN = 4096  , SM_CA = 4096 + 131072  , SM_CH = SM_CA + 262144, SM_CARRY = SM_CH + 262144, SM_SP = SM_CARRY + 262144;

__device__ const float INVF[32] = {1.0f, 0.7498942613601685f, 0.5623413324356079f, 0.4216965138912201f, 0.3162277638912201f, 0.23713737726211548f, 0.17782793939113617f, 0.133352130651474f, 0.10000000149011612f, 0.07498941570520401f, 0.05623413249850273f, 0.04216965287923813f, 0.03162277489900589f, 0.023713737726211548f, 0.017782794311642647f, 0.01333521492779255f, 0.009999999776482582f, 0.007498941849917173f, 0.005623413249850273f, 0.0042169648222625256f, 0.003162277629598975f, 0.00237137358635664f, 0.0017782794311642647f, 0.0013335214462131262f, 0.0010000000474974513f, 0.0007498942431993783f, 0.000562341301701963f, 0.0004216965171508491f, 0.0003162277571391314f, 0.00023713737027719617f, 0.00017782794020604342f, 0.0001333521504420787f};

DI int opaque_tid() { int t = threadIdx.x; asm volatile("" : "+v"(t)); return t; }
DI float bf2f(bf16_t v) { return __uint_as_float((unsigned)v << 16); }
DI float bflo(unsigned w) { return __uint_as_float(w << 16); }
DI float bfhi(unsigned w) { return __uint_as_float(w & 0xffff0000u); }
DI unsigned pk2(float lo, float hi) { f32x2 v = {lo, hi}; bf16x2_t b = __builtin_convertvector(v, bf16x2_t); return __builtin_bit_cast(unsigned, b); }
DI bf16_t f2bf(float f) { return (bf16_t)(pk2(f, 0.f) & 0xffffu); }
DI float wave_sum(float v) {
#pragma unroll
    for (int o = 1; o < 64; o <<= 1) v += __shfl_xor(v, o);
    return v;
}
DI float wave_max(float v) {
#pragma unroll
    for (int o = 1; o < 64; o <<= 1) v = fmaxf(v, __shfl_xor(v, o));
    return v;
}
DI float wave_incl_scan(float v, int lane) {
#pragma unroll
    for (int o = 1; o < 64; o <<= 1) { const float n = __shfl_up(v, o); if (lane >= o) v += n; }
    return v;
}
DI float sigmoidf_(float x) { return __builtin_amdgcn_rcpf(1.f + __expf(-x)); }
DI float logsigmoid_(float x) { return fminf(x, 0.f) - log1pf(expf(-fabsf(x))); }
DI f32x16 mfma32(bf16x8 a, bf16x8 b, f32x16 c) { return __builtin_amdgcn_mfma_f32_32x32x16_bf16(a, b, c, 0, 0, 0); }
DI int crow(int r, int h) { return (r & 3) + 8 * (r >> 2) + 4 * h; }
DI int pi32(int m) { return (m & ~12) | ((m & 4) << 1) | ((m & 8) >> 1); }
typedef short v4i16_t __attribute__((ext_vector_type(4)));
DI s16x4 tr16(LAS const unsigned char* p) { return __builtin_bit_cast(s16x4, __builtin_amdgcn_ds_read_tr16_b64_v4i16((LAS v4i16_t*)p)); }
DI bf16x8 tr_frag(LAS const unsigned char* p, int rs) {
    const s16x4 lo = tr16(p), hi = tr16(p + 4 * rs);
    return __builtin_shufflevector(lo, hi, 0, 1, 2, 3, 4, 5, 6, 7);
}
DI bf16x8 pack8(float a0, float a1, float a2, float a3, float a4, float a5, float a6, float a7) {
    u32x4 w; w.x = pk2(a0, a1); w.y = pk2(a2, a3); w.z = pk2(a4, a5); w.w = pk2(a6, a7); return __builtin_bit_cast(bf16x8, w);
}

namespace pg8 {
constexpr int BM = 256, BK = 64, HALF = 128, HTB = HALF * BK * 2, STAGE_BYTES = 8 * HTB, NXCD = 8, WGM = 8;
DI int lds_byte(int r, int c) { const int st = (r >> 4) * 2 + (c >> 5), rr = r & 15, cc = c & 31, ob = rr * 64 + cc * 2; return st * 1024 + (ob ^ (((ob >> 9) & 1) << 5)); }
DI void stage_rc(int b, int& R, int& C) { const int st = b / 1024, sb = b % 1024, swz = sb ^ (((sb >> 9) & 1) << 5); R = (st >> 1) * 16 + swz / 64; C = (st & 1) * 32 + (swz % 64) / 2; }
DI int perm32(int rho) { const int n = rho >> 4, i = rho & 15; return 8 * (i >> 2) + 4 * n + (i & 3); }
struct Unit { int pm, pn; };
struct Gemm { const bf16_t* A; const bf16_t* Bt; int M, N, K, lda, ldb, apn; };
struct StaticOrder {
    int nM, nN, nwg, G, c;
    DI void init(int M, int N, int G_, int c_) { nM = M / BM; nN = N / BM; nwg = nM * nN; G = G_; c = c_; }
    DI bool next(int i, Unit& u) const {
        const long L = (long)i * G + c; if (L >= nwg) return false;
        int wgid = (int)L; { const int q = nwg / NXCD, r = nwg % NXCD, xcd = wgid % NXCD, off = wgid / NXCD; wgid = (xcd < r ? xcd * (q + 1) : r * (q + 1) + (xcd - r) * q) + off; }
        const int nig = WGM * nN, gid = wgid / nig, fm = gid * WGM, gsz = (nM - fm) < WGM ? (nM - fm) : WGM;
        u.pm = fm + ((wgid % nig) % gsz); u.pn = (wgid % nig) / gsz; return true;
    }
};
template <class Epi>
DI void gemm_phase(LAS unsigned char* lds, const Gemm g, const StaticOrder& S, const Epi& E) {
    const int tid = opaque_tid(), wid = __builtin_amdgcn_readfirstlane(tid >> 6), lane = tid & 63, wr = wid >> 2, wc = wid & 3, fr = lane & 15, fq = lane >> 4;
    int K = g.K; asm volatile("" : "+s"(K)); const int nt = K / BK;
    unsigned voffA[2], voffB[2];
#pragma unroll
    for (int i = 0; i < 2; ++i) { int R, C; stage_rc(tid * 16 + i * 8192, R, C); const int Rb = Epi::PERM ? ((R & ~31) + perm32(R & 31)) : R;
        voffA[i] = (unsigned)(R * g.lda + C) * 2u; voffB[i] = (unsigned)(Rb * g.ldb + C) * 2u; }
    const size_t kstep = (size_t)(BK * 2);
    const size_t hstepA = (size_t)HALF * g.lda * 2, hstepB = (size_t)HALF * g.ldb * 2;
    const unsigned ldsw = (unsigned)wid * 1024u;
    const int aoff = lds_byte(wr * 64 + fr, fq * 8), boff = lds_byte(wc * 32 + fr, fq * 8);
#define PG8_SA(b, h) (((b) * 2 + (h)) * HTB)
#define PG8_SB(b, h) ((4 + (b) * 2 + (h)) * HTB)
#define PG8_STAGE(bufoff, gbase, voff) do { _Pragma("unroll") for (int _i = 0; _i < 2; ++_i) \
        __builtin_amdgcn_global_load_lds((const unsigned*)((const char*)(gbase) + (voff)[_i]), (LAS unsigned*)(lds + (bufoff) + ldsw + _i * 8192), 16, 0, 0); } while (0)
#define PG8_LDA(dst, b, h) do { _Pragma("unroll") for (int m = 0; m < 4; ++m) _Pragma("unroll") for (int k = 0; k < 2; ++k) dst[m][k] = *(const LAS bf16x8*)(lds + PG8_SA(b, h) + aoff + m * 2048 + k * 1024); } while (0)
#define PG8_LDB(dst, b, h) do { _Pragma("unroll") for (int n = 0; n < 2; ++n) _Pragma("unroll") for (int k = 0; k < 2; ++k) dst[n][k] = *(const LAS bf16x8*)(lds + PG8_SB(b, h) + boff + n * 2048 + k * 1024); } while (0)
#define PG8_MMA(ai, bj, At, Bt) do { __builtin_amdgcn_s_setprio(1); _Pragma("unroll") for (int m = 0; m < 4; ++m) _Pragma("unroll") for (int n = 0; n < 2; ++n) _Pragma("unroll") for (int k = 0; k < 2; ++k) \
        acc[ai][bj][m][n] = __builtin_amdgcn_mfma_f32_16x16x32_bf16(Bt[n][k], At[m][k], acc[ai][bj][m][n], 0, 0, 0); __builtin_amdgcn_s_setprio(0); } while (0)
#define PG8_WAIT_V(n) asm volatile("s_waitcnt vmcnt(" #n ")" ::: "memory")
#define PG8_WAIT_L(n) asm volatile("s_waitcnt lgkmcnt(" #n ")" ::: "memory")
#define PG8_BAR __builtin_amdgcn_s_barrier()
#define PG8_SCHED __builtin_amdgcn_sched_barrier(0)
#define PG8_APTR(u) ((const char*)g.A + (size_t)(u).pm * 2 * hstepA + (size_t)(u).pn * (size_t)g.apn * 2)
#define PG8_BPTR(u) ((const char*)g.Bt + (size_t)(u).pn * 2 * hstepB)
    Unit cur, nxt; int ui = 0;
    if (!S.next(0, cur)) return;
    f32x4 acc[2][2][4][2];
#pragma unroll
    for (int a = 0; a < 2; ++a)
#pragma unroll
        for (int b = 0; b < 2; ++b)
#pragma unroll
            for (int m = 0; m < 4; ++m)
#pragma unroll
                for (int n = 0; n < 2; ++n) acc[a][b][m][n] = (f32x4){0.f, 0.f, 0.f, 0.f};
    bf16x8 At[4][2], B0[2][2], B1[2][2];
    const char* cA = PG8_APTR(cur); const char* cB = PG8_BPTR(cur);
    PG8_STAGE(PG8_SB(0, 0), cB, voffB); PG8_STAGE(PG8_SB(0, 1), cB + hstepB, voffB); PG8_STAGE(PG8_SA(0, 0), cA, voffA); PG8_STAGE(PG8_SA(0, 1), cA + hstepA, voffA);
    if (wr == 1) PG8_BAR;
    PG8_WAIT_V(2); PG8_BAR;
    PG8_STAGE(PG8_SB(1, 0), cB + kstep, voffB); PG8_STAGE(PG8_SA(1, 0), cA + kstep, voffA); PG8_STAGE(PG8_SB(1, 1), cB + hstepB + kstep, voffB);
    PG8_WAIT_V(6); PG8_BAR;
    for (;;) {
        const bool has_next = S.next(ui + 1, nxt);
        const char* nA = has_next ? PG8_APTR(nxt) : cA; const char* nB = has_next ? PG8_BPTR(nxt) : cB;
        for (int t = 0; t < nt; t += 2) {
            const bool last = (t == nt - 2);
            const char* a1 = cA + (size_t)(t + 1) * kstep;
            const char* a2 = last ? nA : cA + (size_t)(t + 2) * kstep; const char* b2 = last ? nB : cB + (size_t)(t + 2) * kstep;
            const char* a3 = a2 + kstep; const char* b3 = b2 + kstep;
            PG8_LDB(B0, 0, 0); PG8_LDB(B1, 0, 1); PG8_SCHED; PG8_LDA(At, 0, 0); PG8_STAGE(PG8_SA(1, 1), a1 + hstepA, voffA);
            PG8_WAIT_V(8); PG8_WAIT_L(0); PG8_BAR; PG8_MMA(0, 0, At, B0); PG8_MMA(0, 1, At, B1); PG8_BAR; PG8_SCHED;
            PG8_LDA(At, 0, 1); PG8_STAGE(PG8_SB(0, 0), b2, voffB); PG8_STAGE(PG8_SB(0, 1), b2 + hstepB, voffB); PG8_STAGE(PG8_SA(0, 0), a2, voffA);
            PG8_WAIT_V(8); PG8_WAIT_L(0); PG8_BAR; PG8_MMA(1, 0, At, B0); PG8_MMA(1, 1, At, B1); PG8_BAR; PG8_SCHED;
            PG8_LDB(B0, 1, 0); PG8_LDB(B1, 1, 1); PG8_SCHED; PG8_LDA(At, 1, 0); PG8_STAGE(PG8_SA(0, 1), a2 + hstepA, voffA);
            PG8_WAIT_V(8); PG8_WAIT_L(0); PG8_BAR; PG8_MMA(0, 0, At, B0); PG8_MMA(0, 1, At, B1); PG8_BAR; PG8_SCHED;
            PG8_LDA(At, 1, 1); PG8_STAGE(PG8_SB(1, 0), b3, voffB); PG8_STAGE(PG8_SB(1, 1), b3 + hstepB, voffB); PG8_STAGE(PG8_SA(1, 0), a3, voffA);
            PG8_WAIT_V(8); PG8_WAIT_L(0); PG8_BAR; PG8_MMA(1, 0, At, B0); PG8_MMA(1, 1, At, B1); PG8_BAR; PG8_SCHED;
        }
        if (wr == 0) PG8_BAR;
        E(acc, cur, wr, wc, fr, fq);
        if (!has_next) break;
#pragma unroll
        for (int a = 0; a < 2; ++a)
#pragma unroll
            for (int b = 0; b < 2; ++b)
#pragma unroll
                for (int m = 0; m < 4; ++m)
#pragma unroll
                    for (int n = 0; n < 2; ++n) acc[a][b][m][n] = (f32x4){0.f, 0.f, 0.f, 0.f};
        cur = nxt; cA = nA; cB = nB; ++ui;
        if (wr == 1) PG8_BAR;
    }
    PG8_WAIT_V(0);
    PG8_BAR;
#undef PG8_SA
#undef PG8_SB
#undef PG8_STAGE
#undef PG8_LDA
#undef PG8_LDB
#undef PG8_MMA
#undef PG8_WAIT_V
#undef PG8_WAIT_L
#undef PG8_BAR
#undef PG8_SCHED
#undef PG8_APTR
#undef PG8_BPTR
}

typedef f32x4 Acc[2][2][4][2];
struct EpiStore {
    static constexpr bool PERM = true;
    bf16_t* O; int ldc;
    DI void operator()(const Acc& acc, const Unit& u, int wr, int wc, int fr, int fq) const {
        const int row0 = u.pm * BM + wr * 64 + fr, col0 = u.pn * BM + wc * 32 + 8 * fq;
#pragma unroll
        for (int ai = 0; ai < 2; ++ai)
#pragma unroll
            for (int m = 0; m < 4; ++m) { bf16_t* rowp = O + (size_t)(row0 + ai * HALF + m * 16) * ldc + col0;
#pragma unroll
                for (int bj = 0; bj < 2; ++bj) { const f32x4 v0 = acc[ai][bj][m][0], v1 = acc[ai][bj][m][1];
                    u32x4 w; w.x = pk2(v0[0], v0[1]); w.y = pk2(v0[2], v0[3]); w.z = pk2(v1[0], v1[1]); w.w = pk2(v1[2], v1[3]);
                    *(u32x4*)(rowp + bj * HALF) = w; } }
    }
};
struct EpiSwiglu {
    static constexpr bool PERM = true;
    bf16_t* H;
    DI void operator()(const Acc& acc, const Unit& u, int wr, int wc, int fr, int fq) const {
        const int row0 = u.pm * BM + wr * 64 + fr, col0 = u.pn * HALF + wc * 32 + 8 * fq;
#pragma unroll
        for (int ai = 0; ai < 2; ++ai)
#pragma unroll
            for (int m = 0; m < 4; ++m) { bf16_t* rowp = H + (size_t)(row0 + ai * HALF + m * 16) * FF + col0;
                float o[8];
#pragma unroll
                for (int n = 0; n < 2; ++n)
#pragma unroll
                    for (int j = 0; j < 4; ++j) { const float gt = acc[ai][0][m][n][j], up = acc[ai][1][m][n][j]; o[n * 4 + j] = gt * sigmoidf_(gt) * up; }
                u32x4 w; w.x = pk2(o[0], o[1]); w.y = pk2(o[2], o[3]); w.z = pk2(o[4], o[5]); w.w = pk2(o[6], o[7]);
                *(u32x4*)rowp = w; }
    }
};
struct EpiRes {
    static constexpr bool PERM = false;
    const float* xin; float* xout; float alpha;
    DI void operator()(const Acc& acc, const Unit& u, int wr, int wc, int fr, int fq) const {
        const int col0 = u.pn * BM + wc * 32 + 4 * fq;
#pragma unroll
        for (int ai = 0; ai < 2; ++ai) {
            f32x4 b[4][2][2];
#pragma unroll
            for (int m = 0; m < 4; ++m) { const size_t off = (size_t)(u.pm * BM + ai * HALF + wr * 64 + m * 16 + fr) * DM + col0;
#pragma unroll
                for (int bj = 0; bj < 2; ++bj)
#pragma unroll
                    for (int n = 0; n < 2; ++n) b[m][bj][n] = *(const f32x4*)(xin + off + bj * HALF + n * 16); }
            __builtin_amdgcn_sched_barrier(0);
#pragma unroll
            for (int m = 0; m < 4; ++m) { const size_t off = (size_t)(u.pm * BM + ai * HALF + wr * 64 + m * 16 + fr) * DM + col0;
#pragma unroll
                for (int bj = 0; bj < 2; ++bj)
#pragma unroll
                    for (int n = 0; n < 2; ++n) *(f32x4*)(xout + off + bj * HALF + n * 16) = b[m][bj][n] + acc[ai][bj][m][n] * alpha; }
            __builtin_amdgcn_sched_barrier(0);
        }
    }
};
struct EpiQ {
    static constexpr bool PERM = true;
    bf16_t* Q; const f32x2* tab;
    DI void operator()(const Acc& acc, const Unit& u, int wr, int wc, int fr, int fq) const {
        const int row0 = u.pm * BM + wr * 64 + fr;
#pragma unroll
        for (int bj = 0; bj < 2; ++bj) {
            const int c0 = u.pn * BM + bj * HALF + wc * 32 + 8 * fq; const int hh = c0 / 192, dd = c0 - hh * 192; const bool rope = dd >= 128; const int j0 = rope ? (dd - 128) >> 1 : 0;
#pragma unroll
            for (int ai = 0; ai < 2; ++ai) {
                f32x4 cs[4][2];
#pragma unroll
                for (int m = 0; m < 4; ++m) { const f32x4* tp = (const f32x4*)(tab + (size_t)(row0 + ai * HALF + m * 16) * 32 + j0); cs[m][0] = tp[0]; cs[m][1] = tp[1]; }
                __builtin_amdgcn_sched_barrier(0);
#pragma unroll
                for (int m = 0; m < 4; ++m) { const int row = row0 + ai * HALF + m * 16;
                    float v[8];
#pragma unroll
                    for (int n = 0; n < 2; ++n)
#pragma unroll
                        for (int j = 0; j < 4; ++j) v[n * 4 + j] = acc[ai][bj][m][n][j];
                    if (rope) {
                        const float cc[4] = {cs[m][0].x, cs[m][0].z, cs[m][1].x, cs[m][1].z}, sn[4] = {cs[m][0].y, cs[m][0].w, cs[m][1].y, cs[m][1].w};
#pragma unroll
                        for (int p = 0; p < 4; ++p) { const float x1 = v[2 * p], x2 = v[2 * p + 1]; v[2 * p] = x1 * cc[p] - x2 * sn[p]; v[2 * p + 1] = x1 * sn[p] + x2 * cc[p]; }
                    }
                    u32x4 w; w.x = pk2(v[0] * AQS, v[1] * AQS); w.y = pk2(v[2] * AQS, v[3] * AQS); w.z = pk2(v[4] * AQS, v[5] * AQS); w.w = pk2(v[6] * AQS, v[7] * AQS);
                    *(u32x4*)(Q + (size_t)row * 1536 + c0) = w; }
                __builtin_amdgcn_sched_barrier(0);
            }
        }
    }
};
struct EpiLru {
    static constexpr bool PERM = true;
    bf16_t* XC; bf16_t* LA; const float* ba; const float* bx; const float* sp;
    DI void operator()(const Acc& acc, const Unit& u, int wr, int wc, int fr, int fq) const {
        const int row0 = u.pm * BM + wr * 64 + fr, ch0 = u.pn * HALF + wc * 32 + 8 * fq;
#pragma unroll
        for (int ai = 0; ai < 2; ++ai) {
            u32x4 xall[4];
#pragma unroll
            for (int m = 0; m < 4; ++m) xall[m] = *(const u32x4*)(XC + (size_t)(row0 + ai * HALF + m * 16) * 1024 + ch0);
            __builtin_amdgcn_sched_barrier(0);
#pragma unroll
            for (int m = 0; m < 4; ++m) { const int row = row0 + ai * HALF + m * 16;
                const u32x4 xw = xall[m];
                const float xv[8] = {bflo(xw.x), bfhi(xw.x), bflo(xw.y), bfhi(xw.y), bflo(xw.z), bfhi(xw.z), bflo(xw.w), bfhi(xw.w)};
                u32x4 wl, wu;
#pragma unroll
                for (int n = 0; n < 2; ++n) { const f32x4 spv = *(const f32x4*)(sp + ch0 + 4 * n), bav = *(const f32x4*)(ba + ch0 + 4 * n), bxv = *(const f32x4*)(bx + ch0 + 4 * n);
                    float la[4], uu[4];
#pragma unroll
                    for (int j = 0; j < 4; ++j) { const float r = sigmoidf_(acc[ai][0][m][n][j] + bav[j]), gi = sigmoidf_(acc[ai][1][m][n][j] + bxv[j]);
                        const float l = r * spv[j]; la[j] = l; const float a2 = __expf(2.f * l); uu[j] = sqrtf(fmaxf(1.f - a2, 0.f)) * gi * xv[n * 4 + j]; }
                    if (n == 0) { wl.x = pk2(la[0], la[1]); wl.y = pk2(la[2], la[3]); wu.x = pk2(uu[0], uu[1]); wu.y = pk2(uu[2], uu[3]); }
                    else { wl.z = pk2(la[0], la[1]); wl.w = pk2(la[2], la[3]); wu.z = pk2(uu[0], uu[1]); wu.w = pk2(uu[2], uu[3]); } }
                *(u32x4*)(LA + (size_t)row * NP + ch0) = wl;
                *(u32x4*)(XC + (size_t)row * 1024 + ch0) = wu;
                asm volatile("" ::: "memory"); }
        }
    }
};
struct EpiMerge {
    static constexpr bool PERM = true;
    bf16_t* Z; const bf16_t* G; int first;
    DI void operator()(const Acc& acc, const Unit& u, int wr, int wc, int fr, int fq) const {
        const int row0 = u.pm * BM + wr * 64 + fr, col0 = u.pn * BM + wc * 32 + 8 * fq;
#pragma unroll
        for (int ai = 0; ai < 2; ++ai) {
            u32x4 gw[4][2], zw[4][2];
#pragma unroll
            for (int m = 0; m < 4; ++m) { const int row = row0 + ai * HALF + m * 16;
#pragma unroll
                for (int bj = 0; bj < 2; ++bj) { const int c = col0 + bj * HALF; gw[m][bj] = *(const u32x4*)(G + (size_t)row * NP + c);
                    zw[m][bj] = first ? (u32x4){0u, 0u, 0u, 0u} : *(const u32x4*)(Z + (size_t)row * DM + c); } }
            __builtin_amdgcn_sched_barrier(0);
#pragma unroll
            for (int m = 0; m < 4; ++m) { const int row = row0 + ai * HALF + m * 16;
#pragma unroll
                for (int bj = 0; bj < 2; ++bj) { const int c = col0 + bj * HALF;
                    const u32x4 g4 = gw[m][bj], z4 = zw[m][bj];
                    const float gv[8] = {bflo(g4.x), bfhi(g4.x), bflo(g4.y), bfhi(g4.y), bflo(g4.z), bfhi(g4.z), bflo(g4.w), bfhi(g4.w)};
                    const float zv[8] = {bflo(z4.x), bfhi(z4.x), bflo(z4.y), bfhi(z4.y), bflo(z4.z), bfhi(z4.z), bflo(z4.w), bfhi(z4.w)};
                    float o[8];
#pragma unroll
                    for (int n = 0; n < 2; ++n)
#pragma unroll
                        for (int j = 0; j < 4; ++j) o[n * 4 + j] = zv[n * 4 + j] + sigmoidf_(gv[n * 4 + j]) * acc[ai][bj][m][n][j];
                    u32x4 w; w.x = pk2(o[0], o[1]); w.y = pk2(o[2], o[3]); w.z = pk2(o[4], o[5]); w.w = pk2(o[6], o[7]);
                    *(u32x4*)(Z + (size_t)row * DM + c) = w; } }
            __builtin_amdgcn_sched_barrier(0);
        }
    }
};
}

DI int map_row(int map, int n) {
    switch (map) {
        case 1: return ((n >> 7) << 8) + (n & 127);
        case 2: return ((n >> 7) << 8) + 128 + (n & 127);
        case 3: { if (n < 2048) return n; if (n < 2052) return PC_I + n - 2048; if (n < 2056) return PC_F + n - 2052; if (n < 3080) return PC_O + n - 2056; if (n < 3464) return PC_CQ + n - 3080;
                  if (n < 3720) return PC_CKV + n - 3464; if (n < 3784) return PC_KR + n - 3720; if (n < 4808) return PC_CX + n - 3784; return PC_G + n - 4808; }
        case 4: { const int hh = n / 192, dd = n - hh * 192; if (dd < 128) return n; const int jj = dd - 128; return hh * 192 + 128 + (jj < 32 ? 2 * jj : 2 * (jj - 32) + 1); }
        case 5: { const int hh = n >> 8, dd = n & 255; return dd < 128 ? hh * 128 + dd : 1024 + hh * 128 + dd - 128; }
        default: return n;
    }
}
DI void convert_mat(const float* W, int K, int N, bf16_t* WT, int map, int& rot) {
    const int tid_ = opaque_tid(), lane = tid_ & 63, gw = blockIdx.x * 8 + (tid_ >> 6), ngw = gridDim.x * 8, r = lane >> 3, c = lane & 7;
    const int nnb = (N + 31) >> 5, nkb = K >> 6, nitems = nnb * nkb;
    int it = gw - rot; if (it < 0) it += ngw;
    for (; it < nitems; it += 2 * ngw) {
        const int it2 = it + ngw; const bool two = it2 < nitems;
        const int nbA = it / nkb, kbA = it - nbA * nkb, nA = nbA * 32 + 4 * c, kA = kbA * 64 + 8 * r;
        const int nbB = two ? it2 / nkb : nbA, kbB = two ? it2 - nbB * nkb : kbA, nB = nbB * 32 + 4 * c, kB = kbB * 64 + 8 * r;
        const bool okA = nA < N, okB = two && nB < N;
        f32x4 va[8], vb[8];
        if (okA) { const float* src = W + (size_t)kA * N + nA;
#pragma unroll
            for (int i = 0; i < 8; ++i) va[i] = *(const f32x4*)(src + (size_t)i * N); }
        if (okB) { const float* src = W + (size_t)kB * N + nB;
#pragma unroll
            for (int i = 0; i < 8; ++i) vb[i] = *(const f32x4*)(src + (size_t)i * N); }
        __builtin_amdgcn_sched_barrier(0);
#define CV_STORE(v, n0, k0) do { u32x4 o; \
            o.x = pk2(v[0].x, v[1].x); o.y = pk2(v[2].x, v[3].x); o.z = pk2(v[4].x, v[5].x); o.w = pk2(v[6].x, v[7].x); *(u32x4*)(WT + (size_t)map_row(map, (n0)) * K + (k0)) = o; \
            o.x = pk2(v[0].y, v[1].y); o.y = pk2(v[2].y, v[3].y); o.z = pk2(v[4].y, v[5].y); o.w = pk2(v[6].y, v[7].y); *(u32x4*)(WT + (size_t)map_row(map, (n0) + 1) * K + (k0)) = o; \
            o.x = pk2(v[0].z, v[1].z); o.y = pk2(v[2].z, v[3].z); o.z = pk2(v[4].z, v[5].z); o.w = pk2(v[6].z, v[7].z); *(u32x4*)(WT + (size_t)map_row(map, (n0) + 2) * K + (k0)) = o; \
            o.x = pk2(v[0].w, v[1].w); o.y = pk2(v[2].w, v[3].w); o.z = pk2(v[4].w, v[5].w); o.w = pk2(v[6].w, v[7].w); *(u32x4*)(WT + (size_t)map_row(map, (n0) + 3) * K + (k0)) = o; } while (0)
        if (okA) CV_STORE(va, nA, kA);
        if (okB) CV_STORE(vb, nB, kB);
#undef CV_STORE
    }
    rot = (rot + nitems) % ngw;
}

DI void rmsnorm_rows(const float* X, const float* g, bf16_t* O) {
    const int tid_ = opaque_tid(), lane = tid_ & 63, gw = blockIdx.x * 8 + (tid_ >> 6), ngw = gridDim.x * 8;
    f32x4 gv[8], v[8], vn[8];
#pragma unroll
    for (int j = 0; j < 8; ++j) gv[j] = ((const f32x4*)g)[lane + 64 * j];
    if (gw < S) {
#pragma unroll
        for (int j = 0; j < 8; ++j) v[j] = ((const f32x4*)(X + (size_t)gw * DM) + lane)[64 * j]; }
    for (int r = gw; r < S; r += ngw) {
        const int rn = r + ngw < S ? r + ngw : r;
#pragma unroll
        for (int j = 0; j < 8; ++j) vn[j] = ((const f32x4*)(X + (size_t)rn * DM) + lane)[64 * j];
        __builtin_amdgcn_sched_barrier(0);
        float s = 0.f;
#pragma unroll
        for (int j = 0; j < 8; ++j) s += (v[j].x * v[j].x + v[j].y * v[j].y) + (v[j].z * v[j].z + v[j].w * v[j].w);
        const float rstd = 1.f / sqrtf(wave_sum(s) * (1.f / DM) + EPS);
        u32x2* o8 = (u32x2*)(O + (size_t)r * DM) + lane;
#pragma unroll
        for (int j = 0; j < 8; ++j) { u32x2 w; w.x = pk2(v[j].x * rstd * gv[j].x, v[j].y * rstd * gv[j].y); w.y = pk2(v[j].z * rstd * gv[j].z, v[j].w * rstd * gv[j].w); o8[64 * j] = w; }
        __builtin_amdgcn_sched_barrier(0);
#pragma unroll
        for (int j = 0; j < 8; ++j) v[j] = vn[j];
    }
}
DI void final_norm_rows(float* X, const float* g) {
    const int tid_ = opaque_tid(), lane = tid_ & 63, gw = blockIdx.x * 8 + (tid_ >> 6), ngw = gridDim.x * 8;
    f32x4 gv[8], v[8], vn[8];
#pragma unroll
    for (int j = 0; j < 8; ++j) gv[j] = ((const f32x4*)g)[lane + 64 * j];
    if (gw < S) {
#pragma unroll
        for (int j = 0; j < 8; ++j) v[j] = ((const f32x4*)(X + (size_t)gw * DM) + lane)[64 * j]; }
    for (int r = gw; r < S; r += ngw) {
        const int rn = r + ngw < S ? r + ngw : r;
#pragma unroll
        for (int j = 0; j < 8; ++j) vn[j] = ((const f32x4*)(X + (size_t)rn * DM) + lane)[64 * j];
        __builtin_amdgcn_sched_barrier(0);
        float s = 0.f;
#pragma unroll
        for (int j = 0; j < 8; ++j) s += (v[j].x * v[j].x + v[j].y * v[j].y) + (v[j].z * v[j].z + v[j].w * v[j].w);
        const float rstd = 1.f / sqrtf(wave_sum(s) * (1.f / DM) + EPS);
        f32x4* xr = (f32x4*)(X + (size_t)r * DM) + lane;
#pragma unroll
        for (int j = 0; j < 8; ++j) xr[64 * j] = v[j] * rstd * gv[j];
        __builtin_amdgcn_sched_barrier(0);
#pragma unroll
        for (int j = 0; j < 8; ++j) v[j] = vn[j];
    }
}
DI void prep_rows(bf16_t* P, const float* qn, const float* kvn, const float* cw, const float* cb, const f32x2* tab, bf16_t* XC) {
    const int tid_ = opaque_tid(), lane = tid_ & 63, gw = blockIdx.x * 8 + (tid_ >> 6), ngw = gridDim.x * 8;
    f32x2 qg[3], kg[2], cbv[8], cwv[8][4];
#pragma unroll
    for (int k = 0; k < 3; ++k) qg[k] = *(const f32x2*)(qn + 128 * k + 2 * lane);
#pragma unroll
    for (int k = 0; k < 2; ++k) kg[k] = *(const f32x2*)(kvn + 128 * k + 2 * lane);
#pragma unroll
    for (int k = 0; k < 8; ++k) { cbv[k] = *(const f32x2*)(cb + 128 * k + 2 * lane);
#pragma unroll
        for (int jj = 0; jj < 4; ++jj) cwv[k][jj] = *(const f32x2*)(cw + jj * 1024 + 128 * k + 2 * lane); }
    for (int t = gw; t < S; t += ngw) {
        bf16_t* row = P + (size_t)t * NP;
        unsigned wq[3], wk[2], wc[8][4];
#pragma unroll
        for (int k = 0; k < 3; ++k) wq[k] = *(const unsigned*)(row + PC_CQ + 128 * k + 2 * lane);
#pragma unroll
        for (int k = 0; k < 2; ++k) wk[k] = *(const unsigned*)(row + PC_CKV + 128 * k + 2 * lane);
        const int j = lane & 31; const float x1 = bf2f(row[PC_KR + j]), x2 = bf2f(row[PC_KR + 32 + j]); const f32x2 cs = tab[(size_t)t * 32 + j];
#pragma unroll
        for (int k = 0; k < 8; ++k)
#pragma unroll
            for (int jj = 0; jj < 4; ++jj) { const int tt = t - 3 + jj; wc[k][jj] = tt >= 0 ? *(const unsigned*)(P + (size_t)tt * NP + PC_CX + 128 * k + 2 * lane) : 0u; }
        __builtin_amdgcn_sched_barrier(0);
        { float s = 0.f;
#pragma unroll
          for (int k = 0; k < 3; ++k) { const float a = bflo(wq[k]), b = bfhi(wq[k]); s += a * a + b * b; }
          const float rstd = 1.f / sqrtf(wave_sum(s) * (1.f / 384.f) + EPS);
#pragma unroll
          for (int k = 0; k < 3; ++k) *(unsigned*)(row + PC_CQ + 128 * k + 2 * lane) = pk2(bflo(wq[k]) * rstd * qg[k].x, bfhi(wq[k]) * rstd * qg[k].y); }
        { float s = 0.f;
#pragma unroll
          for (int k = 0; k < 2; ++k) { const float a = bflo(wk[k]), b = bfhi(wk[k]); s += a * a + b * b; }
          const float rstd = 1.f / sqrtf(wave_sum(s) * (1.f / 256.f) + EPS);
#pragma unroll
          for (int k = 0; k < 2; ++k) *(unsigned*)(row + PC_CKV + 128 * k + 2 * lane) = pk2(bflo(wk[k]) * rstd * kg[k].x, bfhi(wk[k]) * rstd * kg[k].y); }
        { const unsigned o = pk2(x1 * cs.x - x2 * cs.y, x1 * cs.y + x2 * cs.x); if (lane < 32) *(unsigned*)(row + PC_KR + 2 * j) = o; }
#pragma unroll
        for (int k = 0; k < 8; ++k) { float a0 = cbv[k].x, a1 = cbv[k].y;
#pragma unroll
            for (int jj = 0; jj < 4; ++jj) { a0 += cwv[k][jj].x * bflo(wc[k][jj]); a1 += cwv[k][jj].y * bfhi(wc[k][jj]); }
            *(unsigned*)(XC + (size_t)t * 1024 + 128 * k + 2 * lane) = pk2(a0, a1); }
    }
}

DI void lru_p1(const bf16_t* LA, const bf16_t* U, float* CA, float* CH) {
    const int tid = opaque_tid();
    for (int c = blockIdx.x; c < 256; c += gridDim.x) {
        float h0 = 0.f, h1 = 0.f, s0 = 0.f, s1 = 0.f;
        unsigned lw[64], uw[64];
#pragma unroll
        for (int i = 0; i < 64; ++i) { const size_t row = (size_t)c * 64 + i; lw[i] = *(const unsigned*)(LA + row * NP + 2 * tid); uw[i] = *(const unsigned*)(U + row * 1024 + 2 * tid); }
#pragma unroll
        for (int i = 0; i < 64; ++i) { const float l0 = bflo(lw[i]), l1 = bfhi(lw[i]); s0 += l0; s1 += l1; h0 = __expf(l0) * h0 + bflo(uw[i]); h1 = __expf(l1) * h1 + bfhi(uw[i]); }
        CA[c * 1024 + 2 * tid] = __expf(s0); CA[c * 1024 + 2 * tid + 1] = __expf(s1); CH[c * 1024 + 2 * tid] = h0; CH[c * 1024 + 2 * tid + 1] = h1;
    }
}
DI void lru_p2(const float* CA, const float* CH, float* CARRY) {
    const int tid = opaque_tid(), lane = tid & 63, gw = blockIdx.x * 8 + (tid >> 6), ngw = gridDim.x * 8;
    for (int ch = gw; ch < 1024; ch += ngw) {
        float a[4], hh[4];
#pragma unroll
        for (int i = 0; i < 4; ++i) { a[i] = CA[(4 * lane + i) * 1024 + ch]; hh[i] = CH[(4 * lane + i) * 1024 + ch]; }
        float A = a[0], H = hh[0];
#pragma unroll
        for (int i = 1; i < 4; ++i) { H = a[i] * H + hh[i]; A = A * a[i]; }
#pragma unroll
        for (int o = 1; o < 64; o <<= 1) { const float Ap = __shfl_up(A, o), Hp = __shfl_up(H, o); if (lane >= o) { H = A * Hp + H; A = A * Ap; } }
        float st = __shfl_up(H, 1); if (lane == 0) st = 0.f;
#pragma unroll
        for (int i = 0; i < 4; ++i) { CARRY[(4 * lane + i) * 1024 + ch] = st; st = a[i] * st + hh[i]; }
    }
}
DI void lru_p3(const bf16_t* LA, const bf16_t* U, const float* CARRY, bf16_t* Y) {
    const int tid = opaque_tid();
    for (int c = blockIdx.x; c < 256; c += gridDim.x) {
        float h0 = CARRY[c * 1024 + 2 * tid], h1 = CARRY[c * 1024 + 2 * tid + 1];
        unsigned lw[64], uw[64];
#pragma unroll
        for (int i = 0; i < 64; ++i) { const size_t row = (size_t)c * 64 + i; lw[i] = *(const unsigned*)(LA + row * NP + 2 * tid); uw[i] = *(const unsigned*)(U + row * 1024 + 2 * tid); }
        __builtin_amdgcn_sched_barrier(0);
#pragma unroll
        for (int i = 0; i < 64; ++i) { const size_t row = (size_t)c * 64 + i; h0 = __expf(bflo(lw[i])) * h0 + bflo(uw[i]); h1 = __expf(bfhi(lw[i])) * h1 + bfhi(uw[i]);
            *(unsigned*)(Y + row * 3072 + 2048 + 2 * tid) = pk2(h0, h1); }
    }
}

DI void mlstm_a(LAS unsigned char* smem, const bf16_t* P, const float* gbias, bf16_t* CS, float* SMALL) {
    const int tid = opaque_tid(), lane = tid & 63, wid = tid >> 6, l31 = lane & 31, h = lane >> 5, q4 = (lane & 15) >> 2, p4 = lane & 3, blk = (lane >> 4) & 1;
    LAS float* sw = (LAS float*)smem;
    LAS unsigned char* Ks = smem + 1024;
    LAS unsigned char* Vs = smem + 1024 + 20480;
    u32x4 kpre[2], vpre[4]; bf16_t gipre = 0, gfpre = 0;
#define MA_LOAD(u_) do { const int c_ = (u_) >> 2, hh_ = (u_) & 3; const size_t r0_ = (size_t)c_ * 64; \
        _Pragma("unroll") for (int i = 0; i < 2; ++i) { const int id = tid + 512 * i, s_ = id >> 4, d8 = (id & 15) * 8; kpre[i] = *(const u32x4*)(P + (r0_ + s_) * NP + PC_K + hh_ * 128 + d8); } \
        _Pragma("unroll") for (int i = 0; i < 4; ++i) { const int id = tid + 512 * i, s_ = id >> 5, d8 = (id & 31) * 8; vpre[i] = *(const u32x4*)(P + (r0_ + s_) * NP + PC_V + hh_ * 256 + d8); } \
        if (wid == 0) { const bf16_t* r_ = P + (r0_ + lane) * NP; gipre = r_[PC_I + hh_]; gfpre = r_[PC_F + hh_]; } } while (0)
    if ((int)blockIdx.x < 1024) MA_LOAD((int)blockIdx.x);
    for (int uid = blockIdx.x; uid < 1024; uid += gridDim.x) {
        const int hh = uid & 3;
        if (wid == 0) {
            const float li = bf2f(gipre) + gbias[hh], lf = logsigmoid_(bf2f(gfpre) + gbias[4 + hh]);
            const float bc = wave_incl_scan(lf, lane), bt = __shfl(bc, 63), ds = bt - bc + li, M = wave_max(ds);
            sw[lane] = expf(ds - M);
            if (lane == 0) { SMALL[SM_BT + uid] = bt; SMALL[SM_MC + uid] = M; }
        }
        __syncthreads();
#pragma unroll
        for (int i = 0; i < 2; ++i) { const int id = tid + 512 * i, s = id >> 4, d8 = (id & 15) * 8; const u32x4 v = kpre[i]; const float w = sw[s];
            u32x4 o; o.x = pk2(bflo(v.x) * w, bfhi(v.x) * w); o.y = pk2(bflo(v.y) * w, bfhi(v.y) * w); o.z = pk2(bflo(v.z) * w, bfhi(v.z) * w); o.w = pk2(bflo(v.w) * w, bfhi(v.w) * w);
            *(LAS u32x4*)(Ks + s * 320 + d8 * 2) = o; }
#pragma unroll
        for (int i = 0; i < 4; ++i) { const int id = tid + 512 * i, s = id >> 5, d8 = (id & 31) * 8; *(LAS u32x4*)(Vs + s * 576 + d8 * 2) = vpre[i]; }
        __syncthreads();
        if (uid + (int)gridDim.x < 1024) MA_LOAD(uid + (int)gridDim.x);
        f32x16 acc[4];
#pragma unroll
        for (int d = 0; d < 4; ++d)
#pragma unroll
            for (int i = 0; i < 16; ++i) acc[d][i] = 0.f;
#pragma unroll
        for (int kk = 0; kk < 4; ++kk) {
            const bf16x8 vf = tr_frag(Vs + (16 * kk + 8 * h + q4) * 576 + (32 * wid + 16 * blk) * 2 + 8 * p4, 576);
#pragma unroll
            for (int d = 0; d < 4; ++d) { const bf16x8 kf = tr_frag(Ks + (16 * kk + 8 * h + q4) * 320 + (32 * d + 16 * blk) * 2 + 8 * p4, 320); acc[d] = mfma32(kf, vf, acc[d]); }
        }
        bf16_t* cs = CS + (size_t)uid * 32768 + (32 * wid + l31) * 128;
#pragma unroll
        for (int d = 0; d < 4; ++d)
#pragma unroll
            for (int g = 0; g < 4; ++g) { u32x2 w; w.x = pk2(acc[d][4 * g], acc[d][4 * g + 1]); w.y = pk2(acc[d][4 * g + 2], acc[d][4 * g + 3]); *(u32x2*)(cs + 32 * d + 8 * g + 4 * h) = w; }
        if (tid < 128) { float s = 0.f;
#pragma unroll 8
            for (int t = 0; t < 64; ++t) s += bf2f(*(LAS const bf16_t*)(Ks + t * 320 + tid * 2));
            SMALL[SM_DN + uid * 128 + tid] = s; }
        __syncthreads();
    }
#undef MA_LOAD
}
DI void mlstm_b(LAS unsigned char* smem, bf16_t* CS, float* SMALL) {
    const int tid = opaque_tid();
    LAS float* dec = (LAS float*)smem; LAS float* inj = dec + 1024;
    LAS float* sbt = inj + 1024; LAS float* smc = sbt + 1024;
    sbt[tid] = SMALL[SM_BT + tid]; sbt[tid + 512] = SMALL[SM_BT + tid + 512]; smc[tid] = SMALL[SM_MC + tid]; smc[tid + 512] = SMALL[SM_MC + tid + 512];
    __syncthreads();
    if (tid < 4) { float m = -1e30f;
        for (int c = 0; c < 256; ++c) { const float bt = sbt[c * 4 + tid], M = smc[c * 4 + tid]; sbt[c * 4 + tid] = m;
            const float mn = fmaxf(bt + m, M); dec[tid * 256 + c] = __expf(bt + m - mn); inj[tid * 256 + c] = __expf(M - mn); m = mn; } }
    __syncthreads();
    if (blockIdx.x == 0) { SMALL[SM_MPREV + tid] = sbt[tid]; SMALL[SM_MPREV + tid + 512] = sbt[tid + 512]; }
    for (int e = blockIdx.x * 512 + tid; e < 131072; e += gridDim.x * 512) {
        const int hh = e >> 15, idx = e & 32767; bf16_t* pp = CS + (size_t)hh * 32768 + idx; float st = 0.f;
        bf16_t d[32];
#pragma unroll
        for (int i = 0; i < 32; ++i) d[i] = pp[(size_t)i * 131072];
#pragma unroll 1
        for (int c0 = 0; c0 < 256; c0 += 32) {
            bf16_t dn[32];
            const int cn = c0 + 32 < 256 ? c0 + 32 : c0;
#pragma unroll
            for (int i = 0; i < 32; ++i) dn[i] = pp[(size_t)(cn + i) * 131072];
            asm volatile("" ::: "memory");
#pragma unroll
            for (int i = 0; i < 32; ++i) { pp[(size_t)(c0 + i) * 131072] = f2bf(st); st = dec[hh * 256 + c0 + i] * st + inj[hh * 256 + c0 + i] * bf2f(d[i]); }
            asm volatile("" ::: "memory");
#pragma unroll
            for (int i = 0; i < 32; ++i) d[i] = dn[i];
        }
    }
    if (blockIdx.x == gridDim.x - 1) { const int hh = tid >> 7; float* pp = SMALL + SM_DN + tid; float st = 0.f;
#pragma unroll 1
        for (int c0 = 0; c0 < 256; c0 += 32) {
            float d[32];
#pragma unroll
            for (int i = 0; i < 32; ++i) d[i] = pp[(c0 + i) * 512];
            asm volatile("" ::: "memory");
#pragma unroll
            for (int i = 0; i < 32; ++i) { pp[(c0 + i) * 512] = st; st = dec[hh * 256 + c0 + i] * st + inj[hh * 256 + c0 + i] * d[i]; }
            asm volatile("" ::: "memory");
        } }
    __syncthreads();
}
DI void mlstm_c(LAS unsigned char* smem, const bf16_t* P, const float* gbias, const float* onorm, const bf16_t* CS, const float* SMALL, bf16_t* Y) {
    const int tid = opaque_tid(), lane = tid & 63, wid = tid >> 6, l31 = lane & 31, h = lane >> 5, q4 = (lane & 15) >> 2, p4 = lane & 3, blk = (lane >> 4) & 1;
    LAS float* sbc = (LAS float*)smem; LAS float* sav = sbc + 64; LAS float* snp = sbc + 128; LAS float* sx = sbc + 256;
    LAS unsigned char* Qs = smem + 2048;
    LAS unsigned char* Ks = Qs + 17408;
    LAS unsigned char* Vs = Ks + 17408;
    const int tb = wid & 1, dvq = wid >> 1, t = 32 * tb + l31, pr = pi32(l31);
    u32x4 qpre[2], kpre[2], vpre[4]; bf16_t gipre = 0, gfpre = 0; float nppre = 0.f, mppre = 0.f;
#define MC_LOAD(u_) do { const int c_ = (u_) >> 2, hh_ = (u_) & 3; const size_t r0_ = (size_t)c_ * 64; \
        _Pragma("unroll") for (int i = 0; i < 2; ++i) { const int id = tid + 512 * i, s_ = id >> 4, d8 = (id & 15) * 8; \
            qpre[i] = *(const u32x4*)(P + (r0_ + s_) * NP + PC_Q + hh_ * 128 + d8); kpre[i] = *(const u32x4*)(P + (r0_ + s_) * NP + PC_K + hh_ * 128 + d8); } \
        _Pragma("unroll") for (int i = 0; i < 4; ++i) { const int id = tid + 512 * i, s_ = id >> 5, d8 = (id & 31) * 8; vpre[i] = *(const u32x4*)(P + (r0_ + s_) * NP + PC_V + hh_ * 256 + d8); } \
        if (wid == 0) { const bf16_t* r_ = P + (r0_ + lane) * NP; gipre = r_[PC_I + hh_]; gfpre = r_[PC_F + hh_]; } \
        if (tid >= 64 && tid < 192) nppre = SMALL[SM_DN + (u_) * 128 + tid - 64]; \
        mppre = SMALL[SM_MPREV + (u_)]; } while (0)
    if ((int)blockIdx.x < 1024) MC_LOAD((int)blockIdx.x);
    for (int uid = blockIdx.x; uid < 1024; uid += gridDim.x) {
        const int c = uid >> 2, hh = uid & 3; const size_t row0 = (size_t)c * 64;
        if (wid == 0) {
            const float li = bf2f(gipre) + gbias[hh], lf = logsigmoid_(bf2f(gfpre) + gbias[4 + hh]);
            const float bc = wave_incl_scan(lf, lane);
            sbc[lane] = bc; sav[lane] = li - bc;
        }
        if (tid >= 64 && tid < 192) snp[tid - 64] = nppre;
#pragma unroll
        for (int i = 0; i < 2; ++i) { const int id = tid + 512 * i, s = id >> 4, d8 = (id & 15) * 8;
            *(LAS u32x4*)(Qs + s * 272 + d8 * 2) = qpre[i]; *(LAS u32x4*)(Ks + s * 272 + d8 * 2) = kpre[i]; }
#pragma unroll
        for (int i = 0; i < 4; ++i) { const int id = tid + 512 * i, s = id >> 5, d8 = (id & 31) * 8; *(LAS u32x4*)(Vs + s * 576 + d8 * 2) = vpre[i]; }
        const float mprev = mppre;
        __syncthreads();
        if (uid + (int)gridDim.x < 1024) MC_LOAD(uid + (int)gridDim.x);
        bf16x8 qf[8];
#pragma unroll
        for (int ks = 0; ks < 8; ++ks) qf[ks] = *(const LAS bf16x8*)(Qs + t * 272 + (16 * ks + 8 * h) * 2);
        f32x16 st0, st1;
#pragma unroll
        for (int i = 0; i < 16; ++i) { st0[i] = 0.f; st1[i] = 0.f; }
#pragma unroll
        for (int ks = 0; ks < 8; ++ks) { const bf16x8 a0 = *(const LAS bf16x8*)(Ks + pr * 272 + (16 * ks + 8 * h) * 2); st0 = mfma32(a0, qf[ks], st0);
            if (tb) { const bf16x8 a1 = *(const LAS bf16x8*)(Ks + (32 + pr) * 272 + (16 * ks + 8 * h) * 2); st1 = mfma32(a1, qf[ks], st1); } }
        const float bt = sbc[t];
        float mx = -1e30f;
#pragma unroll
        for (int i = 0; i < 16; ++i) { const int s = 16 * (i >> 3) + 8 * h + (i & 7); if (s <= t) mx = fmaxf(mx, sav[s]); if (tb) mx = fmaxf(mx, (s + 32 <= t) ? sav[s + 32] : -1e30f); }
        mx = fmaxf(mx, __shfl_xor(mx, 32));
        const float mt = bt + fmaxf(mprev, mx);
        float den = 0.f;
#pragma unroll
        for (int i = 0; i < 16; ++i) { const int s = 16 * (i >> 3) + 8 * h + (i & 7);
            const float w0 = (s <= t) ? __expf(bt + sav[s] - mt) * MQS : 0.f; st0[i] *= w0; den += st0[i];
            const float w1 = (tb && (s + 32 <= t)) ? __expf(bt + sav[s + 32] - mt) * MQS : 0.f; st1[i] *= w1; den += st1[i]; }
        den += __shfl_xor(den, 32);
        float qn = 0.f;
#pragma unroll
        for (int ks = 0; ks < 8; ++ks)
#pragma unroll
            for (int j = 0; j < 8; ++j) qn += bf2f((bf16_t)qf[ks][j]) * snp[16 * ks + 8 * h + j];
        qn += __shfl_xor(qn, 32);
        const float wi = expf(bt + mprev - mt) * MQS;
        den += wi * qn;
        const float dinv = 1.f / fmaxf(fabsf(den), expf(-mt));
        bf16x8 pf[4];
        pf[0] = pack8(st0[0], st0[1], st0[2], st0[3], st0[4], st0[5], st0[6], st0[7]); pf[1] = pack8(st0[8], st0[9], st0[10], st0[11], st0[12], st0[13], st0[14], st0[15]);
        pf[2] = pack8(st1[0], st1[1], st1[2], st1[3], st1[4], st1[5], st1[6], st1[7]); pf[3] = pack8(st1[8], st1[9], st1[10], st1[11], st1[12], st1[13], st1[14], st1[15]);
        float hv[2][16]; float ss = 0.f;
#pragma unroll
        for (int db = 0; db < 2; ++db) { const int dvb = 2 * dvq + db;
            f32x16 a1, a2;
#pragma unroll
            for (int i = 0; i < 16; ++i) { a1[i] = 0.f; a2[i] = 0.f; }
#pragma unroll
            for (int sb = 0; sb < 2; ++sb)
#pragma unroll
                for (int kk = 0; kk < 2; ++kk) { if (sb <= tb) { const bf16x8 vf = tr_frag(Vs + (32 * sb + 16 * kk + 8 * h + q4) * 576 + (32 * dvb + 16 * blk) * 2 + 8 * p4, 576); a1 = mfma32(vf, pf[2 * sb + kk], a1); } }
            const bf16_t* cp = CS + (size_t)uid * 32768 + (32 * dvb + l31) * 128 + 8 * h;
#pragma unroll
            for (int ks = 0; ks < 8; ++ks) { const bf16x8 cf = *(const bf16x8*)(cp + 16 * ks); a2 = mfma32(cf, qf[ks], a2); }
#pragma unroll
            for (int i = 0; i < 16; ++i) { const float v = (a1[i] + wi * a2[i]) * dinv; hv[db][i] = v; ss += v * v; }
        }
        ss += __shfl_xor(ss, 32);
        if (h == 0) sx[(tb * 4 + dvq) * 32 + l31] = ss;
        __syncthreads();
        const float tot = (sx[(tb * 4 + 0) * 32 + l31] + sx[(tb * 4 + 1) * 32 + l31]) + (sx[(tb * 4 + 2) * 32 + l31] + sx[(tb * 4 + 3) * 32 + l31]);
        const float rstd = 1.f / sqrtf(tot * (1.f / 256.f) + EPS);
        f32x4 gnv[2][4]; u32x2 ogv[2][4];
#pragma unroll
        for (int db = 0; db < 2; ++db)
#pragma unroll
            for (int g = 0; g < 4; ++g) { const int col = hh * 256 + 32 * (2 * dvq + db) + 8 * g + 4 * h; gnv[db][g] = *(const f32x4*)(onorm + col); ogv[db][g] = *(const u32x2*)(P + (row0 + t) * NP + PC_O + col); }
        __builtin_amdgcn_sched_barrier(0);
#pragma unroll
        for (int db = 0; db < 2; ++db)
#pragma unroll
            for (int g = 0; g < 4; ++g) { const int col = hh * 256 + 32 * (2 * dvq + db) + 8 * g + 4 * h;
                const f32x4 gn = gnv[db][g]; const u32x2 og = ogv[db][g];
                const float o0 = hv[db][4 * g] * rstd * gn.x * sigmoidf_(bflo(og.x)), o1 = hv[db][4 * g + 1] * rstd * gn.y * sigmoidf_(bfhi(og.x));
                const float o2 = hv[db][4 * g + 2] * rstd * gn.z * sigmoidf_(bflo(og.y)), o3 = hv[db][4 * g + 3] * rstd * gn.w * sigmoidf_(bfhi(og.y));
                u32x2 w; w.x = pk2(o0, o1); w.y = pk2(o2, o3); *(u32x2*)(Y + (row0 + t) * 3072 + col) = w; }
        __syncthreads();
    }
#undef MC_LOAD
}

DI void attn_unit(LAS unsigned char* smem, int hh, int qb, const bf16_t* Q, const bf16_t* KN, const bf16_t* P, const bf16_t* VT, bf16_t* Y) {
    const int tid = opaque_tid(), lane = tid & 63, wid = __builtin_amdgcn_readfirstlane(tid >> 6), l31 = lane & 31, h = lane >> 5;
    LAS unsigned char* Kb = smem; LAS unsigned char* Vb = smem + 51200;
    const int q0 = qb * 256, qw = q0 + 32 * wid, q = qw + l31, NT = 4 * qb + 4;
    bf16x8 qf[12];
#pragma unroll
    for (int ks = 0; ks < 12; ++ks) qf[ks] = *(const bf16x8*)(Q + (size_t)q * 1536 + hh * 192 + 16 * ks + 8 * h);
    f32x16 o[4];
#pragma unroll
    for (int d = 0; d < 4; ++d)
#pragma unroll
        for (int i = 0; i < 16; ++i) o[d][i] = 0.f;
    float mref = 0.f, lrun = 0.f; bool first = true;
    const bf16_t* ksrc0; const bf16_t* ksrc2; const bf16_t* vsrc0; int kdst0, kdst2, vdst0;
    { const int row = tid >> 4, ch = tid & 15; ksrc0 = KN + (size_t)row * 1024 + hh * 128 + 8 * ch; kdst0 = row * 400 + ch * 16; }
    { const int row = tid >> 3, ch = tid & 7; ksrc2 = P + (size_t)row * NP + PC_KR + 8 * ch; kdst2 = row * 400 + 256 + ch * 16; }
    { const int d = tid >> 3, ch = tid & 7; vsrc0 = VT + (size_t)(hh * 128 + d) * S + 8 * ch; vdst0 = d * 144 + ch * 16; }
    u32x4 kr[3], vr[2];
#define ATT_LOAD(tt) do { kr[0] = *(const u32x4*)(ksrc0 + (size_t)(tt) * 65536); kr[1] = *(const u32x4*)(ksrc0 + (size_t)(tt) * 65536 + 32 * 1024); kr[2] = *(const u32x4*)(ksrc2 + (size_t)(tt) * (64 * NP)); \
        vr[0] = *(const u32x4*)(vsrc0 + (size_t)(tt) * 64); vr[1] = *(const u32x4*)(vsrc0 + (size_t)(tt) * 64 + (size_t)64 * S); } while (0)
#define ATT_WRITE(kbuf, vslot) do { *(LAS u32x4*)(Kb + (kbuf) * 25600 + kdst0) = kr[0]; *(LAS u32x4*)(Kb + (kbuf) * 25600 + kdst0 + 32 * 400) = kr[1]; *(LAS u32x4*)(Kb + (kbuf) * 25600 + kdst2) = kr[2]; \
        *(LAS u32x4*)(Vb + (vslot) * 18432 + vdst0) = vr[0]; *(LAS u32x4*)(Vb + (vslot) * 18432 + vdst0 + 64 * 144) = vr[1]; } while (0)
#define ATT_BAR() do { asm volatile("s_waitcnt lgkmcnt(0)" ::: "memory"); __builtin_amdgcn_s_barrier(); asm volatile("" ::: "memory"); } while (0)
    ATT_LOAD(0);
    ATT_WRITE(0, 0);
    ATT_BAR();
    const int koff = pi32(l31) * 400 + 16 * h, voff = l31 * 144 + 16 * h;
#define SB() __builtin_amdgcn_sched_barrier(0)
#define KFR(kb, ks, b) (*(const LAS bf16x8*)((kb) + (b) * 32 * 400 + (ks) * 32))
#define VFR(vb, d, kk) (*(const LAS bf16x8*)((vb) + (d) * 32 * 144 + (kk) * 32))
    int vs = 0;
    for (int t = 0; t < NT; ++t) {
        const int kc = t & 1, vn = vs == 2 ? 0 : vs + 1;
        if (t + 1 < NT) ATT_LOAD(t + 1);
        if (64 * t <= qw + 31) {
            LAS const unsigned char* kb = Kb + kc * 25600 + koff; LAS const unsigned char* vb = Vb + vs * 18432 + voff;
            f32x16 s0, s1;
#pragma unroll
            for (int i = 0; i < 16; ++i) { s0[i] = 0.f; s1[i] = 0.f; }
            bf16x8 fa[4], fb[4];
            fa[0] = KFR(kb, 0, 0); fa[1] = KFR(kb, 0, 1); fa[2] = KFR(kb, 1, 0); fa[3] = KFR(kb, 1, 1); SB();
#pragma unroll
            for (int st = 0; st < 6; st += 2) {
                fb[0] = KFR(kb, 2 * st + 2, 0); fb[1] = KFR(kb, 2 * st + 2, 1); fb[2] = KFR(kb, 2 * st + 3, 0); fb[3] = KFR(kb, 2 * st + 3, 1); SB();
                s0 = mfma32(fa[0], qf[2 * st], s0); s1 = mfma32(fa[1], qf[2 * st], s1); s0 = mfma32(fa[2], qf[2 * st + 1], s0); s1 = mfma32(fa[3], qf[2 * st + 1], s1); SB();
                if (st + 2 < 6) { fa[0] = KFR(kb, 2 * st + 4, 0); fa[1] = KFR(kb, 2 * st + 4, 1); fa[2] = KFR(kb, 2 * st + 5, 0); fa[3] = KFR(kb, 2 * st + 5, 1); }
                else { fa[0] = VFR(vb, 0, 0); fa[1] = VFR(vb, 0, 1); fa[2] = VFR(vb, 0, 2); fa[3] = VFR(vb, 0, 3); }
                SB();
                s0 = mfma32(fb[0], qf[2 * st + 2], s0); s1 = mfma32(fb[1], qf[2 * st + 2], s1); s0 = mfma32(fb[2], qf[2 * st + 3], s0); s1 = mfma32(fb[3], qf[2 * st + 3], s1); SB();
            }
            if (64 * t + 63 > qw) {
#pragma unroll
                for (int i = 0; i < 16; ++i) { const int kv = 64 * t + 16 * (i >> 3) + 8 * h + (i & 7); if (kv > q) s0[i] = -1e30f; if (kv + 32 > q) s1[i] = -1e30f; }
            }
            float mx = fmaxf(s0[0], s1[0]);
#pragma unroll
            for (int i = 1; i < 16; ++i) mx = fmaxf(mx, fmaxf(s0[i], s1[i]));
            mx = fmaxf(mx, __shfl_xor(mx, 32));
            if (first || __any(mx - mref > 8.f)) {
                const float dl = first ? mx : fmaxf(mx - mref, 0.f);
                mref += dl;
                if (!first) { const float f = __builtin_amdgcn_exp2f(-dl); lrun *= f;
#pragma unroll
                    for (int d = 0; d < 4; ++d)
#pragma unroll
                        for (int i = 0; i < 16; ++i) o[d][i] *= f; }
                first = false; }
            float rs = 0.f;
#pragma unroll
            for (int i = 0; i < 16; ++i) { s0[i] = __builtin_amdgcn_exp2f(s0[i] - mref); s1[i] = __builtin_amdgcn_exp2f(s1[i] - mref); rs += s0[i] + s1[i]; }
            lrun += rs;
            bf16x8 pf[4];
            pf[0] = pack8(s0[0], s0[1], s0[2], s0[3], s0[4], s0[5], s0[6], s0[7]); pf[1] = pack8(s0[8], s0[9], s0[10], s0[11], s0[12], s0[13], s0[14], s0[15]);
            pf[2] = pack8(s1[0], s1[1], s1[2], s1[3], s1[4], s1[5], s1[6], s1[7]); pf[3] = pack8(s1[8], s1[9], s1[10], s1[11], s1[12], s1[13], s1[14], s1[15]);
            SB();
            fb[0] = VFR(vb, 1, 0); fb[1] = VFR(vb, 1, 1); fb[2] = VFR(vb, 1, 2); fb[3] = VFR(vb, 1, 3); SB();
            o[0] = mfma32(fa[0], pf[0], o[0]); o[0] = mfma32(fa[1], pf[1], o[0]); o[0] = mfma32(fa[2], pf[2], o[0]); o[0] = mfma32(fa[3], pf[3], o[0]); SB();
            fa[0] = VFR(vb, 2, 0); fa[1] = VFR(vb, 2, 1); fa[2] = VFR(vb, 2, 2); fa[3] = VFR(vb, 2, 3); SB();
            o[1] = mfma32(fb[0], pf[0], o[1]); o[1] = mfma32(fb[1], pf[1], o[1]); o[1] = mfma32(fb[2], pf[2], o[1]); o[1] = mfma32(fb[3], pf[3], o[1]); SB();
            fb[0] = VFR(vb, 3, 0); fb[1] = VFR(vb, 3, 1); fb[2] = VFR(vb, 3, 2); fb[3] = VFR(vb, 3, 3); SB();
            o[2] = mfma32(fa[0], pf[0], o[2]); o[2] = mfma32(fa[1], pf[1], o[2]); o[2] = mfma32(fa[2], pf[2], o[2]); o[2] = mfma32(fa[3], pf[3], o[2]); SB();
            o[3] = mfma32(fb[0], pf[0], o[3]); o[3] = mfma32(fb[1], pf[1], o[3]); o[3] = mfma32(fb[2], pf[2], o[3]); o[3] = mfma32(fb[3], pf[3], o[3]); SB();
        }
        if (t + 1 < NT) ATT_WRITE(kc ^ 1, vn);
        ATT_BAR();
        vs = vn;
    }
#undef SB
#undef KFR
#undef VFR
#undef ATT_LOAD
#undef ATT_WRITE
#undef ATT_BAR
    lrun += __shfl_xor(lrun, 32);
    const float inv = 1.f / lrun;
    bf16_t* yp = Y + (size_t)q * 3072 + 1024 + hh * 128 + 4 * h;
#pragma unroll
    for (int d = 0; d < 4; ++d)
#pragma unroll
        for (int g = 0; g < 4; ++g) { u32x2 w; w.x = pk2(o[d][4 * g] * inv, o[d][4 * g + 1] * inv); w.y = pk2(o[d][4 * g + 2] * inv, o[d][4 * g + 3] * inv); *(u32x2*)(yp + 32 * d + 8 * g) = w; }
}

#define XB_TMO      128
#define XB_XCNT(j)  (256  + 64 * (j))
#define XB_XSUB(j)  (1280 + 64 * (j))
#define XB_XGEN(j)  (2304 + 64 * (j))
#define XB_TOP      3328
#define XB_TOPGEN   3392
#define XCD_BAR_WORDS 3456
#define XB_SPIN_CAP (1u << 23)
DI unsigned xb_ld(unsigned* p)              { return __hip_atomic_load(p, __ATOMIC_RELAXED, __HIP_MEMORY_SCOPE_AGENT); }
DI unsigned xb_add(unsigned* p, unsigned v) { return __hip_atomic_fetch_add(p, v, __ATOMIC_RELAXED, __HIP_MEMORY_SCOPE_AGENT); }
DI unsigned xb_xcc_id() { return (unsigned)__builtin_amdgcn_s_getreg((3 << 11) | 20) & 0xFu; }
#define XB_SPIN(cond, bar) do { unsigned _sp = 0; while (cond) { __builtin_amdgcn_s_sleep(1); \
    if ((++_sp & 255u) == 0u) { if (xb_ld(&(bar)[XB_TMO])) break; if (_sp > XB_SPIN_CAP) { atomicAdd(&(bar)[XB_TMO], 1u); break; } } } } while (0)
struct XcdBarrier { unsigned* bar; unsigned x; volatile LAS unsigned* st; };
DI XcdBarrier xcd_barrier_post(unsigned* bar, volatile LAS unsigned* st) {
    XcdBarrier b; b.bar = bar; b.x = xb_xcc_id(); b.st = st;
    if (threadIdx.x == 0) (void)xb_add(&bar[XB_XCNT(b.x)], 1u);
    return b;
}
DI void xcd_barrier_complete(unsigned* bar, unsigned x, unsigned& nloc, unsigned& nx) {
    const unsigned G = gridDim.x * gridDim.y * gridDim.z;
    unsigned sum, cnt, mine, sp = 0u;
    for (;;) {
        sum = 0u; cnt = 0u; mine = 0u;
#pragma unroll
        for (unsigned j = 0; j < 16; ++j) { const unsigned c = xb_ld(&bar[XB_XCNT(j)]); sum += c; cnt += (c > 0u) ? 1u : 0u; mine = (j == x) ? c : mine; }
        if (sum == G) break;
        __builtin_amdgcn_s_sleep(1);
        if ((++sp & 255u) == 0u) { if (xb_ld(&bar[XB_TMO])) break; if (sp > XB_SPIN_CAP) { atomicAdd(&bar[XB_TMO], 1u); break; } }
    }
    nloc = mine > 0u ? mine : 1u; nx = cnt > 0u ? cnt : 1u;
}
DI void xcd_barrier(const XcdBarrier& b) {
    asm volatile("s_waitcnt vmcnt(0)" ::: "memory");
    __syncthreads();
    if (threadIdx.x == 0) {
        unsigned* bar = b.bar;
        __builtin_amdgcn_s_waitcnt(0);
        unsigned nloc = b.st[0], nx = b.st[1];
        if (nloc == 0u) { xcd_barrier_complete(bar, b.x, nloc, nx); b.st[0] = nloc; b.st[1] = nx; }
        const unsigned old = xb_add(&bar[XB_XSUB(b.x)], 1u);
        const unsigned gen = old / nloc;
        if (old + 1u == (gen + 1u) * nloc) {
            __builtin_amdgcn_fence(__ATOMIC_RELEASE, "agent");
            asm volatile("s_waitcnt vmcnt(0)" ::: "memory");
            const unsigned og = xb_add(&bar[XB_TOP], 1u);
            const unsigned tg = og / nx;
            if (og + 1u == (tg + 1u) * nx) xb_add(&bar[XB_TOPGEN], 1u);
            else XB_SPIN(xb_ld(&bar[XB_TOPGEN]) == tg, bar);
            __builtin_amdgcn_fence(__ATOMIC_ACQUIRE, "agent");
            xb_add(&bar[XB_XGEN(b.x)], 1u);
            asm volatile("s_waitcnt vmcnt(0)" ::: "memory");
        } else {
            XB_SPIN(xb_ld(&bar[XB_XGEN(b.x)]) == gen, bar);
            __builtin_amdgcn_fence(__ATOMIC_ACQUIRE, "agent");
            asm volatile("s_waitcnt vmcnt(0)" ::: "memory");
        }
    }
    __syncthreads();
}

struct Params { const float* in[27]; float* out; unsigned char* ws; };

__global__ void __launch_bounds__(512, 2) mega_fwd(Params p) {
    extern __shared__ __attribute__((aligned(16))) unsigned char smem_raw[];
    LAS unsigned char* smem = (LAS unsigned char*)smem_raw;
    cg::grid_group grid = cg::this_grid();
    const int G = gridDim.x, bx = blockIdx.x;
    { const int t0 = opaque_tid(); if (t0 < 128) ((LAS unsigned*)(smem + 131072))[t0] = 0u; }
    __syncthreads();
    XcdBarrier bar; bar.bar = (unsigned*)(p.ws + WS_CTL); bar.x = 0; bar.st = (volatile LAS unsigned*)(smem + 131072) + 8;
    if (bx == 0) { unsigned* cw = (unsigned*)(p.ws + WS_CTL); for (int i = opaque_tid(); i < XCD_BAR_WORDS; i += 512) cw[i] = 0u; }
    unsigned char* ws = p.ws;
    f32x2* TAB = (f32x2*)(ws + WS_TAB); float* SMALL = (float*)(ws + WS_SMALL);
    bf16_t* WFFGU = (bf16_t*)(ws + WS_WFFGU); bf16_t* WFFD = (bf16_t*)(ws + WS_WFFD); bf16_t* WIN = (bf16_t*)(ws + WS_WIN); bf16_t* WUQ = (bf16_t*)(ws + WS_WUQ);
    bf16_t* WUKV = (bf16_t*)(ws + WS_WUKV); bf16_t* WLRU = (bf16_t*)(ws + WS_WLRU); bf16_t* WBR = (bf16_t*)(ws + WS_WBR); bf16_t* WOUT = (bf16_t*)(ws + WS_WOUT);
    bf16_t* XN = (bf16_t*)(ws + WS_XN); bf16_t* P = (bf16_t*)(ws + WS_P); bf16_t* Hb = P; bf16_t* Qb = (bf16_t*)(ws + WS_Q); bf16_t* KN = (bf16_t*)(ws + WS_KN);
    bf16_t* VT = (bf16_t*)(ws + WS_VT); bf16_t* Y = (bf16_t*)(ws + WS_Y); bf16_t* XC = (bf16_t*)(ws + WS_XC); bf16_t* CS = (bf16_t*)(ws + WS_CS);

    for (int i = bx * 512 + opaque_tid(); i < S * 32; i += G * 512) { const int t = i >> 5, j = i & 31; const float ang = (float)t * INVF[j];
        double r = (double)ang * 0.15915494309189535; r -= __builtin_floor(r); const float fr = (float)r;
        TAB[i] = (f32x2){__builtin_amdgcn_cosf(fr), __builtin_amdgcn_sinf(fr)}; }

#pragma unroll 1
    for (int hl = 0; hl < 4; ++hl) {
        const int l = hl >> 1, second = hl & 1;
        const float* xin = hl == 0 ? p.in[0] : p.out;
#define CONVERT_RANGE(cl, csec, lo, hi) do { int rot = 0; _Pragma("unroll 1") for (int mi = (lo); mi < (hi); ++mi) { \
            const float* src; int K, N, map; bf16_t* dst; \
            if (mi == 0) { src = p.in[(csec) ? 23 : 2] + (size_t)(cl) * DM * FF; K = DM; N = FF; map = 1; dst = WFFGU; } \
            else if (mi == 1) { src = p.in[(csec) ? 24 : 3] + (size_t)(cl) * DM * FF; K = DM; N = FF; map = 2; dst = WFFGU; } \
            else if (mi == 2) { src = p.in[(csec) ? 25 : 4] + (size_t)(cl) * DM * FF; K = FF; N = DM; map = 0; dst = WFFD; } \
            else if (mi == 3) { src = p.in[6] + (size_t)(cl) * DM * NIN; K = DM; N = NIN; map = 3; dst = WIN; } \
            else if (mi == 4) { src = p.in[10] + (size_t)(cl) * 384 * 1536; K = 384; N = 1536; map = 4; dst = WUQ; } \
            else if (mi == 5) { src = p.in[12] + (size_t)(cl) * 256 * 2048; K = 256; N = 2048; map = 5; dst = WUKV; } \
            else if (mi < 22) { const int k = mi - 6, n = k >> 1, wx = k & 1; src = p.in[wx ? 17 : 15] + (size_t)(cl) * 131072 + n * 16384; K = 128; N = 128; map = 0; dst = WLRU + (size_t)(n * 256 + wx * 128) * 128; } \
            else if (mi < 25) { const int j = mi - 22; src = p.in[20] + (size_t)(cl) * 3 * 1024 * 2048 + (size_t)j * 1024 * 2048; K = 1024; N = 2048; map = 0; dst = WBR + (size_t)j * 2048 * 1024; } \
            else { src = p.in[21] + (size_t)(cl) * DM * DM; K = DM; N = DM; map = 0; dst = WOUT; } \
            convert_mat(src, K, N, dst, map, rot); } } while (0)
        const int grp = (bx >> 3) & 1;
        {
            if (hl == 0) CONVERT_RANGE(0, 0, 0, 26);
            rmsnorm_rows(xin, p.in[second ? 22 : 1] + l * DM, XN);
        }
        if (hl == 0) { grid.sync(); bar = xcd_barrier_post((unsigned*)(p.ws + WS_CTL), (volatile LAS unsigned*)(smem + 131072) + 8); } else xcd_barrier(bar);
        { pg8::Gemm g{XN, WFFGU, S, 2 * FF, DM, DM, DM, 0}; pg8::StaticOrder so; so.init(S, 2 * FF, G, bx); pg8::EpiSwiglu E{Hb};
          const int c_lo = hl == 1 ? 3 : 2, c_hi = hl == 1 ? 26 : (hl == 2 ? 3 : 2);
          if (grp == 0) CONVERT_RANGE(1, 0, c_lo, c_hi);
          pg8::gemm_phase(smem, g, so, E);
          if (grp == 1) CONVERT_RANGE(1, 0, c_lo, c_hi); }
        xcd_barrier(bar);
        { pg8::Gemm g{Hb, WFFD, S, DM, FF, FF, FF, 0}; pg8::StaticOrder so; so.init(S, DM, G, bx); pg8::EpiRes E{xin, p.out, 0.5f};
          const int nl = (hl + 1) >> 1, ns = (hl + 1) & 1, c_hi = hl < 3 ? 2 : 0;
          if (grp == 0) CONVERT_RANGE(nl, ns, 0, c_hi);
          pg8::gemm_phase(smem, g, so, E);
          if (grp == 1) CONVERT_RANGE(nl, ns, 0, c_hi); }
        xcd_barrier(bar);
        if (!second) {
            const float* gbias = p.in[7] + l * 8;
            rmsnorm_rows(p.out, p.in[5] + l * DM, XN);
            xcd_barrier(bar);
            { pg8::Gemm g{XN, WIN, S, NP, DM, DM, DM, 0}; pg8::StaticOrder so; so.init(S, NP, G, bx); pg8::EpiStore E{P, NP};
              if (grp == 0) CONVERT_RANGE(l, 1, 2, 3);
              pg8::gemm_phase(smem, g, so, E);
              if (grp == 1) CONVERT_RANGE(l, 1, 2, 3); }
            xcd_barrier(bar);
            if (bx == G - 1) { const float* lam = p.in[19] + l * 1024; for (int ch = opaque_tid(); ch < 1024; ch += 512) SMALL[SM_SP + ch] = -8.f * log1pf(expf(-lam[ch])); }
            mlstm_a(smem, P, gbias, CS, SMALL);
            prep_rows(P, p.in[9] + l * 384, p.in[11] + l * 256, p.in[13] + l * 4096, p.in[14] + l * 1024, TAB, XC);
            xcd_barrier(bar);
            mlstm_b(smem, CS, SMALL);
            { pg8::Gemm g{P + PC_CQ, WUQ, S, 1536, 384, NP, 384, 0}; pg8::StaticOrder so; so.init(S, 1536, G, bx); pg8::EpiQ E{Qb, TAB}; pg8::gemm_phase(smem, g, so, E); }
#pragma unroll 1
            for (int gi = 0; gi < 2; ++gi) {
                pg8::Gemm g; pg8::StaticOrder so; pg8::EpiStore E;
                if (gi == 0) { g = pg8::Gemm{P + PC_CKV, WUKV, S, 1024, 256, NP, 256, 0}; so.init(S, 1024, G, bx); E = pg8::EpiStore{KN, 1024}; }
                else { g = pg8::Gemm{WUKV + 1024 * 256, P + PC_CKV, 1024, S, 256, 256, NP, 0}; so.init(1024, S, G, bx); E = pg8::EpiStore{VT, S}; }
                pg8::gemm_phase(smem, g, so, E);
            }
            { pg8::Gemm g{XC, WLRU, S, 2048, 128, 1024, 128, 128}; pg8::StaticOrder so; so.init(S, 2048, G, bx); pg8::EpiLru E{XC, P + PC_CX, p.in[16] + l * 1024, p.in[18] + l * 1024, SMALL + SM_SP}; pg8::gemm_phase(smem, g, so, E); }
            xcd_barrier(bar);
            mlstm_c(smem, P, gbias, p.in[8] + l * 1024, CS, SMALL, Y);
            lru_p1(P + PC_CX, XC, SMALL + SM_CA, SMALL + SM_CH);
            xcd_barrier(bar);
            lru_p2(SMALL + SM_CA, SMALL + SM_CH, SMALL + SM_CARRY);
            for (int item = bx; item < 256; item += G) { const int hh = item & 7, pp = item >> 3;
#pragma unroll 1
                for (int half = 0; half < 2; ++half) attn_unit(smem, hh, half ? 63 - pp : pp, Qb, KN, P, VT, Y); }
            xcd_barrier(bar);
            lru_p3(P + PC_CX, XC, SMALL + SM_CARRY, Y);
#pragma unroll 1
            for (int j = 0; j < 3; ++j) {
                if (j == 2) xcd_barrier(bar);
                pg8::Gemm g{Y + j * 1024, WBR + (size_t)j * 2048 * 1024, S, DM, 1024, 3072, 1024, 0}; pg8::StaticOrder so; so.init(S, DM, G, bx); pg8::EpiMerge E{XN, P + PC_G + j * 2048, j == 0}; pg8::gemm_phase(smem, g, so, E);
            }
            xcd_barrier(bar);
            { pg8::Gemm g{XN, WOUT, S, DM, DM, DM, DM, 0}; pg8::StaticOrder so; so.init(S, DM, G, bx); pg8::EpiRes E{p.out, p.out, 1.0f}; pg8::gemm_phase(smem, g, so, E); }
            xcd_barrier(bar);
        }
    }
    final_norm_rows(p.out, p.in[26]);
}

constexpr int LDS_BYTES = 143360;

extern "C" void kernel_launch(void* const* d_in, const int* in_sizes, int n_in, void* d_out, int out_size, void* d_ws, size_t ws_size, hipStream_t stream) {
    static int grid = 0;
    if (grid == 0) {
        if (n_in != 27 || out_size != S * DM || ws_size < WS_END) { fprintf(stderr, "kernel_launch: unexpected problem (n_in %d out %d ws %zu, need %zu)\n", n_in, out_size, ws_size, (size_t)WS_END); grid = -1; return; }
        int dev = 0, cus = 0, per_cu = 0;
        hipGetDevice(&dev); hipDeviceGetAttribute(&cus, hipDeviceAttributeMultiprocessorCount, dev);
        if (hipFuncSetAttribute((const void*)mega_fwd, hipFuncAttributeMaxDynamicSharedMemorySize, LDS_BYTES) != hipSuccess) { fprintf(stderr, "kernel_launch: hipFuncSetAttribute failed\n"); grid = -1; return; }
        if (hipOccupancyMaxActiveBlocksPerMultiprocessor(&per_cu, (const void*)mega_fwd, 512, LDS_BYTES) != hipSuccess || per_cu < 1) { fprintf(stderr, "kernel_launch: occupancy query says %d\n", per_cu); per_cu = 1; }
        (void)hipGetLastError();
        grid = cus * (per_cu > 1 ? 1 : per_cu);
    }
    if (grid < 0) return;
    Params p{};
    for (int i = 0; i < 27; ++i) p.in[i] = (const float*)d_in[i];
    p.out = (float*)d_out; p.ws = (unsigned char*)d_ws;
    void* args[] = {&p};
    hipError_t e = hipLaunchCooperativeKernel((const void*)mega_fwd, dim3(grid), dim3(512), args, LDS_BYTES, stream);
    if (e != hipSuccess) fprintf(stderr, "cooperative launch failed: %s (grid %d)\n", hipGetErrorString(e), grid);
}
```

```cpp
#include <hip/hip_runtime.h>
#include <hip/hip_cooperative_groups.h>
#include <cstdio>
#include <cstdint>
namespace cg = cooperative_groups;

#define DI __device__ __forceinline__
#define LAS __attribute__((address_space(3)))
typedef unsigned short bf16_t;
typedef short bf16x8 __attribute__((ext_vector_type(8)));
typedef short s16x4 __attribute__((ext_vector_type(4)));
typedef float f32x2 __attribute__((ext_vector_type(2)));
typedef float f32x4 __attribute__((ext_vector_type(4)));
typedef float f32x16 __attribute__((ext_vector_type(16)));
typedef unsigned u32x2 __attribute__((ext_vector_type(2)));
typedef unsigned u32x4 __attribute__((ext_vector_type(4)));
typedef __bf16 bf16x2_t __attribute__((ext_vector_type(2)));

constexpr int S = 16384, DM = 2048, FF = 5632, NIN = 10952, NP = 11008;
constexpr float EPS = 1e-6f;
constexpr int PC_Q = 0, PC_K = 512, PC_V = 1024, PC_O = 2048, PC_CQ = 3072, PC_CKV = 3456, PC_KR = 3712, PC_CX = 3776, PC_G = 4800, PC_I = 10944, PC_F = 10948;
constexpr float MQS = 0.08838834764831845f;
constexpr float AQS = 0.07216878364870322f * 1.4426950408889634f;

constexpr size_t MiB = 1u << 20;
constexpr size_t WS_TAB = 0;
constexpr size_t WS_SMALL = 4 * MiB;
constexpr size_t WS_WFFGU = 12 * MiB;
constexpr size_t WS_WFFD = 56 * MiB;
constexpr size_t WS_WIN = 78 * MiB;
constexpr size_t WS_WUQ = 121 * MiB;
constexpr size_t WS_WUKV = 123 * MiB;
constexpr size_t WS_WLRU = 124 * MiB;
constexpr size_t WS_WBR = 125 * MiB;
constexpr size_t WS_WOUT = 137 * MiB;
constexpr size_t WS_XN = 145 * MiB;
constexpr size_t WS_P = 209 * MiB;
constexpr size_t WS_Q = 553 * MiB;
constexpr size_t WS_KN = 601 * MiB;
constexpr size_t WS_VT = 633 * MiB;
constexpr size_t WS_Y = 665 * MiB;
constexpr size_t WS_XC = 761 * MiB;
constexpr size_t WS_CS = 793 * MiB;
constexpr size_t WS_END = 857 * MiB;
constexpr size_t WS_CTL = 11 * MiB, CTL_BYTES = 16384;
constexpr int SM_BT = 0, SM_MC = 1024, SM_MPREV = 2048, SM_DN = 4096  , SM_CA = 4096 + 131072  , SM_CH = SM_CA + 262144, SM_CARRY = SM_CH + 262144, SM_SP = SM_CARRY + 262144;

__device__ const float INVF[32] = {1.0f, 0.7498942613601685f, 0.5623413324356079f, 0.4216965138912201f, 0.3162277638912201f, 0.23713737726211548f, 0.17782793939113617f, 0.133352130651474f, 0.10000000149011612f, 0.07498941570520401f, 0.05623413249850273f, 0.04216965287923813f, 0.03162277489900589f, 0.023713737726211548f, 0.017782794311642647f, 0.01333521492779255f, 0.009999999776482582f, 0.007498941849917173f, 0.005623413249850273f, 0.0042169648222625256f, 0.003162277629598975f, 0.00237137358635664f, 0.0017782794311642647f, 0.0013335214462131262f, 0.0010000000474974513f, 0.0007498942431993783f, 0.000562341301701963f, 0.0004216965171508491f, 0.0003162277571391314f, 0.00023713737027719617f, 0.00017782794020604342f, 0.0001333521504420787f};

DI int opaque_tid() { int t = threadIdx.x; asm volatile("" : "+v"(t)); return t; }
DI float bf2f(bf16_t v) { return __uint_as_float((unsigned)v << 16); }
DI float bflo(unsigned w) { return __uint_as_float(w << 16); }
DI float bfhi(unsigned w) { return __uint_as_float(w & 0xffff0000u); }
DI unsigned pk2(float lo, float hi) { f32x2 v = {lo, hi}; bf16x2_t b = __builtin_convertvector(v, bf16x2_t); return __builtin_bit_cast(unsigned, b); }
DI bf16_t f2bf(float f) { return (bf16_t)(pk2(f, 0.f) & 0xffffu); }
DI float wave_sum(float v) {
#pragma unroll
    for (int o = 1; o < 64; o <<= 1) v += __shfl_xor(v, o);
    return v;
}
DI float wave_max(float v) {
#pragma unroll
    for (int o = 1; o < 64; o <<= 1) v = fmaxf(v, __shfl_xor(v, o));
    return v;
}
DI float wave_incl_scan(float v, int lane) {
#pragma unroll
    for (int o = 1; o < 64; o <<= 1) { const float n = __shfl_up(v, o); if (lane >= o) v += n; }
    return v;
}
DI float sigmoidf_(float x) { return __builtin_amdgcn_rcpf(1.f + __expf(-x)); }
DI float logsigmoid_(float x) { return fminf(x, 0.f) - log1pf(expf(-fabsf(x))); }
DI f32x16 mfma32(bf16x8 a, bf16x8 b, f32x16 c) { return __builtin_amdgcn_mfma_f32_32x32x16_bf16(a, b, c, 0, 0, 0); }
DI int crow(int r, int h) { return (r & 3) + 8 * (r >> 2) + 4 * h; }
DI int pi32(int m) { return (m & ~12) | ((m & 4) << 1) | ((m & 8) >> 1); }
typedef short v4i16_t __attribute__((ext_vector_type(4)));
DI s16x4 tr16(LAS const unsigned char* p) { return __builtin_bit_cast(s16x4, __builtin_amdgcn_ds_read_tr16_b64_v4i16((LAS v4i16_t*)p)); }
DI bf16x8 tr_frag(LAS const unsigned char* p, int rs) {
    const s16x4 lo = tr16(p), hi = tr16(p + 4 * rs);
    return __builtin_shufflevector(lo, hi, 0, 1, 2, 3, 4, 5, 6, 7);
}
DI bf16x8 pack8(float a0, float a1, float a2, float a3, float a4, float a5, float a6, float a7) {
    u32x4 w; w.x = pk2(a0, a1); w.y = pk2(a2, a3); w.z = pk2(a4, a5); w.w = pk2(a6, a7); return __builtin_bit_cast(bf16x8, w);
}

namespace pg8 {
constexpr int BM = 256, BK = 64, HALF = 128, HTB = HALF * BK * 2, STAGE_BYTES = 8 * HTB, NXCD = 8, WGM = 8;
DI int lds_byte(int r, int c) { const int st = (r >> 4) * 2 + (c >> 5), rr = r & 15, cc = c & 31, ob = rr * 64 + cc * 2; return st * 1024 + (ob ^ (((ob >> 9) & 1) << 5)); }
DI void stage_rc(int b, int& R, int& C) { const int st = b / 1024, sb = b % 1024, swz = sb ^ (((sb >> 9) & 1) << 5); R = (st >> 1) * 16 + swz / 64; C = (st & 1) * 32 + (swz % 64) / 2; }
DI int perm32(int rho) { const int n = rho >> 4, i = rho & 15; return 8 * (i >> 2) + 4 * n + (i & 3); }
struct Unit { int pm, pn; };
struct Gemm { const bf16_t* A; const bf16_t* Bt; int M, N, K, lda, ldb, apn; };
struct StaticOrder {
    int nM, nN, nwg, G, c;
    DI void init(int M, int N, int G_, int c_) { nM = M / BM; nN = N / BM; nwg = nM * nN; G = G_; c = c_; }
    DI bool next(int i, Unit& u) const {
        const long L = (long)i * G + c; if (L >= nwg) return false;
        int wgid = (int)L; { const int q = nwg / NXCD, r = nwg % NXCD, xcd = wgid % NXCD, off = wgid / NXCD; wgid = (xcd < r ? xcd * (q + 1) : r * (q + 1) + (xcd - r) * q) + off; }
        const int nig = WGM * nN, gid = wgid / nig, fm = gid * WGM, gsz = (nM - fm) < WGM ? (nM - fm) : WGM;
        u.pm = fm + ((wgid % nig) % gsz); u.pn = (wgid % nig) / gsz; return true;
    }
};
template <class Epi>
DI void gemm_phase(LAS unsigned char* lds, const Gemm g, const StaticOrder& S, const Epi& E) {
    const int tid = opaque_tid(), wid = __builtin_amdgcn_readfirstlane(tid >> 6), lane = tid & 63, wr = wid >> 2, wc = wid & 3, fr = lane & 15, fq = lane >> 4;
    int K = g.K; asm volatile("" : "+s"(K)); const int nt = K / BK;
    unsigned voffA[2], voffB[2];
#pragma unroll
    for (int i = 0; i < 2; ++i) { int R, C; stage_rc(tid * 16 + i * 8192, R, C); const int Rb = Epi::PERM ? ((R & ~31) + perm32(R & 31)) : R;
        voffA[i] = (unsigned)(R * g.lda + C) * 2u; voffB[i] = (unsigned)(Rb * g.ldb + C) * 2u; }
    const size_t kstep = (size_t)(BK * 2);
    const size_t hstepA = (size_t)HALF * g.lda * 2, hstepB = (size_t)HALF * g.ldb * 2;
    const unsigned ldsw = (unsigned)wid * 1024u;
    const int aoff = lds_byte(wr * 64 + fr, fq * 8), boff = lds_byte(wc * 32 + fr, fq * 8);
#define PG8_SA(b, h) (((b) * 2 + (h)) * HTB)
#define PG8_SB(b, h) ((4 + (b) * 2 + (h)) * HTB)
#define PG8_STAGE(bufoff, gbase, voff) do { _Pragma("unroll") for (int _i = 0; _i < 2; ++_i) \
        __builtin_amdgcn_global_load_lds((const unsigned*)((const char*)(gbase) + (voff)[_i]), (LAS unsigned*)(lds + (bufoff) + ldsw + _i * 8192), 16, 0, 0); } while (0)
#define PG8_LDA(dst, b, h) do { _Pragma("unroll") for (int m = 0; m < 4; ++m) _Pragma("unroll") for (int k = 0; k < 2; ++k) dst[m][k] = *(const LAS bf16x8*)(lds + PG8_SA(b, h) + aoff + m * 2048 + k * 1024); } while (0)
#define PG8_LDB(dst, b, h) do { _Pragma("unroll") for (int n = 0; n < 2; ++n) _Pragma("unroll") for (int k = 0; k < 2; ++k) dst[n][k] = *(const LAS bf16x8*)(lds + PG8_SB(b, h) + boff + n * 2048 + k * 1024); } while (0)
#define PG8_MMA(ai, bj, At, Bt) do { __builtin_amdgcn_s_setprio(1); _Pragma("unroll") for (int m = 0; m < 4; ++m) _Pragma("unroll") for (int n = 0; n < 2; ++n) _Pragma("unroll") for (int k = 0; k < 2; ++k) \
        acc[ai][bj][m][n] = __builtin_amdgcn_mfma_f32_16x16x32_bf16(Bt[n][k], At[m][k], acc[ai][bj][m][n], 0, 0, 0); __builtin_amdgcn_s_setprio(0); } while (0)
#define PG8_WAIT_V(n) asm volatile("s_waitcnt vmcnt(" #n ")" ::: "memory")
#define PG8_WAIT_L(n) asm volatile("s_waitcnt lgkmcnt(" #n ")" ::: "memory")
#define PG8_BAR __builtin_amdgcn_s_barrier()
#define PG8_SCHED __builtin_amdgcn_sched_barrier(0)
#define PG8_APTR(u) ((const char*)g.A + (size_t)(u).pm * 2 * hstepA + (size_t)(u).pn * (size_t)g.apn * 2)
#define PG8_BPTR(u) ((const char*)g.Bt + (size_t)(u).pn * 2 * hstepB)
    Unit cur, nxt; int ui = 0;
    if (!S.next(0, cur)) return;
    f32x4 acc[2][2][4][2];
#pragma unroll
    for (int a = 0; a < 2; ++a)
#pragma unroll
        for (int b = 0; b < 2; ++b)
#pragma unroll
            for (int m = 0; m < 4; ++m)
#pragma unroll
                for (int n = 0; n < 2; ++n) acc[a][b][m][n] = (f32x4){0.f, 0.f, 0.f, 0.f};
    bf16x8 At[4][2], B0[2][2], B1[2][2];
    const char* cA = PG8_APTR(cur); const char* cB = PG8_BPTR(cur);
    PG8_STAGE(PG8_SB(0, 0), cB, voffB); PG8_STAGE(PG8_SB(0, 1), cB + hstepB, voffB); PG8_STAGE(PG8_SA(0, 0), cA, voffA); PG8_STAGE(PG8_SA(0, 1), cA + hstepA, voffA);
    if (wr == 1) PG8_BAR;
    PG8_WAIT_V(2); PG8_BAR;
    PG8_STAGE(PG8_SB(1, 0), cB + kstep, voffB); PG8_STAGE(PG8_SA(1, 0), cA + kstep, voffA); PG8_STAGE(PG8_SB(1, 1), cB + hstepB + kstep, voffB);
    PG8_WAIT_V(6); PG8_BAR;
    for (;;) {
        const bool has_next = S.next(ui + 1, nxt);
        const char* nA = has_next ? PG8_APTR(nxt) : cA; const char* nB = has_next ? PG8_BPTR(nxt) : cB;
        for (int t = 0; t < nt; t += 2) {
            const bool last = (t == nt - 2);
            const char* a1 = cA + (size_t)(t + 1) * kstep;
            const char* a2 = last ? nA : cA + (size_t)(t + 2) * kstep; const char* b2 = last ? nB : cB + (size_t)(t + 2) * kstep;
            const char* a3 = a2 + kstep; const char* b3 = b2 + kstep;
            PG8_LDB(B0, 0, 0); PG8_LDB(B1, 0, 1); PG8_SCHED; PG8_LDA(At, 0, 0); PG8_STAGE(PG8_SA(1, 1), a1 + hstepA, voffA);
            PG8_WAIT_V(8); PG8_WAIT_L(0); PG8_BAR; PG8_MMA(0, 0, At, B0); PG8_MMA(0, 1, At, B1); PG8_BAR; PG8_SCHED;
            PG8_LDA(At, 0, 1); PG8_STAGE(PG8_SB(0, 0), b2, voffB); PG8_STAGE(PG8_SB(0, 1), b2 + hstepB, voffB); PG8_STAGE(PG8_SA(0, 0), a2, voffA);
            PG8_WAIT_V(8); PG8_WAIT_L(0); PG8_BAR; PG8_MMA(1, 0, At, B0); PG8_MMA(1, 1, At, B1); PG8_BAR; PG8_SCHED;
            PG8_LDB(B0, 1, 0); PG8_LDB(B1, 1, 1); PG8_SCHED; PG8_LDA(At, 1, 0); PG8_STAGE(PG8_SA(0, 1), a2 + hstepA, voffA);
            PG8_WAIT_V(8); PG8_WAIT_L(0); PG8_BAR; PG8_MMA(0, 0, At, B0); PG8_MMA(0, 1, At, B1); PG8_BAR; PG8_SCHED;
            PG8_LDA(At, 1, 1); PG8_STAGE(PG8_SB(1, 0), b3, voffB); PG8_STAGE(PG8_SB(1, 1), b3 + hstepB, voffB); PG8_STAGE(PG8_SA(1, 0), a3, voffA);
            PG8_WAIT_V(8); PG8_WAIT_L(0); PG8_BAR; PG8_MMA(1, 0, At, B0); PG8_MMA(1, 1, At, B1); PG8_BAR; PG8_SCHED;
        }
        if (wr == 0) PG8_BAR;
        E(acc, cur, wr, wc, fr, fq);
        if (!has_next) break;
#pragma unroll
        for (int a = 0; a < 2; ++a)
#pragma unroll
            for (int b = 0; b < 2; ++b)
#pragma unroll
                for (int m = 0; m < 4; ++m)
#pragma unroll
                    for (int n = 0; n < 2; ++n) acc[a][b][m][n] = (f32x4){0.f, 0.f, 0.f, 0.f};
        cur = nxt; cA = nA; cB = nB; ++ui;
        if (wr == 1) PG8_BAR;
    }
    PG8_WAIT_V(0);
    PG8_BAR;
#undef PG8_SA
#undef PG8_SB
#undef PG8_STAGE
#undef PG8_LDA
#undef PG8_LDB
#undef PG8_MMA
#undef PG8_WAIT_V
#undef PG8_WAIT_L
#undef PG8_BAR
#undef PG8_SCHED
#undef PG8_APTR
#undef PG8_BPTR
}

typedef f32x4 Acc[2][2][4][2];
struct EpiStore {
    static constexpr bool PERM = true;
    bf16_t* O; int ldc;
    DI void operator()(const Acc& acc, const Unit& u, int wr, int wc, int fr, int fq) const {
        const int row0 = u.pm * BM + wr * 64 + fr, col0 = u.pn * BM + wc * 32 + 8 * fq;
#pragma unroll
        for (int ai = 0; ai < 2; ++ai)
#pragma unroll
            for (int m = 0; m < 4; ++m) { bf16_t* rowp = O + (size_t)(row0 + ai * HALF + m * 16) * ldc + col0;
#pragma unroll
                for (int bj = 0; bj < 2; ++bj) { const f32x4 v0 = acc[ai][bj][m][0], v1 = acc[ai][bj][m][1];
                    u32x4 w; w.x = pk2(v0[0], v0[1]); w.y = pk2(v0[2], v0[3]); w.z = pk2(v1[0], v1[1]); w.w = pk2(v1[2], v1[3]);
                    *(u32x4*)(rowp + bj * HALF) = w; } }
    }
};
struct EpiSwiglu {
    static constexpr bool PERM = true;
    bf16_t* H;
    DI void operator()(const Acc& acc, const Unit& u, int wr, int wc, int fr, int fq) const {
        const int row0 = u.pm * BM + wr * 64 + fr, col0 = u.pn * HALF + wc * 32 + 8 * fq;
#pragma unroll
        for (int ai = 0; ai < 2; ++ai)
#pragma unroll
            for (int m = 0; m < 4; ++m) { bf16_t* rowp = H + (size_t)(row0 + ai * HALF + m * 16) * FF + col0;
                float o[8];
#pragma unroll
                for (int n = 0; n < 2; ++n)
#pragma unroll
                    for (int j = 0; j < 4; ++j) { const float gt = acc[ai][0][m][n][j], up = acc[ai][1][m][n][j]; o[n * 4 + j] = gt * sigmoidf_(gt) * up; }
                u32x4 w; w.x = pk2(o[0], o[1]); w.y = pk2(o[2], o[3]); w.z = pk2(o[4], o[5]); w.w = pk2(o[6], o[7]);
                *(u32x4*)rowp = w; }
    }
};
struct EpiRes {
    static constexpr bool PERM = false;
    const float* xin; float* xout; float alpha;
    DI void operator()(const Acc& acc, const Unit& u, int wr, int wc, int fr, int fq) const {
        const int col0 = u.pn * BM + wc * 32 + 4 * fq;
#pragma unroll
        for (int ai = 0; ai < 2; ++ai) {
            f32x4 b[4][2][2];
#pragma unroll
            for (int m = 0; m < 4; ++m) { const size_t off = (size_t)(u.pm * BM + ai * HALF + wr * 64 + m * 16 + fr) * DM + col0;
#pragma unroll
                for (int bj = 0; bj < 2; ++bj)
#pragma unroll
                    for (int n = 0; n < 2; ++n) b[m][bj][n] = *(const f32x4*)(xin + off + bj * HALF + n * 16); }
            __builtin_amdgcn_sched_barrier(0);
#pragma unroll
            for (int m = 0; m < 4; ++m) { const size_t off = (size_t)(u.pm * BM + ai * HALF + wr * 64 + m * 16 + fr) * DM + col0;
#pragma unroll
                for (int bj = 0; bj < 2; ++bj)
#pragma unroll
                    for (int n = 0; n < 2; ++n) *(f32x4*)(xout + off + bj * HALF + n * 16) = b[m][bj][n] + acc[ai][bj][m][n] * alpha; }
            __builtin_amdgcn_sched_barrier(0);
        }
    }
};
struct EpiQ {
    static constexpr bool PERM = true;
    bf16_t* Q; const f32x2* tab;
    DI void operator()(const Acc& acc, const Unit& u, int wr, int wc, int fr, int fq) const {
        const int row0 = u.pm * BM + wr * 64 + fr;
#pragma unroll
        for (int bj = 0; bj < 2; ++bj) {
            const int c0 = u.pn * BM + bj * HALF + wc * 32 + 8 * fq; const int hh = c0 / 192, dd = c0 - hh * 192; const bool rope = dd >= 128; const int j0 = rope ? (dd - 128) >> 1 : 0;
#pragma unroll
            for (int ai = 0; ai < 2; ++ai) {
                f32x4 cs[4][2];
#pragma unroll
                for (int m = 0; m < 4; ++m) { const f32x4* tp = (const f32x4*)(tab + (size_t)(row0 + ai * HALF + m * 16) * 32 + j0); cs[m][0] = tp[0]; cs[m][1] = tp[1]; }
                __builtin_amdgcn_sched_barrier(0);
#pragma unroll
                for (int m = 0; m < 4; ++m) { const int row = row0 + ai * HALF + m * 16;
                    float v[8];
#pragma unroll
                    for (int n = 0; n < 2; ++n)
#pragma unroll
                        for (int j = 0; j < 4; ++j) v[n * 4 + j] = acc[ai][bj][m][n][j];
                    if (rope) {
                        const float cc[4] = {cs[m][0].x, cs[m][0].z, cs[m][1].x, cs[m][1].z}, sn[4] = {cs[m][0].y, cs[m][0].w, cs[m][1].y, cs[m][1].w};
#pragma unroll
                        for (int p = 0; p < 4; ++p) { const float x1 = v[2 * p], x2 = v[2 * p + 1]; v[2 * p] = x1 * cc[p] - x2 * sn[p]; v[2 * p + 1] = x1 * sn[p] + x2 * cc[p]; }
                    }
                    u32x4 w; w.x = pk2(v[0] * AQS, v[1] * AQS); w.y = pk2(v[2] * AQS, v[3] * AQS); w.z = pk2(v[4] * AQS, v[5] * AQS); w.w = pk2(v[6] * AQS, v[7] * AQS);
                    *(u32x4*)(Q + (size_t)row * 1536 + c0) = w; }
                __builtin_amdgcn_sched_barrier(0);
            }
        }
    }
};
struct EpiLru {
    static constexpr bool PERM = true;
    bf16_t* XC; bf16_t* LA; const float* ba; const float* bx; const float* sp;
    DI void operator()(const Acc& acc, const Unit& u, int wr, int wc, int fr, int fq) const {
        const int row0 = u.pm * BM + wr * 64 + fr, ch0 = u.pn * HALF + wc * 32 + 8 * fq;
#pragma unroll
        for (int ai = 0; ai < 2; ++ai) {
            u32x4 xall[4];
#pragma unroll
            for (int m = 0; m < 4; ++m) xall[m] = *(const u32x4*)(XC + (size_t)(row0 + ai * HALF + m * 16) * 1024 + ch0);
            __builtin_amdgcn_sched_barrier(0);
#pragma unroll
            for (int m = 0; m < 4; ++m) { const int row = row0 + ai * HALF + m * 16;
                const u32x4 xw = xall[m];
                const float xv[8] = {bflo(xw.x), bfhi(xw.x), bflo(xw.y), bfhi(xw.y), bflo(xw.z), bfhi(xw.z), bflo(xw.w), bfhi(xw.w)};
                u32x4 wl, wu;
#pragma unroll
                for (int n = 0; n < 2; ++n) { const f32x4 spv = *(const f32x4*)(sp + ch0 + 4 * n), bav = *(const f32x4*)(ba + ch0 + 4 * n), bxv = *(const f32x4*)(bx + ch0 + 4 * n);
                    float la[4], uu[4];
#pragma unroll
                    for (int j = 0; j < 4; ++j) { const float r = sigmoidf_(acc[ai][0][m][n][j] + bav[j]), gi = sigmoidf_(acc[ai][1][m][n][j] + bxv[j]);
                        const float l = r * spv[j]; la[j] = l; const float a2 = __expf(2.f * l); uu[j] = sqrtf(fmaxf(1.f - a2, 0.f)) * gi * xv[n * 4 + j]; }
                    if (n == 0) { wl.x = pk2(la[0], la[1]); wl.y = pk2(la[2], la[3]); wu.x = pk2(uu[0], uu[1]); wu.y = pk2(uu[2], uu[3]); }
                    else { wl.z = pk2(la[0], la[1]); wl.w = pk2(la[2], la[3]); wu.z = pk2(uu[0], uu[1]); wu.w = pk2(uu[2], uu[3]); } }
                *(u32x4*)(LA + (size_t)row * NP + ch0) = wl;
                *(u32x4*)(XC + (size_t)row * 1024 + ch0) = wu;
                asm volatile("" ::: "memory"); }
        }
    }
};
struct EpiMerge {
    static constexpr bool PERM = true;
    bf16_t* Z; const bf16_t* G; int first;
    DI void operator()(const Acc& acc, const Unit& u, int wr, int wc, int fr, int fq) const {
        const int row0 = u.pm * BM + wr * 64 + fr, col0 = u.pn * BM + wc * 32 + 8 * fq;
#pragma unroll
        for (int ai = 0; ai < 2; ++ai) {
            u32x4 gw[4][2], zw[4][2];
#pragma unroll
            for (int m = 0; m < 4; ++m) { const int row = row0 + ai * HALF + m * 16;
#pragma unroll
                for (int bj = 0; bj < 2; ++bj) { const int c = col0 + bj * HALF; gw[m][bj] = *(const u32x4*)(G + (size_t)row * NP + c);
                    zw[m][bj] = first ? (u32x4){0u, 0u, 0u, 0u} : *(const u32x4*)(Z + (size_t)row * DM + c); } }
            __builtin_amdgcn_sched_barrier(0);
#pragma unroll
            for (int m = 0; m < 4; ++m) { const int row = row0 + ai * HALF + m * 16;
#pragma unroll
                for (int bj = 0; bj < 2; ++bj) { const int c = col0 + bj * HALF;
                    const u32x4 g4 = gw[m][bj], z4 = zw[m][bj];
                    const float gv[8] = {bflo(g4.x), bfhi(g4.x), bflo(g4.y), bfhi(g4.y), bflo(g4.z), bfhi(g4.z), bflo(g4.w), bfhi(g4.w)};
                    const float zv[8] = {bflo(z4.x), bfhi(z4.x), bflo(z4.y), bfhi(z4.y), bflo(z4.z), bfhi(z4.z), bflo(z4.w), bfhi(z4.w)};
                    float o[8];
#pragma unroll
                    for (int n = 0; n < 2; ++n)
#pragma unroll
                        for (int j = 0; j < 4; ++j) o[n * 4 + j] = zv[n * 4 + j] + sigmoidf_(gv[n * 4 + j]) * acc[ai][bj][m][n][j];
                    u32x4 w; w.x = pk2(o[0], o[1]); w.y = pk2(o[2], o[3]); w.z = pk2(o[4], o[5]); w.w = pk2(o[6], o[7]);
                    *(u32x4*)(Z + (size_t)row * DM + c) = w; } }
            __builtin_amdgcn_sched_barrier(0);
        }
    }
};
}

DI int map_row(int map, int n) {
    switch (map) {
        case 1: return ((n >> 7) << 8) + (n & 127);
        case 2: return ((n >> 7) << 8) + 128 + (n & 127);
        case 3: { if (n < 2048) return n; if (n < 2052) return PC_I + n - 2048; if (n < 2056) return PC_F + n - 2052; if (n < 3080) return PC_O + n - 2056; if (n < 3464) return PC_CQ + n - 3080;
                  if (n < 3720) return PC_CKV + n - 3464; if (n < 3784) return PC_KR + n - 3720; if (n < 4808) return PC_CX + n - 3784; return PC_G + n - 4808; }
        case 4: { const int hh = n / 192, dd = n - hh * 192; if (dd < 128) return n; const int jj = dd - 128; return hh * 192 + 128 + (jj < 32 ? 2 * jj : 2 * (jj - 32) + 1); }
        case 5: { const int hh = n >> 8, dd = n & 255; return dd < 128 ? hh * 128 + dd : 1024 + hh * 128 + dd - 128; }
        default: return n;
    }
}
DI void convert_mat(const float* W, int K, int N, bf16_t* WT, int map, int& rot) {
    const int tid_ = opaque_tid(), lane = tid_ & 63, gw = blockIdx.x * 8 + (tid_ >> 6), ngw = gridDim.x * 8, r = lane >> 3, c = lane & 7;
    const int nnb = (N + 31) >> 5, nkb = K >> 6, nitems = nnb * nkb;
    int it = gw - rot; if (it < 0) it += ngw;
    for (; it < nitems; it += 2 * ngw) {
        const int it2 = it + ngw; const bool two = it2 < nitems;
        const int kbA = it / nnb, nbA = it - kbA * nnb, nA = nbA * 32 + 4 * c, kA = kbA * 64 + 8 * r;
        const int kbB = two ? it2 / nnb : kbA, nbB = two ? it2 - kbB * nnb : nbA, nB = nbB * 32 + 4 * c, kB = kbB * 64 + 8 * r;
        const bool okA = nA < N, okB = two && nB < N;
        f32x4 va[8], vb[8];
        if (okA) { const float* src = W + (size_t)kA * N + nA;
#pragma unroll
            for (int i = 0; i < 8; ++i) va[i] = *(const f32x4*)(src + (size_t)i * N); }
        if (okB) { const float* src = W + (size_t)kB * N + nB;
#pragma unroll
            for (int i = 0; i < 8; ++i) vb[i] = *(const f32x4*)(src + (size_t)i * N); }
        __builtin_amdgcn_sched_barrier(0);
#define CV_STORE(v, n0, k0) do { u32x4 o; \
            o.x = pk2(v[0].x, v[1].x); o.y = pk2(v[2].x, v[3].x); o.z = pk2(v[4].x, v[5].x); o.w = pk2(v[6].x, v[7].x); *(u32x4*)(WT + (size_t)map_row(map, (n0)) * K + (k0)) = o; \
            o.x = pk2(v[0].y, v[1].y); o.y = pk2(v[2].y, v[3].y); o.z = pk2(v[4].y, v[5].y); o.w = pk2(v[6].y, v[7].y); *(u32x4*)(WT + (size_t)map_row(map, (n0) + 1) * K + (k0)) = o; \
            o.x = pk2(v[0].z, v[1].z); o.y = pk2(v[2].z, v[3].z); o.z = pk2(v[4].z, v[5].z); o.w = pk2(v[6].z, v[7].z); *(u32x4*)(WT + (size_t)map_row(map, (n0) + 2) * K + (k0)) = o; \
            o.x = pk2(v[0].w, v[1].w); o.y = pk2(v[2].w, v[3].w); o.z = pk2(v[4].w, v[5].w); o.w = pk2(v[6].w, v[7].w); *(u32x4*)(WT + (size_t)map_row(map, (n0) + 3) * K + (k0)) = o; } while (0)
        if (okA) CV_STORE(va, nA, kA);
        if (okB) CV_STORE(vb, nB, kB);
#undef CV_STORE
    }
    rot = (rot + nitems) % ngw;
}

DI void rmsnorm_rows(const float* X, const float* g, bf16_t* O) {
    const int tid_ = opaque_tid(), lane = tid_ & 63, gw = blockIdx.x * 8 + (tid_ >> 6), ngw = gridDim.x * 8;
    f32x4 gv[8], v[8], vn[8];
#pragma unroll
    for (int j = 0; j < 8; ++j) gv[j] = ((const f32x4*)g)[lane + 64 * j];
    if (gw < S) {
#pragma unroll
        for (int j = 0; j < 8; ++j) v[j] = ((const f32x4*)(X + (size_t)gw * DM) + lane)[64 * j]; }
    for (int r = gw; r < S; r += ngw) {
        const int rn = r + ngw < S ? r + ngw : r;
#pragma unroll
        for (int j = 0; j < 8; ++j) vn[j] = ((const f32x4*)(X + (size_t)rn * DM) + lane)[64 * j];
        __builtin_amdgcn_sched_barrier(0);
        float s = 0.f;
#pragma unroll
        for (int j = 0; j < 8; ++j) s += (v[j].x * v[j].x + v[j].y * v[j].y) + (v[j].z * v[j].z + v[j].w * v[j].w);
        const float rstd = 1.f / sqrtf(wave_sum(s) * (1.f / DM) + EPS);
        u32x2* o8 = (u32x2*)(O + (size_t)r * DM) + lane;
#pragma unroll
        for (int j = 0; j < 8; ++j) { u32x2 w; w.x = pk2(v[j].x * rstd * gv[j].x, v[j].y * rstd * gv[j].y); w.y = pk2(v[j].z * rstd * gv[j].z, v[j].w * rstd * gv[j].w); o8[64 * j] = w; }
        __builtin_amdgcn_sched_barrier(0);
#pragma unroll
        for (int j = 0; j < 8; ++j) v[j] = vn[j];
    }
}
DI void final_norm_rows(float* X, const float* g) {
    const int tid_ = opaque_tid(), lane = tid_ & 63, gw = blockIdx.x * 8 + (tid_ >> 6), ngw = gridDim.x * 8;
    f32x4 gv[8], v[8], vn[8];
#pragma unroll
    for (int j = 0; j < 8; ++j) gv[j] = ((const f32x4*)g)[lane + 64 * j];
    if (gw < S) {
#pragma unroll
        for (int j = 0; j < 8; ++j) v[j] = ((const f32x4*)(X + (size_t)gw * DM) + lane)[64 * j]; }
    for (int r = gw; r < S; r += ngw) {
        const int rn = r + ngw < S ? r + ngw : r;
#pragma unroll
        for (int j = 0; j < 8; ++j) vn[j] = ((const f32x4*)(X + (size_t)rn * DM) + lane)[64 * j];
        __builtin_amdgcn_sched_barrier(0);
        float s = 0.f;
#pragma unroll
        for (int j = 0; j < 8; ++j) s += (v[j].x * v[j].x + v[j].y * v[j].y) + (v[j].z * v[j].z + v[j].w * v[j].w);
        const float rstd = 1.f / sqrtf(wave_sum(s) * (1.f / DM) + EPS);
        f32x4* xr = (f32x4*)(X + (size_t)r * DM) + lane;
#pragma unroll
        for (int j = 0; j < 8; ++j) xr[64 * j] = v[j] * rstd * gv[j];
        __builtin_amdgcn_sched_barrier(0);
#pragma unroll
        for (int j = 0; j < 8; ++j) v[j] = vn[j];
    }
}
DI void prep_rows(bf16_t* P, const float* qn, const float* kvn, const float* cw, const float* cb, const f32x2* tab, bf16_t* XC) {
    const int tid_ = opaque_tid(), lane = tid_ & 63, gw = blockIdx.x * 8 + (tid_ >> 6), ngw = gridDim.x * 8;
    f32x2 qg[3], kg[2], cbv[8], cwv[8][4];
#pragma unroll
    for (int k = 0; k < 3; ++k) qg[k] = *(const f32x2*)(qn + 128 * k + 2 * lane);
#pragma unroll
    for (int k = 0; k < 2; ++k) kg[k] = *(const f32x2*)(kvn + 128 * k + 2 * lane);
#pragma unroll
    for (int k = 0; k < 8; ++k) { cbv[k] = *(const f32x2*)(cb + 128 * k + 2 * lane);
#pragma unroll
        for (int jj = 0; jj < 4; ++jj) cwv[k][jj] = *(const f32x2*)(cw + jj * 1024 + 128 * k + 2 * lane); }
    for (int t = gw; t < S; t += ngw) {
        bf16_t* row = P + (size_t)t * NP;
        unsigned wq[3], wk[2], wc[8][4];
#pragma unroll
        for (int k = 0; k < 3; ++k) wq[k] = *(const unsigned*)(row + PC_CQ + 128 * k + 2 * lane);
#pragma unroll
        for (int k = 0; k < 2; ++k) wk[k] = *(const unsigned*)(row + PC_CKV + 128 * k + 2 * lane);
        const int j = lane & 31; const float x1 = bf2f(row[PC_KR + j]), x2 = bf2f(row[PC_KR + 32 + j]); const f32x2 cs = tab[(size_t)t * 32 + j];
#pragma unroll
        for (int k = 0; k < 8; ++k)
#pragma unroll
            for (int jj = 0; jj < 4; ++jj) { const int tt = t - 3 + jj; wc[k][jj] = tt >= 0 ? *(const unsigned*)(P + (size_t)tt * NP + PC_CX + 128 * k + 2 * lane) : 0u; }
        __builtin_amdgcn_sched_barrier(0);
        { float s = 0.f;
#pragma unroll
          for (int k = 0; k < 3; ++k) { const float a = bflo(wq[k]), b = bfhi(wq[k]); s += a * a + b * b; }
          const float rstd = 1.f / sqrtf(wave_sum(s) * (1.f / 384.f) + EPS);
#pragma unroll
          for (int k = 0; k < 3; ++k) *(unsigned*)(row + PC_CQ + 128 * k + 2 * lane) = pk2(bflo(wq[k]) * rstd * qg[k].x, bfhi(wq[k]) * rstd * qg[k].y); }
        { float s = 0.f;
#pragma unroll
          for (int k = 0; k < 2; ++k) { const float a = bflo(wk[k]), b = bfhi(wk[k]); s += a * a + b * b; }
          const float rstd = 1.f / sqrtf(wave_sum(s) * (1.f / 256.f) + EPS);
#pragma unroll
          for (int k = 0; k < 2; ++k) *(unsigned*)(row + PC_CKV + 128 * k + 2 * lane) = pk2(bflo(wk[k]) * rstd * kg[k].x, bfhi(wk[k]) * rstd * kg[k].y); }
        { const unsigned o = pk2(x1 * cs.x - x2 * cs.y, x1 * cs.y + x2 * cs.x); if (lane < 32) *(unsigned*)(row + PC_KR + 2 * j) = o; }
#pragma unroll
        for (int k = 0; k < 8; ++k) { float a0 = cbv[k].x, a1 = cbv[k].y;
#pragma unroll
            for (int jj = 0; jj < 4; ++jj) { a0 += cwv[k][jj].x * bflo(wc[k][jj]); a1 += cwv[k][jj].y * bfhi(wc[k][jj]); }
            *(unsigned*)(XC + (size_t)t * 1024 + 128 * k + 2 * lane) = pk2(a0, a1); }
    }
}

DI void lru_p1(const bf16_t* LA, const bf16_t* U, float* CA, float* CH) {
    const int tid = opaque_tid();
    for (int c = blockIdx.x; c < 256; c += gridDim.x) {
        float h0 = 0.f, h1 = 0.f, s0 = 0.f, s1 = 0.f;
        unsigned lw[64], uw[64];
#pragma unroll
        for (int i = 0; i < 64; ++i) { const size_t row = (size_t)c * 64 + i; lw[i] = *(const unsigned*)(LA + row * NP + 2 * tid); uw[i] = *(const unsigned*)(U + row * 1024 + 2 * tid); }
#pragma unroll
        for (int i = 0; i < 64; ++i) { const float l0 = bflo(lw[i]), l1 = bfhi(lw[i]); s0 += l0; s1 += l1; h0 = __expf(l0) * h0 + bflo(uw[i]); h1 = __expf(l1) * h1 + bfhi(uw[i]); }
        CA[c * 1024 + 2 * tid] = __expf(s0); CA[c * 1024 + 2 * tid + 1] = __expf(s1); CH[c * 1024 + 2 * tid] = h0; CH[c * 1024 + 2 * tid + 1] = h1;
    }
}
DI void lru_p2(const float* CA, const float* CH, float* CARRY) {
    const int tid = opaque_tid(), lane = tid & 63, gw = blockIdx.x * 8 + (tid >> 6), ngw = gridDim.x * 8;
    for (int ch = gw; ch < 1024; ch += ngw) {
        float a[4], hh[4];
#pragma unroll
        for (int i = 0; i < 4; ++i) { a[i] = CA[(4 * lane + i) * 1024 + ch]; hh[i] = CH[(4 * lane + i) * 1024 + ch]; }
        float A = a[0], H = hh[0];
#pragma unroll
        for (int i = 1; i < 4; ++i) { H = a[i] * H + hh[i]; A = A * a[i]; }
#pragma unroll
        for (int o = 1; o < 64; o <<= 1) { const float Ap = __shfl_up(A, o), Hp = __shfl_up(H, o); if (lane >= o) { H = A * Hp + H; A = A * Ap; } }
        float st = __shfl_up(H, 1); if (lane == 0) st = 0.f;
#pragma unroll
        for (int i = 0; i < 4; ++i) { CARRY[(4 * lane + i) * 1024 + ch] = st; st = a[i] * st + hh[i]; }
    }
}
DI void lru_p3(const bf16_t* LA, const bf16_t* U, const float* CARRY, bf16_t* Y) {
    const int tid = opaque_tid();
    for (int c = blockIdx.x; c < 256; c += gridDim.x) {
        float h0 = CARRY[c * 1024 + 2 * tid], h1 = CARRY[c * 1024 + 2 * tid + 1];
        unsigned lw[64], uw[64];
#pragma unroll
        for (int i = 0; i < 64; ++i) { const size_t row = (size_t)c * 64 + i; lw[i] = *(const unsigned*)(LA + row * NP + 2 * tid); uw[i] = *(const unsigned*)(U + row * 1024 + 2 * tid); }
        __builtin_amdgcn_sched_barrier(0);
#pragma unroll
        for (int i = 0; i < 64; ++i) { const size_t row = (size_t)c * 64 + i; h0 = __expf(bflo(lw[i])) * h0 + bflo(uw[i]); h1 = __expf(bfhi(lw[i])) * h1 + bfhi(uw[i]);
            *(unsigned*)(Y + row * 3072 + 2048 + 2 * tid) = pk2(h0, h1); }
    }
}

DI void mlstm_a(LAS unsigned char* smem, const bf16_t* P, const float* gbias, bf16_t* CS, float* SMALL) {
    const int tid = opaque_tid(), lane = tid & 63, wid = tid >> 6, l31 = lane & 31, h = lane >> 5, q4 = (lane & 15) >> 2, p4 = lane & 3, blk = (lane >> 4) & 1;
    LAS float* sw = (LAS float*)smem;
    LAS unsigned char* Ks = smem + 1024;
    LAS unsigned char* Vs = smem + 1024 + 20480;
    u32x4 kpre[2], vpre[4]; bf16_t gipre = 0, gfpre = 0;
#define MA_LOAD(u_) do { const int c_ = (u_) >> 2, hh_ = (u_) & 3; const size_t r0_ = (size_t)c_ * 64; \
        _Pragma("unroll") for (int i = 0; i < 2; ++i) { const int id = tid + 512 * i, s_ = id >> 4, d8 = (id & 15) * 8; kpre[i] = *(const u32x4*)(P + (r0_ + s_) * NP + PC_K + hh_ * 128 + d8); } \
        _Pragma("unroll") for (int i = 0; i < 4; ++i) { const int id = tid + 512 * i, s_ = id >> 5, d8 = (id & 31) * 8; vpre[i] = *(const u32x4*)(P + (r0_ + s_) * NP + PC_V + hh_ * 256 + d8); } \
        if (wid == 0) { const bf16_t* r_ = P + (r0_ + lane) * NP; gipre = r_[PC_I + hh_]; gfpre = r_[PC_F + hh_]; } } while (0)
    if ((int)blockIdx.x < 1024) MA_LOAD((int)blockIdx.x);
    for (int uid = blockIdx.x; uid < 1024; uid += gridDim.x) {
        const int hh = uid & 3;
        if (wid == 0) {
            const float li = bf2f(gipre) + gbias[hh], lf = logsigmoid_(bf2f(gfpre) + gbias[4 + hh]);
            const float bc = wave_incl_scan(lf, lane), bt = __shfl(bc, 63), ds = bt - bc + li, M = wave_max(ds);
            sw[lane] = expf(ds - M);
            if (lane == 0) { SMALL[SM_BT + uid] = bt; SMALL[SM_MC + uid] = M; }
        }
        __syncthreads();
#pragma unroll
        for (int i = 0; i < 2; ++i) { const int id = tid + 512 * i, s = id >> 4, d8 = (id & 15) * 8; const u32x4 v = kpre[i]; const float w = sw[s];
            u32x4 o; o.x = pk2(bflo(v.x) * w, bfhi(v.x) * w); o.y = pk2(bflo(v.y) * w, bfhi(v.y) * w); o.z = pk2(bflo(v.z) * w, bfhi(v.z) * w); o.w = pk2(bflo(v.w) * w, bfhi(v.w) * w);
            *(LAS u32x4*)(Ks + s * 320 + d8 * 2) = o; }
#pragma unroll
        for (int i = 0; i < 4; ++i) { const int id = tid + 512 * i, s = id >> 5, d8 = (id & 31) * 8; *(LAS u32x4*)(Vs + s * 576 + d8 * 2) = vpre[i]; }
        __syncthreads();
        if (uid + (int)gridDim.x < 1024) MA_LOAD(uid + (int)gridDim.x);
        f32x16 acc[4];
#pragma unroll
        for (int d = 0; d < 4; ++d)
#pragma unroll
            for (int i = 0; i < 16; ++i) acc[d][i] = 0.f;
#pragma unroll
        for (int kk = 0; kk < 4; ++kk) {
            const bf16x8 vf = tr_frag(Vs + (16 * kk + 8 * h + q4) * 576 + (32 * wid + 16 * blk) * 2 + 8 * p4, 576);
#pragma unroll
            for (int d = 0; d < 4; ++d) { const bf16x8 kf = tr_frag(Ks + (16 * kk + 8 * h + q4) * 320 + (32 * d + 16 * blk) * 2 + 8 * p4, 320); acc[d] = mfma32(kf, vf, acc[d]); }
        }
        bf16_t* cs = CS + (size_t)uid * 32768 + (32 * wid + l31) * 128;
#pragma unroll
        for (int d = 0; d < 4; ++d)
#pragma unroll
            for (int g = 0; g < 4; ++g) { u32x2 w; w.x = pk2(acc[d][4 * g], acc[d][4 * g + 1]); w.y = pk2(acc[d][4 * g + 2], acc[d][4 * g + 3]); *(u32x2*)(cs + 32 * d + 8 * g + 4 * h) = w; }
        if (tid < 128) { float s = 0.f;
#pragma unroll 8
            for (int t = 0; t < 64; ++t) s += bf2f(*(LAS const bf16_t*)(Ks + t * 320 + tid * 2));
            SMALL[SM_DN + uid * 128 + tid] = s; }
        __syncthreads();
    }
#undef MA_LOAD
}
DI void mlstm_b(LAS unsigned char* smem, bf16_t* CS, float* SMALL) {
    const int tid = opaque_tid();
    LAS float* dec = (LAS float*)smem; LAS float* inj = dec + 1024;
    LAS float* sbt = inj + 1024; LAS float* smc = sbt + 1024;
    sbt[tid] = SMALL[SM_BT + tid]; sbt[tid + 512] = SMALL[SM_BT + tid + 512]; smc[tid] = SMALL[SM_MC + tid]; smc[tid + 512] = SMALL[SM_MC + tid + 512];
    __syncthreads();
    if (tid < 4) { float m = -1e30f;
        for (int c = 0; c < 256; ++c) { const float bt = sbt[c * 4 + tid], M = smc[c * 4 + tid]; sbt[c * 4 + tid] = m;
            const float mn = fmaxf(bt + m, M); dec[tid * 256 + c] = __expf(bt + m - mn); inj[tid * 256 + c] = __expf(M - mn); m = mn; } }
    __syncthreads();
    if (blockIdx.x == 0) { SMALL[SM_MPREV + tid] = sbt[tid]; SMALL[SM_MPREV + tid + 512] = sbt[tid + 512]; }
    for (int e = blockIdx.x * 512 + tid; e < 131072; e += gridDim.x * 512) {
        const int hh = e >> 15, idx = e & 32767; bf16_t* pp = CS + (size_t)hh * 32768 + idx; float st = 0.f;
        bf16_t d[32];
#pragma unroll
        for (int i = 0; i < 32; ++i) d[i] = pp[(size_t)i * 131072];
#pragma unroll 1
        for (int c0 = 0; c0 < 256; c0 += 32) {
            bf16_t dn[32];
            const int cn = c0 + 32 < 256 ? c0 + 32 : c0;
#pragma unroll
            for (int i = 0; i < 32; ++i) dn[i] = pp[(size_t)(cn + i) * 131072];
            asm volatile("" ::: "memory");
#pragma unroll
            for (int i = 0; i < 32; ++i) { pp[(size_t)(c0 + i) * 131072] = f2bf(st); st = dec[hh * 256 + c0 + i] * st + inj[hh * 256 + c0 + i] * bf2f(d[i]); }
            asm volatile("" ::: "memory");
#pragma unroll
            for (int i = 0; i < 32; ++i) d[i] = dn[i];
        }
    }
    if (blockIdx.x == gridDim.x - 1) { const int hh = tid >> 7; float* pp = SMALL + SM_DN + tid; float st = 0.f;
#pragma unroll 1
        for (int c0 = 0; c0 < 256; c0 += 32) {
            float d[32];
#pragma unroll
            for (int i = 0; i < 32; ++i) d[i] = pp[(c0 + i) * 512];
            asm volatile("" ::: "memory");
#pragma unroll
            for (int i = 0; i < 32; ++i) { pp[(c0 + i) * 512] = st; st = dec[hh * 256 + c0 + i] * st + inj[hh * 256 + c0 + i] * d[i]; }
            asm volatile("" ::: "memory");
        } }
    __syncthreads();
}
DI void mlstm_c(LAS unsigned char* smem, const bf16_t* P, const float* gbias, const float* onorm, const bf16_t* CS, const float* SMALL, bf16_t* Y) {
    const int tid = opaque_tid(), lane = tid & 63, wid = tid >> 6, l31 = lane & 31, h = lane >> 5, q4 = (lane & 15) >> 2, p4 = lane & 3, blk = (lane >> 4) & 1;
    LAS float* sbc = (LAS float*)smem; LAS float* sav = sbc + 64; LAS float* snp = sbc + 128; LAS float* sx = sbc + 256;
    LAS unsigned char* Qs = smem + 2048;
    LAS unsigned char* Ks = Qs + 17408;
    LAS unsigned char* Vs = Ks + 17408;
    const int tb = wid & 1, dvq = wid >> 1, t = 32 * tb + l31, pr = pi32(l31);
    u32x4 qpre[2], kpre[2], vpre[4]; bf16_t gipre = 0, gfpre = 0; float nppre = 0.f, mppre = 0.f;
#define MC_LOAD(u_) do { const int c_ = (u_) >> 2, hh_ = (u_) & 3; const size_t r0_ = (size_t)c_ * 64; \
        _Pragma("unroll") for (int i = 0; i < 2; ++i) { const int id = tid + 512 * i, s_ = id >> 4, d8 = (id & 15) * 8; \
            qpre[i] = *(const u32x4*)(P + (r0_ + s_) * NP + PC_Q + hh_ * 128 + d8); kpre[i] = *(const u32x4*)(P + (r0_ + s_) * NP + PC_K + hh_ * 128 + d8); } \
        _Pragma("unroll") for (int i = 0; i < 4; ++i) { const int id = tid + 512 * i, s_ = id >> 5, d8 = (id & 31) * 8; vpre[i] = *(const u32x4*)(P + (r0_ + s_) * NP + PC_V + hh_ * 256 + d8); } \
        if (wid == 0) { const bf16_t* r_ = P + (r0_ + lane) * NP; gipre = r_[PC_I + hh_]; gfpre = r_[PC_F + hh_]; } \
        if (tid >= 64 && tid < 192) nppre = SMALL[SM_DN + (u_) * 128 + tid - 64]; \
        mppre = SMALL[SM_MPREV + (u_)]; } while (0)
    if ((int)blockIdx.x < 1024) MC_LOAD((int)blockIdx.x);
    for (int uid = blockIdx.x; uid < 1024; uid += gridDim.x) {
        const int c = uid >> 2, hh = uid & 3; const size_t row0 = (size_t)c * 64;
        if (wid == 0) {
            const float li = bf2f(gipre) + gbias[hh], lf = logsigmoid_(bf2f(gfpre) + gbias[4 + hh]);
            const float bc = wave_incl_scan(lf, lane);
            sbc[lane] = bc; sav[lane] = li - bc;
        }
        if (tid >= 64 && tid < 192) snp[tid - 64] = nppre;
#pragma unroll
        for (int i = 0; i < 2; ++i) { const int id = tid + 512 * i, s = id >> 4, d8 = (id & 15) * 8;
            *(LAS u32x4*)(Qs + s * 272 + d8 * 2) = qpre[i]; *(LAS u32x4*)(Ks + s * 272 + d8 * 2) = kpre[i]; }
#pragma unroll
        for (int i = 0; i < 4; ++i) { const int id = tid + 512 * i, s = id >> 5, d8 = (id & 31) * 8; *(LAS u32x4*)(Vs + s * 576 + d8 * 2) = vpre[i]; }
        const float mprev = mppre;
        __syncthreads();
        if (uid + (int)gridDim.x < 1024) MC_LOAD(uid + (int)gridDim.x);
        bf16x8 qf[8];
#pragma unroll
        for (int ks = 0; ks < 8; ++ks) qf[ks] = *(const LAS bf16x8*)(Qs + t * 272 + (16 * ks + 8 * h) * 2);
        f32x16 st0, st1;
#pragma unroll
        for (int i = 0; i < 16; ++i) { st0[i] = 0.f; st1[i] = 0.f; }
#pragma unroll
        for (int ks = 0; ks < 8; ++ks) { const bf16x8 a0 = *(const LAS bf16x8*)(Ks + pr * 272 + (16 * ks + 8 * h) * 2); st0 = mfma32(a0, qf[ks], st0);
            if (tb) { const bf16x8 a1 = *(const LAS bf16x8*)(Ks + (32 + pr) * 272 + (16 * ks + 8 * h) * 2); st1 = mfma32(a1, qf[ks], st1); } }
        const float bt = sbc[t];
        float mx = -1e30f;
#pragma unroll
        for (int i = 0; i < 16; ++i) { const int s = 16 * (i >> 3) + 8 * h + (i & 7); if (s <= t) mx = fmaxf(mx, sav[s]); if (tb) mx = fmaxf(mx, (s + 32 <= t) ? sav[s + 32] : -1e30f); }
        mx = fmaxf(mx, __shfl_xor(mx, 32));
        const float mt = bt + fmaxf(mprev, mx);
        float den = 0.f;
#pragma unroll
        for (int i = 0; i < 16; ++i) { const int s = 16 * (i >> 3) + 8 * h + (i & 7);
            const float w0 = (s <= t) ? __expf(bt + sav[s] - mt) * MQS : 0.f; st0[i] *= w0; den += st0[i];
            const float w1 = (tb && (s + 32 <= t)) ? __expf(bt + sav[s + 32] - mt) * MQS : 0.f; st1[i] *= w1; den += st1[i]; }
        den += __shfl_xor(den, 32);
        float qn = 0.f;
#pragma unroll
        for (int ks = 0; ks < 8; ++ks)
#pragma unroll
            for (int j = 0; j < 8; ++j) qn += bf2f((bf16_t)qf[ks][j]) * snp[16 * ks + 8 * h + j];
        qn += __shfl_xor(qn, 32);
        const float wi = expf(bt + mprev - mt) * MQS;
        den += wi * qn;
        const float dinv = 1.f / fmaxf(fabsf(den), expf(-mt));
        bf16x8 pf[4];
        pf[0] = pack8(st0[0], st0[1], st0[2], st0[3], st0[4], st0[5], st0[6], st0[7]); pf[1] = pack8(st0[8], st0[9], st0[10], st0[11], st0[12], st0[13], st0[14], st0[15]);
        pf[2] = pack8(st1[0], st1[1], st1[2], st1[3], st1[4], st1[5], st1[6], st1[7]); pf[3] = pack8(st1[8], st1[9], st1[10], st1[11], st1[12], st1[13], st1[14], st1[15]);
        float hv[2][16]; float ss = 0.f;
#pragma unroll
        for (int db = 0; db < 2; ++db) { const int dvb = 2 * dvq + db;
            f32x16 a1, a2;
#pragma unroll
            for (int i = 0; i < 16; ++i) { a1[i] = 0.f; a2[i] = 0.f; }
#pragma unroll
            for (int sb = 0; sb < 2; ++sb)
#pragma unroll
                for (int kk = 0; kk < 2; ++kk) { if (sb <= tb) { const bf16x8 vf = tr_frag(Vs + (32 * sb + 16 * kk + 8 * h + q4) * 576 + (32 * dvb + 16 * blk) * 2 + 8 * p4, 576); a1 = mfma32(vf, pf[2 * sb + kk], a1); } }
            const bf16_t* cp = CS + (size_t)uid * 32768 + (32 * dvb + l31) * 128 + 8 * h;
#pragma unroll
            for (int ks = 0; ks < 8; ++ks) { const bf16x8 cf = *(const bf16x8*)(cp + 16 * ks); a2 = mfma32(cf, qf[ks], a2); }
#pragma unroll
            for (int i = 0; i < 16; ++i) { const float v = (a1[i] + wi * a2[i]) * dinv; hv[db][i] = v; ss += v * v; }
        }
        ss += __shfl_xor(ss, 32);
        if (h == 0) sx[(tb * 4 + dvq) * 32 + l31] = ss;
        __syncthreads();
        const float tot = (sx[(tb * 4 + 0) * 32 + l31] + sx[(tb * 4 + 1) * 32 + l31]) + (sx[(tb * 4 + 2) * 32 + l31] + sx[(tb * 4 + 3) * 32 + l31]);
        const float rstd = 1.f / sqrtf(tot * (1.f / 256.f) + EPS);
        f32x4 gnv[2][4]; u32x2 ogv[2][4];
#pragma unroll
        for (int db = 0; db < 2; ++db)
#pragma unroll
            for (int g = 0; g < 4; ++g) { const int col = hh * 256 + 32 * (2 * dvq + db) + 8 * g + 4 * h; gnv[db][g] = *(const f32x4*)(onorm + col); ogv[db][g] = *(const u32x2*)(P + (row0 + t) * NP + PC_O + col); }
        __builtin_amdgcn_sched_barrier(0);
#pragma unroll
        for (int db = 0; db < 2; ++db)
#pragma unroll
            for (int g = 0; g < 4; ++g) { const int col = hh * 256 + 32 * (2 * dvq + db) + 8 * g + 4 * h;
                const f32x4 gn = gnv[db][g]; const u32x2 og = ogv[db][g];
                const float o0 = hv[db][4 * g] * rstd * gn.x * sigmoidf_(bflo(og.x)), o1 = hv[db][4 * g + 1] * rstd * gn.y * sigmoidf_(bfhi(og.x));
                const float o2 = hv[db][4 * g + 2] * rstd * gn.z * sigmoidf_(bflo(og.y)), o3 = hv[db][4 * g + 3] * rstd * gn.w * sigmoidf_(bfhi(og.y));
                u32x2 w; w.x = pk2(o0, o1); w.y = pk2(o2, o3); *(u32x2*)(Y + (row0 + t) * 3072 + col) = w; }
        __syncthreads();
    }
#undef MC_LOAD
}

DI void attn_unit(LAS unsigned char* smem, int hh, int qb, const bf16_t* Q, const bf16_t* KN, const bf16_t* P, const bf16_t* VT, bf16_t* Y) {
    const int tid = opaque_tid(), lane = tid & 63, wid = __builtin_amdgcn_readfirstlane(tid >> 6), l31 = lane & 31, h = lane >> 5;
    LAS unsigned char* Kb = smem; LAS unsigned char* Vb = smem + 51200;
    const int q0 = qb * 256, qw = q0 + 32 * wid, q = qw + l31, NT = 4 * qb + 4;
    bf16x8 qf[12];
#pragma unroll
    for (int ks = 0; ks < 12; ++ks) qf[ks] = *(const bf16x8*)(Q + (size_t)q * 1536 + hh * 192 + 16 * ks + 8 * h);
    f32x16 o[4];
#pragma unroll
    for (int d = 0; d < 4; ++d)
#pragma unroll
        for (int i = 0; i < 16; ++i) o[d][i] = 0.f;
    float mref = 0.f, lrun = 0.f; bool first = true;
    const bf16_t* ksrc0; const bf16_t* ksrc2; const bf16_t* vsrc0; int kdst0, kdst2, vdst0;
    { const int row = tid >> 4, ch = tid & 15; ksrc0 = KN + (size_t)row * 1024 + hh * 128 + 8 * ch; kdst0 = row * 400 + ch * 16; }
    { const int row = tid >> 3, ch = tid & 7; ksrc2 = P + (size_t)row * NP + PC_KR + 8 * ch; kdst2 = row * 400 + 256 + ch * 16; }
    { const int d = tid >> 3, ch = tid & 7; vsrc0 = VT + (size_t)(hh * 128 + d) * S + 8 * ch; vdst0 = d * 144 + ch * 16; }
    u32x4 kr[3], vr[2];
#define ATT_LOAD(tt) do { kr[0] = *(const u32x4*)(ksrc0 + (size_t)(tt) * 65536); kr[1] = *(const u32x4*)(ksrc0 + (size_t)(tt) * 65536 + 32 * 1024); kr[2] = *(const u32x4*)(ksrc2 + (size_t)(tt) * (64 * NP)); \
        vr[0] = *(const u32x4*)(vsrc0 + (size_t)(tt) * 64); vr[1] = *(const u32x4*)(vsrc0 + (size_t)(tt) * 64 + (size_t)64 * S); } while (0)
#define ATT_WRITE(kbuf, vslot) do { *(LAS u32x4*)(Kb + (kbuf) * 25600 + kdst0) = kr[0]; *(LAS u32x4*)(Kb + (kbuf) * 25600 + kdst0 + 32 * 400) = kr[1]; *(LAS u32x4*)(Kb + (kbuf) * 25600 + kdst2) = kr[2]; \
        *(LAS u32x4*)(Vb + (vslot) * 18432 + vdst0) = vr[0]; *(LAS u32x4*)(Vb + (vslot) * 18432 + vdst0 + 64 * 144) = vr[1]; } while (0)
#define ATT_BAR() do { asm volatile("s_waitcnt lgkmcnt(0)" ::: "memory"); __builtin_amdgcn_s_barrier(); asm volatile("" ::: "memory"); } while (0)
    ATT_LOAD(0);
    ATT_WRITE(0, 0);
    ATT_BAR();
    const int koff = pi32(l31) * 400 + 16 * h, voff = l31 * 144 + 16 * h;
#define SB() __builtin_amdgcn_sched_barrier(0)
#define KFR(kb, ks, b) (*(const LAS bf16x8*)((kb) + (b) * 32 * 400 + (ks) * 32))
#define VFR(vb, d, kk) (*(const LAS bf16x8*)((vb) + (d) * 32 * 144 + (kk) * 32))
    int vs = 0;
    for (int t = 0; t < NT; ++t) {
        const int kc = t & 1, vn = vs == 2 ? 0 : vs + 1;
        if (t + 1 < NT) ATT_LOAD(t + 1);
        if (64 * t <= qw + 31) {
            LAS const unsigned char* kb = Kb + kc * 25600 + koff; LAS const unsigned char* vb = Vb + vs * 18432 + voff;
            f32x16 s0, s1;
#pragma unroll
            for (int i = 0; i < 16; ++i) { s0[i] = 0.f; s1[i] = 0.f; }
            bf16x8 fa[4], fb[4];
            fa[0] = KFR(kb, 0, 0); fa[1] = KFR(kb, 0, 1); fa[2] = KFR(kb, 1, 0); fa[3] = KFR(kb, 1, 1); SB();
#pragma unroll
            for (int st = 0; st < 6; st += 2) {
                fb[0] = KFR(kb, 2 * st + 2, 0); fb[1] = KFR(kb, 2 * st + 2, 1); fb[2] = KFR(kb, 2 * st + 3, 0); fb[3] = KFR(kb, 2 * st + 3, 1); SB();
                s0 = mfma32(fa[0], qf[2 * st], s0); s1 = mfma32(fa[1], qf[2 * st], s1); s0 = mfma32(fa[2], qf[2 * st + 1], s0); s1 = mfma32(fa[3], qf[2 * st + 1], s1); SB();
                if (st + 2 < 6) { fa[0] = KFR(kb, 2 * st + 4, 0); fa[1] = KFR(kb, 2 * st + 4, 1); fa[2] = KFR(kb, 2 * st + 5, 0); fa[3] = KFR(kb, 2 * st + 5, 1); }
                else { fa[0] = VFR(vb, 0, 0); fa[1] = VFR(vb, 0, 1); fa[2] = VFR(vb, 0, 2); fa[3] = VFR(vb, 0, 3); }
                SB();
                s0 = mfma32(fb[0], qf[2 * st + 2], s0); s1 = mfma32(fb[1], qf[2 * st + 2], s1); s0 = mfma32(fb[2], qf[2 * st + 3], s0); s1 = mfma32(fb[3], qf[2 * st + 3], s1); SB();
            }
            if (64 * t + 63 > qw) {
#pragma unroll
                for (int i = 0; i < 16; ++i) { const int kv = 64 * t + 16 * (i >> 3) + 8 * h + (i & 7); if (kv > q) s0[i] = -1e30f; if (kv + 32 > q) s1[i] = -1e30f; }
            }
            float mx = fmaxf(s0[0], s1[0]);
#pragma unroll
            for (int i = 1; i < 16; ++i) mx = fmaxf(mx, fmaxf(s0[i], s1[i]));
            mx = fmaxf(mx, __shfl_xor(mx, 32));
            if (first || __any(mx - mref > 8.f)) {
                const float dl = first ? mx : fmaxf(mx - mref, 0.f);
                mref += dl;
                if (!first) { const float f = __builtin_amdgcn_exp2f(-dl); lrun *= f;
#pragma unroll
                    for (int d = 0; d < 4; ++d)
#pragma unroll
                        for (int i = 0; i < 16; ++i) o[d][i] *= f; }
                first = false; }
            float rs = 0.f;
#pragma unroll
            for (int i = 0; i < 16; ++i) { s0[i] = __builtin_amdgcn_exp2f(s0[i] - mref); s1[i] = __builtin_amdgcn_exp2f(s1[i] - mref); rs += s0[i] + s1[i]; }
            lrun += rs;
            bf16x8 pf[4];
            pf[0] = pack8(s0[0], s0[1], s0[2], s0[3], s0[4], s0[5], s0[6], s0[7]); pf[1] = pack8(s0[8], s0[9], s0[10], s0[11], s0[12], s0[13], s0[14], s0[15]);
            pf[2] = pack8(s1[0], s1[1], s1[2], s1[3], s1[4], s1[5], s1[6], s1[7]); pf[3] = pack8(s1[8], s1[9], s1[10], s1[11], s1[12], s1[13], s1[14], s1[15]);
            SB();
            fb[0] = VFR(vb, 1, 0); fb[1] = VFR(vb, 1, 1); fb[2] = VFR(vb, 1, 2); fb[3] = VFR(vb, 1, 3); SB();
            o[0] = mfma32(fa[0], pf[0], o[0]); o[0] = mfma32(fa[1], pf[1], o[0]); o[0] = mfma32(fa[2], pf[2], o[0]); o[0] = mfma32(fa[3], pf[3], o[0]); SB();
            fa[0] = VFR(vb, 2, 0); fa[1] = VFR(vb, 2, 1); fa[2] = VFR(vb, 2, 2); fa[3] = VFR(vb, 2, 3); SB();
            o[1] = mfma32(fb[0], pf[0], o[1]); o[1] = mfma32(fb[1], pf[1], o[1]); o[1] = mfma32(fb[2], pf[2], o[1]); o[1] = mfma32(fb[3], pf[3], o[1]); SB();
            fb[0] = VFR(vb, 3, 0); fb[1] = VFR(vb, 3, 1); fb[2] = VFR(vb, 3, 2); fb[3] = VFR(vb, 3, 3); SB();
            o[2] = mfma32(fa[0], pf[0], o[2]); o[2] = mfma32(fa[1], pf[1], o[2]); o[2] = mfma32(fa[2], pf[2], o[2]); o[2] = mfma32(fa[3], pf[3], o[2]); SB();
            o[3] = mfma32(fb[0], pf[0], o[3]); o[3] = mfma32(fb[1], pf[1], o[3]); o[3] = mfma32(fb[2], pf[2], o[3]); o[3] = mfma32(fb[3], pf[3], o[3]); SB();
        }
        if (t + 1 < NT) ATT_WRITE(kc ^ 1, vn);
        ATT_BAR();
        vs = vn;
    }
#undef SB
#undef KFR
#undef VFR
#undef ATT_LOAD
#undef ATT_WRITE
#undef ATT_BAR
    lrun += __shfl_xor(lrun, 32);
    const float inv = 1.f / lrun;
    bf16_t* yp = Y + (size_t)q * 3072 + 1024 + hh * 128 + 4 * h;
#pragma unroll
    for (int d = 0; d < 4; ++d)
#pragma unroll
        for (int g = 0; g < 4; ++g) { u32x2 w; w.x = pk2(o[d][4 * g] * inv, o[d][4 * g + 1] * inv); w.y = pk2(o[d][4 * g + 2] * inv, o[d][4 * g + 3] * inv); *(u32x2*)(yp + 32 * d + 8 * g) = w; }
}

#define XB_TMO      128
#define XB_XCNT(j)  (256  + 64 * (j))
#define XB_XSUB(j)  (1280 + 64 * (j))
#define XB_XGEN(j)  (2304 + 64 * (j))
#define XB_TOP      3328
#define XB_TOPGEN   3392
#define XCD_BAR_WORDS 3456
#define XB_SPIN_CAP (1u << 23)
DI unsigned xb_ld(unsigned* p)              { return __hip_atomic_load(p, __ATOMIC_RELAXED, __HIP_MEMORY_SCOPE_AGENT); }
DI unsigned xb_add(unsigned* p, unsigned v) { return __hip_atomic_fetch_add(p, v, __ATOMIC_RELAXED, __HIP_MEMORY_SCOPE_AGENT); }
DI unsigned xb_xcc_id() { return (unsigned)__builtin_amdgcn_s_getreg((3 << 11) | 20) & 0xFu; }
#define XB_SPIN(cond, bar) do { unsigned _sp = 0; while (cond) { __builtin_amdgcn_s_sleep(1); \
    if ((++_sp & 255u) == 0u) { if (xb_ld(&(bar)[XB_TMO])) break; if (_sp > XB_SPIN_CAP) { atomicAdd(&(bar)[XB_TMO], 1u); break; } } } } while (0)
struct XcdBarrier { unsigned* bar; unsigned x; volatile LAS unsigned* st; };
DI XcdBarrier xcd_barrier_post(unsigned* bar, volatile LAS unsigned* st) {
    XcdBarrier b; b.bar = bar; b.x = xb_xcc_id(); b.st = st;
    if (threadIdx.x == 0) (void)xb_add(&bar[XB_XCNT(b.x)], 1u);
    return b;
}
DI void xcd_barrier_complete(unsigned* bar, unsigned x, unsigned& nloc, unsigned& nx) {
    const unsigned G = gridDim.x * gridDim.y * gridDim.z;
    unsigned sum, cnt, mine, sp = 0u;
    for (;;) {
        sum = 0u; cnt = 0u; mine = 0u;
#pragma unroll
        for (unsigned j = 0; j < 16; ++j) { const unsigned c = xb_ld(&bar[XB_XCNT(j)]); sum += c; cnt += (c > 0u) ? 1u : 0u; mine = (j == x) ? c : mine; }
        if (sum == G) break;
        __builtin_amdgcn_s_sleep(1);
        if ((++sp & 255u) == 0u) { if (xb_ld(&bar[XB_TMO])) break; if (sp > XB_SPIN_CAP) { atomicAdd(&bar[XB_TMO], 1u); break; } }
    }
    nloc = mine > 0u ? mine : 1u; nx = cnt > 0u ? cnt : 1u;
}
DI void xcd_barrier(const XcdBarrier& b) {
    asm volatile("s_waitcnt vmcnt(0)" ::: "memory");
    __syncthreads();
    if (threadIdx.x == 0) {
        unsigned* bar = b.bar;
        __builtin_amdgcn_s_waitcnt(0);
        unsigned nloc = b.st[0], nx = b.st[1];
        if (nloc == 0u) { xcd_barrier_complete(bar, b.x, nloc, nx); b.st[0] = nloc; b.st[1] = nx; }
        const unsigned old = xb_add(&bar[XB_XSUB(b.x)], 1u);
        const unsigned gen = old / nloc;
        if (old + 1u == (gen + 1u) * nloc) {
            __builtin_amdgcn_fence(__ATOMIC_RELEASE, "agent");
            asm volatile("s_waitcnt vmcnt(0)" ::: "memory");
            const unsigned og = xb_add(&bar[XB_TOP], 1u);
            const unsigned tg = og / nx;
            if (og + 1u == (tg + 1u) * nx) xb_add(&bar[XB_TOPGEN], 1u);
            else XB_SPIN(xb_ld(&bar[XB_TOPGEN]) == tg, bar);
            __builtin_amdgcn_fence(__ATOMIC_ACQUIRE, "agent");
            xb_add(&bar[XB_XGEN(b.x)], 1u);
            asm volatile("s_waitcnt vmcnt(0)" ::: "memory");
        } else {
            XB_SPIN(xb_ld(&bar[XB_XGEN(b.x)]) == gen, bar);
            __builtin_amdgcn_fence(__ATOMIC_ACQUIRE, "agent");
            asm volatile("s_waitcnt vmcnt(0)" ::: "memory");
        }
    }
    __syncthreads();
}

struct Params { const float* in[27]; float* out; unsigned char* ws; };

__global__ void __launch_bounds__(512, 2) mega_fwd(Params p) {
    extern __shared__ __attribute__((aligned(16))) unsigned char smem_raw[];
    LAS unsigned char* smem = (LAS unsigned char*)smem_raw;
    cg::grid_group grid = cg::this_grid();
    const int G = gridDim.x, bx = blockIdx.x;
    { const int t0 = opaque_tid(); if (t0 < 128) ((LAS unsigned*)(smem + 131072))[t0] = 0u; }
    __syncthreads();
    XcdBarrier bar; bar.bar = (unsigned*)(p.ws + WS_CTL); bar.x = 0; bar.st = (volatile LAS unsigned*)(smem + 131072) + 8;
    if (bx == 0) { unsigned* cw = (unsigned*)(p.ws + WS_CTL); for (int i = opaque_tid(); i < XCD_BAR_WORDS; i += 512) cw[i] = 0u; }
    unsigned char* ws = p.ws;
    f32x2* TAB = (f32x2*)(ws + WS_TAB); float* SMALL = (float*)(ws + WS_SMALL);
    bf16_t* WFFGU = (bf16_t*)(ws + WS_WFFGU); bf16_t* WFFD = (bf16_t*)(ws + WS_WFFD); bf16_t* WIN = (bf16_t*)(ws + WS_WIN); bf16_t* WUQ = (bf16_t*)(ws + WS_WUQ);
    bf16_t* WUKV = (bf16_t*)(ws + WS_WUKV); bf16_t* WLRU = (bf16_t*)(ws + WS_WLRU); bf16_t* WBR = (bf16_t*)(ws + WS_WBR); bf16_t* WOUT = (bf16_t*)(ws + WS_WOUT);
    bf16_t* XN = (bf16_t*)(ws + WS_XN); bf16_t* P = (bf16_t*)(ws + WS_P); bf16_t* Hb = P; bf16_t* Qb = (bf16_t*)(ws + WS_Q); bf16_t* KN = (bf16_t*)(ws + WS_KN);
    bf16_t* VT = (bf16_t*)(ws + WS_VT); bf16_t* Y = (bf16_t*)(ws + WS_Y); bf16_t* XC = (bf16_t*)(ws + WS_XC); bf16_t* CS = (bf16_t*)(ws + WS_CS);

    for (int i = bx * 512 + opaque_tid(); i < S * 32; i += G * 512) { const int t = i >> 5, j = i & 31; const float ang = (float)t * INVF[j];
        double r = (double)ang * 0.15915494309189535; r -= __builtin_floor(r); const float fr = (float)r;
        TAB[i] = (f32x2){__builtin_amdgcn_cosf(fr), __builtin_amdgcn_sinf(fr)}; }

#pragma unroll 1
    for (int hl = 0; hl < 4; ++hl) {
        const int l = hl >> 1, second = hl & 1;
        const float* xin = hl == 0 ? p.in[0] : p.out;
#define CONVERT_RANGE(cl, csec, lo, hi) do { int rot = 0; _Pragma("unroll 1") for (int mi = (lo); mi < (hi); ++mi) { \
            const float* src; int K, N, map; bf16_t* dst; \
            if (mi == 0) { src = p.in[(csec) ? 23 : 2] + (size_t)(cl) * DM * FF; K = DM; N = FF; map = 1; dst = WFFGU; } \
            else if (mi == 1) { src = p.in[(csec) ? 24 : 3] + (size_t)(cl) * DM * FF; K = DM; N = FF; map = 2; dst = WFFGU; } \
            else if (mi == 2) { src = p.in[(csec) ? 25 : 4] + (size_t)(cl) * DM * FF; K = FF; N = DM; map = 0; dst = WFFD; } \
            else if (mi == 3) { src = p.in[6] + (size_t)(cl) * DM * NIN; K = DM; N = NIN; map = 3; dst = WIN; } \
            else if (mi == 4) { src = p.in[10] + (size_t)(cl) * 384 * 1536; K = 384; N = 1536; map = 4; dst = WUQ; } \
            else if (mi == 5) { src = p.in[12] + (size_t)(cl) * 256 * 2048; K = 256; N = 2048; map = 5; dst = WUKV; } \
            else if (mi < 22) { const int k = mi - 6, n = k >> 1, wx = k & 1; src = p.in[wx ? 17 : 15] + (size_t)(cl) * 131072 + n * 16384; K = 128; N = 128; map = 0; dst = WLRU + (size_t)(n * 256 + wx * 128) * 128; } \
            else if (mi < 25) { const int j = mi - 22; src = p.in[20] + (size_t)(cl) * 3 * 1024 * 2048 + (size_t)j * 1024 * 2048; K = 1024; N = 2048; map = 0; dst = WBR + (size_t)j * 2048 * 1024; } \
            else { src = p.in[21] + (size_t)(cl) * DM * DM; K = DM; N = DM; map = 0; dst = WOUT; } \
            convert_mat(src, K, N, dst, map, rot); } } while (0)
        const int grp = (bx >> 3) & 1;
        {
            if (hl == 0) CONVERT_RANGE(0, 0, 0, 26);
            rmsnorm_rows(xin, p.in[second ? 22 : 1] + l * DM, XN);
        }
        if (hl == 0) { grid.sync(); bar = xcd_barrier_post((unsigned*)(p.ws + WS_CTL), (volatile LAS unsigned*)(smem + 131072) + 8); } else xcd_barrier(bar);
        { pg8::Gemm g{XN, WFFGU, S, 2 * FF, DM, DM, DM, 0}; pg8::StaticOrder so; so.init(S, 2 * FF, G, bx); pg8::EpiSwiglu E{Hb};
          const int c_lo = hl == 1 ? 3 : 2, c_hi = hl == 1 ? 26 : (hl == 2 ? 3 : 2);
          if (grp == 0) CONVERT_RANGE(1, 0, c_lo, c_hi);
          pg8::gemm_phase(smem, g, so, E);
          if (grp == 1) CONVERT_RANGE(1, 0, c_lo, c_hi); }
        xcd_barrier(bar);
        { pg8::Gemm g{Hb, WFFD, S, DM, FF, FF, FF, 0}; pg8::StaticOrder so; so.init(S, DM, G, bx); pg8::EpiRes E{xin, p.out, 0.5f};
          const int nl = (hl + 1) >> 1, ns = (hl + 1) & 1, c_hi = hl < 3 ? 2 : 0;
          if (grp == 0) CONVERT_RANGE(nl, ns, 0, c_hi);
          pg8::gemm_phase(smem, g, so, E);
          if (grp == 1) CONVERT_RANGE(nl, ns, 0, c_hi); }
        xcd_barrier(bar);
        if (!second) {
            const float* gbias = p.in[7] + l * 8;
            rmsnorm_rows(p.out, p.in[5] + l * DM, XN);
            xcd_barrier(bar);
            { pg8::Gemm g{XN, WIN, S, NP, DM, DM, DM, 0}; pg8::StaticOrder so; so.init(S, NP, G, bx); pg8::EpiStore E{P, NP};
              if (grp == 0) CONVERT_RANGE(l, 1, 2, 3);
              pg8::gemm_phase(smem, g, so, E);
              if (grp == 1) CONVERT_RANGE(l, 1, 2, 3); }
            xcd_barrier(bar);
            if (bx == G - 1) { const float* lam = p.in[19] + l * 1024; for (int ch = opaque_tid(); ch < 1024; ch += 512) SMALL[SM_SP + ch] = -8.f * log1pf(expf(-lam[ch])); }
            mlstm_a(smem, P, gbias, CS, SMALL);
            prep_rows(P, p.in[9] + l * 384, p.in[11] + l * 256, p.in[13] + l * 4096, p.in[14] + l * 1024, TAB, XC);
            xcd_barrier(bar);
            mlstm_b(smem, CS, SMALL);
            { pg8::Gemm g{P + PC_CQ, WUQ, S, 1536, 384, NP, 384, 0}; pg8::StaticOrder so; so.init(S, 1536, G, bx); pg8::EpiQ E{Qb, TAB}; pg8::gemm_phase(smem, g, so, E); }
#pragma unroll 1
            for (int gi = 0; gi < 2; ++gi) {
                pg8::Gemm g; pg8::StaticOrder so; pg8::EpiStore E;
                if (gi == 0) { g = pg8::Gemm{P + PC_CKV, WUKV, S, 1024, 256, NP, 256, 0}; so.init(S, 1024, G, bx); E = pg8::EpiStore{KN, 1024}; }
                else { g = pg8::Gemm{WUKV + 1024 * 256, P + PC_CKV, 1024, S, 256, 256, NP, 0}; so.init(1024, S, G, bx); E = pg8::EpiStore{VT, S}; }
                pg8::gemm_phase(smem, g, so, E);
            }
            { pg8::Gemm g{XC, WLRU, S, 2048, 128, 1024, 128, 128}; pg8::StaticOrder so; so.init(S, 2048, G, bx); pg8::EpiLru E{XC, P + PC_CX, p.in[16] + l * 1024, p.in[18] + l * 1024, SMALL + SM_SP}; pg8::gemm_phase(smem, g, so, E); }
            xcd_barrier(bar);
            mlstm_c(smem, P, gbias, p.in[8] + l * 1024, CS, SMALL, Y);
            lru_p1(P + PC_CX, XC, SMALL + SM_CA, SMALL + SM_CH);
            xcd_barrier(bar);
            lru_p2(SMALL + SM_CA, SMALL + SM_CH, SMALL + SM_CARRY);
            for (int item = bx; item < 256; item += G) { const int hh = item & 7, pp = item >> 3;
#pragma unroll 1
                for (int half = 0; half < 2; ++half) attn_unit(smem, hh, half ? 63 - pp : pp, Qb, KN, P, VT, Y); }
            xcd_barrier(bar);
            lru_p3(P + PC_CX, XC, SMALL + SM_CARRY, Y);
#pragma unroll 1
            for (int j = 0; j < 3; ++j) {
                if (j == 2) xcd_barrier(bar);
                pg8::Gemm g{Y + j * 1024, WBR + (size_t)j * 2048 * 1024, S, DM, 1024, 3072, 1024, 0}; pg8::StaticOrder so; so.init(S, DM, G, bx); pg8::EpiMerge E{XN, P + PC_G + j * 2048, j == 0}; pg8::gemm_phase(smem, g, so, E);
            }
            xcd_barrier(bar);
            { pg8::Gemm g{XN, WOUT, S, DM, DM, DM, DM, 0}; pg8::StaticOrder so; so.init(S, DM, G, bx); pg8::EpiRes E{p.out, p.out, 1.0f}; pg8::gemm_phase(smem, g, so, E); }
            xcd_barrier(bar);
        }
    }
    final_norm_rows(p.out, p.in[26]);
}

constexpr int LDS_BYTES = 143360;

extern "C" void kernel_launch(void* const* d_in, const int* in_sizes, int n_in, void* d_out, int out_size, void* d_ws, size_t ws_size, hipStream_t stream) {
    static int grid = 0;
    if (grid == 0) {
        if (n_in != 27 || out_size != S * DM || ws_size < WS_END) { fprintf(stderr, "kernel_launch: unexpected problem (n_in %d out %d ws %zu, need %zu)\n", n_in, out_size, ws_size, (size_t)WS_END); grid = -1; return; }
        int dev = 0, cus = 0, per_cu = 0;
        hipGetDevice(&dev); hipDeviceGetAttribute(&cus, hipDeviceAttributeMultiprocessorCount, dev);
        if (hipFuncSetAttribute((const void*)mega_fwd, hipFuncAttributeMaxDynamicSharedMemorySize, LDS_BYTES) != hipSuccess) { fprintf(stderr, "kernel_launch: hipFuncSetAttribute failed\n"); grid = -1; return; }
        if (hipOccupancyMaxActiveBlocksPerMultiprocessor(&per_cu, (const void*)mega_fwd, 512, LDS_BYTES) != hipSuccess || per_cu < 1) { fprintf(stderr, "kernel_launch: occupancy query says %d\n", per_cu); per_cu = 1; }
        (void)hipGetLastError();
        grid = cus * (per_cu > 1 ? 1 : per_cu);
    }
    if (grid < 0) return;
    Params p{};
    for (int i = 0; i < 27; ++i) p.in[i] = (const float*)d_in[i];
    p.out = (float*)d_out; p.ws = (unsigned char*)d_ws;
    void* args[] = {&p};
    hipError_t e = hipLaunchCooperativeKernel((const void*)mega_fwd, dim3(grid), dim3(512), args, LDS_BYTES, stream);
    if (e != hipSuccess) fprintf(stderr, "cooperative launch failed: %s (grid %d)\n", hipGetErrorString(e), grid);
}
```

```cpp
#include <hip/hip_runtime.h>
#include <hip/hip_cooperative_groups.h>
#include <cstdio>
#include <cstdint>
namespace cg = cooperative_groups;

#define DI __device__ __forceinline__
#define LAS __attribute__((address_space(3)))
typedef unsigned short bf16_t;
typedef short bf16x8 __attribute__((ext_vector_type(8)));
typedef short s16x4 __attribute__((ext_vector_type(4)));
typedef float f32x2 __attribute__((ext_vector_type(2)));
typedef float f32x4 __attribute__((ext_vector_type(4)));
typedef float f32x16 __attribute__((ext_vector_type(16)));
typedef unsigned u32x2 __attribute__((ext_vector_type(2)));
typedef unsigned u32x4 __attribute__((ext_vector_type(4)));
typedef __bf16 bf16x2_t __attribute__((ext_vector_type(2)));

constexpr int S = 16384, DM = 2048, FF = 5632, NIN = 10952, NP = 11008;
constexpr float EPS = 1e-6f;
constexpr int PC_Q = 0, PC_K = 512, PC_V = 1024, PC_O = 2048, PC_CQ = 3072, PC_CKV = 3456, PC_KR = 3712, PC_CX = 3776, PC_G = 4800, PC_I = 10944, PC_F = 10948;
constexpr float MQS = 0.08838834764831845f;
constexpr float AQS = 0.07216878364870322f * 1.4426950408889634f;

constexpr size_t MiB = 1u << 20;
constexpr size_t WS_TAB = 0;
constexpr size_t WS_SMALL = 4 * MiB;
constexpr size_t WS_WFFGU = 12 * MiB;
constexpr size_t WS_WFFD = 56 * MiB;
constexpr size_t WS_WIN = 78 * MiB;
constexpr size_t WS_WUQ = 121 * MiB;
constexpr size_t WS_WUKV = 123 * MiB;
constexpr size_t WS_WLRU = 124 * MiB;
constexpr size_t WS_WBR = 125 * MiB;
constexpr size_t WS_WOUT = 137 * MiB;
constexpr size_t WS_XN = 145 * MiB;
constexpr size_t WS_P = 209 * MiB;
constexpr size_t WS_Q = 553 * MiB;
constexpr size_t WS_KN = 601 * MiB;
constexpr size_t WS_VT = 633 * MiB;
constexpr size_t WS_Y = 665 * MiB;
constexpr size_t WS_XC = 761 * MiB;
constexpr size_t WS_CS = 793 * MiB;
constexpr size_t WS_END = 857 * MiB;
constexpr size_t WS_CTL = 11 * MiB, CTL_BYTES = 16384;
constexpr int SM_BT = 0, SM_MC = 1024, SM_MPREV = 2048, SM_DN = 4096  , SM_CA = 4096 + 131072  , SM_CH = SM_CA + 262144, SM_CARRY = SM_CH + 262144, SM_SP = SM_CARRY + 262144;

__device__ const float INVF[32] = {1.0f, 0.7498942613601685f, 0.5623413324356079f, 0.4216965138912201f, 0.3162277638912201f, 0.23713737726211548f, 0.17782793939113617f, 0.133352130651474f, 0.10000000149011612f, 0.07498941570520401f, 0.05623413249850273f, 0.04216965287923813f, 0.03162277489900589f, 0.023713737726211548f, 0.017782794311642647f, 0.01333521492779255f, 0.009999999776482582f, 0.007498941849917173f, 0.005623413249850273f, 0.0042169648222625256f, 0.003162277629598975f, 0.00237137358635664f, 0.0017782794311642647f, 0.0013335214462131262f, 0.0010000000474974513f, 0.0007498942431993783f, 0.000562341301701963f, 0.0004216965171508491f, 0.0003162277571391314f, 0.00023713737027719617f, 0.00017782794020604342f, 0.0001333521504420787f};

DI int opaque_tid() { int t = threadIdx.x; asm volatile("" : "+v"(t)); return t; }
DI float bf2f(bf16_t v) { return __uint_as_float((unsigned)v << 16); }
DI float bflo(unsigned w) { return __uint_as_float(w << 16); }
DI float bfhi(unsigned w) { return __uint_as_float(w & 0xffff0000u); }
DI unsigned pk2(float lo, float hi) { f32x2 v = {lo, hi}; bf16x2_t b = __builtin_convertvector(v, bf16x2_t); return __builtin_bit_cast(unsigned, b); }
DI bf16_t f2bf(float f) { return (bf16_t)(pk2(f, 0.f) & 0xffffu); }
DI float wave_sum(float v) {
#pragma unroll
    for (int o = 1; o < 64; o <<= 1) v += __shfl_xor(v, o);
    return v;
}
DI float wave_max(float v) {
#pragma unroll
    for (int o = 1; o < 64; o <<= 1) v = fmaxf(v, __shfl_xor(v, o));
    return v;
}
DI float wave_incl_scan(float v, int lane) {
#pragma unroll
    for (int o = 1; o < 64; o <<= 1) { const float n = __shfl_up(v, o); if (lane >= o) v += n; }
    return v;
}
DI float sigmoidf_(float x) { return __builtin_amdgcn_rcpf(1.f + __expf(-x)); }
DI float logsigmoid_(float x) { return fminf(x, 0.f) - log1pf(expf(-fabsf(x))); }
DI f32x16 mfma32(bf16x8 a, bf16x8 b, f32x16 c) { return __builtin_amdgcn_mfma_f32_32x32x16_bf16(a, b, c, 0, 0, 0); }
DI int crow(int r, int h) { return (r & 3) + 8 * (r >> 2) + 4 * h; }
DI int pi32(int m) { return (m & ~12) | ((m & 4) << 1) | ((m & 8) >> 1); }
typedef short v4i16_t __attribute__((ext_vector_type(4)));
DI s16x4 tr16(LAS const unsigned char* p) { return __builtin_bit_cast(s16x4, __builtin_amdgcn_ds_read_tr16_b64_v4i16((LAS v4i16_t*)p)); }
DI bf16x8 tr_frag(LAS const unsigned char* p, int rs) {
    const s16x4 lo = tr16(p), hi = tr16(p + 4 * rs);
    return __builtin_shufflevector(lo, hi, 0, 1, 2, 3, 4, 5, 6, 7);
}
DI bf16x8 pack8(float a0, float a1, float a2, float a3, float a4, float a5, float a6, float a7) {
    u32x4 w; w.x = pk2(a0, a1); w.y = pk2(a2, a3); w.z = pk2(a4, a5); w.w = pk2(a6, a7); return __builtin_bit_cast(bf16x8, w);
}

namespace pg8 {
constexpr int BM = 256, BK = 64, HALF = 128, HTB = HALF * BK * 2, STAGE_BYTES = 8 * HTB, NXCD = 8, WGM = 4;
DI int lds_byte(int r, int c) { const int st = (r >> 4) * 2 + (c >> 5), rr = r & 15, cc = c & 31, ob = rr * 64 + cc * 2; return st * 1024 + (ob ^ (((ob >> 9) & 1) << 5)); }
DI void stage_rc(int b, int& R, int& C) { const int st = b / 1024, sb = b % 1024, swz = sb ^ (((sb >> 9) & 1) << 5); R = (st >> 1) * 16 + swz / 64; C = (st & 1) * 32 + (swz % 64) / 2; }
DI int perm32(int rho) { const int n = rho >> 4, i = rho & 15; return 8 * (i >> 2) + 4 * n + (i & 3); }
struct Unit { int pm, pn; };
struct Gemm { const bf16_t* A; const bf16_t* Bt; int M, N, K, lda, ldb, apn; };
struct StaticOrder {
    int nM, nN, nwg, G, c;
    DI void init(int M, int N, int G_, int c_) { nM = M / BM; nN = N / BM; nwg = nM * nN; G = G_; c = c_; }
    DI bool next(int i, Unit& u) const {
        const long L = (long)i * G + c; if (L >= nwg) return false;
        int wgid = (int)L; { const int q = nwg / NXCD, r = nwg % NXCD, xcd = wgid % NXCD, off = wgid / NXCD; wgid = (xcd < r ? xcd * (q + 1) : r * (q + 1) + (xcd - r) * q) + off; }
        const int nig = WGM * nN, gid = wgid / nig, fm = gid * WGM, gsz = (nM - fm) < WGM ? (nM - fm) : WGM;
        u.pm = fm + ((wgid % nig) % gsz); u.pn = (wgid % nig) / gsz; return true;
    }
};
template <class Epi>
DI void gemm_phase(LAS unsigned char* lds, const Gemm g, const StaticOrder& S, const Epi& E) {
    const int tid = opaque_tid(), wid = __builtin_amdgcn_readfirstlane(tid >> 6), lane = tid & 63, wr = wid >> 2, wc = wid & 3, fr = lane & 15, fq = lane >> 4;
    int K = g.K; asm volatile("" : "+s"(K)); const int nt = K / BK;
    unsigned voffA[2], voffB[2];
#pragma unroll
    for (int i = 0; i < 2; ++i) { int R, C; stage_rc(tid * 16 + i * 8192, R, C); const int Rb = Epi::PERM ? ((R & ~31) + perm32(R & 31)) : R;
        voffA[i] = (unsigned)(R * g.lda + C) * 2u; voffB[i] = (unsigned)(Rb * g.ldb + C) * 2u; }
    const size_t kstep = (size_t)(BK * 2);
    const size_t hstepA = (size_t)HALF * g.lda * 2, hstepB = (size_t)HALF * g.ldb * 2;
    const unsigned ldsw = (unsigned)wid * 1024u;
    const int aoff = lds_byte(wr * 64 + fr, fq * 8), boff = lds_byte(wc * 32 + fr, fq * 8);
#define PG8_SA(b, h) (((b) * 2 + (h)) * HTB)
#define PG8_SB(b, h) ((4 + (b) * 2 + (h)) * HTB)
#define PG8_STAGE(bufoff, gbase, voff) do { _Pragma("unroll") for (int _i = 0; _i < 2; ++_i) \
        __builtin_amdgcn_global_load_lds((const unsigned*)((const char*)(gbase) + (voff)[_i]), (LAS unsigned*)(lds + (bufoff) + ldsw + _i * 8192), 16, 0, 0); } while (0)
#define PG8_LDA(dst, b, h) do { _Pragma("unroll") for (int m = 0; m < 4; ++m) _Pragma("unroll") for (int k = 0; k < 2; ++k) dst[m][k] = *(const LAS bf16x8*)(lds + PG8_SA(b, h) + aoff + m * 2048 + k * 1024); } while (0)
#define PG8_LDB(dst, b, h) do { _Pragma("unroll") for (int n = 0; n < 2; ++n) _Pragma("unroll") for (int k = 0; k < 2; ++k) dst[n][k] = *(const LAS bf16x8*)(lds + PG8_SB(b, h) + boff + n * 2048 + k * 1024); } while (0)
#define PG8_MMA(ai, bj, At, Bt) do { __builtin_amdgcn_s_setprio(1); _Pragma("unroll") for (int m = 0; m < 4; ++m) _Pragma("unroll") for (int n = 0; n < 2; ++n) _Pragma("unroll") for (int k = 0; k < 2; ++k) \
        acc[ai][bj][m][n] = __builtin_amdgcn_mfma_f32_16x16x32_bf16(Bt[n][k], At[m][k], acc[ai][bj][m][n], 0, 0, 0); __builtin_amdgcn_s_setprio(0); } while (0)
#define PG8_WAIT_V(n) asm volatile("s_waitcnt vmcnt(" #n ")" ::: "memory")
#define PG8_WAIT_L(n) asm volatile("s_waitcnt lgkmcnt(" #n ")" ::: "memory")
#define PG8_BAR __builtin_amdgcn_s_barrier()
#define PG8_SCHED __builtin_amdgcn_sched_barrier(0)
#define PG8_APTR(u) ((const char*)g.A + (size_t)(u).pm * 2 * hstepA + (size_t)(u).pn * (size_t)g.apn * 2)
#define PG8_BPTR(u) ((const char*)g.Bt + (size_t)(u).pn * 2 * hstepB)
    Unit cur, nxt; int ui = 0;
    if (!S.next(0, cur)) return;
    f32x4 acc[2][2][4][2];
#pragma unroll
    for (int a = 0; a < 2; ++a)
#pragma unroll
        for (int b = 0; b < 2; ++b)
#pragma unroll
            for (int m = 0; m < 4; ++m)
#pragma unroll
                for (int n = 0; n < 2; ++n) acc[a][b][m][n] = (f32x4){0.f, 0.f, 0.f, 0.f};
    bf16x8 At[4][2], B0[2][2], B1[2][2];
    const char* cA = PG8_APTR(cur); const char* cB = PG8_BPTR(cur);
    PG8_STAGE(PG8_SB(0, 0), cB, voffB); PG8_STAGE(PG8_SB(0, 1), cB + hstepB, voffB); PG8_STAGE(PG8_SA(0, 0), cA, voffA); PG8_STAGE(PG8_SA(0, 1), cA + hstepA, voffA);
    if (wr == 1) PG8_BAR;
    PG8_WAIT_V(2); PG8_BAR;
    PG8_STAGE(PG8_SB(1, 0), cB + kstep, voffB); PG8_STAGE(PG8_SA(1, 0), cA + kstep, voffA); PG8_STAGE(PG8_SB(1, 1), cB + hstepB + kstep, voffB);
    PG8_WAIT_V(6); PG8_BAR;
    for (;;) {
        const bool has_next = S.next(ui + 1, nxt);
        const char* nA = has_next ? PG8_APTR(nxt) : cA; const char* nB = has_next ? PG8_BPTR(nxt) : cB;
        for (int t = 0; t < nt; t += 2) {
            const bool last = (t == nt - 2);
            const char* a1 = cA + (size_t)(t + 1) * kstep;
            const char* a2 = last ? nA : cA + (size_t)(t + 2) * kstep; const char* b2 = last ? nB : cB + (size_t)(t + 2) * kstep;
            const char* a3 = a2 + kstep; const char* b3 = b2 + kstep;
            PG8_LDB(B0, 0, 0); PG8_LDB(B1, 0, 1); PG8_SCHED; PG8_LDA(At, 0, 0); PG8_STAGE(PG8_SA(1, 1), a1 + hstepA, voffA);
            PG8_WAIT_V(8); PG8_WAIT_L(0); PG8_BAR; PG8_MMA(0, 0, At, B0); PG8_MMA(0, 1, At, B1); PG8_BAR; PG8_SCHED;
            PG8_LDA(At, 0, 1); PG8_STAGE(PG8_SB(0, 0), b2, voffB); PG8_STAGE(PG8_SB(0, 1), b2 + hstepB, voffB); PG8_STAGE(PG8_SA(0, 0), a2, voffA);
            PG8_WAIT_V(8); PG8_WAIT_L(0); PG8_BAR; PG8_MMA(1, 0, At, B0); PG8_MMA(1, 1, At, B1); PG8_BAR; PG8_SCHED;
            PG8_LDB(B0, 1, 0); PG8_LDB(B1, 1, 1); PG8_SCHED; PG8_LDA(At, 1, 0); PG8_STAGE(PG8_SA(0, 1), a2 + hstepA, voffA);
            PG8_WAIT_V(8); PG8_WAIT_L(0); PG8_BAR; PG8_MMA(0, 0, At, B0); PG8_MMA(0, 1, At, B1); PG8_BAR; PG8_SCHED;
            PG8_LDA(At, 1, 1); PG8_STAGE(PG8_SB(1, 0), b3, voffB); PG8_STAGE(PG8_SB(1, 1), b3 + hstepB, voffB); PG8_STAGE(PG8_SA(1, 0), a3, voffA);
            PG8_WAIT_V(8); PG8_WAIT_L(0); PG8_BAR; PG8_MMA(1, 0, At, B0); PG8_MMA(1, 1, At, B1); PG8_BAR; PG8_SCHED;
        }
        if (wr == 0) PG8_BAR;
        E(acc, cur, wr, wc, fr, fq);
        if (!has_next) break;
#pragma unroll
        for (int a = 0; a < 2; ++a)
#pragma unroll
            for (int b = 0; b < 2; ++b)
#pragma unroll
                for (int m = 0; m < 4; ++m)
#pragma unroll
                    for (int n = 0; n < 2; ++n) acc[a][b][m][n] = (f32x4){0.f, 0.f, 0.f, 0.f};
        cur = nxt; cA = nA; cB = nB; ++ui;
        if (wr == 1) PG8_BAR;
    }
    PG8_WAIT_V(0);
    PG8_BAR;
#undef PG8_SA
#undef PG8_SB
#undef PG8_STAGE
#undef PG8_LDA
#undef PG8_LDB
#undef PG8_MMA
#undef PG8_WAIT_V
#undef PG8_WAIT_L
#undef PG8_BAR
#undef PG8_SCHED
#undef PG8_APTR
#undef PG8_BPTR
}

typedef f32x4 Acc[2][2][4][2];
struct EpiStore {
    static constexpr bool PERM = true;
    bf16_t* O; int ldc;
    DI void operator()(const Acc& acc, const Unit& u, int wr, int wc, int fr, int fq) const {
        const int row0 = u.pm * BM + wr * 64 + fr, col0 = u.pn * BM + wc * 32 + 8 * fq;
#pragma unroll
        for (int ai = 0; ai < 2; ++ai)
#pragma unroll
            for (int m = 0; m < 4; ++m) { bf16_t* rowp = O + (size_t)(row0 + ai * HALF + m * 16) * ldc + col0;
#pragma unroll
                for (int bj = 0; bj < 2; ++bj) { const f32x4 v0 = acc[ai][bj][m][0], v1 = acc[ai][bj][m][1];
                    u32x4 w; w.x = pk2(v0[0], v0[1]); w.y = pk2(v0[2], v0[3]); w.z = pk2(v1[0], v1[1]); w.w = pk2(v1[2], v1[3]);
                    *(u32x4*)(rowp + bj * HALF) = w; } }
    }
};
struct EpiSwiglu {
    static constexpr bool PERM = true;
    bf16_t* H;
    DI void operator()(const Acc& acc, const Unit& u, int wr, int wc, int fr, int fq) const {
        const int row0 = u.pm * BM + wr * 64 + fr, col0 = u.pn * HALF + wc * 32 + 8 * fq;
#pragma unroll
        for (int ai = 0; ai < 2; ++ai)
#pragma unroll
            for (int m = 0; m < 4; ++m) { bf16_t* rowp = H + (size_t)(row0 + ai * HALF + m * 16) * FF + col0;
                float o[8];
#pragma unroll
                for (int n = 0; n < 2; ++n)
#pragma unroll
                    for (int j = 0; j < 4; ++j) { const float gt = acc[ai][0][m][n][j], up = acc[ai][1][m][n][j]; o[n * 4 + j] = gt * sigmoidf_(gt) * up; }
                u32x4 w; w.x = pk2(o[0], o[1]); w.y = pk2(o[2], o[3]); w.z = pk2(o[4], o[5]); w.w = pk2(o[6], o[7]);
                *(u32x4*)rowp = w; }
    }
};
struct EpiRes {
    static constexpr bool PERM = false;
    const float* xin; float* xout; float alpha;
    DI void operator()(const Acc& acc, const Unit& u, int wr, int wc, int fr, int fq) const {
        const int col0 = u.pn * BM + wc * 32 + 4 * fq;
#pragma unroll
        for (int ai = 0; ai < 2; ++ai) {
            f32x4 b[4][2][2];
#pragma unroll
            for (int m = 0; m < 4; ++m) { const size_t off = (size_t)(u.pm * BM + ai * HALF + wr * 64 + m * 16 + fr) * DM + col0;
#pragma unroll
                for (int bj = 0; bj < 2; ++bj)
#pragma unroll
                    for (int n = 0; n < 2; ++n) b[m][bj][n] = *(const f32x4*)(xin + off + bj * HALF + n * 16); }
            __builtin_amdgcn_sched_barrier(0);
#pragma unroll
            for (int m = 0; m < 4; ++m) { const size_t off = (size_t)(u.pm * BM + ai * HALF + wr * 64 + m * 16 + fr) * DM + col0;
#pragma unroll
                for (int bj = 0; bj < 2; ++bj)
#pragma unroll
                    for (int n = 0; n < 2; ++n) *(f32x4*)(xout + off + bj * HALF + n * 16) = b[m][bj][n] + acc[ai][bj][m][n] * alpha; }
            __builtin_amdgcn_sched_barrier(0);
        }
    }
};
struct EpiQ {
    static constexpr bool PERM = true;
    bf16_t* Q; const f32x2* tab;
    DI void operator()(const Acc& acc, const Unit& u, int wr, int wc, int fr, int fq) const {
        const int row0 = u.pm * BM + wr * 64 + fr;
#pragma unroll
        for (int bj = 0; bj < 2; ++bj) {
            const int c0 = u.pn * BM + bj * HALF + wc * 32 + 8 * fq; const int hh = c0 / 192, dd = c0 - hh * 192; const bool rope = dd >= 128; const int j0 = rope ? (dd - 128) >> 1 : 0;
#pragma unroll
            for (int ai = 0; ai < 2; ++ai) {
                f32x4 cs[4][2];
#pragma unroll
                for (int m = 0; m < 4; ++m) { const f32x4* tp = (const f32x4*)(tab + (size_t)(row0 + ai * HALF + m * 16) * 32 + j0); cs[m][0] = tp[0]; cs[m][1] = tp[1]; }
                __builtin_amdgcn_sched_barrier(0);
#pragma unroll
                for (int m = 0; m < 4; ++m) { const int row = row0 + ai * HALF + m * 16;
                    float v[8];
#pragma unroll
                    for (int n = 0; n < 2; ++n)
#pragma unroll
                        for (int j = 0; j < 4; ++j) v[n * 4 + j] = acc[ai][bj][m][n][j];
                    if (rope) {
                        const float cc[4] = {cs[m][0].x, cs[m][0].z, cs[m][1].x, cs[m][1].z}, sn[4] = {cs[m][0].y, cs[m][0].w, cs[m][1].y, cs[m][1].w};
#pragma unroll
                        for (int p = 0; p < 4; ++p) { const float x1 = v[2 * p], x2 = v[2 * p + 1]; v[2 * p] = x1 * cc[p] - x2 * sn[p]; v[2 * p + 1] = x1 * sn[p] + x2 * cc[p]; }
                    }
                    u32x4 w; w.x = pk2(v[0] * AQS, v[1] * AQS); w.y = pk2(v[2] * AQS, v[3] * AQS); w.z = pk2(v[4] * AQS, v[5] * AQS); w.w = pk2(v[6] * AQS, v[7] * AQS);
                    *(u32x4*)(Q + (size_t)row * 1536 + c0) = w; }
                __builtin_amdgcn_sched_barrier(0);
            }
        }
    }
};
struct EpiLru {
    static constexpr bool PERM = true;
    bf16_t* XC; bf16_t* LA; const float* ba; const float* bx; const float* sp;
    DI void operator()(const Acc& acc, const Unit& u, int wr, int wc, int fr, int fq) const {
        const int row0 = u.pm * BM + wr * 64 + fr, ch0 = u.pn * HALF + wc * 32 + 8 * fq;
#pragma unroll
        for (int ai = 0; ai < 2; ++ai) {
            u32x4 xall[4];
#pragma unroll
            for (int m = 0; m < 4; ++m) xall[m] = *(const u32x4*)(XC + (size_t)(row0 + ai * HALF + m * 16) * 1024 + ch0);
            __builtin_amdgcn_sched_barrier(0);
#pragma unroll
            for (int m = 0; m < 4; ++m) { const int row = row0 + ai * HALF + m * 16;
                const u32x4 xw = xall[m];
                const float xv[8] = {bflo(xw.x), bfhi(xw.x), bflo(xw.y), bfhi(xw.y), bflo(xw.z), bfhi(xw.z), bflo(xw.w), bfhi(xw.w)};
                u32x4 wl, wu;
#pragma unroll
                for (int n = 0; n < 2; ++n) { const f32x4 spv = *(const f32x4*)(sp + ch0 + 4 * n), bav = *(const f32x4*)(ba + ch0 + 4 * n), bxv = *(const f32x4*)(bx + ch0 + 4 * n);
                    float la[4], uu[4];
#pragma unroll
                    for (int j = 0; j < 4; ++j) { const float r = sigmoidf_(acc[ai][0][m][n][j] + bav[j]), gi = sigmoidf_(acc[ai][1][m][n][j] + bxv[j]);
                        const float l = r * spv[j]; la[j] = l; const float a2 = __expf(2.f * l); uu[j] = sqrtf(fmaxf(1.f - a2, 0.f)) * gi * xv[n * 4 + j]; }
                    if (n == 0) { wl.x = pk2(la[0], la[1]); wl.y = pk2(la[2], la[3]); wu.x = pk2(uu[0], uu[1]); wu.y = pk2(uu[2], uu[3]); }
                    else { wl.z = pk2(la[0], la[1]); wl.w = pk2(la[2], la[3]); wu.z = pk2(uu[0], uu[1]); wu.w = pk2(uu[2], uu[3]); } }
                *(u32x4*)(LA + (size_t)row * NP + ch0) = wl;
                *(u32x4*)(XC + (size_t)row * 1024 + ch0) = wu;
                asm volatile("" ::: "memory"); }
        }
    }
};
struct EpiMerge {
    static constexpr bool PERM = true;
    bf16_t* Z; const bf16_t* G; int first;
    DI void operator()(const Acc& acc, const Unit& u, int wr, int wc, int fr, int fq) const {
        const int row0 = u.pm * BM + wr * 64 + fr, col0 = u.pn * BM + wc * 32 + 8 * fq;
#pragma unroll
        for (int ai = 0; ai < 2; ++ai) {
            u32x4 gw[4][2], zw[4][2];
#pragma unroll
            for (int m = 0; m < 4; ++m) { const int row = row0 + ai * HALF + m * 16;
#pragma unroll
                for (int bj = 0; bj < 2; ++bj) { const int c = col0 + bj * HALF; gw[m][bj] = *(const u32x4*)(G + (size_t)row * NP + c);
                    zw[m][bj] = first ? (u32x4){0u, 0u, 0u, 0u} : *(const u32x4*)(Z + (size_t)row * DM + c); } }
            __builtin_amdgcn_sched_barrier(0);
#pragma unroll
            for (int m = 0; m < 4; ++m) { const int row = row0 + ai * HALF + m * 16;
#pragma unroll
                for (int bj = 0; bj < 2; ++bj) { const int c = col0 + bj * HALF;
                    const u32x4 g4 = gw[m][bj], z4 = zw[m][bj];
                    const float gv[8] = {bflo(g4.x), bfhi(g4.x), bflo(g4.y), bfhi(g4.y), bflo(g4.z), bfhi(g4.z), bflo(g4.w), bfhi(g4.w)};
                    const float zv[8] = {bflo(z4.x), bfhi(z4.x), bflo(z4.y), bfhi(z4.y), bflo(z4.z), bfhi(z4.z), bflo(z4.w), bfhi(z4.w)};
                    float o[8];
#pragma unroll
                    for (int n = 0; n < 2; ++n)
#pragma unroll
                        for (int j = 0; j < 4; ++j) o[n * 4 + j] = zv[n * 4 + j] + sigmoidf_(gv[n * 4 + j]) * acc[ai][bj][m][n][j];
                    u32x4 w; w.x = pk2(o[0], o[1]); w.y = pk2(o[2], o[3]); w.z = pk2(o[4], o[5]); w.w = pk2(o[6], o[7]);
                    *(u32x4*)(Z + (size_t)row * DM + c) = w; } }
            __builtin_amdgcn_sched_barrier(0);
        }
    }
};
}

DI int map_row(int map, int n) {
    switch (map) {
        case 1: return ((n >> 7) << 8) + (n & 127);
        case 2: return ((n >> 7) << 8) + 128 + (n & 127);
        case 3: { if (n < 2048) return n; if (n < 2052) return PC_I + n - 2048; if (n < 2056) return PC_F + n - 2052; if (n < 3080) return PC_O + n - 2056; if (n < 3464) return PC_CQ + n - 3080;
                  if (n < 3720) return PC_CKV + n - 3464; if (n < 3784) return PC_KR + n - 3720; if (n < 4808) return PC_CX + n - 3784; return PC_G + n - 4808; }
        case 4: { const int hh = n / 192, dd = n - hh * 192; if (dd < 128) return n; const int jj = dd - 128; return hh * 192 + 128 + (jj < 32 ? 2 * jj : 2 * (jj - 32) + 1); }
        case 5: { const int hh = n >> 8, dd = n & 255; return dd < 128 ? hh * 128 + dd : 1024 + hh * 128 + dd - 128; }
        default: return n;
    }
}
DI void convert_mat(const float* W, int K, int N, bf16_t* WT, int map, int& rot) {
    const int tid_ = opaque_tid(), lane = tid_ & 63, gw = blockIdx.x * 8 + (tid_ >> 6), ngw = gridDim.x * 8, r = lane >> 3, c = lane & 7;
    const int nnb = (N + 31) >> 5, nkb = K >> 6, nitems = nnb * nkb;
    int it = gw - rot; if (it < 0) it += ngw;
    for (; it < nitems; it += 2 * ngw) {
        const int it2 = it + ngw; const bool two = it2 < nitems;
        const int kbA = it / nnb, nbA = it - kbA * nnb, nA = nbA * 32 + 4 * c, kA = kbA * 64 + 8 * r;
        const int kbB = two ? it2 / nnb : kbA, nbB = two ? it2 - kbB * nnb : nbA, nB = nbB * 32 + 4 * c, kB = kbB * 64 + 8 * r;
        const bool okA = nA < N, okB = two && nB < N;
        f32x4 va[8], vb[8];
        if (okA) { const float* src = W + (size_t)kA * N + nA;
#pragma unroll
            for (int i = 0; i < 8; ++i) va[i] = *(const f32x4*)(src + (size_t)i * N); }
        if (okB) { const float* src = W + (size_t)kB * N + nB;
#pragma unroll
            for (int i = 0; i < 8; ++i) vb[i] = *(const f32x4*)(src + (size_t)i * N); }
        __builtin_amdgcn_sched_barrier(0);
#define CV_STORE(v, n0, k0) do { u32x4 o; \
            o.x = pk2(v[0].x, v[1].x); o.y = pk2(v[2].x, v[3].x); o.z = pk2(v[4].x, v[5].x); o.w = pk2(v[6].x, v[7].x); *(u32x4*)(WT + (size_t)map_row(map, (n0)) * K + (k0)) = o; \
            o.x = pk2(v[0].y, v[1].y); o.y = pk2(v[2].y, v[3].y); o.z = pk2(v[4].y, v[5].y); o.w = pk2(v[6].y, v[7].y); *(u32x4*)(WT + (size_t)map_row(map, (n0) + 1) * K + (k0)) = o; \
            o.x = pk2(v[0].z, v[1].z); o.y = pk2(v[2].z, v[3].z); o.z = pk2(v[4].z, v[5].z); o.w = pk2(v[6].z, v[7].z); *(u32x4*)(WT + (size_t)map_row(map, (n0) + 2) * K + (k0)) = o; \
            o.x = pk2(v[0].w, v[1].w); o.y = pk2(v[2].w, v[3].w); o.z = pk2(v[4].w, v[5].w); o.w = pk2(v[6].w, v[7].w); *(u32x4*)(WT + (size_t)map_row(map, (n0) + 3) * K + (k0)) = o; } while (0)
        if (okA) CV_STORE(va, nA, kA);
        if (okB) CV_STORE(vb, nB, kB);
#undef CV_STORE
    }
    rot = (rot + nitems) % ngw;
}

DI void rmsnorm_rows(const float* X, const float* g, bf16_t* O) {
    const int tid_ = opaque_tid(), lane = tid_ & 63, gw = blockIdx.x * 8 + (tid_ >> 6), ngw = gridDim.x * 8;
    f32x4 gv[8], v[8], vn[8];
#pragma unroll
    for (int j = 0; j < 8; ++j) gv[j] = ((const f32x4*)g)[lane + 64 * j];
    if (gw < S) {
#pragma unroll
        for (int j = 0; j < 8; ++j) v[j] = ((const f32x4*)(X + (size_t)gw * DM) + lane)[64 * j]; }
    for (int r = gw; r < S; r += ngw) {
        const int rn = r + ngw < S ? r + ngw : r;
#pragma unroll
        for (int j = 0; j < 8; ++j) vn[j] = ((const f32x4*)(X + (size_t)rn * DM) + lane)[64 * j];
        __builtin_amdgcn_sched_barrier(0);
        float s = 0.f;
#pragma unroll
        for (int j = 0; j < 8; ++j) s += (v[j].x * v[j].x + v[j].y * v[j].y) + (v[j].z * v[j].z + v[j].w * v[j].w);
        const float rstd = 1.f / sqrtf(wave_sum(s) * (1.f / DM) + EPS);
        u32x2* o8 = (u32x2*)(O + (size_t)r * DM) + lane;
#pragma unroll
        for (int j = 0; j < 8; ++j) { u32x2 w; w.x = pk2(v[j].x * rstd * gv[j].x, v[j].y * rstd * gv[j].y); w.y = pk2(v[j].z * rstd * gv[j].z, v[j].w * rstd * gv[j].w); o8[64 * j] = w; }
        __builtin_amdgcn_sched_barrier(0);
#pragma unroll
        for (int j = 0; j < 8; ++j) v[j] = vn[j];
    }
}
DI void final_norm_rows(float* X, const float* g) {
    const int tid_ = opaque_tid(), lane = tid_ & 63, gw = blockIdx.x * 8 + (tid_ >> 6), ngw = gridDim.x * 8;
    f32x4 gv[8], v[8], vn[8];
#pragma unroll
    for (int j = 0; j < 8; ++j) gv[j] = ((const f32x4*)g)[lane + 64 * j];
    if (gw < S) {
#pragma unroll
        for (int j = 0; j < 8; ++j) v[j] = ((const f32x4*)(X + (size_t)gw * DM) + lane)[64 * j]; }
    for (int r = gw; r < S; r += ngw) {
        const int rn = r + ngw < S ? r + ngw : r;
#pragma unroll
        for (int j = 0; j < 8; ++j) vn[j] = ((const f32x4*)(X + (size_t)rn * DM) + lane)[64 * j];
        __builtin_amdgcn_sched_barrier(0);
        float s = 0.f;
#pragma unroll
        for (int j = 0; j < 8; ++j) s += (v[j].x * v[j].x + v[j].y * v[j].y) + (v[j].z * v[j].z + v[j].w * v[j].w);
        const float rstd = 1.f / sqrtf(wave_sum(s) * (1.f / DM) + EPS);
        f32x4* xr = (f32x4*)(X + (size_t)r * DM) + lane;
#pragma unroll
        for (int j = 0; j < 8; ++j) xr[64 * j] = v[j] * rstd * gv[j];
        __builtin_amdgcn_sched_barrier(0);
#pragma unroll
        for (int j = 0; j < 8; ++j) v[j] = vn[j];
    }
}
DI void prep_rows(bf16_t* P, const float* qn, const float* kvn, const float* cw, const float* cb, const f32x2* tab, bf16_t* XC) {
    const int tid_ = opaque_tid(), lane = tid_ & 63, gw = blockIdx.x * 8 + (tid_ >> 6), ngw = gridDim.x * 8;
    f32x2 qg[3], kg[2], cbv[8], cwv[8][4];
#pragma unroll
    for (int k = 0; k < 3; ++k) qg[k] = *(const f32x2*)(qn + 128 * k + 2 * lane);
#pragma unroll
    for (int k = 0; k < 2; ++k) kg[k] = *(const f32x2*)(kvn + 128 * k + 2 * lane);
#pragma unroll
    for (int k = 0; k < 8; ++k) { cbv[k] = *(const f32x2*)(cb + 128 * k + 2 * lane);
#pragma unroll
        for (int jj = 0; jj < 4; ++jj) cwv[k][jj] = *(const f32x2*)(cw + jj * 1024 + 128 * k + 2 * lane); }
    for (int t = gw; t < S; t += ngw) {
        bf16_t* row = P + (size_t)t * NP;
        unsigned wq[3], wk[2], wc[8][4];
#pragma unroll
        for (int k = 0; k < 3; ++k) wq[k] = *(const unsigned*)(row + PC_CQ + 128 * k + 2 * lane);
#pragma unroll
        for (int k = 0; k < 2; ++k) wk[k] = *(const unsigned*)(row + PC_CKV + 128 * k + 2 * lane);
        const int j = lane & 31; const float x1 = bf2f(row[PC_KR + j]), x2 = bf2f(row[PC_KR + 32 + j]); const f32x2 cs = tab[(size_t)t * 32 + j];
#pragma unroll
        for (int k = 0; k < 8; ++k)
#pragma unroll
            for (int jj = 0; jj < 4; ++jj) { const int tt = t - 3 + jj; wc[k][jj] = tt >= 0 ? *(const unsigned*)(P + (size_t)tt * NP + PC_CX + 128 * k + 2 * lane) : 0u; }
        __builtin_amdgcn_sched_barrier(0);
        { float s = 0.f;
#pragma unroll
          for (int k = 0; k < 3; ++k) { const float a = bflo(wq[k]), b = bfhi(wq[k]); s += a * a + b * b; }
          const float rstd = 1.f / sqrtf(wave_sum(s) * (1.f / 384.f) + EPS);
#pragma unroll
          for (int k = 0; k < 3; ++k) *(unsigned*)(row + PC_CQ + 128 * k + 2 * lane) = pk2(bflo(wq[k]) * rstd * qg[k].x, bfhi(wq[k]) * rstd * qg[k].y); }
        { float s = 0.f;
#pragma unroll
          for (int k = 0; k < 2; ++k) { const float a = bflo(wk[k]), b = bfhi(wk[k]); s += a * a + b * b; }
          const float rstd = 1.f / sqrtf(wave_sum(s) * (1.f / 256.f) + EPS);
#pragma unroll
          for (int k = 0; k < 2; ++k) *(unsigned*)(row + PC_CKV + 128 * k + 2 * lane) = pk2(bflo(wk[k]) * rstd * kg[k].x, bfhi(wk[k]) * rstd * kg[k].y); }
        { const unsigned o = pk2(x1 * cs.x - x2 * cs.y, x1 * cs.y + x2 * cs.x); if (lane < 32) *(unsigned*)(row + PC_KR + 2 * j) = o; }
#pragma unroll
        for (int k = 0; k < 8; ++k) { float a0 = cbv[k].x, a1 = cbv[k].y;
#pragma unroll
            for (int jj = 0; jj < 4; ++jj) { a0 += cwv[k][jj].x * bflo(wc[k][jj]); a1 += cwv[k][jj].y * bfhi(wc[k][jj]); }
            *(unsigned*)(XC + (size_t)t * 1024 + 128 * k + 2 * lane) = pk2(a0, a1); }
    }
}

DI void lru_p1(const bf16_t* LA, const bf16_t* U, float* CA, float* CH) {
    const int tid = opaque_tid();
    for (int c = blockIdx.x; c < 256; c += gridDim.x) {
        float h0 = 0.f, h1 = 0.f, s0 = 0.f, s1 = 0.f;
        unsigned lw[64], uw[64];
#pragma unroll
        for (int i = 0; i < 64; ++i) { const size_t row = (size_t)c * 64 + i; lw[i] = *(const unsigned*)(LA + row * NP + 2 * tid); uw[i] = *(const unsigned*)(U + row * 1024 + 2 * tid); }
#pragma unroll
        for (int i = 0; i < 64; ++i) { const float l0 = bflo(lw[i]), l1 = bfhi(lw[i]); s0 += l0; s1 += l1; h0 = __expf(l0) * h0 + bflo(uw[i]); h1 = __expf(l1) * h1 + bfhi(uw[i]); }
        CA[c * 1024 + 2 * tid] = __expf(s0); CA[c * 1024 + 2 * tid + 1] = __expf(s1); CH[c * 1024 + 2 * tid] = h0; CH[c * 1024 + 2 * tid + 1] = h1;
    }
}
DI void lru_p2(const float* CA, const float* CH, float* CARRY) {
    const int tid = opaque_tid(), lane = tid & 63, gw = blockIdx.x * 8 + (tid >> 6), ngw = gridDim.x * 8;
    for (int ch = gw; ch < 1024; ch += ngw) {
        float a[4], hh[4];
#pragma unroll
        for (int i = 0; i < 4; ++i) { a[i] = CA[(4 * lane + i) * 1024 + ch]; hh[i] = CH[(4 * lane + i) * 1024 + ch]; }
        float A = a[0], H = hh[0];
#pragma unroll
        for (int i = 1; i < 4; ++i) { H = a[i] * H + hh[i]; A = A * a[i]; }
#pragma unroll
        for (int o = 1; o < 64; o <<= 1) { const float Ap = __shfl_up(A, o), Hp = __shfl_up(H, o); if (lane >= o) { H = A * Hp + H; A = A * Ap; } }
        float st = __shfl_up(H, 1); if (lane == 0) st = 0.f;
#pragma unroll
        for (int i = 0; i < 4; ++i) { CARRY[(4 * lane + i) * 1024 + ch] = st; st = a[i] * st + hh[i]; }
    }
}
DI void lru_p3(const bf16_t* LA, const bf16_t* U, const float* CARRY, bf16_t* Y) {
    const int tid = opaque_tid();
    for (int c = blockIdx.x; c < 256; c += gridDim.x) {
        float h0 = CARRY[c * 1024 + 2 * tid], h1 = CARRY[c * 1024 + 2 * tid + 1];
        unsigned lw[64], uw[64];
#pragma unroll
        for (int i = 0; i < 64; ++i) { const size_t row = (size_t)c * 64 + i; lw[i] = *(const unsigned*)(LA + row * NP + 2 * tid); uw[i] = *(const unsigned*)(U + row * 1024 + 2 * tid); }
        __builtin_amdgcn_sched_barrier(0);
#pragma unroll
        for (int i = 0; i < 64; ++i) { const size_t row = (size_t)c * 64 + i; h0 = __expf(bflo(lw[i])) * h0 + bflo(uw[i]); h1 = __expf(bfhi(lw[i])) * h1 + bfhi(uw[i]);
            *(unsigned*)(Y + row * 3072 + 2048 + 2 * tid) = pk2(h0, h1); }
    }
}

DI void mlstm_a(LAS unsigned char* smem, const bf16_t* P, const float* gbias, bf16_t* CS, float* SMALL) {
    const int tid = opaque_tid(), lane = tid & 63, wid = tid >> 6, l31 = lane & 31, h = lane >> 5, q4 = (lane & 15) >> 2, p4 = lane & 3, blk = (lane >> 4) & 1;
    LAS float* sw = (LAS float*)smem;
    LAS unsigned char* Ks = smem + 1024;
    LAS unsigned char* Vs = smem + 1024 + 20480;
    u32x4 kpre[2], vpre[4]; bf16_t gipre = 0, gfpre = 0;
#define MA_LOAD(u_) do { const int c_ = (u_) >> 2, hh_ = (u_) & 3; const size_t r0_ = (size_t)c_ * 64; \
        _Pragma("unroll") for (int i = 0; i < 2; ++i) { const int id = tid + 512 * i, s_ = id >> 4, d8 = (id & 15) * 8; kpre[i] = *(const u32x4*)(P + (r0_ + s_) * NP + PC_K + hh_ * 128 + d8); } \
        _Pragma("unroll") for (int i = 0; i < 4; ++i) { const int id = tid + 512 * i, s_ = id >> 5, d8 = (id & 31) * 8; vpre[i] = *(const u32x4*)(P + (r0_ + s_) * NP + PC_V + hh_ * 256 + d8); } \
        if (wid == 0) { const bf16_t* r_ = P + (r0_ + lane) * NP; gipre = r_[PC_I + hh_]; gfpre = r_[PC_F + hh_]; } } while (0)
    if ((int)blockIdx.x < 1024) MA_LOAD((int)blockIdx.x);
    for (int uid = blockIdx.x; uid < 1024; uid += gridDim.x) {
        const int hh = uid & 3;
        if (wid == 0) {
            const float li = bf2f(gipre) + gbias[hh], lf = logsigmoid_(bf2f(gfpre) + gbias[4 + hh]);
            const float bc = wave_incl_scan(lf, lane), bt = __shfl(bc, 63), ds = bt - bc + li, M = wave_max(ds);
            sw[lane] = expf(ds - M);
            if (lane == 0) { SMALL[SM_BT + uid] = bt; SMALL[SM_MC + uid] = M; }
        }
        __syncthreads();
#pragma unroll
        for (int i = 0; i < 2; ++i) { const int id = tid + 512 * i, s = id >> 4, d8 = (id & 15) * 8; const u32x4 v = kpre[i]; const float w = sw[s];
            u32x4 o; o.x = pk2(bflo(v.x) * w, bfhi(v.x) * w); o.y = pk2(bflo(v.y) * w, bfhi(v.y) * w); o.z = pk2(bflo(v.z) * w, bfhi(v.z) * w); o.w = pk2(bflo(v.w) * w, bfhi(v.w) * w);
            *(LAS u32x4*)(Ks + s * 320 + d8 * 2) = o; }
#pragma unroll
        for (int i = 0; i < 4; ++i) { const int id = tid + 512 * i, s = id >> 5, d8 = (id & 31) * 8; *(LAS u32x4*)(Vs + s * 576 + d8 * 2) = vpre[i]; }
        __syncthreads();
        if (uid + (int)gridDim.x < 1024) MA_LOAD(uid + (int)gridDim.x);
        f32x16 acc[4];
#pragma unroll
        for (int d = 0; d < 4; ++d)
#pragma unroll
            for (int i = 0; i < 16; ++i) acc[d][i] = 0.f;
#pragma unroll
        for (int kk = 0; kk < 4; ++kk) {
            const bf16x8 vf = tr_frag(Vs + (16 * kk + 8 * h + q4) * 576 + (32 * wid + 16 * blk) * 2 + 8 * p4, 576);
#pragma unroll
            for (int d = 0; d < 4; ++d) { const bf16x8 kf = tr_frag(Ks + (16 * kk + 8 * h + q4) * 320 + (32 * d + 16 * blk) * 2 + 8 * p4, 320); acc[d] = mfma32(kf, vf, acc[d]); }
        }
        bf16_t* cs = CS + (size_t)uid * 32768 + (32 * wid + l31) * 128;
#pragma unroll
        for (int d = 0; d < 4; ++d)
#pragma unroll
            for (int g = 0; g < 4; ++g) { u32x2 w; w.x = pk2(acc[d][4 * g], acc[d][4 * g + 1]); w.y = pk2(acc[d][4 * g + 2], acc[d][4 * g + 3]); *(u32x2*)(cs + 32 * d + 8 * g + 4 * h) = w; }
        if (tid < 128) { float s = 0.f;
#pragma unroll 8
            for (int t = 0; t < 64; ++t) s += bf2f(*(LAS const bf16_t*)(Ks + t * 320 + tid * 2));
            SMALL[SM_DN + uid * 128 + tid] = s; }
        __syncthreads();
    }
#undef MA_LOAD
}
DI void mlstm_b(LAS unsigned char* smem, bf16_t* CS, float* SMALL) {
    const int tid = opaque_tid();
    LAS float* dec = (LAS float*)smem; LAS float* inj = dec + 1024;
    LAS float* sbt = inj + 1024; LAS float* smc = sbt + 1024;
    sbt[tid] = SMALL[SM_BT + tid]; sbt[tid + 512] = SMALL[SM_BT + tid + 512]; smc[tid] = SMALL[SM_MC + tid]; smc[tid + 512] = SMALL[SM_MC + tid + 512];
    __syncthreads();
    if (tid < 4) { float m = -1e30f;
        for (int c = 0; c < 256; ++c) { const float bt = sbt[c * 4 + tid], M = smc[c * 4 + tid]; sbt[c * 4 + tid] = m;
            const float mn = fmaxf(bt + m, M); dec[tid * 256 + c] = __expf(bt + m - mn); inj[tid * 256 + c] = __expf(M - mn); m = mn; } }
    __syncthreads();
    if (blockIdx.x == 0) { SMALL[SM_MPREV + tid] = sbt[tid]; SMALL[SM_MPREV + tid + 512] = sbt[tid + 512]; }
    for (int e = blockIdx.x * 512 + tid; e < 131072; e += gridDim.x * 512) {
        const int hh = e >> 15, idx = e & 32767; bf16_t* pp = CS + (size_t)hh * 32768 + idx; float st = 0.f;
        bf16_t d[32];
#pragma unroll
        for (int i = 0; i < 32; ++i) d[i] = pp[(size_t)i * 131072];
#pragma unroll 1
        for (int c0 = 0; c0 < 256; c0 += 32) {
            bf16_t dn[32];
            const int cn = c0 + 32 < 256 ? c0 + 32 : c0;
#pragma unroll
            for (int i = 0; i < 32; ++i) dn[i] = pp[(size_t)(cn + i) * 131072];
            asm volatile("" ::: "memory");
#pragma unroll
            for (int i = 0; i < 32; ++i) { pp[(size_t)(c0 + i) * 131072] = f2bf(st); st = dec[hh * 256 + c0 + i] * st + inj[hh * 256 + c0 + i] * bf2f(d[i]); }
            asm volatile("" ::: "memory");
#pragma unroll
            for (int i = 0; i < 32; ++i) d[i] = dn[i];
        }
    }
    if (blockIdx.x == gridDim.x - 1) { const int hh = tid >> 7; float* pp = SMALL + SM_DN + tid; float st = 0.f;
#pragma unroll 1
        for (int c0 = 0; c0 < 256; c0 += 32) {
            float d[32];
#pragma unroll
            for (int i = 0; i < 32; ++i) d[i] = pp[(c0 + i) * 512];
            asm volatile("" ::: "memory");
#pragma unroll
            for (int i = 0; i < 32; ++i) { pp[(c0 + i) * 512] = st; st = dec[hh * 256 + c0 + i] * st + inj[hh * 256 + c0 + i] * d[i]; }
            asm volatile("" ::: "memory");
        } }
    __syncthreads();
}
DI void mlstm_c(LAS unsigned char* smem, const bf16_t* P, const float* gbias, const float* onorm, const bf16_t* CS, const float* SMALL, bf16_t* Y) {
    const int tid = opaque_tid(), lane = tid & 63, wid = tid >> 6, l31 = lane & 31, h = lane >> 5, q4 = (lane & 15) >> 2, p4 = lane & 3, blk = (lane >> 4) & 1;
    LAS float* sbc = (LAS float*)smem; LAS float* sav = sbc + 64; LAS float* snp = sbc + 128; LAS float* sx = sbc + 256;
    LAS unsigned char* Qs = smem + 2048;
    LAS unsigned char* Ks = Qs + 17408;
    LAS unsigned char* Vs = Ks + 17408;
    const int tb = wid & 1, dvq = wid >> 1, t = 32 * tb + l31, pr = pi32(l31);
    u32x4 qpre[2], kpre[2], vpre[4]; bf16_t gipre = 0, gfpre = 0; float nppre = 0.f, mppre = 0.f;
#define MC_LOAD(u_) do { const int c_ = (u_) >> 2, hh_ = (u_) & 3; const size_t r0_ = (size_t)c_ * 64; \
        _Pragma("unroll") for (int i = 0; i < 2; ++i) { const int id = tid + 512 * i, s_ = id >> 4, d8 = (id & 15) * 8; \
            qpre[i] = *(const u32x4*)(P + (r0_ + s_) * NP + PC_Q + hh_ * 128 + d8); kpre[i] = *(const u32x4*)(P + (r0_ + s_) * NP + PC_K + hh_ * 128 + d8); } \
        _Pragma("unroll") for (int i = 0; i < 4; ++i) { const int id = tid + 512 * i, s_ = id >> 5, d8 = (id & 31) * 8; vpre[i] = *(const u32x4*)(P + (r0_ + s_) * NP + PC_V + hh_ * 256 + d8); } \
        if (wid == 0) { const bf16_t* r_ = P + (r0_ + lane) * NP; gipre = r_[PC_I + hh_]; gfpre = r_[PC_F + hh_]; } \
        if (tid >= 64 && tid < 192) nppre = SMALL[SM_DN + (u_) * 128 + tid - 64]; \
        mppre = SMALL[SM_MPREV + (u_)]; } while (0)
    if ((int)blockIdx.x < 1024) MC_LOAD((int)blockIdx.x);
    for (int uid = blockIdx.x; uid < 1024; uid += gridDim.x) {
        const int c = uid >> 2, hh = uid & 3; const size_t row0 = (size_t)c * 64;
        if (wid == 0) {
            const float li = bf2f(gipre) + gbias[hh], lf = logsigmoid_(bf2f(gfpre) + gbias[4 + hh]);
            const float bc = wave_incl_scan(lf, lane);
            sbc[lane] = bc; sav[lane] = li - bc;
        }
        if (tid >= 64 && tid < 192) snp[tid - 64] = nppre;
#pragma unroll
        for (int i = 0; i < 2; ++i) { const int id = tid + 512 * i, s = id >> 4, d8 = (id & 15) * 8;
            *(LAS u32x4*)(Qs + s * 272 + d8 * 2) = qpre[i]; *(LAS u32x4*)(Ks + s * 272 + d8 * 2) = kpre[i]; }
#pragma unroll
        for (int i = 0; i < 4; ++i) { const int id = tid + 512 * i, s = id >> 5, d8 = (id & 31) * 8; *(LAS u32x4*)(Vs + s * 576 + d8 * 2) = vpre[i]; }
        const float mprev = mppre;
        __syncthreads();
        if (uid + (int)gridDim.x < 1024) MC_LOAD(uid + (int)gridDim.x);
        bf16x8 qf[8];
#pragma unroll
        for (int ks = 0; ks < 8; ++ks) qf[ks] = *(const LAS bf16x8*)(Qs + t * 272 + (16 * ks + 8 * h) * 2);
        f32x16 st0, st1;
#pragma unroll
        for (int i = 0; i < 16; ++i) { st0[i] = 0.f; st1[i] = 0.f; }
#pragma unroll
        for (int ks = 0; ks < 8; ++ks) { const bf16x8 a0 = *(const LAS bf16x8*)(Ks + pr * 272 + (16 * ks + 8 * h) * 2); st0 = mfma32(a0, qf[ks], st0);
            if (tb) { const bf16x8 a1 = *(const LAS bf16x8*)(Ks + (32 + pr) * 272 + (16 * ks + 8 * h) * 2); st1 = mfma32(a1, qf[ks], st1); } }
        const float bt = sbc[t];
        float mx = -1e30f;
#pragma unroll
        for (int i = 0; i < 16; ++i) { const int s = 16 * (i >> 3) + 8 * h + (i & 7); if (s <= t) mx = fmaxf(mx, sav[s]); if (tb) mx = fmaxf(mx, (s + 32 <= t) ? sav[s + 32] : -1e30f); }
        mx = fmaxf(mx, __shfl_xor(mx, 32));
        const float mt = bt + fmaxf(mprev, mx);
        float den = 0.f;
#pragma unroll
        for (int i = 0; i < 16; ++i) { const int s = 16 * (i >> 3) + 8 * h + (i & 7);
            const float w0 = (s <= t) ? __expf(bt + sav[s] - mt) * MQS : 0.f; st0[i] *= w0; den += st0[i];
            const float w1 = (tb && (s + 32 <= t)) ? __expf(bt + sav[s + 32] - mt) * MQS : 0.f; st1[i] *= w1; den += st1[i]; }
        den += __shfl_xor(den, 32);
        float qn = 0.f;
#pragma unroll
        for (int ks = 0; ks < 8; ++ks)
#pragma unroll
            for (int j = 0; j < 8; ++j) qn += bf2f((bf16_t)qf[ks][j]) * snp[16 * ks + 8 * h + j];
        qn += __shfl_xor(qn, 32);
        const float wi = expf(bt + mprev - mt) * MQS;
        den += wi * qn;
        const float dinv = 1.f / fmaxf(fabsf(den), expf(-mt));
        bf16x8 pf[4];
        pf[0] = pack8(st0[0], st0[1], st0[2], st0[3], st0[4], st0[5], st0[6], st0[7]); pf[1] = pack8(st0[8], st0[9], st0[10], st0[11], st0[12], st0[13], st0[14], st0[15]);
        pf[2] = pack8(st1[0], st1[1], st1[2], st1[3], st1[4], st1[5], st1[6], st1[7]); pf[3] = pack8(st1[8], st1[9], st1[10], st1[11], st1[12], st1[13], st1[14], st1[15]);
        float hv[2][16]; float ss = 0.f;
#pragma unroll
        for (int db = 0; db < 2; ++db) { const int dvb = 2 * dvq + db;
            f32x16 a1, a2;
#pragma unroll
            for (int i = 0; i < 16; ++i) { a1[i] = 0.f; a2[i] = 0.f; }
#pragma unroll
            for (int sb = 0; sb < 2; ++sb)
#pragma unroll
                for (int kk = 0; kk < 2; ++kk) { if (sb <= tb) { const bf16x8 vf = tr_frag(Vs + (32 * sb + 16 * kk + 8 * h + q4) * 576 + (32 * dvb + 16 * blk) * 2 + 8 * p4, 576); a1 = mfma32(vf, pf[2 * sb + kk], a1); } }
            const bf16_t* cp = CS + (size_t)uid * 32768 + (32 * dvb + l31) * 128 + 8 * h;
#pragma unroll
            for (int ks = 0; ks < 8; ++ks) { const bf16x8 cf = *(const bf16x8*)(cp + 16 * ks); a2 = mfma32(cf, qf[ks], a2); }
#pragma unroll
            for (int i = 0; i < 16; ++i) { const float v = (a1[i] + wi * a2[i]) * dinv; hv[db][i] = v; ss += v * v; }
        }
        ss += __shfl_xor(ss, 32);
        if (h == 0) sx[(tb * 4 + dvq) * 32 + l31] = ss;
        __syncthreads();
        const float tot = (sx[(tb * 4 + 0) * 32 + l31] + sx[(tb * 4 + 1) * 32 + l31]) + (sx[(tb * 4 + 2) * 32 + l31] + sx[(tb * 4 + 3) * 32 + l31]);
        const float rstd = 1.f / sqrtf(tot * (1.f / 256.f) + EPS);
        f32x4 gnv[2][4]; u32x2 ogv[2][4];
#pragma unroll
        for (int db = 0; db < 2; ++db)
#pragma unroll
            for (int g = 0; g < 4; ++g) { const int col = hh * 256 + 32 * (2 * dvq + db) + 8 * g + 4 * h; gnv[db][g] = *(const f32x4*)(onorm + col); ogv[db][g] = *(const u32x2*)(P + (row0 + t) * NP + PC_O + col); }
        __builtin_amdgcn_sched_barrier(0);
#pragma unroll
        for (int db = 0; db < 2; ++db)
#pragma unroll
            for (int g = 0; g < 4; ++g) { const int col = hh * 256 + 32 * (2 * dvq + db) + 8 * g + 4 * h;
                const f32x4 gn = gnv[db][g]; const u32x2 og = ogv[db][g];
                const float o0 = hv[db][4 * g] * rstd * gn.x * sigmoidf_(bflo(og.x)), o1 = hv[db][4 * g + 1] * rstd * gn.y * sigmoidf_(bfhi(og.x));
                const float o2 = hv[db][4 * g + 2] * rstd * gn.z * sigmoidf_(bflo(og.y)), o3 = hv[db][4 * g + 3] * rstd * gn.w * sigmoidf_(bfhi(og.y));
                u32x2 w; w.x = pk2(o0, o1); w.y = pk2(o2, o3); *(u32x2*)(Y + (row0 + t) * 3072 + col) = w; }
        __syncthreads();
    }
#undef MC_LOAD
}

DI void attn_unit(LAS unsigned char* smem, int hh, int qb, const bf16_t* Q, const bf16_t* KN, const bf16_t* P, const bf16_t* VT, bf16_t* Y) {
    const int tid = opaque_tid(), lane = tid & 63, wid = __builtin_amdgcn_readfirstlane(tid >> 6), l31 = lane & 31, h = lane >> 5;
    LAS unsigned char* Kb = smem; LAS unsigned char* Vb = smem + 51200;
    const int q0 = qb * 256, qw = q0 + 32 * wid, q = qw + l31, NT = 4 * qb + 4;
    bf16x8 qf[12];
#pragma unroll
    for (int ks = 0; ks < 12; ++ks) qf[ks] = *(const bf16x8*)(Q + (size_t)q * 1536 + hh * 192 + 16 * ks + 8 * h);
    f32x16 o[4];
#pragma unroll
    for (int d = 0; d < 4; ++d)
#pragma unroll
        for (int i = 0; i < 16; ++i) o[d][i] = 0.f;
    float mref = 0.f, lrun = 0.f; bool first = true;
    const bf16_t* ksrc0; const bf16_t* ksrc2; const bf16_t* vsrc0; int kdst0, kdst2, vdst0;
    { const int row = tid >> 4, ch = tid & 15; ksrc0 = KN + (size_t)row * 1024 + hh * 128 + 8 * ch; kdst0 = row * 400 + ch * 16; }
    { const int row = tid >> 3, ch = tid & 7; ksrc2 = P + (size_t)row * NP + PC_KR + 8 * ch; kdst2 = row * 400 + 256 + ch * 16; }
    { const int d = tid >> 3, ch = tid & 7; vsrc0 = VT + (size_t)(hh * 128 + d) * S + 8 * ch; vdst0 = d * 144 + ch * 16; }
    u32x4 kr[3], vr[2];
#define ATT_LOAD(tt) do { kr[0] = *(const u32x4*)(ksrc0 + (size_t)(tt) * 65536); kr[1] = *(const u32x4*)(ksrc0 + (size_t)(tt) * 65536 + 32 * 1024); kr[2] = *(const u32x4*)(ksrc2 + (size_t)(tt) * (64 * NP)); \
        vr[0] = *(const u32x4*)(vsrc0 + (size_t)(tt) * 64); vr[1] = *(const u32x4*)(vsrc0 + (size_t)(tt) * 64 + (size_t)64 * S); } while (0)
#define ATT_WRITE(kbuf, vslot) do { *(LAS u32x4*)(Kb + (kbuf) * 25600 + kdst0) = kr[0]; *(LAS u32x4*)(Kb + (kbuf) * 25600 + kdst0 + 32 * 400) = kr[1]; *(LAS u32x4*)(Kb + (kbuf) * 25600 + kdst2) = kr[2]; \
        *(LAS u32x4*)(Vb + (vslot) * 18432 + vdst0) = vr[0]; *(LAS u32x4*)(Vb + (vslot) * 18432 + vdst0 + 64 * 144) = vr[1]; } while (0)
#define ATT_BAR() do { asm volatile("s_waitcnt lgkmcnt(0)" ::: "memory"); __builtin_amdgcn_s_barrier(); asm volatile("" ::: "memory"); } while (0)
    ATT_LOAD(0);
    ATT_WRITE(0, 0);
    ATT_BAR();
    const int koff = pi32(l31) * 400 + 16 * h, voff = l31 * 144 + 16 * h;
#define SB() __builtin_amdgcn_sched_barrier(0)
#define KFR(kb, ks, b) (*(const LAS bf16x8*)((kb) + (b) * 32 * 400 + (ks) * 32))
#define VFR(vb, d, kk) (*(const LAS bf16x8*)((vb) + (d) * 32 * 144 + (kk) * 32))
    int vs = 0;
    for (int t = 0; t < NT; ++t) {
        const int kc = t & 1, vn = vs == 2 ? 0 : vs + 1;
        if (t + 1 < NT) ATT_LOAD(t + 1);
        if (64 * t <= qw + 31) {
            LAS const unsigned char* kb = Kb + kc * 25600 + koff; LAS const unsigned char* vb = Vb + vs * 18432 + voff;
            f32x16 s0, s1;
#pragma unroll
            for (int i = 0; i < 16; ++i) { s0[i] = 0.f; s1[i] = 0.f; }
            bf16x8 fa[4], fb[4];
            fa[0] = KFR(kb, 0, 0); fa[1] = KFR(kb, 0, 1); fa[2] = KFR(kb, 1, 0); fa[3] = KFR(kb, 1, 1); SB();
#pragma unroll
            for (int st = 0; st < 6; st += 2) {
                fb[0] = KFR(kb, 2 * st + 2, 0); fb[1] = KFR(kb, 2 * st + 2, 1); fb[2] = KFR(kb, 2 * st + 3, 0); fb[3] = KFR(kb, 2 * st + 3, 1); SB();
                s0 = mfma32(fa[0], qf[2 * st], s0); s1 = mfma32(fa[1], qf[2 * st], s1); s0 = mfma32(fa[2], qf[2 * st + 1], s0); s1 = mfma32(fa[3], qf[2 * st + 1], s1); SB();
                if (st + 2 < 6) { fa[0] = KFR(kb, 2 * st + 4, 0); fa[1] = KFR(kb, 2 * st + 4, 1); fa[2] = KFR(kb, 2 * st + 5, 0); fa[3] = KFR(kb, 2 * st + 5, 1); }
                else { fa[0] = VFR(vb, 0, 0); fa[1] = VFR(vb, 0, 1); fa[2] = VFR(vb, 0, 2); fa[3] = VFR(vb, 0, 3); }
                SB();
                s0 = mfma32(fb[0], qf[2 * st + 2], s0); s1 = mfma32(fb[1], qf[2 * st + 2], s1); s0 = mfma32(fb[2], qf[2 * st + 3], s0); s1 = mfma32(fb[3], qf[2 * st + 3], s1); SB();
            }
            if (64 * t + 63 > qw) {
#pragma unroll
                for (int i = 0; i < 16; ++i) { const int kv = 64 * t + 16 * (i >> 3) + 8 * h + (i & 7); if (kv > q) s0[i] = -1e30f; if (kv + 32 > q) s1[i] = -1e30f; }
            }
            float mx = fmaxf(s0[0], s1[0]);
#pragma unroll
            for (int i = 1; i < 16; ++i) mx = fmaxf(mx, fmaxf(s0[i], s1[i]));
            mx = fmaxf(mx, __shfl_xor(mx, 32));
            if (first || __any(mx - mref > 8.f)) {
                const float dl = first ? mx : fmaxf(mx - mref, 0.f);
                mref += dl;
                if (!first) { const float f = __builtin_amdgcn_exp2f(-dl); lrun *= f;
#pragma unroll
                    for (int d = 0; d < 4; ++d)
#pragma unroll
                        for (int i = 0; i < 16; ++i) o[d][i] *= f; }
                first = false; }
            float rs = 0.f;
#pragma unroll
            for (int i = 0; i < 16; ++i) { s0[i] = __builtin_amdgcn_exp2f(s0[i] - mref); s1[i] = __builtin_amdgcn_exp2f(s1[i] - mref); rs += s0[i] + s1[i]; }
            lrun += rs;
            bf16x8 pf[4];
            pf[0] = pack8(s0[0], s0[1], s0[2], s0[3], s0[4], s0[5], s0[6], s0[7]); pf[1] = pack8(s0[8], s0[9], s0[10], s0[11], s0[12], s0[13], s0[14], s0[15]);
            pf[2] = pack8(s1[0], s1[1], s1[2], s1[3], s1[4], s1[5], s1[6], s1[7]); pf[3] = pack8(s1[8], s1[9], s1[10], s1[11], s1[12], s1[13], s1[14], s1[15]);
            SB();
            fb[0] = VFR(vb, 1, 0); fb[1] = VFR(vb, 1, 1); fb[2] = VFR(vb, 1, 2); fb[3] = VFR(vb, 1, 3); SB();
            o[0] = mfma32(fa[0], pf[0], o[0]); o[0] = mfma32(fa[1], pf[1], o[0]); o[0] = mfma32(fa[2], pf[2], o[0]); o[0] = mfma32(fa[3], pf[3], o[0]); SB();
            fa[0] = VFR(vb, 2, 0); fa[1] = VFR(vb, 2, 1); fa[2] = VFR(vb, 2, 2); fa[3] = VFR(vb, 2, 3); SB();
            o[1] = mfma32(fb[0], pf[0], o[1]); o[1] = mfma32(fb[1], pf[1], o[1]); o[1] = mfma32(fb[2], pf[2], o[1]); o[1] = mfma32(fb[3], pf[3], o[1]); SB();
            fb[0] = VFR(vb, 3, 0); fb[1] = VFR(vb, 3, 1); fb[2] = VFR(vb, 3, 2); fb[3] = VFR(vb, 3, 3); SB();
            o[2] = mfma32(fa[0], pf[0], o[2]); o[2] = mfma32(fa[1], pf[1], o[2]); o[2] = mfma32(fa[2], pf[2], o[2]); o[2] = mfma32(fa[3], pf[3], o[2]); SB();
            o[3] = mfma32(fb[0], pf[0], o[3]); o[3] = mfma32(fb[1], pf[1], o[3]); o[3] = mfma32(fb[2], pf[2], o[3]); o[3] = mfma32(fb[3], pf[3], o[3]); SB();
        }
        if (t + 1 < NT) ATT_WRITE(kc ^ 1, vn);
        ATT_BAR();
        vs = vn;
    }
#undef SB
#undef KFR
#undef VFR
#undef ATT_LOAD
#undef ATT_WRITE
#undef ATT_BAR
    lrun += __shfl_xor(lrun, 32);
    const float inv = 1.f / lrun;
    bf16_t* yp = Y + (size_t)q * 3072 + 1024 + hh * 128 + 4 * h;
#pragma unroll
    for (int d = 0; d < 4; ++d)
#pragma unroll
        for (int g = 0; g < 4; ++g) { u32x2 w; w.x = pk2(o[d][4 * g] * inv, o[d][4 * g + 1] * inv); w.y = pk2(o[d][4 * g + 2] * inv, o[d][4 * g + 3] * inv); *(u32x2*)(yp + 32 * d + 8 * g) = w; }
}

#define XB_TMO      128
#define XB_XCNT(j)  (256  + 64 * (j))
#define XB_XSUB(j)  (1280 + 64 * (j))
#define XB_XGEN(j)  (2304 + 64 * (j))
#define XB_TOP      3328
#define XB_TOPGEN   3392
#define XCD_BAR_WORDS 3456
#define XB_SPIN_CAP (1u << 23)
DI unsigned xb_ld(unsigned* p)              { return __hip_atomic_load(p, __ATOMIC_RELAXED, __HIP_MEMORY_SCOPE_AGENT); }
DI unsigned xb_add(unsigned* p, unsigned v) { return __hip_atomic_fetch_add(p, v, __ATOMIC_RELAXED, __HIP_MEMORY_SCOPE_AGENT); }
DI unsigned xb_xcc_id() { return (unsigned)__builtin_amdgcn_s_getreg((3 << 11) | 20) & 0xFu; }
#define XB_SPIN(cond, bar) do { unsigned _sp = 0; while (cond) { __builtin_amdgcn_s_sleep(1); \
    if ((++_sp & 255u) == 0u) { if (xb_ld(&(bar)[XB_TMO])) break; if (_sp > XB_SPIN_CAP) { atomicAdd(&(bar)[XB_TMO], 1u); break; } } } } while (0)
struct XcdBarrier { unsigned* bar; unsigned x; volatile LAS unsigned* st; };
DI XcdBarrier xcd_barrier_post(unsigned* bar, volatile LAS unsigned* st) {
    XcdBarrier b; b.bar = bar; b.x = xb_xcc_id(); b.st = st;
    if (threadIdx.x == 0) (void)xb_add(&bar[XB_XCNT(b.x)], 1u);
    return b;
}
DI void xcd_barrier_complete(unsigned* bar, unsigned x, unsigned& nloc, unsigned& nx) {
    const unsigned G = gridDim.x * gridDim.y * gridDim.z;
    unsigned sum, cnt, mine, sp = 0u;
    for (;;) {
        sum = 0u; cnt = 0u; mine = 0u;
#pragma unroll
        for (unsigned j = 0; j < 16; ++j) { const unsigned c = xb_ld(&bar[XB_XCNT(j)]); sum += c; cnt += (c > 0u) ? 1u : 0u; mine = (j == x) ? c : mine; }
        if (sum == G) break;
        __builtin_amdgcn_s_sleep(1);
        if ((++sp & 255u) == 0u) { if (xb_ld(&bar[XB_TMO])) break; if (sp > XB_SPIN_CAP) { atomicAdd(&bar[XB_TMO], 1u); break; } }
    }
    nloc = mine > 0u ? mine : 1u; nx = cnt > 0u ? cnt : 1u;
}
DI void xcd_barrier(const XcdBarrier& b) {
    asm volatile("s_waitcnt vmcnt(0)" ::: "memory");
    __syncthreads();
    if (threadIdx.x == 0) {
        unsigned* bar = b.bar;
        __builtin_amdgcn_s_waitcnt(0);
        unsigned nloc = b.st[0], nx = b.st[1];
        if (nloc == 0u) { xcd_barrier_complete(bar, b.x, nloc, nx); b.st[0] = nloc; b.st[1] = nx; }
        const unsigned old = xb_add(&bar[XB_XSUB(b.x)], 1u);
        const unsigned gen = old / nloc;
        if (old + 1u == (gen + 1u) * nloc) {
            __builtin_amdgcn_fence(__ATOMIC_RELEASE, "agent");
            asm volatile("s_waitcnt vmcnt(0)" ::: "memory");
            const unsigned og = xb_add(&bar[XB_TOP], 1u);
            const unsigned tg = og / nx;
            if (og + 1u == (tg + 1u) * nx) xb_add(&bar[XB_TOPGEN], 1u);
            else XB_SPIN(xb_ld(&bar[XB_TOPGEN]) == tg, bar);
            __builtin_amdgcn_fence(__ATOMIC_ACQUIRE, "agent");
            xb_add(&bar[XB_XGEN(b.x)], 1u);
            asm volatile("s_waitcnt vmcnt(0)" ::: "memory");
        } else {
            XB_SPIN(xb_ld(&bar[XB_XGEN(b.x)]) == gen, bar);
            __builtin_amdgcn_fence(__ATOMIC_ACQUIRE, "agent");
            asm volatile("s_waitcnt vmcnt(0)" ::: "memory");
        }
    }
    __syncthreads();
}

struct Params { const float* in[27]; float* out; unsigned char* ws; };

__global__ void __launch_bounds__(512, 2) mega_fwd(Params p) {
    extern __shared__ __attribute__((aligned(16))) unsigned char smem_raw[];
    LAS unsigned char* smem = (LAS unsigned char*)smem_raw;
    cg::grid_group grid = cg::this_grid();
    const int G = gridDim.x, bx = blockIdx.x;
    { const int t0 = opaque_tid(); if (t0 < 128) ((LAS unsigned*)(smem + 131072))[t0] = 0u; }
    __syncthreads();
    XcdBarrier bar; bar.bar = (unsigned*)(p.ws + WS_CTL); bar.x = 0; bar.st = (volatile LAS unsigned*)(smem + 131072) + 8;
    if (bx == 0) { unsigned* cw = (unsigned*)(p.ws + WS_CTL); for (int i = opaque_tid(); i < XCD_BAR_WORDS; i += 512) cw[i] = 0u; }
    unsigned char* ws = p.ws;
    f32x2* TAB = (f32x2*)(ws + WS_TAB); float* SMALL = (float*)(ws + WS_SMALL);
    bf16_t* WFFGU = (bf16_t*)(ws + WS_WFFGU); bf16_t* WFFD = (bf16_t*)(ws + WS_WFFD); bf16_t* WIN = (bf16_t*)(ws + WS_WIN); bf16_t* WUQ = (bf16_t*)(ws + WS_WUQ);
    bf16_t* WUKV = (bf16_t*)(ws + WS_WUKV); bf16_t* WLRU = (bf16_t*)(ws + WS_WLRU); bf16_t* WBR = (bf16_t*)(ws + WS_WBR); bf16_t* WOUT = (bf16_t*)(ws + WS_WOUT);
    bf16_t* XN = (bf16_t*)(ws + WS_XN); bf16_t* P = (bf16_t*)(ws + WS_P); bf16_t* Hb = P; bf16_t* Qb = (bf16_t*)(ws + WS_Q); bf16_t* KN = (bf16_t*)(ws + WS_KN);
    bf16_t* VT = (bf16_t*)(ws + WS_VT); bf16_t* Y = (bf16_t*)(ws + WS_Y); bf16_t* XC = (bf16_t*)(ws + WS_XC); bf16_t* CS = (bf16_t*)(ws + WS_CS);

    for (int i = bx * 512 + opaque_tid(); i < S * 32; i += G * 512) { const int t = i >> 5, j = i & 31; const float ang = (float)t * INVF[j];
        double r = (double)ang * 0.15915494309189535; r -= __builtin_floor(r); const float fr = (float)r;
        TAB[i] = (f32x2){__builtin_amdgcn_cosf(fr), __builtin_amdgcn_sinf(fr)}; }

#pragma unroll 1
    for (int hl = 0; hl < 4; ++hl) {
        const int l = hl >> 1, second = hl & 1;
        const float* xin = hl == 0 ? p.in[0] : p.out;
#define CONVERT_RANGE(cl, csec, lo, hi) do { int rot = 0; _Pragma("unroll 1") for (int mi = (lo); mi < (hi); ++mi) { \
            const float* src; int K, N, map; bf16_t* dst; \
            if (mi == 0) { src = p.in[(csec) ? 23 : 2] + (size_t)(cl) * DM * FF; K = DM; N = FF; map = 1; dst = WFFGU; } \
            else if (mi == 1) { src = p.in[(csec) ? 24 : 3] + (size_t)(cl) * DM * FF; K = DM; N = FF; map = 2; dst = WFFGU; } \
            else if (mi == 2) { src = p.in[(csec) ? 25 : 4] + (size_t)(cl) * DM * FF; K = FF; N = DM; map = 0; dst = WFFD; } \
            else if (mi == 3) { src = p.in[6] + (size_t)(cl) * DM * NIN; K = DM; N = NIN; map = 3; dst = WIN; } \
            else if (mi == 4) { src = p.in[10] + (size_t)(cl) * 384 * 1536; K = 384; N = 1536; map = 4; dst = WUQ; } \
            else if (mi == 5) { src = p.in[12] + (size_t)(cl) * 256 * 2048; K = 256; N = 2048; map = 5; dst = WUKV; } \
            else if (mi < 22) { const int k = mi - 6, n = k >> 1, wx = k & 1; src = p.in[wx ? 17 : 15] + (size_t)(cl) * 131072 + n * 16384; K = 128; N = 128; map = 0; dst = WLRU + (size_t)(n * 256 + wx * 128) * 128; } \
            else if (mi < 25) { const int j = mi - 22; src = p.in[20] + (size_t)(cl) * 3 * 1024 * 2048 + (size_t)j * 1024 * 2048; K = 1024; N = 2048; map = 0; dst = WBR + (size_t)j * 2048 * 1024; } \
            else { src = p.in[21] + (size_t)(cl) * DM * DM; K = DM; N = DM; map = 0; dst = WOUT; } \
            convert_mat(src, K, N, dst, map, rot); } } while (0)
        const int grp = (bx >> 3) & 1;
        {
            if (hl == 0) CONVERT_RANGE(0, 0, 0, 26);
            rmsnorm_rows(xin, p.in[second ? 22 : 1] + l * DM, XN);
        }
        if (hl == 0) { grid.sync(); bar = xcd_barrier_post((unsigned*)(p.ws + WS_CTL), (volatile LAS unsigned*)(smem + 131072) + 8); } else xcd_barrier(bar);
        { pg8::Gemm g{XN, WFFGU, S, 2 * FF, DM, DM, DM, 0}; pg8::StaticOrder so; so.init(S, 2 * FF, G, bx); pg8::EpiSwiglu E{Hb};
          const int c_lo = hl == 1 ? 3 : 2, c_hi = hl == 1 ? 26 : (hl == 2 ? 3 : 2);
          if (grp == 0) CONVERT_RANGE(1, 0, c_lo, c_hi);
          pg8::gemm_phase(smem, g, so, E);
          if (grp == 1) CONVERT_RANGE(1, 0, c_lo, c_hi); }
        xcd_barrier(bar);
        { pg8::Gemm g{Hb, WFFD, S, DM, FF, FF, FF, 0}; pg8::StaticOrder so; so.init(S, DM, G, bx); pg8::EpiRes E{xin, p.out, 0.5f};
          const int nl = (hl + 1) >> 1, ns = (hl + 1) & 1, c_hi = hl < 3 ? 2 : 0;
          if (grp == 0) CONVERT_RANGE(nl, ns, 0, c_hi);
          pg8::gemm_phase(smem, g, so, E);
          if (grp == 1) CONVERT_RANGE(nl, ns, 0, c_hi); }
        xcd_barrier(bar);
        if (!second) {
            const float* gbias = p.in[7] + l * 8;
            rmsnorm_rows(p.out, p.in[5] + l * DM, XN);
            xcd_barrier(bar);
            { pg8::Gemm g{XN, WIN, S, NP, DM, DM, DM, 0}; pg8::StaticOrder so; so.init(S, NP, G, bx); pg8::EpiStore E{P, NP};
              if (grp == 0) CONVERT_RANGE(l, 1, 2, 3);
              pg8::gemm_phase(smem, g, so, E);
              if (grp == 1) CONVERT_RANGE(l, 1, 2, 3); }
            xcd_barrier(bar);
            if (bx == G - 1) { const float* lam = p.in[19] + l * 1024; for (int ch = opaque_tid(); ch < 1024; ch += 512) SMALL[SM_SP + ch] = -8.f * log1pf(expf(-lam[ch])); }
            mlstm_a(smem, P, gbias, CS, SMALL);
            prep_rows(P, p.in[9] + l * 384, p.in[11] + l * 256, p.in[13] + l * 4096, p.in[14] + l * 1024, TAB, XC);
            xcd_barrier(bar);
            mlstm_b(smem, CS, SMALL);
            { pg8::Gemm g{P + PC_CQ, WUQ, S, 1536, 384, NP, 384, 0}; pg8::StaticOrder so; so.init(S, 1536, G, bx); pg8::EpiQ E{Qb, TAB}; pg8::gemm_phase(smem, g, so, E); }
#pragma unroll 1
            for (int gi = 0; gi < 2; ++gi) {
                pg8::Gemm g; pg8::StaticOrder so; pg8::EpiStore E;
                if (gi == 0) { g = pg8::Gemm{P + PC_CKV, WUKV, S, 1024, 256, NP, 256, 0}; so.init(S, 1024, G, bx); E = pg8::EpiStore{KN, 1024}; }
                else { g = pg8::Gemm{WUKV + 1024 * 256, P + PC_CKV, 1024, S, 256, 256, NP, 0}; so.init(1024, S, G, bx); E = pg8::EpiStore{VT, S}; }
                pg8::gemm_phase(smem, g, so, E);
            }
            { pg8::Gemm g{XC, WLRU, S, 2048, 128, 1024, 128, 128}; pg8::StaticOrder so; so.init(S, 2048, G, bx); pg8::EpiLru E{XC, P + PC_CX, p.in[16] + l * 1024, p.in[18] + l * 1024, SMALL + SM_SP}; pg8::gemm_phase(smem, g, so, E); }
            xcd_barrier(bar);
            mlstm_c(smem, P, gbias, p.in[8] + l * 1024, CS, SMALL, Y);
            lru_p1(P + PC_CX, XC, SMALL + SM_CA, SMALL + SM_CH);
            xcd_barrier(bar);
            lru_p2(SMALL + SM_CA, SMALL + SM_CH, SMALL + SM_CARRY);
            for (int item = bx; item < 256; item += G) { const int hh = item & 7, pp = item >> 3;
#pragma unroll 1
                for (int half = 0; half < 2; ++half) attn_unit(smem, hh, half ? 63 - pp : pp, Qb, KN, P, VT, Y); }
            xcd_barrier(bar);
            lru_p3(P + PC_CX, XC, SMALL + SM_CARRY, Y);
#pragma unroll 1
            for (int j = 0; j < 3; ++j) {
                if (j == 2) xcd_barrier(bar);
                pg8::Gemm g{Y + j * 1024, WBR + (size_t)j * 2048 * 1024, S, DM, 1024, 3072, 1024, 0}; pg8::StaticOrder so; so.init(S, DM, G, bx); pg8::EpiMerge E{XN, P + PC_G + j * 2048, j == 0}; pg8::gemm_phase(smem, g, so, E);
            }
            xcd_barrier(bar);
            { pg8::Gemm g{XN, WOUT, S, DM, DM, DM, DM, 0}; pg8::StaticOrder so; so.init(S, DM, G, bx); pg8::EpiRes E{p.out, p.out, 1.0f}; pg8::gemm_phase(smem, g, so, E); }
            xcd_barrier(bar);
        }
    }
    final_norm_rows(p.out, p.in[26]);
}

constexpr int LDS_BYTES = 143360;

extern "C" void kernel_launch(void* const* d_in, const int* in_sizes, int n_in, void* d_out, int out_size, void* d_ws, size_t ws_size, hipStream_t stream) {
    static int grid = 0;
    if (grid == 0) {
        if (n_in != 27 || out_size != S * DM || ws_size < WS_END) { fprintf(stderr, "kernel_launch: unexpected problem (n_in %d out %d ws %zu, need %zu)\n", n_in, out_size, ws_size, (size_t)WS_END); grid = -1; return; }
        int dev = 0, cus = 0, per_cu = 0;
        hipGetDevice(&dev); hipDeviceGetAttribute(&cus, hipDeviceAttributeMultiprocessorCount, dev);
        if (hipFuncSetAttribute((const void*)mega_fwd, hipFuncAttributeMaxDynamicSharedMemorySize, LDS_BYTES) != hipSuccess) { fprintf(stderr, "kernel_launch: hipFuncSetAttribute failed\n"); grid = -1; return; }
        if (hipOccupancyMaxActiveBlocksPerMultiprocessor(&per_cu, (const void*)mega_fwd, 512, LDS_BYTES) != hipSuccess || per_cu < 1) { fprintf(stderr, "kernel_launch: occupancy query says %d\n", per_cu); per_cu = 1; }
        (void)hipGetLastError();
        grid = cus * (per_cu > 1 ? 1 : per_cu);
    }
    if (grid < 0) return;
    Params p{};
    for (int i = 0; i < 27; ++i) p.in[i] = (const float*)d_in[i];
    p.out = (float*)d_out; p.ws = (unsigned char*)d_ws;
    void* args[] = {&p};
    hipError_t e = hipLaunchCooperativeKernel((const void*)mega_fwd, dim3(grid), dim3(512), args, LDS_BYTES, stream);
    if (e != hipSuccess) fprintf(stderr, "cooperative launch failed: %s (grid %d)\n", hipGetErrorString(e), grid);
}
```
